# Optimizing an MI355X kernel written in HIP

```python
import math
import jax, jax.numpy as jnp
from jax import lax
import numpy as np

D_MODEL = 1024
BATCH = 16
SEQ = 2048
DEPTH = 4

MIX_WIDTH = D_MODEL
GM_HEADS = 4
GM_HEAD_DIM = D_MODEL // 16
GM_WIDTH = GM_HEADS * GM_HEAD_DIM
GM_CHUNK = 128
MLA_HEADS = 8
MLA_NOPE = D_MODEL // 16
MLA_ROPE = D_MODEL // 32
MLA_V = D_MODEL // 16
MLA_WIDTH = MLA_HEADS * MLA_V
MLA_Q_RANK = D_MODEL // 4
MLA_KV_RANK = D_MODEL // 8
ROPE_THETA = 10000.0
ATTN_BLOCK = 128
MASK_VALUE = -1e30
HG_HEADS = 4
HG_KEY = D_MODEL // 16
HG_VAL = D_MODEL // 16
HG_KEY_WIDTH = HG_HEADS * HG_KEY
HG_WIDTH = HG_HEADS * HG_VAL
HG_CHUNK = 64
GATE_FLOOR = 1e-20
IN_WIDTHS = (GM_WIDTH, GM_WIDTH, MLA_Q_RANK, MLA_KV_RANK, MLA_ROPE,
             HG_KEY_WIDTH, HG_KEY_WIDTH, HG_WIDTH, HG_WIDTH)
IN_WIDTH = 2 * GM_WIDTH + MLA_Q_RANK + MLA_KV_RANK + MLA_ROPE + 2 * HG_KEY_WIDTH + 2 * HG_WIDTH
PEER_HEADS = 8
PEER_N_KEYS = 128
PEER_N_EXPERTS = PEER_N_KEYS * PEER_N_KEYS
PEER_TOPK = 16
PEER_QDIM = D_MODEL // 8
PEER_BLOCK = 128
NORM_EPS = 1e-6

kernel_name = "hymba_gmlp_mla_hgrn2_peer_trunk"

F32 = jnp.float32


def rmsnorm(x, g):
    xf = x.astype(F32)
    y = xf * lax.rsqrt(jnp.mean(xf * xf, axis=-1, keepdims=True) + NORM_EPS)
    return (y * g.astype(F32)).astype(x.dtype)


def head_rmsnorm(x, g, n_heads):
    shp = x.shape
    d = shp[-1] // n_heads
    y = rmsnorm(x.reshape(shp[:-1] + (n_heads, d)), g.reshape(n_heads, d))
    return y.reshape(shp)


def apply_rope(x, positions):
    half = MLA_ROPE // 2
    inv_freq = jnp.exp(-math.log(ROPE_THETA) * jnp.arange(half, dtype=F32) / half)
    ang = positions.astype(F32)[..., None] * inv_freq
    ang = ang.reshape(ang.shape[:2] + (1,) * (x.ndim - 3) + (half,))
    cos, sin = jnp.cos(ang), jnp.sin(ang)
    xf = x.astype(F32)
    x1, x2 = xf[..., :half], xf[..., half:]
    return jnp.concatenate([x1 * cos - x2 * sin, x2 * cos + x1 * sin], axis=-1).astype(x.dtype)


def chunked_gmlp(u, v, v_gain, w_s, b_s):
    B, S, _ = u.shape
    u = jax.nn.gelu(u)
    v = head_rmsnorm(jax.nn.gelu(v), v_gain, GM_HEADS)
    v = v.reshape(B, S // GM_CHUNK, GM_CHUNK, GM_HEADS, GM_HEAD_DIM)
    causal = jnp.tril(jnp.ones((GM_CHUNK, GM_CHUNK), dtype=bool))
    w = jnp.where(causal, w_s, 0).astype(v.dtype)
    z = jnp.einsum('hts,bcshd->bcthd', w, v) + b_s.T.astype(v.dtype)[None, None, :, :, None]
    return u * z.reshape(B, S, GM_WIDTH)


def mla(c_q, c_kv, k_rope, positions, q_norm, w_uq, kv_norm, w_ukv):
    B, S, _ = c_q.shape
    q = (rmsnorm(c_q, q_norm) @ w_uq).reshape(B, S, MLA_HEADS, MLA_NOPE + MLA_ROPE)
    q_nope = q[..., :MLA_NOPE]
    q_rope = apply_rope(q[..., MLA_NOPE:], positions)
    kv = (rmsnorm(c_kv, kv_norm) @ w_ukv).reshape(B, S, MLA_HEADS, MLA_NOPE + MLA_V)
    k_nope, v = kv[..., :MLA_NOPE], kv[..., MLA_NOPE:]
    k_rope = apply_rope(k_rope, positions)
    scale = (MLA_NOPE + MLA_ROPE) ** -0.5
    nb = S // ATTN_BLOCK
    qn_b = q_nope.reshape(B, nb, ATTN_BLOCK, MLA_HEADS, MLA_NOPE).transpose(1, 0, 2, 3, 4)
    qr_b = q_rope.reshape(B, nb, ATTN_BLOCK, MLA_HEADS, MLA_ROPE).transpose(1, 0, 2, 3, 4)
    k_pos = jnp.arange(S)

    def block(args):
        qn, qr, i = args
        s = jnp.einsum('bqhd,bkhd->bhqk', qn, k_nope) + jnp.einsum('bqhr,bkr->bhqk', qr, k_rope)
        s = s.astype(F32) * scale
        q_pos = i * ATTN_BLOCK + jnp.arange(ATTN_BLOCK)
        s = jnp.where(k_pos[None, :] <= q_pos[:, None], s, MASK_VALUE)
        p = jax.nn.softmax(s, axis=-1).astype(v.dtype)
        return jnp.einsum('bhqk,bkhd->bqhd', p, v)

    o = lax.map(block, (qn_b, qr_b, jnp.arange(nb)))
    return o.transpose(1, 0, 2, 3, 4).reshape(B, S, MLA_WIDTH)


def hgrn_lower_bounds(logits):
    p = jax.nn.softmax(logits.astype(F32), axis=0)
    return jnp.cumsum(p, axis=0) - p[0]


def hgrn2(q, f, i, g, lb, out_norm):
    B, S, _ = q.shape
    dt = i.dtype
    C, nc = HG_CHUNK, S // HG_CHUNK
    qf = jax.nn.silu(q.astype(F32)).reshape(B, S, HG_HEADS, HG_KEY)
    fx = f.astype(F32).reshape(B, S, HG_HEADS, HG_KEY)
    lbh = lb.reshape(HG_HEADS, HG_KEY)
    f_gate = lbh + (1.0 - lbh) * jax.nn.sigmoid(fx)
    log_f = jnp.log(jnp.maximum(f_gate, GATE_FLOOR))
    kf = (1.0 - lbh) * jax.nn.sigmoid(-fx)
    vf = i.astype(F32).reshape(B, S, HG_HEADS, HG_VAL)

    def to_chunks(t):
        return t.reshape(B, nc, C, HG_HEADS, t.shape[-1]).transpose(1, 0, 3, 2, 4)

    causal = jnp.tril(jnp.ones((C, C), dtype=bool))[:, :, None]

    def step(state, inp):
        qc, kc, vc, lfc = inp
        b = jnp.cumsum(lfc, axis=2)
        o_inter = jnp.einsum('bhtk,bhkv->bhtv', qc * jnp.exp(b), state)
        diff = b[:, :, :, None, :] - b[:, :, None, :, :]
        decay = jnp.where(causal, jnp.exp(jnp.where(causal, diff, 0.0)), 0.0)
        a = jnp.einsum('bhtk,bhsk,bhtsk->bhts', qc, kc, decay)
        o_intra = jnp.einsum('bhts,bhsv->bhtv', a, vc)
        b_last = b[:, :, -1:, :]
        new_state = jnp.exp(b_last[:, :, 0, :])[..., None] * state + \
            jnp.einsum('bhsk,bhsv->bhkv', kc * jnp.exp(b_last - b), vc)
        return new_state, o_inter + o_intra

    s0 = jnp.zeros((B, HG_HEADS, HG_KEY, HG_VAL), F32)
    _, o = lax.scan(step, s0, (to_chunks(qf), to_chunks(kf), to_chunks(vf), to_chunks(log_f)))
    o = o.transpose(1, 0, 3, 2, 4).reshape(B, S, HG_WIDTH)
    o = head_rmsnorm(o, out_norm, HG_HEADS) * jax.nn.silu(g.astype(F32))
    return o.astype(dt)


def peer(xn, w_q, sub_keys, u_tab, v_tab):
    B, S, D = xn.shape
    xb = xn.reshape((B * S) // PEER_BLOCK, PEER_BLOCK, D)
    K = PEER_TOPK

    def block(xt):
        q = (xt @ w_q).reshape(PEER_BLOCK, PEER_HEADS, 2, PEER_QDIM // 2)
        s = jnp.einsum('thpd,hpkd->thpk', q, sub_keys).astype(F32)
        s_top, i_top = lax.top_k(s, K)
        cand_s = (s_top[:, :, 0, :, None] + s_top[:, :, 1, None, :]).reshape(PEER_BLOCK, PEER_HEADS, K * K)
        cand_i = (i_top[:, :, 0, :, None] * PEER_N_KEYS + i_top[:, :, 1, None, :]).reshape(PEER_BLOCK, PEER_HEADS, K * K)
        best_s, pos = lax.top_k(cand_s, K)
        ids = jnp.take_along_axis(cand_i, pos, axis=-1)
        gate = jax.nn.softmax(best_s, axis=-1).astype(xt.dtype)
        u = jnp.take(u_tab, ids, axis=0)
        act = jax.nn.gelu(jnp.einsum('td,thkd->thk', xt, u))
        vv = jnp.take(v_tab, ids, axis=0)
        return jnp.einsum('thk,thkd->td', gate * act, vv)

    return lax.map(block, xb).reshape(B, S, D)


def setup_inputs(seed: int = 0) -> dict:
    key = jax.random.key(seed)
    ks = jax.random.split(key, 24)
    nrm = lambda k, shape, s: jax.random.normal(k, shape, F32) * s
    gain = lambda k, shape: 1.0 + 0.02 * jax.random.normal(k, shape, F32)
    x = jax.random.normal(ks[0], (BATCH, SEQ, D_MODEL), F32)
    offset = jax.random.randint(ks[1], (BATCH, 1), 0, SEQ, dtype=jnp.int32)
    positions = (jnp.arange(SEQ, dtype=jnp.int32)[None, :] + offset).astype(jnp.int32)
    return {
        "x": x,
        "positions": positions,
        "norm_mix": gain(ks[2], (DEPTH, D_MODEL)),
        "w_in": nrm(ks[3], (DEPTH, D_MODEL, IN_WIDTH), D_MODEL ** -0.5),
        "gm_v_norm": gain(ks[4], (DEPTH, GM_WIDTH)),
        "gm_ws": nrm(ks[5], (DEPTH, GM_HEADS, GM_CHUNK, GM_CHUNK), 0.5 * GM_CHUNK ** -0.5),
        "gm_b": 1.0 + 0.1 * jax.random.normal(ks[6], (DEPTH, GM_HEADS, GM_CHUNK), F32),
        "gm_out_norm": gain(ks[7], (DEPTH, GM_WIDTH)),
        "mla_q_norm": gain(ks[8], (DEPTH, MLA_Q_RANK)),
        "mla_w_uq": nrm(ks[9], (DEPTH, MLA_Q_RANK, MLA_HEADS * (MLA_NOPE + MLA_ROPE)), MLA_Q_RANK ** -0.5),
        "mla_kv_norm": gain(ks[10], (DEPTH, MLA_KV_RANK)),
        "mla_w_ukv": nrm(ks[11], (DEPTH, MLA_KV_RANK, MLA_HEADS * (MLA_NOPE + MLA_V)), MLA_KV_RANK ** -0.5),
        "mla_out_norm": gain(ks[12], (DEPTH, MLA_WIDTH)),
        "hg_lb_logits": nrm(ks[13], (DEPTH, HG_KEY_WIDTH), 0.5),
        "hg_out_norm": gain(ks[14], (DEPTH, HG_WIDTH)),
        "w_out": nrm(ks[15], (DEPTH, MIX_WIDTH, D_MODEL), MIX_WIDTH ** -0.5),
        "norm_ffn": gain(ks[16], (DEPTH, D_MODEL)),
        "peer_w_q": nrm(ks[17], (DEPTH, D_MODEL, PEER_HEADS * PEER_QDIM), D_MODEL ** -0.5),
        "peer_sub_keys": nrm(ks[18], (DEPTH, PEER_HEADS, 2, PEER_N_KEYS, PEER_QDIM // 2), (PEER_QDIM // 2) ** -0.5),
        "peer_u": nrm(ks[19], (DEPTH, PEER_N_EXPERTS, D_MODEL), D_MODEL ** -0.5),
        "peer_v": nrm(ks[20], (DEPTH, PEER_N_EXPERTS, D_MODEL), PEER_HEADS ** -0.5),
        "norm_final": gain(ks[21], (D_MODEL,)),
    }


def reference(x, positions, norm_mix, w_in, gm_v_norm, gm_ws, gm_b, gm_out_norm,
              mla_q_norm, mla_w_uq, mla_kv_norm, mla_w_ukv, mla_out_norm,
              hg_lb_logits, hg_out_norm, w_out, norm_ffn, peer_w_q, peer_sub_keys,
              peer_u, peer_v, norm_final):
    split_points = [int(s) for s in np.cumsum(IN_WIDTHS)[:-1]]
    lower_bounds = hgrn_lower_bounds(hg_lb_logits)
    for l in range(DEPTH):
        n = rmsnorm(x, norm_mix[l])
        proj = n @ w_in[l]
        u, v, c_q, c_kv, k_rope, hq, hf, hi, hg = jnp.split(proj, split_points, axis=-1)
        y_a = head_rmsnorm(chunked_gmlp(u, v, gm_v_norm[l], gm_ws[l], gm_b[l]), gm_out_norm[l], GM_HEADS)
        y_b = head_rmsnorm(mla(c_q, c_kv, k_rope, positions, mla_q_norm[l], mla_w_uq[l],
                               mla_kv_norm[l], mla_w_ukv[l]), mla_out_norm[l], MLA_HEADS)
        y_c = hgrn2(hq, hf, hi, hg, lower_bounds[l], hg_out_norm[l])
        x = x + jnp.concatenate([y_a, y_b, y_c], axis=-1) @ w_out[l]
        x = x + peer(rmsnorm(x, norm_ffn[l]), peer_w_q[l], peer_sub_keys[l], peer_u[l], peer_v[l])
    return rmsnorm(x, norm_final)
```

```cpp
#include <hip/hip_runtime.h>
#include <cstdio>
#include <cstdint>
#include <cmath>

constexpr int T = 32768, DM = 1024, NL = 4, SEQ = 2048;
constexpr int PW = 2048;
constexpr int PC_U = 0, PC_V = 256, PC_CQ = 512, PC_CKV = 768, PC_KR = 896, PC_HQ = 1024, PC_HF = 1280, PC_HI = 1536, PC_HG = 1792;
constexpr int NEXP = 16384;
constexpr float EPS = 1e-6f;

typedef unsigned short bfu;
typedef __attribute__((ext_vector_type(8))) short bf16x8;
typedef __attribute__((ext_vector_type(4))) short s16x4;
typedef __attribute__((ext_vector_type(4))) float f32x4;
typedef __attribute__((ext_vector_type(16))) float f32x16;
typedef __attribute__((ext_vector_type(2))) __bf16 bf2_t;
typedef __attribute__((ext_vector_type(2))) float f2_t;
typedef __attribute__((ext_vector_type(4))) unsigned u32x4;
typedef __attribute__((ext_vector_type(2))) unsigned u32x2;
typedef short v4i16_t __attribute__((ext_vector_type(4)));
#define DI __device__ __forceinline__
#define LAS __attribute__((address_space(3)))

DI float bf2f(bfu v) { return __uint_as_float((unsigned)v << 16); }
DI float bflo(unsigned u) { return __uint_as_float(u << 16); }
DI float bfhi(unsigned u) { return __uint_as_float(u & 0xffff0000u); }
DI unsigned pk2(float a, float b) { f2_t v = {a, b}; bf2_t r = __builtin_convertvector(v, bf2_t); return __builtin_bit_cast(unsigned, r); }
DI bfu f2bf(float a) { return (bfu)(pk2(a, 0.f) & 0xffffu); }
DI f32x16 mfma32(bf16x8 a, bf16x8 b, f32x16 c) { return __builtin_amdgcn_mfma_f32_32x32x16_bf16(a, b, c, 0, 0, 0); }
DI int crow(int r, int hi) { return (r & 3) + 8 * (r >> 2) + 4 * hi; }
DI f32x16 zero16() { f32x16 z; for (int i = 0; i < 16; ++i) z[i] = 0.f; return z; }
DI bf16x8 pack8(const f32x16& x, int s) {
    u32x4 p; p[0] = pk2(x[8 * s], x[8 * s + 1]); p[1] = pk2(x[8 * s + 2], x[8 * s + 3]); p[2] = pk2(x[8 * s + 4], x[8 * s + 5]); p[3] = pk2(x[8 * s + 6], x[8 * s + 7]);
    return __builtin_bit_cast(bf16x8, p);
}
DI float swap32(float v) { return __shfl_xor(v, 32); }
DI float wave_sum(float v) {
    v += __shfl_xor(v, 1); v += __shfl_xor(v, 2); v += __shfl_xor(v, 4); v += __shfl_xor(v, 8); v += __shfl_xor(v, 16); v += __shfl_xor(v, 32); return v;
}
DI float sum16(float v) { v += __shfl_xor(v, 1); v += __shfl_xor(v, 2); v += __shfl_xor(v, 4); v += __shfl_xor(v, 8); return v; }
DI float fast_exp(float x) { return __expf(x); }
DI float sigmoidf(float x) { return 1.f / (1.f + __expf(-x)); }
DI float geluf(float x) { const float u = 1.5957691216057308f * (x + 0.044715f * x * x * x); return x / (1.f + __expf(-u)); }
DI float siluf(float x) { return x / (1.f + __expf(-x)); }
DI s16x4 ldtr(const LAS char* p) { return __builtin_bit_cast(s16x4, __builtin_amdgcn_ds_read_tr16_b64_v4i16((LAS v4i16_t*)p)); }
DI bf16x8 cat4(s16x4 a, s16x4 b) { return __builtin_shufflevector(a, b, 0, 1, 2, 3, 4, 5, 6, 7); }
DI int mk_tid(int wv) { int ln; asm volatile("v_mbcnt_lo_u32_b32 %0, -1, 0\n\tv_mbcnt_hi_u32_b32 %0, -1, %0" : "=v"(ln)); return wv * 64 + ln; }
DI unsigned char* opq(unsigned char* q) { asm volatile("" : "+s"(q)); return q; }
DI LAS char* opql(LAS char* q) { unsigned v = (unsigned)(size_t)q; asm volatile("" : "+s"(v)); return (LAS char*)(size_t)v; }
DI int opqi(int v) { asm volatile("" : "+s"(v)); return v; }
DI f32x4 zero4_opaque() { float z; asm volatile("v_mov_b32 %0, 0" : "=v"(z)); return (f32x4){z, z, z, z}; }
DI float dot2u(unsigned a, unsigned b, float c) { return __builtin_amdgcn_fdot2_f32_bf16(__builtin_bit_cast(bf2_t, a), __builtin_bit_cast(bf2_t, b), c, false); }

constexpr size_t WS_CTL   = 0;
constexpr size_t WS_XB    = 65536;
constexpr size_t WS_PROJ  = WS_XB   + (size_t)T * DM * 2;
constexpr size_t WS_Q     = WS_PROJ + (size_t)T * PW * 2;
constexpr size_t WS_KV    = WS_Q    + (size_t)T * 768 * 2;
constexpr size_t WS_YCAT  = WS_KV   + (size_t)T * 1024 * 2;
constexpr size_t WS_PQ    = WS_YCAT + (size_t)T * 1024 * 2;
constexpr size_t WS_IDS   = WS_PQ   + (size_t)T * 1024 * 2;
constexpr size_t WS_GATE  = WS_IDS  + (size_t)T * 128 * 4;
constexpr size_t WS_HST   = WS_GATE + (size_t)T * 128 * 4;
constexpr size_t WS_HDEC  = WS_HST  + (size_t)2048 * 4096 * 4;
constexpr size_t WS_COS   = WS_HDEC + (size_t)512 * 256 * 4;
constexpr size_t WS_SIN   = WS_COS  + (size_t)T * 16 * 4;
constexpr size_t WS_RSTD  = WS_SIN  + (size_t)T * 16 * 4;
constexpr size_t WS_LB    = WS_RSTD + (size_t)T * 4;
constexpr size_t WS_SP    = WS_LB   + 4096;
constexpr int SP_GMV = 0, SP_GMB = 256, SP_GMO = 768, SP_MLO = 1024, SP_HGO = 1536, SP_NFF = 1792, SP_STRIDE = 3072, SP_FIN = NL * SP_STRIDE;
constexpr size_t WS_W     = WS_SP   + (size_t)(SP_FIN + 1024) * 4;
constexpr size_t WL_IN    = 0;
constexpr size_t WL_UQ    = WL_IN  + (size_t)2048 * 1024 * 2;
constexpr size_t WL_UKV   = WL_UQ  + (size_t)768 * 256 * 2;
constexpr size_t WL_OUT   = WL_UKV + (size_t)1024 * 256 * 2;
constexpr size_t WL_Q     = WL_OUT + (size_t)1024 * 1024 * 2;
constexpr size_t WL_SK    = WL_Q   + (size_t)1024 * 1024 * 2;
constexpr size_t WL_GM    = WL_SK  + (size_t)16 * 128 * 64 * 2;
constexpr size_t WL_SIZE  = WL_GM  + (size_t)4 * 128 * 128 * 2;
constexpr size_t WS_TABU  = WS_W + NL * WL_SIZE;
constexpr size_t WS_TABV  = WS_TABU + (size_t)NL * NEXP * DM * 2;
constexpr size_t WS_END   = WS_TABV + (size_t)NL * NEXP * DM * 2;

struct Params {
    const float* x; const int* pos; const float* norm_mix; const float* w_in; const float* gm_v_norm; const float* gm_ws; const float* gm_b; const float* gm_out_norm;
    const float* mla_q_norm; const float* mla_w_uq; const float* mla_kv_norm; const float* mla_w_ukv; const float* mla_out_norm; const float* hg_lb_logits; const float* hg_out_norm;
    const float* w_out; const float* norm_ffn; const float* peer_w_q; const float* peer_sub_keys; const float* peer_u; const float* peer_v; const float* norm_final;
    float* out; unsigned char* ws;
    int ph_lo, ph_hi;
};

#define XB_TMO      128
#define XB_XCNT(j)  (256  + 64 * (j))
#define XB_XSUB(j)  (1280 + 64 * (j))
#define XB_XGEN(j)  (2304 + 64 * (j))
#define XB_TOP      3328
#define XB_TOPGEN   3392
#define XCD_BAR_WORDS 3456
#define XB_SPIN_CAP (1u << 20)
DI unsigned xb_ld(unsigned* p)              { return __hip_atomic_load(p, __ATOMIC_RELAXED, __HIP_MEMORY_SCOPE_AGENT); }
DI unsigned xb_add(unsigned* p, unsigned v) { return __hip_atomic_fetch_add(p, v, __ATOMIC_RELAXED, __HIP_MEMORY_SCOPE_AGENT); }
DI unsigned xb_xcc_id() { return (unsigned)__builtin_amdgcn_s_getreg((3 << 11) | 20) & 0xFu; }
#define XB_SPIN(cond, bar) do { unsigned _sp = 0; while (cond) { __builtin_amdgcn_s_sleep(1); \
    if ((++_sp & 255u) == 0u) { if (xb_ld(&(bar)[XB_TMO])) break; if (_sp > XB_SPIN_CAP) { atomicAdd(&(bar)[XB_TMO], 1u); break; } } } } while (0)
struct XcdBarrier { unsigned* bar; unsigned x; volatile LAS unsigned* st; int wv; };
DI XcdBarrier xcd_barrier_post(unsigned* bar, volatile LAS unsigned* st, int wv) {
    XcdBarrier b; b.bar = bar; b.x = xb_xcc_id(); b.st = st; b.wv = wv;
    if (mk_tid(wv) == 0) (void)xb_add(&bar[XB_XCNT(b.x)], 1u);
    return b;
}
DI void xcd_barrier_complete(unsigned* bar, unsigned x, unsigned& nloc, unsigned& nx) {
    const unsigned G = gridDim.x * gridDim.y * gridDim.z;
    unsigned sum, cnt, mine, sp = 0u;
    for (;;) {
        sum = 0u; cnt = 0u; mine = 0u;
#pragma unroll
        for (unsigned j = 0; j < 16; ++j) { const unsigned c = xb_ld(&bar[XB_XCNT(j)]); sum += c; cnt += (c > 0u) ? 1u : 0u; mine = (j == x) ? c : mine; }
        if (sum == G) break;
        __builtin_amdgcn_s_sleep(1);
        if ((++sp & 255u) == 0u) { if (xb_ld(&bar[XB_TMO])) break; if (sp > XB_SPIN_CAP) { atomicAdd(&bar[XB_TMO], 1u); break; } }
    }
    nloc = mine > 0u ? mine : 1u; nx = cnt > 0u ? cnt : 1u;
}
DI void xcd_barrier(const XcdBarrier& b) {
    asm volatile("s_waitcnt vmcnt(0)" ::: "memory");
    __syncthreads();
    if (mk_tid(b.wv) == 0) {
        unsigned* bar = b.bar;
        __builtin_amdgcn_s_waitcnt(0);
        unsigned nloc = b.st[0], nx = b.st[1];
        if (nloc == 0u) { xcd_barrier_complete(bar, b.x, nloc, nx); b.st[0] = nloc; b.st[1] = nx; }
        const unsigned old = xb_add(&bar[XB_XSUB(b.x)], 1u);
        const unsigned gen = old / nloc;
        if (old + 1u == (gen + 1u) * nloc) {
            __builtin_amdgcn_fence(__ATOMIC_RELEASE, "agent");
            asm volatile("s_waitcnt vmcnt(0)" ::: "memory");
            const unsigned og = xb_add(&bar[XB_TOP], 1u);
            const unsigned tg = og / nx;
            if (og + 1u == (tg + 1u) * nx) xb_add(&bar[XB_TOPGEN], 1u);
            else XB_SPIN(xb_ld(&bar[XB_TOPGEN]) == tg, bar);
            __builtin_amdgcn_fence(__ATOMIC_ACQUIRE, "agent");
            xb_add(&bar[XB_XGEN(b.x)], 1u);
            asm volatile("s_waitcnt vmcnt(0)" ::: "memory");
        } else {
            XB_SPIN(xb_ld(&bar[XB_XGEN(b.x)]) == gen, bar);
            __builtin_amdgcn_fence(__ATOMIC_ACQUIRE, "agent");
            asm volatile("s_waitcnt vmcnt(0)" ::: "memory");
        }
    }
    __syncthreads();
}

template <int MODE>
DI int srccol(int n) {
    if (MODE == 1) { return n < 928 ? n : (n < 1024 ? -1 : n - 96); }
    if (MODE == 2) { return n < 512 ? ((n >> 6) * 128 + (n & 63)) : (((n - 512) >> 6) * 128 + 64 + ((n - 512) & 63)); }
    return n;
}
template <int MODE>
DI void conv_tile(int t, const float* __restrict__ src, int ld_src, const float* __restrict__ gain, bfu* __restrict__ dst, int K, int n0, int k0, float* tile, int ksrc = 1 << 30) {
#pragma unroll
    for (int i = 0; i < 8; ++i) {
        const int kk = (t >> 6) + i * 8, nn = t & 63;
        const int sc = srccol<MODE>(n0 + nn);
        float v = 0.f;
        if (sc >= 0 && k0 + kk < ksrc) { v = src[(size_t)(k0 + kk) * ld_src + sc]; if (gain) v *= gain[k0 + kk]; }
        tile[kk * 65 + nn] = v;
    }
    __syncthreads();
#pragma unroll
    for (int i = 0; i < 8; ++i) {
        const int nn = (t >> 6) + i * 8, kk = t & 63;
        dst[(size_t)(n0 + nn) * K + k0 + kk] = f2bf(tile[kk * 65 + nn]);
    }
    __syncthreads();
}

DI void phase_prologue(const Params& p, LAS char* smem, int wv) {
    const int tid = mk_tid(wv), bid = blockIdx.x, nb = gridDim.x; smem = opql(smem);
    const int w = tid >> 6, lane = tid & 63;
    unsigned char* ws = opq(p.ws);
    {
        bfu* xb = (bfu*)(ws + WS_XB); float* rstd = (float*)(ws + WS_RSTD);
        for (int t = bid * 8 + w; t < T; t += nb * 8) {
            const float4* xr = (const float4*)(p.x + (size_t)t * DM);
            float ss = 0.f;
#pragma unroll
            for (int i = 0; i < 4; ++i) {
                const float4 v = xr[i * 64 + lane];
                ss += v.x * v.x + v.y * v.y + v.z * v.z + v.w * v.w;
                u32x2 o; o[0] = pk2(v.x, v.y); o[1] = pk2(v.z, v.w);
                *(u32x2*)(xb + (size_t)t * DM + (i * 64 + lane) * 4) = o;
            }
            ss = wave_sum(ss);
            if (lane == 0) rstd[t] = rsqrtf(ss * (1.f / DM) + EPS);
        }
    }
    {
        float* tile = (float*)smem;
        for (int u = bid; u < NL * 1136; u += nb) {
            const int l = u / 1136; int r = u % 1136;
            unsigned char* wl = ws + WS_W + (size_t)l * WL_SIZE;
            if (r < 512) { conv_tile<1>(tid, p.w_in + (size_t)l * 1024 * 1952, 1952, p.norm_mix + l * 1024, (bfu*)(wl + WL_IN), 1024, (r >> 4) * 64, (r & 15) * 64, tile); continue; }
            r -= 512;
            if (r < 48) { conv_tile<0>(tid, p.mla_w_uq + (size_t)l * 256 * 768, 768, p.mla_q_norm + l * 256, (bfu*)(wl + WL_UQ), 256, (r >> 2) * 64, (r & 3) * 64, tile); continue; }
            r -= 48;
            if (r < 64) { conv_tile<2>(tid, p.mla_w_ukv + (size_t)l * 128 * 1024, 1024, p.mla_kv_norm + l * 128, (bfu*)(wl + WL_UKV), 256, (r >> 2) * 64, (r & 3) * 64, tile, 128); continue; }
            r -= 64;
            if (r < 256) { conv_tile<0>(tid, p.w_out + (size_t)l * 1024 * 1024, 1024, nullptr, (bfu*)(wl + WL_OUT), 1024, (r >> 4) * 64, (r & 15) * 64, tile); continue; }
            r -= 256;
            conv_tile<0>(tid, p.peer_w_q + (size_t)l * 1024 * 1024, 1024, p.norm_ffn + l * 1024, (bfu*)(wl + WL_Q), 1024, (r >> 4) * 64, (r & 15) * 64, tile);
        }
    }
    const size_t gtid = (size_t)bid * 512 + tid, gsz = (size_t)nb * 512;
    for (size_t e = gtid; e < (size_t)NL * 16 * 128 * 64; e += gsz) {
        const int l = (int)(e / (16 * 128 * 64)); const size_t r = e % (16 * 128 * 64);
        ((bfu*)(ws + WS_W + (size_t)l * WL_SIZE + WL_SK))[r] = f2bf(p.peer_sub_keys[e]);
    }
    for (size_t e = gtid; e < (size_t)NL * 4 * 128 * 128; e += gsz) {
        const int l = (int)(e / (4 * 128 * 128)); const size_t r = e % (4 * 128 * 128);
        const int tt = (int)((r >> 7) & 127), s = (int)(r & 127);
        ((bfu*)(ws + WS_W + (size_t)l * WL_SIZE + WL_GM))[r] = f2bf(s <= tt ? p.gm_ws[e] : 0.f);
    }
    {
        const size_t n4 = (size_t)NL * NEXP * DM / 4;
        const float4* su = (const float4*)p.peer_u; const float4* sv = (const float4*)p.peer_v;
        u32x2* du = (u32x2*)(ws + WS_TABU); u32x2* dv = (u32x2*)(ws + WS_TABV);
        for (size_t e = gtid; e < n4; e += gsz) {
            const float4 a = su[e]; u32x2 o; o[0] = pk2(a.x, a.y); o[1] = pk2(a.z, a.w); du[e] = o;
            const float4 b = sv[e]; u32x2 q; q[0] = pk2(b.x, b.y); q[1] = pk2(b.z, b.w); dv[e] = q;
        }
    }
    {
        float* ct = (float*)(ws + WS_COS); float* st = (float*)(ws + WS_SIN);
        for (size_t e = gtid; e < (size_t)T * 16; e += gsz) {
            const int t = (int)(e >> 4), i = (int)(e & 15);
            const float inv = expf(-9.210340371976184f * (float)i * (1.f / 16.f));
            const float ang = (float)p.pos[t] * inv;
            const float kq = rintf(ang * 0.15915494309189535f);
            float rr = fmaf(-kq, 6.2831854820251465f, ang); rr = fmaf(-kq, -1.7484555e-7f, rr);
            ct[e] = __cosf(rr); st[e] = __sinf(rr);
        }
    }
    {
        float* sp = (float*)(ws + WS_SP);
        for (int e = (int)gtid; e < NL * SP_STRIDE + 1024; e += (int)gsz) {
            float v = 0.f;
            if (e >= SP_FIN) v = p.norm_final[e - SP_FIN];
            else { const int l = e / SP_STRIDE, r = e % SP_STRIDE;
                if (r < SP_GMB) v = p.gm_v_norm[l * 256 + r];
                else if (r < SP_GMO) v = p.gm_b[l * 512 + r - SP_GMB];
                else if (r < SP_MLO) v = p.gm_out_norm[l * 256 + r - SP_GMO];
                else if (r < SP_HGO) v = p.mla_out_norm[l * 512 + r - SP_MLO];
                else if (r < SP_NFF) v = p.hg_out_norm[l * 256 + r - SP_HGO];
                else if (r < SP_NFF + 1024) v = p.norm_ffn[l * 1024 + r - SP_NFF]; }
            sp[e] = v;
        }
    }
    if (bid == 0 && tid < 256) {
        float lg[NL], mx = -1e30f;
#pragma unroll
        for (int l = 0; l < NL; ++l) { lg[l] = p.hg_lb_logits[l * 256 + tid]; mx = fmaxf(mx, lg[l]); }
        float sum = 0.f; for (int l = 0; l < NL; ++l) { lg[l] = expf(lg[l] - mx); sum += lg[l]; }
        float cum = 0.f; const float p0 = lg[0] / sum;
        for (int l = 0; l < NL; ++l) { cum += lg[l] / sum; ((float*)(ws + WS_LB))[l * 256 + tid] = cum - p0; }
    }
}

constexpr int BM = 256, BK = 64, HALF = 128, HTB = HALF * BK * 2, STAGE_BYTES = 8 * HTB;
constexpr int LDS_RS = STAGE_BYTES;
constexpr int LDS_TOTAL = 163840;
constexpr int LDS_BAR = LDS_TOTAL - 16;
DI int lds_byte(int r, int c) { const int st = (r >> 4) * 2 + (c >> 5), rr = r & 15, cc = c & 31, ob = rr * 64 + cc * 2; return st * 1024 + (ob ^ (((ob >> 9) & 1) << 5)); }
DI void stage_rc(int b, int& R, int& C) { const int st = b / 1024, sb = b % 1024, swz = sb ^ (((sb >> 9) & 1) << 5); R = (st >> 1) * 16 + swz / 64; C = (st & 1) * 32 + (swz % 64) / 2; }
DI int perm32(int rho) { const int n = rho >> 4, i = rho & 15; return 8 * (i >> 2) + 4 * n + (i & 3); }
struct Unit { int pm, pn, idx; };
struct Gemm { const bfu* A; const bfu* Bt; int lda, ldb, K; };
struct XSched {
    int nN, nunits, G, c, wv;
    DI bool next(int i, Unit& u) const { const int L = i * G + c; if (L >= nunits) return false; const int xcd = L & 7, slot = L >> 3; u.pm = (slot / nN) * 8 + xcd; u.pn = slot % nN; u.idx = i; return true; }
    DI void a_ready(const Unit&) const {}
    DI void done(const Unit&) const {}
};
template <class Epi, class Sched, bool STAMP = false>
DI void gemm_phase(LAS unsigned char* lds, const Gemm g, const Sched& S, const Epi& E, unsigned long long* stamps = nullptr) {
    int tid_ = mk_tid(S.wv);
    const int tid = tid_, wid = __builtin_amdgcn_readfirstlane(tid >> 6), lane = tid & 63, wr = wid >> 2, wc = wid & 3, fr = lane & 15, fq = lane >> 4;
    const int K = g.K, nt = K / BK, lda = g.lda, ldb = g.ldb;
    int ts_lo = 0, ts_hi = 0, nts = 0; const unsigned long long rt_entry = STAMP ? (unsigned long long)wall_clock64() : 0ull;
#define PG8_STAMP() do { if (STAMP && wid == 0 && nts < 64) { const unsigned long long _c = (unsigned long long)clock64(); \
        ts_lo = (lane == nts) ? (int)(unsigned)_c : ts_lo; ts_hi = (lane == nts) ? (int)(unsigned)(_c >> 32) : ts_hi; ++nts; } } while (0)
    PG8_STAMP();
    unsigned voffA[2], voffB[2];
#pragma unroll
    for (int i = 0; i < 2; ++i) { int R, C; stage_rc(tid * 16 + i * 8192, R, C); const int Rb = Epi::PERM ? ((R & ~31) + perm32(R & 31)) : R;
        voffA[i] = (unsigned)(R * lda + C) * 2u; voffB[i] = (unsigned)(Rb * ldb + C) * 2u; }
    const size_t kstep = (size_t)(BK * 2);
    const size_t hstepA = (size_t)HALF * lda * 2, hstepB = (size_t)HALF * ldb * 2;
    const size_t tstepA = 2 * hstepA, tstepB = 2 * hstepB;
    const unsigned ldsw = (unsigned)wid * 1024u;
    const int aoff = lds_byte(wr * 64 + fr, fq * 8), boff = lds_byte(wc * 32 + fr, fq * 8);
#define PG8_SA(b, h) (((b) * 2 + (h)) * HTB)
#define PG8_SB(b, h) ((4 + (b) * 2 + (h)) * HTB)
#define PG8_STAGE(bufoff, gbase, voff) do { _Pragma("unroll") for (int _i = 0; _i < 2; ++_i) \
        __builtin_amdgcn_global_load_lds((const unsigned*)((const char*)(gbase) + (voff)[_i]), (LAS unsigned*)(lds + (bufoff) + ldsw + _i * 8192), 16, 0, 0); } while (0)
#define PG8_LDA(dst, b, h) do { _Pragma("unroll") for (int m = 0; m < 4; ++m) _Pragma("unroll") for (int k = 0; k < 2; ++k) dst[m][k] = *(const LAS bf16x8*)(lds + PG8_SA(b, h) + aoff + m * 2048 + k * 1024); } while (0)
#define PG8_LDB(dst, b, h) do { _Pragma("unroll") for (int n = 0; n < 2; ++n) _Pragma("unroll") for (int k = 0; k < 2; ++k) dst[n][k] = *(const LAS bf16x8*)(lds + PG8_SB(b, h) + boff + n * 2048 + k * 1024); } while (0)
#define PG8_MMA(ai, bj, At, Bt) do { __builtin_amdgcn_s_setprio(1); _Pragma("unroll") for (int m = 0; m < 4; ++m) _Pragma("unroll") for (int n = 0; n < 2; ++n) _Pragma("unroll") for (int k = 0; k < 2; ++k) \
        acc[ai][bj][m][n] = __builtin_amdgcn_mfma_f32_16x16x32_bf16(Bt[n][k], At[m][k], acc[ai][bj][m][n], 0, 0, 0); __builtin_amdgcn_s_setprio(0); } while (0)
#define PG8_WAIT_V(n) asm volatile("s_waitcnt vmcnt(" #n ")" ::: "memory")
#define PG8_WAIT_L(n) asm volatile("s_waitcnt lgkmcnt(" #n ")" ::: "memory")
#define PG8_BAR __builtin_amdgcn_s_barrier()
#define PG8_SCHED __builtin_amdgcn_sched_barrier(0)
    Unit cur, nxt; int ui = 0;
    if (!S.next(0, cur)) return;
    f32x4 acc[2][2][4][2]; { const f32x4 zz = zero4_opaque();
#pragma unroll
    for (int a = 0; a < 2; ++a)
#pragma unroll
        for (int b = 0; b < 2; ++b)
#pragma unroll
            for (int m = 0; m < 4; ++m)
#pragma unroll
                for (int n = 0; n < 2; ++n) acc[a][b][m][n] = zz; }
    bf16x8 At[4][2], B0[2][2], B1[2][2];
    const char* cA = (const char*)g.A + (size_t)cur.pm * tstepA; const char* cB = (const char*)g.Bt + (size_t)cur.pn * tstepB;
    S.a_ready(cur);
    PG8_STAGE(PG8_SB(0, 0), cB, voffB); PG8_STAGE(PG8_SA(0, 0), cA, voffA); PG8_STAGE(PG8_SB(0, 1), cB + hstepB, voffB); PG8_STAGE(PG8_SA(0, 1), cA + hstepA, voffA);
    if (wr == 1) PG8_BAR;
    PG8_WAIT_V(4); PG8_BAR;
    PG8_STAGE(PG8_SB(1, 0), cB + kstep, voffB); PG8_STAGE(PG8_SA(1, 0), cA + kstep, voffA); PG8_STAGE(PG8_SB(1, 1), cB + hstepB + kstep, voffB);
    PG8_WAIT_V(6); PG8_BAR;
    PG8_STAMP();
    for (;;) {
        const bool has_next = S.next(ui + 1, nxt);
        const char* nA = has_next ? (const char*)g.A + (size_t)nxt.pm * tstepA : cA; const char* nB = has_next ? (const char*)g.Bt + (size_t)nxt.pn * tstepB : cB;
        for (int t = 0; t < nt; t += 2) {
            const bool last = (t == nt - 2);
            const char* a1 = cA + (size_t)(t + 1) * kstep;
            const char* a2 = last ? nA : cA + (size_t)(t + 2) * kstep; const char* b2 = last ? nB : cB + (size_t)(t + 2) * kstep;
            const char* a3 = a2 + kstep; const char* b3 = b2 + kstep;
            if (last && has_next) S.a_ready(nxt);
            PG8_LDB(B0, 0, 0); PG8_SCHED; PG8_LDA(At, 0, 0); PG8_STAGE(PG8_SA(1, 1), a1 + hstepA, voffA);
            PG8_WAIT_L(8); PG8_BAR; PG8_WAIT_L(0); PG8_MMA(0, 0, At, B0); PG8_BAR; PG8_SCHED;
            PG8_LDB(B1, 0, 1); PG8_STAGE(PG8_SB(0, 0), b2, voffB);
            PG8_BAR; PG8_WAIT_L(0); PG8_MMA(0, 1, At, B1); PG8_BAR;
            PG8_LDA(At, 0, 1); PG8_STAGE(PG8_SA(0, 0), a2, voffA);
            PG8_BAR; PG8_WAIT_L(0); PG8_MMA(1, 0, At, B0); PG8_BAR; PG8_SCHED;
            PG8_STAGE(PG8_SB(0, 1), b2 + hstepB, voffB);
            PG8_WAIT_V(6); PG8_BAR; PG8_MMA(1, 1, At, B1); PG8_BAR;
            PG8_LDB(B0, 1, 0); PG8_SCHED; PG8_LDA(At, 1, 0); PG8_STAGE(PG8_SA(0, 1), a2 + hstepA, voffA);
            PG8_WAIT_L(8); PG8_BAR; PG8_WAIT_L(0); PG8_MMA(0, 0, At, B0); PG8_BAR; PG8_SCHED;
            PG8_LDB(B1, 1, 1); PG8_STAGE(PG8_SB(1, 0), b3, voffB);
            PG8_BAR; PG8_WAIT_L(0); PG8_MMA(0, 1, At, B1); PG8_BAR;
            PG8_LDA(At, 1, 1); PG8_STAGE(PG8_SA(1, 0), a3, voffA);
            PG8_BAR; PG8_WAIT_L(0); PG8_MMA(1, 0, At, B0); PG8_BAR; PG8_SCHED;
            PG8_STAGE(PG8_SB(1, 1), b3 + hstepB, voffB);
            PG8_WAIT_V(6); PG8_BAR; PG8_MMA(1, 1, At, B1); PG8_BAR;
        }
        PG8_STAMP();
        if constexpr (!Epi::AFTER_DRAIN) { E(acc, cur, wr, wc, fr, fq); S.done(cur); }
        PG8_STAMP();
        if (!has_next) break;
        { const f32x4 zz = zero4_opaque();
#pragma unroll
        for (int a = 0; a < 2; ++a)
#pragma unroll
            for (int b = 0; b < 2; ++b)
#pragma unroll
                for (int m = 0; m < 4; ++m)
#pragma unroll
                    for (int n = 0; n < 2; ++n) acc[a][b][m][n] = zz; }
        cur = nxt; cA = nA; cB = nB; ++ui;
    }
    PG8_WAIT_V(0);
    if (wr == 0) PG8_BAR;
    PG8_BAR;
    if constexpr (Epi::AFTER_DRAIN) { E.fused(acc, cur, wr, wc, fr, fq, lds, wid, lane); S.done(cur); }
    PG8_STAMP();
    if (STAMP && wid == 0) { stamps[lane] = lane < nts ? (((unsigned long long)(unsigned)ts_hi << 32) | (unsigned)ts_lo) : 0ull;
        if (lane == 62) stamps[62] = rt_entry; if (lane == 63) stamps[63] = (unsigned long long)wall_clock64(); }
#undef PG8_STAMP
#undef PG8_SA
#undef PG8_SB
#undef PG8_STAGE
#undef PG8_LDA
#undef PG8_LDB
#undef PG8_MMA
#undef PG8_WAIT_V
#undef PG8_WAIT_L
#undef PG8_BAR
#undef PG8_SCHED
}

template <int NC>
DI void rows_rstd_lds(const bfu* __restrict__ A, int lda, int brow, LAS float* rs, int wv) {
    int tid = mk_tid(wv);
    const int w = tid >> 6, lane = tid & 63;
    constexpr int PER = NC / 64;
    for (int i = 0; i < 32; ++i) {
        const int r = w * 32 + i;
        const bfu* row = A + (size_t)(brow + r) * lda;
        float ss = 0.f;
        if (PER == 16) {
            const u32x4 a = *(const u32x4*)(row + lane * 8), b = *(const u32x4*)(row + 512 + lane * 8);
#pragma unroll
            for (int j = 0; j < 4; ++j) { float x0 = bflo(a[j]), x1 = bfhi(a[j]), y0 = bflo(b[j]), y1 = bfhi(b[j]); ss += x0 * x0 + x1 * x1 + y0 * y0 + y1 * y1; }
        } else if (PER == 4) {
            const u32x2 a = *(const u32x2*)(row + lane * 4);
            float x0 = bflo(a[0]), x1 = bfhi(a[0]), y0 = bflo(a[1]), y1 = bfhi(a[1]); ss = x0 * x0 + x1 * x1 + y0 * y0 + y1 * y1;
        } else {
            const unsigned a = *(const unsigned*)(row + lane * 2);
            float x0 = bflo(a), x1 = bfhi(a); ss = x0 * x0 + x1 * x1;
        }
        ss = wave_sum(ss);
        if (lane == 0) rs[r] = rsqrtf(ss * (1.f / NC) + EPS);
    }
}
DI u32x2 pack4(f32x4 v) { u32x2 o; o[0] = pk2(v[0], v[1]); o[1] = pk2(v[2], v[3]); return o; }

struct EpiProj {
    static constexpr bool PERM = false, AFTER_DRAIN = false;
    const float* rs; bfu* out; const float* ct; const float* st;
    DI void operator()(const f32x4 (&acc)[2][2][4][2], const Unit& u, int wr, int wc, int fr_, int fq_) const {
        int tz = mk_tid(wr * 4 + wc); const int fr = tz & 15, fq = (tz >> 4) & 3;
        const int row0 = u.pm * BM + wr * 64 + fr, colg = u.pn * BM + wc * 32;
#pragma unroll
        for (int ai = 0; ai < 2; ++ai)
#pragma unroll
            for (int m = 0; m < 4; ++m) {
                const int row = row0 + ai * HALF + m * 16; const float s = rs[row];
#pragma unroll
                for (int bj = 0; bj < 2; ++bj) {
                    const int cg = colg + bj * HALF;
                    f32x4 a = acc[ai][bj][m][0] * s, b = acc[ai][bj][m][1] * s;
                    if (cg == PC_KR) { const f32x4 c = *(const f32x4*)(ct + (size_t)row * 16 + 4 * fq), sn = *(const f32x4*)(st + (size_t)row * 16 + 4 * fq);
                        const f32x4 a2 = a * c - b * sn, b2 = b * c + a * sn; a = a2; b = b2; }
                    bfu* o = out + (size_t)row * PW + cg + 4 * fq;
                    *(u32x2*)o = pack4(a); *(u32x2*)(o + 16) = pack4(b);
                }
            }
    }
};
template <bool ROPE>
struct EpiScaled {
    static constexpr bool PERM = false, AFTER_DRAIN = false;
    const LAS float* rs; bfu* out; int ld; const float* ct; const float* st; float scale;
    DI void operator()(const f32x4 (&acc)[2][2][4][2], const Unit& u, int wr, int wc, int fr_, int fq_) const {
        int tz = mk_tid(wr * 4 + wc); const int fr = tz & 15, fq = (tz >> 4) & 3;
        const int lrow0 = wr * 64 + fr, colg = u.pn * BM + wc * 32;
#pragma unroll
        for (int ai = 0; ai < 2; ++ai)
#pragma unroll
            for (int m = 0; m < 4; ++m) {
                const int lrow = lrow0 + ai * HALF + m * 16; const int row = u.pm * BM + lrow; const float s = rs[u.idx * 256 + lrow] * scale;
#pragma unroll
                for (int bj = 0; bj < 2; ++bj) {
                    const int cg = colg + bj * HALF;
                    f32x4 a = acc[ai][bj][m][0] * s, b = acc[ai][bj][m][1] * s;
                    if (ROPE && ((cg >> 5) % 3) == 2) { const f32x4 c = *(const f32x4*)(ct + (size_t)row * 16 + 4 * fq), sn = *(const f32x4*)(st + (size_t)row * 16 + 4 * fq);
                        const f32x4 a2 = a * c - b * sn, b2 = b * c + a * sn; a = a2; b = b2; }
                    bfu* o = out + (size_t)row * ld + cg + 4 * fq;
                    *(u32x2*)o = pack4(a); *(u32x2*)(o + 16) = pack4(b);
                }
            }
    }
};
struct EpiResid {
    static constexpr bool PERM = false, AFTER_DRAIN = false;
    bfu* x;
    DI void operator()(const f32x4 (&acc)[2][2][4][2], const Unit& u, int wr, int wc, int fr_, int fq_) const {
        int tz = mk_tid(wr * 4 + wc); const int fr = tz & 15, fq = (tz >> 4) & 3;
        const int row0 = u.pm * BM + wr * 64 + fr, colg = u.pn * BM + wc * 32 + 4 * fq;
#pragma unroll
        for (int ai = 0; ai < 2; ++ai)
#pragma unroll
            for (int m = 0; m < 4; ++m) {
                bfu* rowp = x + (size_t)(row0 + ai * HALF + m * 16) * DM + colg;
#pragma unroll
                for (int bj = 0; bj < 2; ++bj)
#pragma unroll
                    for (int n = 0; n < 2; ++n) {
                        u32x2* p = (u32x2*)(rowp + bj * HALF + n * 16); const u32x2 old = *p; const f32x4 v = acc[ai][bj][m][n];
                        u32x2 o; o[0] = pk2(bflo(old[0]) + v[0], bfhi(old[0]) + v[1]); o[1] = pk2(bflo(old[1]) + v[2], bfhi(old[1]) + v[3]); *p = o;
                    }
            }
    }
};

constexpr int AT_KS = 208;
constexpr int AT_VS = 192;
constexpr int AT_KB = 64 * AT_KS, AT_VB = 64 * AT_VS, AT_BUF = AT_KB + AT_VB;

DI void attn_unit(const Params& p, unsigned char* ws, int l, int b, int h, int qt, LAS char* smem, int tid) {
    const int w = tid >> 6, lane = tid & 63, r = lane & 31, hh = lane >> 5;
    const bfu* Q = (const bfu*)(ws + WS_Q); const bfu* KV = (const bfu*)(ws + WS_KV); const bfu* PR = (const bfu*)(ws + WS_PROJ);
    const size_t tok0 = (size_t)b * SEQ;
    const int q0 = qt * 256 + w * 32;
    bf16x8 qf[6];
    { const bfu* qrow = Q + (tok0 + q0 + r) * 768 + h * 96 + 8 * hh;
#pragma unroll
      for (int ks = 0; ks < 6; ++ks) qf[ks] = *(const bf16x8*)(qrow + 16 * ks); }
    f32x16 o0 = zero16(), o1 = zero16();
    float mrun = -1e30f, lsum = 0.f;
    const int nkt = qt * 4 + 4, my_last = qt * 4 + (w >> 1);
    const int skey = tid >> 3, sch = tid & 7, rkey = (tid & 255) >> 2, rch = tid & 3;
    u32x4 gk, gv, gr;
    auto gload = [&](int kt) {
        const size_t t1 = tok0 + (size_t)kt * 64 + skey;
        gk = *(const u32x4*)(KV + t1 * 1024 + h * 64 + sch * 8);
        gv = *(const u32x4*)(KV + t1 * 1024 + 512 + h * 64 + sch * 8);
        if (tid < 256) gr = *(const u32x4*)(PR + (tok0 + (size_t)kt * 64 + rkey) * PW + PC_KR + rch * 8);
    };
    auto lstore = [&](int buf) {
        LAS char* kb = smem + buf * AT_BUF; LAS char* vb = kb + AT_KB;
        *(LAS u32x4*)(kb + skey * AT_KS + sch * 16) = gk;
        *(LAS u32x4*)(vb + skey * AT_VS + sch * 16) = gv;
        if (tid < 256) *(LAS u32x4*)(kb + rkey * AT_KS + 128 + rch * 16) = gr;
    };
    __syncthreads();
    gload(0); lstore(0);
    __syncthreads();
    const int i16 = lane & 15, q4 = i16 >> 2, p4 = i16 & 3, blk = (lane >> 4) & 1;
    for (int kt = 0; kt < nkt; ++kt) {
        const int cur = kt & 1;
        if (kt + 1 < nkt) gload(kt + 1);
        if (kt <= my_last) {
            const LAS char* kb = smem + cur * AT_BUF; const LAS char* vb = kb + AT_KB;
            f32x16 s0 = zero16(), s1 = zero16();
#pragma unroll
            for (int ks = 0; ks < 6; ++ks) {
                const bf16x8 a0 = *(const LAS bf16x8*)(kb + r * AT_KS + ks * 32 + hh * 16);
                const bf16x8 a1 = *(const LAS bf16x8*)(kb + (32 + r) * AT_KS + ks * 32 + hh * 16);
                s0 = mfma32(a0, qf[ks], s0); s1 = mfma32(a1, qf[ks], s1);
            }
            if (kt == my_last) {
                const int qa = q0 + r, kbase = kt * 64 + 4 * hh;
#pragma unroll
                for (int i = 0; i < 16; ++i) { const int kk = kbase + (i & 3) + 8 * (i >> 2); if (kk > qa) s0[i] = -1e30f; if (kk + 32 > qa) s1[i] = -1e30f; }
            }
            float mx = s0[0];
#pragma unroll
            for (int i = 1; i < 16; ++i) mx = fmaxf(mx, s0[i]);
#pragma unroll
            for (int i = 0; i < 16; ++i) mx = fmaxf(mx, s1[i]);
            mx = fmaxf(mx, swap32(mx));
            const float mnew = fmaxf(mrun, mx);
            const float alpha = __builtin_amdgcn_exp2f(mrun - mnew);
            mrun = mnew;
            float ps = 0.f;
#pragma unroll
            for (int i = 0; i < 16; ++i) { s0[i] = __builtin_amdgcn_exp2f(s0[i] - mnew); s1[i] = __builtin_amdgcn_exp2f(s1[i] - mnew); ps += s0[i] + s1[i]; }
            lsum = lsum * alpha + ps;
#pragma unroll
            for (int i = 0; i < 16; ++i) { o0[i] *= alpha; o1[i] *= alpha; }
#pragma unroll
            for (int kk = 0; kk < 2; ++kk)
#pragma unroll
                for (int s = 0; s < 2; ++s) {
                    const bf16x8 pf = pack8(kk == 0 ? s0 : s1, s);
                    const int key0 = 32 * kk + 16 * s + 4 * hh + q4;
#pragma unroll
                    for (int vt = 0; vt < 2; ++vt) {
                        const LAS char* a = vb + key0 * AT_VS + (32 * vt + 16 * blk) * 2 + 8 * p4;
                        const bf16x8 vf = cat4(ldtr(a), ldtr(a + 8 * AT_VS));
                        if (vt == 0) o0 = mfma32(vf, pf, o0); else o1 = mfma32(vf, pf, o1);
                    }
                }
        }
        if (kt + 1 < nkt) lstore(cur ^ 1);
        __syncthreads();
    }
    const float ltot = lsum + swap32(lsum);
    const float inv = 1.f / ltot;
    float ss = 0.f;
#pragma unroll
    for (int i = 0; i < 16; ++i) { o0[i] *= inv; o1[i] *= inv; ss += o0[i] * o0[i] + o1[i] * o1[i]; }
    ss += swap32(ss);
    const float rstd = rsqrtf(ss * (1.f / 64.f) + EPS);
    const float* gain = (const float*)(ws + WS_SP) + l * SP_STRIDE + SP_MLO + h * 64;
    bfu* yrow = (bfu*)(ws + WS_YCAT) + (tok0 + q0 + r) * 1024 + 256 + h * 64;
#pragma unroll
    for (int vt = 0; vt < 2; ++vt)
#pragma unroll
        for (int g = 0; g < 4; ++g) {
            const int v0 = 32 * vt + 8 * g + 4 * hh;
            const f32x4 gn = *(const f32x4*)(gain + v0);
            f32x4 ov;
#pragma unroll
            for (int i = 0; i < 4; ++i) ov[i] = (vt == 0 ? o0[4 * g + i] : o1[4 * g + i]) * rstd * gn[i];
            *(u32x2*)(yrow + v0) = pack4(ov);
        }
}

DI void attn_phase(const Params& p, int l, LAS char* smem, int wv) {
    int tid = mk_tid(wv); smem = opql(smem);
    unsigned char* ws = opq(p.ws);
    for (int pi = blockIdx.x; pi < 512; pi += gridDim.x) {
        const int bh = pi >> 2, j = pi & 3;
        attn_unit(p, ws, l, bh >> 3, bh & 7, 7 - j, smem, tid);
        attn_unit(p, ws, l, bh >> 3, bh & 7, j, smem, tid);
    }
}

constexpr int GM_VS = 576;

DI void gmlp_phase(const Params& p, int l, LAS char* smem, int wv) {
    int tid = mk_tid(wv); smem = opql(smem);
    const int w = tid >> 6, lane = tid & 63, r = lane & 31, hh = lane >> 5;
    unsigned char* ws = opq(p.ws);
    const bfu* PR = (const bfu*)(ws + WS_PROJ);
    bfu* YC = (bfu*)(ws + WS_YCAT);
    const bfu* WC = (const bfu*)(ws + WS_W + (size_t)l * WL_SIZE + WL_GM);
    for (int c = blockIdx.x; c < T / 128; c += gridDim.x) {
        const size_t tok0 = (size_t)c * 128;
        __syncthreads();
        {
            const f32x4 gn = *(const f32x4*)((const float*)(ws + WS_SP) + l * SP_STRIDE + SP_GMV + lane * 4);
            for (int i = 0; i < 16; ++i) {
                const int s = w * 16 + i;
                const u32x2 raw = *(const u32x2*)(PR + (tok0 + s) * PW + PC_V + lane * 4);
                f32x4 v; v[0] = geluf(bflo(raw[0])); v[1] = geluf(bfhi(raw[0])); v[2] = geluf(bflo(raw[1])); v[3] = geluf(bfhi(raw[1]));
                float ss = v[0] * v[0] + v[1] * v[1] + v[2] * v[2] + v[3] * v[3];
                ss = sum16(ss);
                const float rstd = rsqrtf(ss * (1.f / 64.f) + EPS);
                f32x4 o; for (int j = 0; j < 4; ++j) o[j] = v[j] * rstd * gn[j];
                *(LAS u32x2*)(smem + s * GM_VS + lane * 8) = pack4(o);
            }
        }
        __syncthreads();
        const int h = w >> 1, th = w & 1;
        const int i16 = lane & 15, q4 = i16 >> 2, p4 = i16 & 3, blk = (lane >> 4) & 1;
        f32x16 acc[2][2];
#pragma unroll
        for (int a = 0; a < 2; ++a)
#pragma unroll
            for (int b2 = 0; b2 < 2; ++b2) acc[a][b2] = zero16();
        const bfu* wrow = WC + ((size_t)h * 128 + 64 * th + r) * 128 + 8 * hh;
#pragma unroll
        for (int ks = 0; ks < 8; ++ks) {
            bf16x8 af[2];
#pragma unroll
            for (int mt = 0; mt < 2; ++mt) {
                const LAS char* a = smem + (16 * ks + 8 * hh + q4) * GM_VS + (h * 64 + 32 * mt + 16 * blk) * 2 + 8 * p4;
                af[mt] = cat4(ldtr(a), ldtr(a + 4 * GM_VS));
            }
#pragma unroll
            for (int nt = 0; nt < 2; ++nt) {
                if (ks <= 4 * th + 2 * nt + 1) {
                    const bf16x8 bfr = *(const bf16x8*)(wrow + (size_t)nt * 32 * 128 + 16 * ks);
                    acc[0][nt] = mfma32(af[0], bfr, acc[0][nt]); acc[1][nt] = mfma32(af[1], bfr, acc[1][nt]);
                }
            }
        }
        const float* og = (const float*)(ws + WS_SP) + l * SP_STRIDE + SP_GMO + h * 64;
#pragma unroll
        for (int nt = 0; nt < 2; ++nt) {
            const int tl = 64 * th + 32 * nt + r;
            const float bv = ((const float*)(ws + WS_SP))[l * SP_STRIDE + SP_GMB + h * 128 + tl];
            const bfu* urow = PR + (tok0 + tl) * PW + PC_U + h * 64;
            f32x4 y[2][4]; float ss = 0.f;
#pragma unroll
            for (int mt = 0; mt < 2; ++mt)
#pragma unroll
                for (int g = 0; g < 4; ++g) {
                    const int d0 = 32 * mt + 8 * g + 4 * hh;
                    const u32x2 raw = *(const u32x2*)(urow + d0);
                    f32x4 u; u[0] = geluf(bflo(raw[0])); u[1] = geluf(bfhi(raw[0])); u[2] = geluf(bflo(raw[1])); u[3] = geluf(bfhi(raw[1]));
#pragma unroll
                    for (int i = 0; i < 4; ++i) { const float yy = u[i] * (acc[mt][nt][4 * g + i] + bv); y[mt][g][i] = yy; ss += yy * yy; }
                }
            ss += swap32(ss);
            const float rstd = rsqrtf(ss * (1.f / 64.f) + EPS);
            bfu* yrow = YC + (tok0 + tl) * 1024 + h * 64;
#pragma unroll
            for (int mt = 0; mt < 2; ++mt)
#pragma unroll
                for (int g = 0; g < 4; ++g) {
                    const int d0 = 32 * mt + 8 * g + 4 * hh;
                    const f32x4 gn = *(const f32x4*)(og + d0);
                    f32x4 o; for (int i = 0; i < 4; ++i) o[i] = y[mt][g][i] * rstd * gn[i];
                    *(u32x2*)(yrow + d0) = pack4(o);
                }
        }
    }
}

constexpr int HG_RS = 528;
constexpr int HG_TS = 576;
constexpr float HG_CLAMP = 80.f;

struct HgScan { float cum[32]; float kf[32]; float tot0, tot1; };
DI void hg_scan(const bfu* PR, size_t tok0, int ch, int half, float lb, LAS float* xch, HgScan& S) {
    float run = 0.f;
#pragma unroll
    for (int i = 0; i < 32; ++i) {
        const float fx = bf2f(PR[(tok0 + 32 * half + i) * PW + PC_HF + ch]);
        const float sg = sigmoidf(fx);
        const float f = lb + (1.f - lb) * sg;
        run += __logf(fmaxf(f, 1e-20f));
        S.cum[i] = run; S.kf[i] = (1.f - lb) * (1.f - sg);
    }
    xch[half * 256 + ch] = run;
    __syncthreads();
    S.tot0 = xch[ch]; S.tot1 = xch[256 + ch];
}

DI void hg_local_phase(const Params& p, int l, LAS char* smem, int wv) {
    int tid = mk_tid(wv); smem = opql(smem);
    const int w = tid >> 6, lane = tid & 63, r = lane & 31, hh = lane >> 5;
    const int ch = tid & 255, half = tid >> 8;
    unsigned char* ws = opq(p.ws);
    const bfu* PR = (const bfu*)(ws + WS_PROJ);
    float* HST = (float*)(ws + WS_HST); float* HDEC = (float*)(ws + WS_HDEC);
    const float lb = ((const float*)(ws + WS_LB))[l * 256 + ch];
    LAS char* Kt = smem;
    LAS char* Vn = smem + 64 * HG_TS;
    LAS float* xch = (LAS float*)(smem + 2 * 64 * HG_TS);
    for (int uc = blockIdx.x; uc < 512; uc += gridDim.x) {
        const size_t tok0 = (size_t)uc * 64;
        __syncthreads();
        HgScan S; hg_scan(PR, tok0, ch, half, lb, xch, S);
        const float btot = S.tot0 + S.tot1;
        const float e0 = half == 0 ? btot : S.tot1;
#pragma unroll
        for (int i = 0; i < 32; ++i) {
            const float kv = S.kf[i] * __expf(e0 - S.cum[i]);
            *(LAS bfu*)(Kt + (32 * half + i) * HG_TS + ch * 2) = f2bf(kv);
        }
        if (half == 0) HDEC[(size_t)uc * 256 + ch] = __expf(btot);
#pragma unroll
        for (int i = 0; i < 4; ++i) {
            const int e = tid + i * 512, s = e >> 5, cch = e & 31;
            *(LAS u32x4*)(Vn + s * HG_TS + cch * 16) = *(const u32x4*)(PR + (tok0 + s) * PW + PC_HI + cch * 8);
        }
        __syncthreads();
        const int h = w >> 1, vh = w & 1;
        const int i16 = lane & 15, q4 = i16 >> 2, p4 = i16 & 3, blk = (lane >> 4) & 1;
        f32x16 acc0 = zero16(), acc1 = zero16();
#pragma unroll
        for (int ks = 0; ks < 4; ++ks) {
            const int srow = 16 * ks + 8 * hh + q4;
            const LAS char* a = Vn + srow * HG_TS + (h * 64 + 32 * vh + 16 * blk) * 2 + 8 * p4;
            const bf16x8 af = cat4(ldtr(a), ldtr(a + 4 * HG_TS));
            const LAS char* b0 = Kt + srow * HG_TS + (h * 64 + 16 * blk) * 2 + 8 * p4;
            const bf16x8 bf0 = cat4(ldtr(b0), ldtr(b0 + 4 * HG_TS));
            const bf16x8 bf1 = cat4(ldtr(b0 + 64), ldtr(b0 + 64 + 4 * HG_TS));
            acc0 = mfma32(af, bf0, acc0); acc1 = mfma32(af, bf1, acc1);
        }
        float* out = HST + ((size_t)uc * 4 + h) * 4096;
#pragma unroll
        for (int i = 0; i < 16; ++i) {
            const int v = 32 * vh + crow(i, hh);
            out[v * 64 + r] = acc0[i]; out[v * 64 + 32 + r] = acc1[i];
        }
    }
}

DI void hg_prefix_phase(const Params& p, int wv) {
    unsigned char* ws = opq(p.ws);
    float* HST = (float*)(ws + WS_HST); const float* HDEC = (const float*)(ws + WS_HDEC);
    int tid = mk_tid(wv);
    const int gsz = gridDim.x * 512;
    for (int e = blockIdx.x * 512 + tid; e < 64 * 4096; e += gsz) {
        const int bh = e >> 12, idx = e & 4095, b = bh >> 2, h = bh & 3;
        float S = 0.f;
        for (int c = 0; c < 32; ++c) {
            const size_t uc = (size_t)b * 32 + c;
            float* gp = HST + (uc * 4 + h) * 4096 + idx;
            const float g = *gp, dec = HDEC[uc * 256 + h * 64 + (idx & 63)];
            *gp = S;
            S = dec * S + g;
        }
    }
}

DI void hg_out_phase(const Params& p, int l, LAS char* smem, int wv) {
    int tid = mk_tid(wv); smem = opql(smem);
    const int w = tid >> 6, lane = tid & 63, r = lane & 31, hh = lane >> 5;
    const int ch = tid & 255, half = tid >> 8;
    unsigned char* ws = opq(p.ws);
    const bfu* PR = (const bfu*)(ws + WS_PROJ);
    const float* HST = (const float*)(ws + WS_HST);
    bfu* YC = (bfu*)(ws + WS_YCAT);
    const float lb = ((const float*)(ws + WS_LB))[l * 256 + ch];
    LAS char* Qe = smem;
    LAS char* Qm = smem + 64 * HG_RS;
    LAS char* Km = smem + 2 * 64 * HG_RS;
    LAS char* Vn = smem + 3 * 64 * HG_RS;
    LAS float* xch = (LAS float*)(smem + 3 * 64 * HG_RS + 64 * HG_TS);
    for (int uc = blockIdx.x; uc < 512; uc += gridDim.x) {
        const size_t tok0 = (size_t)uc * 64;
        __syncthreads();
        HgScan S; hg_scan(PR, tok0, ch, half, lb, xch, S);
#pragma unroll
        for (int i = 0; i < 32; ++i) {
            const int s = 32 * half + i;
            const float q = siluf(bf2f(PR[(tok0 + s) * PW + PC_HQ + ch]));
            const float b = half == 0 ? S.cum[i] : S.tot0 + S.cum[i];
            const float bm = half == 0 ? S.cum[i] - S.tot0 : S.cum[i];
            const float qe = q * __expf(b);
            const float qm = q * __expf(fminf(bm, HG_CLAMP));
            const float km = S.kf[i] * __expf(fminf(-bm, HG_CLAMP));
            *(LAS bfu*)(Qe + s * HG_RS + ch * 2) = f2bf(qe);
            *(LAS bfu*)(Qm + s * HG_RS + ch * 2) = f2bf(qm);
            *(LAS bfu*)(Km + s * HG_RS + ch * 2) = f2bf(km);
        }
#pragma unroll
        for (int i = 0; i < 4; ++i) {
            const int e = tid + i * 512, s = e >> 5, cch = e & 31;
            *(LAS u32x4*)(Vn + s * HG_TS + cch * 16) = *(const u32x4*)(PR + (tok0 + s) * PW + PC_HI + cch * 8);
        }
        __syncthreads();
        const int h = w >> 1, th = w & 1;
        const int i16 = lane & 15, q4 = i16 >> 2, p4 = i16 & 3, blk = (lane >> 4) & 1;
        f32x16 o0 = zero16(), o1 = zero16();
#ifndef ABL_HG_NOINTER
        {
            const float* st = HST + ((size_t)uc * 4 + h) * 4096;
#pragma unroll
            for (int ks = 0; ks < 4; ++ks) {
                const bf16x8 bq = *(const LAS bf16x8*)(Qe + (32 * th + r) * HG_RS + (h * 64 + 16 * ks + 8 * hh) * 2);
#pragma unroll
                for (int vt = 0; vt < 2; ++vt) {
                    const float* sp = st + (32 * vt + r) * 64 + 16 * ks + 8 * hh;
                    const f32x4 s0 = *(const f32x4*)sp, s1 = *(const f32x4*)(sp + 4);
                    u32x4 pa; pa[0] = pk2(s0[0], s0[1]); pa[1] = pk2(s0[2], s0[3]); pa[2] = pk2(s1[0], s1[1]); pa[3] = pk2(s1[2], s1[3]);
                    const bf16x8 af = __builtin_bit_cast(bf16x8, pa);
                    if (vt == 0) o0 = mfma32(af, bq, o0); else o1 = mfma32(af, bq, o1);
                }
            }
        }
#endif
#pragma unroll
        for (int st_ = 0; st_ < 2; ++st_) {
            if (st_ <= th) {
                f32x16 x = zero16();
#pragma unroll
                for (int ks = 0; ks < 4; ++ks) {
                    const bf16x8 ak = *(const LAS bf16x8*)(Km + (32 * st_ + r) * HG_RS + (h * 64 + 16 * ks + 8 * hh) * 2);
                    const bf16x8 bq = *(const LAS bf16x8*)(Qm + (32 * th + r) * HG_RS + (h * 64 + 16 * ks + 8 * hh) * 2);
                    x = mfma32(ak, bq, x);
                }
                if (st_ == th) {
#pragma unroll
                    for (int i = 0; i < 16; ++i) if (crow(i, hh) > r) x[i] = 0.f;
                }
#pragma unroll
                for (int s2 = 0; s2 < 2; ++s2) {
                    const bf16x8 pf = pack8(x, s2);
                    const int srow = 32 * st_ + 16 * s2 + 4 * hh + q4;
#pragma unroll
                    for (int vt = 0; vt < 2; ++vt) {
                        const LAS char* a = Vn + srow * HG_TS + (h * 64 + 32 * vt + 16 * blk) * 2 + 8 * p4;
                        const bf16x8 vf = cat4(ldtr(a), ldtr(a + 8 * HG_TS));
                        if (vt == 0) o0 = mfma32(vf, pf, o0); else o1 = mfma32(vf, pf, o1);
                    }
                }
            }
        }
        float ss = 0.f;
#pragma unroll
        for (int i = 0; i < 16; ++i) ss += o0[i] * o0[i] + o1[i] * o1[i];
        ss += swap32(ss);
        const float rstd = rsqrtf(ss * (1.f / 64.f) + EPS);
        const size_t tok = tok0 + 32 * th + r;
        const bfu* grow = PR + tok * PW + PC_HG + h * 64;
        bfu* yrow = YC + tok * 1024 + 768 + h * 64;
        const float* og = (const float*)(ws + WS_SP) + l * SP_STRIDE + SP_HGO + h * 64;
#pragma unroll
        for (int vt = 0; vt < 2; ++vt)
#pragma unroll
            for (int g = 0; g < 4; ++g) {
                const int v0 = 32 * vt + 8 * g + 4 * hh;
                const u32x2 raw = *(const u32x2*)(grow + v0);
                const f32x4 gn = *(const f32x4*)(og + v0);
                f32x4 gg; gg[0] = siluf(bflo(raw[0])); gg[1] = siluf(bfhi(raw[0])); gg[2] = siluf(bflo(raw[1])); gg[3] = siluf(bfhi(raw[1]));
                f32x4 ov;
#pragma unroll
                for (int i = 0; i < 4; ++i) ov[i] = (vt == 0 ? o0[4 * g + i] : o1[4 * g + i]) * rstd * gn[i] * gg[i];
                *(u32x2*)(yrow + v0) = pack4(ov);
            }
    }
}

DI void ins16(float (&a)[16], float v) {
#pragma unroll
    for (int j = 15; j >= 1; --j) a[j] = __builtin_amdgcn_fmed3f(a[j - 1], a[j], v);
    a[0] = fmaxf(a[0], v);
}
DI void peer_topk_phase(const Params& p, int l, LAS char* smem, int wv) {
    int tid = mk_tid(wv); smem = opql(smem);
    const int w = tid >> 6, lane = tid & 63, r = lane & 31, hh = lane >> 5;
    unsigned char* ws = opq(p.ws);
    const bfu* PQ = (const bfu*)(ws + WS_PQ);
    const bfu* SK = (const bfu*)(ws + WS_W + (size_t)l * WL_SIZE + WL_SK);
    int* IDS = (int*)(ws + WS_IDS); float* GATE = (float*)(ws + WS_GATE);
    for (int u = blockIdx.x; u < T / 32; u += gridDim.x) {
        const size_t tok = (size_t)u * 32 + r;
        float lst[2][16];
#pragma unroll
        for (int pp = 0; pp < 2; ++pp) {
            bf16x8 qf[4];
#pragma unroll
            for (int ks = 0; ks < 4; ++ks) qf[ks] = *(const bf16x8*)(PQ + tok * 1024 + w * 128 + pp * 64 + 16 * ks + 8 * hh);
            const bfu* skb = SK + ((size_t)(w * 2 + pp) * 128 + r) * 64 + 8 * hh;
            float a[16];
#pragma unroll
            for (int j = 0; j < 16; ++j) a[j] = -3.0e38f;
#pragma unroll
            for (int kt = 0; kt < 4; ++kt) {
                f32x16 acc = zero16();
#pragma unroll
                for (int ks = 0; ks < 4; ++ks) acc = mfma32(*(const bf16x8*)(skb + (size_t)kt * 32 * 64 + 16 * ks), qf[ks], acc);
#pragma unroll
                for (int i = 0; i < 16; ++i) {
                    const unsigned key = 32 * kt + (i & 3) + 8 * (i >> 2) + 4 * hh;
                    ins16(a, __uint_as_float((__float_as_uint(acc[i]) & 0xffffff80u) | key));
                }
            }
            float ob[16];
#pragma unroll
            for (int j = 0; j < 16; ++j) ob[j] = swap32(a[j]);
#pragma unroll
            for (int j = 0; j < 16; ++j) {
#ifndef ABL_NOMERGE
                ins16(a, ob[j]);
#endif
            }
#pragma unroll
            for (int j = 0; j < 16; ++j) lst[pp][j] = a[j];
        }
        float c[16];
#pragma unroll
        for (int j = 0; j < 16; ++j) c[j] = -3.0e38f;
#pragma unroll
        for (int i = 0; i < 16; ++i)
#pragma unroll
            for (int j = 0; j < 16; ++j) if ((i + 1) * (j + 1) <= 16) ins16(c, lst[0][i] + lst[1][j]);
        const float thr = c[15], mx = c[0];
        float den = 0.f;
#pragma unroll
        for (int j = 0; j < 16; ++j) den += __expf(c[j] - mx);
        const float rden = 1.f / den;
        int cnt = 0;
        int* idp = IDS + tok * 128 + w * 16; float* gp = GATE + tok * 128 + w * 16;
        if (hh == 0) {
#pragma unroll
            for (int i = 0; i < 16; ++i)
#pragma unroll
                for (int j = 0; j < 16; ++j) if ((i + 1) * (j + 1) <= 16) {
                    const float s = lst[0][i] + lst[1][j];
                    if (s >= thr && cnt < 16) {
                        idp[cnt] = (int)((__float_as_uint(lst[0][i]) & 127u) * 128u + (__float_as_uint(lst[1][j]) & 127u));
                        gp[cnt] = __expf(s - mx) * rden;
                        ++cnt;
                    }
                }
            for (int k = cnt; k < 16; ++k) { idp[k] = 0; gp[k] = 0.f; }
        }
    }
}

#ifdef ABL_PK_BRUTE
DI void peer_topk_brute(const Params& p, int l, int wv) {
    int tid = mk_tid(wv);
    unsigned char* ws = opq(p.ws);
    const bfu* PQ = (const bfu*)(ws + WS_PQ);
    const bfu* SK = (const bfu*)(ws + WS_W + (size_t)l * WL_SIZE + WL_SK);
    int* IDS = (int*)(ws + WS_IDS); float* GATE = (float*)(ws + WS_GATE);
    for (int idx = blockIdx.x * 512 + tid; idx < T * 8; idx += gridDim.x * 512) {
        const int h = idx & 7; const size_t tok = idx >> 3;
        float lst[2][16];
#pragma unroll
        for (int pp = 0; pp < 2; ++pp) {
            unsigned q[32];
#ifdef ABL_PK_BRUTE_Q
            {
                const bfu* xr = (const bfu*)(ws + WS_XB) + tok * DM;
                float ss = 0.f;
                for (int k = 0; k < DM; ++k) { const float xx = bf2f(xr[k]); ss += xx * xx; }
                const float rstd = rsqrtf(ss * (1.f / DM) + EPS);
                float qa[64];
#pragma unroll
                for (int j = 0; j < 64; ++j) qa[j] = 0.f;
                const float* wqp = p.peer_w_q + (size_t)l * DM * 1024 + h * 128 + pp * 64;
                const float* gnp = p.norm_ffn + l * DM;
                for (int k = 0; k < DM; ++k) {
                    const float xx = bf2f(xr[k]) * rstd * gnp[k];
                    const f32x4* wr = (const f32x4*)(wqp + (size_t)k * 1024);
#pragma unroll
                    for (int j = 0; j < 16; ++j) { const f32x4 wv4 = wr[j]; qa[4 * j] += xx * wv4[0]; qa[4 * j + 1] += xx * wv4[1]; qa[4 * j + 2] += xx * wv4[2]; qa[4 * j + 3] += xx * wv4[3]; }
                }
#pragma unroll
                for (int j = 0; j < 32; ++j) q[j] = pk2(qa[2 * j], qa[2 * j + 1]);
            }
#else
#pragma unroll
            for (int j = 0; j < 32; ++j) q[j] = *(const unsigned*)(PQ + tok * 1024 + h * 128 + pp * 64 + 2 * j);
#endif
            float a[16];
#pragma unroll
            for (int j = 0; j < 16; ++j) a[j] = -3.0e38f;
            for (int key = 0; key < 128; ++key) {
                float sc = 0.f;
#ifdef ABL_PK_BRUTE_Q
                const float* krf = p.peer_sub_keys + (((size_t)l * 16 + h * 2 + pp) * 128 + key) * 64;
#pragma unroll
                for (int j = 0; j < 32; ++j) { sc += krf[2 * j] * bflo(q[j]) + krf[2 * j + 1] * bfhi(q[j]); }
#else
                const unsigned* kr = (const unsigned*)(SK + ((size_t)(h * 2 + pp) * 128 + key) * 64);
#pragma unroll
                for (int j = 0; j < 32; ++j) { const unsigned kk = kr[j]; sc += bflo(kk) * bflo(q[j]) + bfhi(kk) * bfhi(q[j]); }
#endif
                ins16(a, __uint_as_float((__float_as_uint(sc) & 0xffffff80u) | (unsigned)key));
            }
#pragma unroll
            for (int j = 0; j < 16; ++j) lst[pp][j] = a[j];
        }
        float c[16];
#pragma unroll
        for (int j = 0; j < 16; ++j) c[j] = -3.0e38f;
#pragma unroll
        for (int i = 0; i < 16; ++i)
#pragma unroll
            for (int j = 0; j < 16; ++j) if ((i + 1) * (j + 1) <= 16) ins16(c, lst[0][i] + lst[1][j]);
        const float thr = c[15], mx = c[0];
        float den = 0.f;
#pragma unroll
        for (int j = 0; j < 16; ++j) den += __expf(c[j] - mx);
        const float rden = 1.f / den;
        int cnt = 0;
        int* idp = IDS + tok * 128 + h * 16; float* gp = GATE + tok * 128 + h * 16;
#pragma unroll
        for (int i = 0; i < 16; ++i)
#pragma unroll
            for (int j = 0; j < 16; ++j) if ((i + 1) * (j + 1) <= 16) {
                const float s = lst[0][i] + lst[1][j];
                if (s >= thr && cnt < 16) {
                    idp[cnt] = (int)((__float_as_uint(lst[0][i]) & 127u) * 128u + (__float_as_uint(lst[1][j]) & 127u));
                    gp[cnt] = __expf(s - mx) * rden;
                    ++cnt;
                }
            }
        for (int k = cnt; k < 16; ++k) { idp[k] = 0; gp[k] = 0.f; }
    }
}
#endif

#ifdef ABL_PG_BRUTE
DI float blk_sum(LAS float* part, LAS float* red, int tid, float v) {
    __syncthreads();
    part[tid] = v;
    __syncthreads();
    if (tid < 16) { float s = 0.f; for (int i = 0; i < 32; ++i) s += part[tid * 32 + i]; red[tid] = s; }
    __syncthreads();
    float t = 0.f; for (int i = 0; i < 16; ++i) t += red[i];
    return t;
}
DI void peer_gather_brute(const Params& p, int l, LAS char* smem, int wv) {
    int tid = mk_tid(wv); smem = opql(smem);
    unsigned char* ws = opq(p.ws);
    bfu* XB = (bfu*)(ws + WS_XB);
    const int* IDS = (const int*)(ws + WS_IDS); const float* GATE = (const float*)(ws + WS_GATE);
    float* RSTD = (float*)(ws + WS_RSTD);
    LAS float* part = (LAS float*)smem;
    LAS float* red = part + 512;
    LAS float* coef = part + 544;
    for (int t = blockIdx.x; t < T; t += gridDim.x) {
        bfu* xrow = XB + (size_t)t * DM;
        const float x0 = bf2f(xrow[tid]), x1 = bf2f(xrow[tid + 512]);
        const float rstd = rsqrtf(blk_sum(part, red, tid, x0 * x0 + x1 * x1) * (1.f / DM) + EPS);
        const float n0 = x0 * rstd * p.norm_ffn[l * DM + tid], n1 = x1 * rstd * p.norm_ffn[l * DM + tid + 512];
        for (int e = 0; e < 128; ++e) {
            const int id = IDS[(size_t)t * 128 + e];
            const float* ur = p.peer_u + ((size_t)l * NEXP + id) * DM;
            const float d = blk_sum(part, red, tid, n0 * ur[tid] + n1 * ur[tid + 512]);
            if (tid == 0) coef[e] = geluf(d) * GATE[(size_t)t * 128 + e];
        }
        __syncthreads();
        float a0 = 0.f, a1 = 0.f;
        for (int e = 0; e < 128; ++e) {
            const int id = IDS[(size_t)t * 128 + e];
            const float* vr = p.peer_v + ((size_t)l * NEXP + id) * DM;
            const float cf = coef[e];
            a0 += cf * vr[tid]; a1 += cf * vr[tid + 512];
        }
        const float y0 = x0 + a0, y1 = x1 + a1;
        const float r2 = rsqrtf(blk_sum(part, red, tid, y0 * y0 + y1 * y1) * (1.f / DM) + EPS);
        if (l == NL - 1) { p.out[(size_t)t * DM + tid] = y0 * r2 * p.norm_final[tid]; p.out[(size_t)t * DM + tid + 512] = y1 * r2 * p.norm_final[tid + 512]; }
        else { xrow[tid] = f2bf(y0); xrow[tid + 512] = f2bf(y1); if (tid == 0) RSTD[t] = r2; }
        __syncthreads();
    }
}
#endif

DI void peer_gather_phase(const Params& p, int l, LAS char* smem, int wv) {
    int tid = mk_tid(wv); smem = opql(smem);
    const int w = tid >> 6, lane = tid & 63;
    unsigned char* ws = opq(p.ws);
    bfu* XB = (bfu*)(ws + WS_XB);
    const int* IDS = (const int*)(ws + WS_IDS); const float* GATE = (const float*)(ws + WS_GATE);
    const bfu* TU = (const bfu*)(ws + WS_TABU) + (size_t)l * NEXP * DM;
    const bfu* TV = (const bfu*)(ws + WS_TABV) + (size_t)l * NEXP * DM;
    float* RSTD = (float*)(ws + WS_RSTD);
    f32x4 gf[4];
    { const float* g = (const float*)(ws + WS_SP) + l * SP_STRIDE + SP_NFF; gf[0] = *(const f32x4*)(g + 8 * lane); gf[1] = *(const f32x4*)(g + 8 * lane + 4); gf[2] = *(const f32x4*)(g + 512 + 8 * lane); gf[3] = *(const f32x4*)(g + 512 + 8 * lane + 4); }
    for (int t = blockIdx.x * 8 + w; t < T; t += gridDim.x * 8) {
        bfu* xrow = XB + (size_t)t * DM;
        const u32x4 xa = *(const u32x4*)(xrow + 8 * lane), xb2 = *(const u32x4*)(xrow + 512 + 8 * lane);
        float xv[16];
#pragma unroll
        for (int j = 0; j < 4; ++j) { xv[2 * j] = bflo(xa[j]); xv[2 * j + 1] = bfhi(xa[j]); xv[8 + 2 * j] = bflo(xb2[j]); xv[8 + 2 * j + 1] = bfhi(xb2[j]); }
        float ss = 0.f;
#pragma unroll
        for (int j = 0; j < 16; ++j) ss += xv[j] * xv[j];
        ss = wave_sum(ss);
        const float rstd = rsqrtf(ss * (1.f / DM) + EPS);
        unsigned xn[8];
#pragma unroll
        for (int j = 0; j < 8; ++j) xn[j] = pk2(xv[2 * j] * rstd * gf[j >> 1][(2 * j) & 3], xv[2 * j + 1] * rstd * gf[j >> 1][(2 * j + 1) & 3]);
        const int ida = IDS[(size_t)t * 128 + lane], idb = IDS[(size_t)t * 128 + 64 + lane];
        const float ga = GATE[(size_t)t * 128 + lane], gb = GATE[(size_t)t * 128 + 64 + lane];
        float ca = 0.f, cb = 0.f;
#pragma unroll 4
        for (int e = 0; e < 128; ++e) {
            const int id = __builtin_amdgcn_readlane(e < 64 ? ida : idb, e & 63);
#ifdef ABL_F32TAB
            const float* urf = p.peer_u + ((size_t)l * NEXP + id) * DM;
            const f32x4 fa = *(const f32x4*)(urf + 8 * lane), fb = *(const f32x4*)(urf + 8 * lane + 4), fc = *(const f32x4*)(urf + 512 + 8 * lane), fd = *(const f32x4*)(urf + 512 + 8 * lane + 4);
            u32x4 u0, u1; u0[0] = pk2(fa[0], fa[1]); u0[1] = pk2(fa[2], fa[3]); u0[2] = pk2(fb[0], fb[1]); u0[3] = pk2(fb[2], fb[3]);
            u1[0] = pk2(fc[0], fc[1]); u1[1] = pk2(fc[2], fc[3]); u1[2] = pk2(fd[0], fd[1]); u1[3] = pk2(fd[2], fd[3]);
#else
            const bfu* ur = TU + (size_t)id * DM;
            const u32x4 u0 = *(const u32x4*)(ur + 8 * lane), u1 = *(const u32x4*)(ur + 512 + 8 * lane);
#endif
            float d = 0.f;
#pragma unroll
            for (int j = 0; j < 4; ++j) {
                const unsigned ua = u0[j], ub = u1[j];
                d = dot2u(ua, xn[j], d);
                d = dot2u(ub, xn[4 + j], d);
            }
            d = wave_sum(d);
            const float act = geluf(d);
            if (e < 64) { if (lane == e) ca = act * ga; } else { if (lane == e - 64) cb = act * gb; }
        }
        float acc[16];
#pragma unroll
        for (int j = 0; j < 16; ++j) acc[j] = 0.f;
#pragma unroll 4
        for (int e = 0; e < 128; ++e) {
            const int id = __builtin_amdgcn_readlane(e < 64 ? ida : idb, e & 63);
            const float cf = __builtin_bit_cast(float, __builtin_amdgcn_readlane(__builtin_bit_cast(int, e < 64 ? ca : cb), e & 63));
#ifdef ABL_F32TAB
            const float* vrf = p.peer_v + ((size_t)l * NEXP + id) * DM;
            const f32x4 fa = *(const f32x4*)(vrf + 8 * lane), fb = *(const f32x4*)(vrf + 8 * lane + 4), fc = *(const f32x4*)(vrf + 512 + 8 * lane), fd = *(const f32x4*)(vrf + 512 + 8 * lane + 4);
            u32x4 v0, v1; v0[0] = pk2(fa[0], fa[1]); v0[1] = pk2(fa[2], fa[3]); v0[2] = pk2(fb[0], fb[1]); v0[3] = pk2(fb[2], fb[3]);
            v1[0] = pk2(fc[0], fc[1]); v1[1] = pk2(fc[2], fc[3]); v1[2] = pk2(fd[0], fd[1]); v1[3] = pk2(fd[2], fd[3]);
#else
            const bfu* vr = TV + (size_t)id * DM;
            const u32x4 v0 = *(const u32x4*)(vr + 8 * lane), v1 = *(const u32x4*)(vr + 512 + 8 * lane);
#endif
#pragma unroll
            for (int j = 0; j < 4; ++j) { acc[2 * j] += cf * bflo(v0[j]); acc[2 * j + 1] += cf * bfhi(v0[j]); acc[8 + 2 * j] += cf * bflo(v1[j]); acc[8 + 2 * j + 1] += cf * bfhi(v1[j]); }
        }
        float s2 = 0.f;
#pragma unroll
        for (int j = 0; j < 16; ++j) {
#ifdef ABL_PEER_L0ONLY
            if (l == 0) xv[j] += acc[j];
#elif !defined(ABL_PEER0)
#ifdef ABL_PEER_SCALE
            xv[j] += (ABL_PEER_SCALE) * acc[j];
#else
            xv[j] += acc[j];
#endif
#endif
            s2 += xv[j] * xv[j]; }
        s2 = wave_sum(s2);
        const float r2 = rsqrtf(s2 * (1.f / DM) + EPS);
        if (l == NL - 1) {
            const float* gfin = (const float*)(ws + WS_SP) + SP_FIN; float* orow = p.out + (size_t)t * DM;
#pragma unroll
            for (int q = 0; q < 4; ++q) {
                const int base = (q < 2 ? 0 : 512) + 8 * lane + 4 * (q & 1);
                const f32x4 g = *(const f32x4*)(gfin + base);
                f32x4 o; for (int i = 0; i < 4; ++i) o[i] = xv[4 * q + i] * r2 * g[i];
                *(f32x4*)(orow + base) = o;
            }
        } else {
            u32x4 oa, ob;
#pragma unroll
            for (int j = 0; j < 4; ++j) { oa[j] = pk2(xv[2 * j], xv[2 * j + 1]); ob[j] = pk2(xv[8 + 2 * j], xv[8 + 2 * j + 1]); }
            *(u32x4*)(xrow + 8 * lane) = oa; *(u32x4*)(xrow + 512 + 8 * lane) = ob;
            if (lane == 0) RSTD[t] = r2;
        }
    }
}

constexpr int NPH = 1 + 8 * NL;
__global__ void __launch_bounds__(512, 2) hymba_fwd(Params p) {
    extern __shared__ __attribute__((aligned(16))) char smem_raw[];
    LAS char* smem0 = (LAS char*)smem_raw;
    const int wv = __builtin_amdgcn_readfirstlane((int)(threadIdx.x >> 6));
    if (mk_tid(wv) < 4) ((LAS unsigned*)(smem0 + LDS_BAR))[mk_tid(wv)] = 0u;
    __syncthreads();
    XcdBarrier bar = xcd_barrier_post((unsigned*)(p.ws + WS_CTL), (volatile LAS unsigned*)(smem0 + LDS_BAR), wv);
    const int lo = p.ph_lo, hi = p.ph_hi;
#define IN(k) (lo <= (k) && (k) < hi)
#define SEAM(k) do { if (IN(k) && IN((k) + 1)) xcd_barrier(bar); } while (0)
    if (IN(0)) { phase_prologue(p, smem0, wv); }
    SEAM(0);
    for (int l = 0; l < NL; ++l) {
        const int pb = 1 + 8 * l;
        if (IN(pb + 0)) {
            const int G = opqi((int)gridDim.x), bid = opqi((int)blockIdx.x); LAS char* smem = opql(smem0); LAS unsigned char* smemu = (LAS unsigned char*)smem; unsigned char* ws = opq(p.ws); const unsigned char* wl = ws + WS_W + (size_t)l * WL_SIZE; const float* ct = (const float*)(ws + WS_COS); const float* st = (const float*)(ws + WS_SIN); (void)wl; (void)ct; (void)st;
            EpiProj e{(const float*)(ws + WS_RSTD), (bfu*)(ws + WS_PROJ), ct, st};
            XSched s{8, 128 * 8, G, bid, wv};
            gemm_phase(smemu, Gemm{(const bfu*)(ws + WS_XB), (const bfu*)(wl + WL_IN), 1024, 1024, 1024}, s, e);
        }
        SEAM(pb + 0);
        if (IN(pb + 1)) {
            const int G = opqi((int)gridDim.x), bid = opqi((int)blockIdx.x); LAS char* smem = opql(smem0); LAS unsigned char* smemu = (LAS unsigned char*)smem; unsigned char* ws = opq(p.ws); const unsigned char* wl = ws + WS_W + (size_t)l * WL_SIZE; const float* ct = (const float*)(ws + WS_COS); const float* st = (const float*)(ws + WS_SIN); (void)wl; (void)ct; (void)st;
            {
                XSched s{3, 128 * 3, G, bid, wv};
                Unit u; __syncthreads();
                for (int i = 0; s.next(i, u); ++i) rows_rstd_lds<256>((const bfu*)(ws + WS_PROJ) + PC_CQ, PW, u.pm * 256, (LAS float*)(smem + LDS_RS) + i * 256, wv);
                __syncthreads();
                EpiScaled<true> e{(const LAS float*)(smem + LDS_RS), (bfu*)(ws + WS_Q), 768, ct, st, 0.10206207261596577f * 1.4426950408889634f};
                gemm_phase(smemu, Gemm{(const bfu*)(ws + WS_PROJ) + PC_CQ, (const bfu*)(wl + WL_UQ), PW, 256, 256}, s, e);
            }
            {
                XSched s{4, 128 * 4, G, (bid + 128) % G, wv};
                Unit u; __syncthreads();
                for (int i = 0; s.next(i, u); ++i) rows_rstd_lds<128>((const bfu*)(ws + WS_PROJ) + PC_CKV, PW, u.pm * 256, (LAS float*)(smem + LDS_RS) + i * 256, wv);
                __syncthreads();
                EpiScaled<false> e{(const LAS float*)(smem + LDS_RS), (bfu*)(ws + WS_KV), 1024, ct, st, 1.f};
                gemm_phase(smemu, Gemm{(const bfu*)(ws + WS_PROJ) + PC_CKV, (const bfu*)(wl + WL_UKV), PW, 256, 256}, s, e);
            }
            gmlp_phase(p, l, smem0, wv);
            hg_local_phase(p, l, smem0, wv);
        }
        SEAM(pb + 1);
        if (IN(pb + 2)) { attn_phase(p, l, smem0, wv); hg_prefix_phase(p, wv); }
        SEAM(pb + 2);
        if (IN(pb + 3)) { hg_out_phase(p, l, smem0, wv); }
        SEAM(pb + 3);
        if (IN(pb + 4)) {
            const int G = opqi((int)gridDim.x), bid = opqi((int)blockIdx.x); LAS char* smem = opql(smem0); LAS unsigned char* smemu = (LAS unsigned char*)smem; unsigned char* ws = opq(p.ws); const unsigned char* wl = ws + WS_W + (size_t)l * WL_SIZE; const float* ct = (const float*)(ws + WS_COS); const float* st = (const float*)(ws + WS_SIN); (void)wl; (void)ct; (void)st;
            EpiResid e{(bfu*)(ws + WS_XB)};
            XSched s{4, 128 * 4, G, bid, wv};
            __syncthreads();
            gemm_phase(smemu, Gemm{(const bfu*)(ws + WS_YCAT), (const bfu*)(wl + WL_OUT), 1024, 1024, 1024}, s, e);
        }
        SEAM(pb + 4);
        if (IN(pb + 5)) {
            const int G = opqi((int)gridDim.x), bid = opqi((int)blockIdx.x); LAS char* smem = opql(smem0); LAS unsigned char* smemu = (LAS unsigned char*)smem; unsigned char* ws = opq(p.ws); const unsigned char* wl = ws + WS_W + (size_t)l * WL_SIZE; const float* ct = (const float*)(ws + WS_COS); const float* st = (const float*)(ws + WS_SIN); (void)wl; (void)ct; (void)st;
            XSched s{4, 128 * 4, G, bid, wv};
            Unit u; __syncthreads();
            for (int i = 0; s.next(i, u); ++i) rows_rstd_lds<1024>((const bfu*)(ws + WS_XB), DM, u.pm * 256, (LAS float*)(smem + LDS_RS) + i * 256, wv);
            __syncthreads();
            EpiScaled<false> e{(const LAS float*)(smem + LDS_RS), (bfu*)(ws + WS_PQ), 1024, ct, st, 1.f};
            gemm_phase(smemu, Gemm{(const bfu*)(ws + WS_XB), (const bfu*)(wl + WL_Q), 1024, 1024, 1024}, s, e);
        }
        SEAM(pb + 5);
#ifdef ABL_PK_BRUTE
        if (IN(pb + 6)) { peer_topk_brute(p, l, wv); }
#else
        if (IN(pb + 6)) { peer_topk_phase(p, l, smem0, wv); }
#endif
        SEAM(pb + 6);
#ifdef ABL_PG_BRUTE
        if (IN(pb + 7)) { peer_gather_brute(p, l, smem0, wv); }
#else
        if (IN(pb + 7)) { peer_gather_phase(p, l, smem0, wv); }
#endif
        SEAM(pb + 7);
    }
#undef IN
#undef SEAM
}

#ifndef N_LAUNCH_MODE
#define N_LAUNCH_MODE 1
#endif
extern "C" void kernel_launch(void* const* d_in, const int* in_sizes, int n_in, void* d_out, int out_size, void* d_ws, size_t ws_size, hipStream_t stream) {
    static int grid = 0;
    if (grid == 0) {
        if (n_in != 22 || in_sizes[0] != T * DM || out_size != T * DM || ws_size < WS_END) {
            fprintf(stderr, "kernel_launch: unexpected shapes (n_in %d, in0 %d, out %d, ws %zu, need %zu)\n", n_in, n_in > 0 ? in_sizes[0] : -1, out_size, ws_size, (size_t)WS_END); grid = -1; return; }
        int dev = 0, cus = 0, per_cu = 0;
        if (hipGetDevice(&dev) != hipSuccess || hipDeviceGetAttribute(&cus, hipDeviceAttributeMultiprocessorCount, dev) != hipSuccess) { grid = -1; return; }
        if (hipFuncSetAttribute((const void*)hymba_fwd, hipFuncAttributeMaxDynamicSharedMemorySize, LDS_TOTAL) != hipSuccess) { fprintf(stderr, "kernel_launch: hipFuncSetAttribute failed\n"); grid = -1; return; }
        if (hipOccupancyMaxActiveBlocksPerMultiprocessor(&per_cu, (const void*)hymba_fwd, 512, LDS_TOTAL) != hipSuccess || per_cu < 1) fprintf(stderr, "kernel_launch: occupancy query says %d\n", per_cu);
        (void)hipGetLastError();
        grid = cus;
    }
    if (grid < 0) return;
    (void)hipMemsetAsync((char*)d_ws + WS_CTL, 0, 65536, stream);
    Params p{};
    p.x = (const float*)d_in[0]; p.pos = (const int*)d_in[1]; p.norm_mix = (const float*)d_in[2]; p.w_in = (const float*)d_in[3]; p.gm_v_norm = (const float*)d_in[4];
    p.gm_ws = (const float*)d_in[5]; p.gm_b = (const float*)d_in[6]; p.gm_out_norm = (const float*)d_in[7]; p.mla_q_norm = (const float*)d_in[8]; p.mla_w_uq = (const float*)d_in[9];
    p.mla_kv_norm = (const float*)d_in[10]; p.mla_w_ukv = (const float*)d_in[11]; p.mla_out_norm = (const float*)d_in[12]; p.hg_lb_logits = (const float*)d_in[13];
    p.hg_out_norm = (const float*)d_in[14]; p.w_out = (const float*)d_in[15]; p.norm_ffn = (const float*)d_in[16]; p.peer_w_q = (const float*)d_in[17];
    p.peer_sub_keys = (const float*)d_in[18]; p.peer_u = (const float*)d_in[19]; p.peer_v = (const float*)d_in[20]; p.norm_final = (const float*)d_in[21];
    p.out = (float*)d_out; p.ws = (unsigned char*)d_ws;
#if N_LAUNCH_MODE == 1
    p.ph_lo = 0; p.ph_hi = NPH;
    hipLaunchKernelGGL(hymba_fwd, dim3(grid), dim3(512), LDS_TOTAL, stream, p);
#else
    for (int ph = 0; ph < NPH; ++ph) { p.ph_lo = ph; p.ph_hi = ph + 1; hipLaunchKernelGGL(hymba_fwd, dim3(grid), dim3(512), LDS_TOTAL, stream, p); }
#endif
}
```

```cpp
#include <hip/hip_runtime.h>
#include <cstdio>
#include <cstdint>
#include <cmath>
#include <type_traits>

constexpr int T = 32768, DM = 1024, NL = 4, SEQ = 2048;
constexpr int PW = 2048;
constexpr int PC_U = 0, PC_V = 256, PC_CQ = 512, PC_CKV = 768, PC_KR = 896, PC_HQ = 1024, PC_HF = 1280, PC_HI = 1536, PC_HG = 1792;
constexpr int NEXP = 16384;
constexpr float EPS = 1e-6f;

typedef unsigned short bfu;
typedef __attribute__((ext_vector_type(8))) short bf16x8;
typedef __attribute__((ext_vector_type(4))) short s16x4;
typedef __attribute__((ext_vector_type(4))) float f32x4;
typedef __attribute__((ext_vector_type(16))) float f32x16;
typedef __attribute__((ext_vector_type(2))) __bf16 bf2_t;
typedef __attribute__((ext_vector_type(2))) float f2_t;
typedef __attribute__((ext_vector_type(4))) unsigned u32x4;
typedef __attribute__((ext_vector_type(2))) unsigned u32x2;
typedef short v4i16_t __attribute__((ext_vector_type(4)));
#define DI __device__ __forceinline__
#define LAS __attribute__((address_space(3)))

DI float bf2f(bfu v) { return __uint_as_float((unsigned)v << 16); }
DI float bflo(unsigned u) { return __uint_as_float(u << 16); }
DI float bfhi(unsigned u) { return __uint_as_float(u & 0xffff0000u); }
DI unsigned pk2(float a, float b) { f2_t v = {a, b}; bf2_t r = __builtin_convertvector(v, bf2_t); return __builtin_bit_cast(unsigned, r); }
DI bfu f2bf(float a) { return (bfu)(pk2(a, 0.f) & 0xffffu); }
DI f32x16 mfma32(bf16x8 a, bf16x8 b, f32x16 c) { return __builtin_amdgcn_mfma_f32_32x32x16_bf16(a, b, c, 0, 0, 0); }
DI int crow(int r, int hi) { return (r & 3) + 8 * (r >> 2) + 4 * hi; }
DI f32x16 zero16() { f32x16 z; for (int i = 0; i < 16; ++i) z[i] = 0.f; return z; }
DI bf16x8 pack8(const f32x16& x, int s) {
    u32x4 p; p[0] = pk2(x[8 * s], x[8 * s + 1]); p[1] = pk2(x[8 * s + 2], x[8 * s + 3]); p[2] = pk2(x[8 * s + 4], x[8 * s + 5]); p[3] = pk2(x[8 * s + 6], x[8 * s + 7]);
    return __builtin_bit_cast(bf16x8, p);
}
DI float swap32(float v) { return __shfl_xor(v, 32); }
DI float wave_sum(float v) {
    v += __shfl_xor(v, 1); v += __shfl_xor(v, 2); v += __shfl_xor(v, 4); v += __shfl_xor(v, 8); v += __shfl_xor(v, 16); v += __shfl_xor(v, 32); return v;
}
DI float sum16(float v) { v += __shfl_xor(v, 1); v += __shfl_xor(v, 2); v += __shfl_xor(v, 4); v += __shfl_xor(v, 8); return v; }
DI float fast_exp(float x) { return __expf(x); }
DI float sigmoidf(float x) { return 1.f / (1.f + __expf(-x)); }
DI float geluf(float x) { const float u = 1.5957691216057308f * (x + 0.044715f * x * x * x); return x / (1.f + __expf(-u)); }
DI float siluf(float x) { return x / (1.f + __expf(-x)); }
DI s16x4 ldtr(const LAS char* p) { return __builtin_bit_cast(s16x4, __builtin_amdgcn_ds_read_tr16_b64_v4i16((LAS v4i16_t*)p)); }
DI bf16x8 cat4(s16x4 a, s16x4 b) { return __builtin_shufflevector(a, b, 0, 1, 2, 3, 4, 5, 6, 7); }
DI int mk_tid(int wv) { int ln; asm volatile("v_mbcnt_lo_u32_b32 %0, -1, 0\n\tv_mbcnt_hi_u32_b32 %0, -1, %0" : "=v"(ln)); return wv * 64 + ln; }
DI unsigned char* opq(unsigned char* q) { asm volatile("" : "+s"(q)); return q; }
DI LAS char* opql(LAS char* q) { unsigned v = (unsigned)(size_t)q; asm volatile("" : "+s"(v)); return (LAS char*)(size_t)v; }
DI int opqi(int v) { asm volatile("" : "+s"(v)); return v; }
DI f32x4 zero4_opaque() { float z; asm volatile("v_mov_b32 %0, 0" : "=v"(z)); return (f32x4){z, z, z, z}; }
DI float dot2u(unsigned a, unsigned b, float c) { return __builtin_amdgcn_fdot2_f32_bf16(__builtin_bit_cast(bf2_t, a), __builtin_bit_cast(bf2_t, b), c, false); }
#define GAS __attribute__((address_space(1)))
typedef __attribute__((ext_vector_type(2))) float f32x2;
template <int CTRL, int ROWMASK> DI float dpp_get(float v) { return __builtin_bit_cast(float, __builtin_amdgcn_update_dpp(0, __builtin_bit_cast(int, v), CTRL, ROWMASK, 0xf, false)); }
DI float dpp_sum63(float v) {
    v += dpp_get<0x111, 0xf>(v); v += dpp_get<0x112, 0xf>(v); v += dpp_get<0x114, 0xf>(v); v += dpp_get<0x118, 0xf>(v);
    v += dpp_get<0x142, 0xa>(v); v += dpp_get<0x143, 0xc>(v); return v;
}
DI float dpp_max63(float v) {
    v = fmaxf(v, dpp_get<0x111, 0xf>(v)); v = fmaxf(v, dpp_get<0x112, 0xf>(v)); v = fmaxf(v, dpp_get<0x114, 0xf>(v)); v = fmaxf(v, dpp_get<0x118, 0xf>(v));
    v = fmaxf(v, dpp_get<0x142, 0xa>(v)); v = fmaxf(v, dpp_get<0x143, 0xc>(v)); return v;
}
DI float rdlane_f(float v, int l) { return __builtin_bit_cast(float, __builtin_amdgcn_readlane(__builtin_bit_cast(int, v), l)); }
DI unsigned pack_i8x4(float a, float b, float c, float d) {
    const int q0 = (int)__builtin_rintf(fminf(fmaxf(a, -127.f), 127.f)), q1 = (int)__builtin_rintf(fminf(fmaxf(b, -127.f), 127.f));
    const int q2 = (int)__builtin_rintf(fminf(fmaxf(c, -127.f), 127.f)), q3 = (int)__builtin_rintf(fminf(fmaxf(d, -127.f), 127.f));
    return (unsigned)(q0 & 0xff) | ((unsigned)(q1 & 0xff) << 8) | ((unsigned)(q2 & 0xff) << 16) | ((unsigned)(q3 & 0xff) << 24);
}

constexpr size_t WS_CTL   = 0;
constexpr size_t WS_XB    = 65536;
constexpr size_t WS_PROJ  = WS_XB   + (size_t)T * DM * 2;
constexpr size_t WS_Q     = WS_PROJ + (size_t)T * PW * 2;
constexpr size_t WS_KV    = WS_Q    + (size_t)T * 768 * 2;
constexpr size_t WS_YCAT  = WS_KV   + (size_t)T * 1024 * 2;
constexpr size_t WS_PQ    = WS_YCAT + (size_t)T * 1024 * 2;
constexpr size_t WS_IDS   = WS_PQ   + (size_t)T * 1024 * 2;
constexpr size_t WS_GATE  = WS_IDS  + (size_t)T * 128 * 4;
constexpr size_t WS_HST   = WS_GATE + (size_t)T * 128 * 4;
constexpr size_t WS_HDEC  = WS_HST  + (size_t)2048 * 4096 * 4;
constexpr size_t WS_COS   = WS_HDEC + (size_t)512 * 256 * 4;
constexpr size_t WS_SIN   = WS_COS  + (size_t)T * 16 * 4;
constexpr size_t WS_SSP   = WS_SIN  + (size_t)T * 16 * 4;
constexpr size_t WS_RSTF  = WS_SSP  + (size_t)T * 8 * 4;
constexpr size_t WS_COEF  = WS_RSTF + (size_t)T * 4;
constexpr size_t WS_LB    = WS_COEF + (size_t)T * 128 * 4;
constexpr size_t WS_SP    = WS_LB   + 4096;
constexpr int SP_GMV = 0, SP_GMB = 256, SP_GMO = 768, SP_MLO = 1024, SP_HGO = 1536, SP_NFF = 1792, SP_STRIDE = 3072, SP_FIN = NL * SP_STRIDE;
constexpr size_t WS_W     = WS_SP   + (size_t)(SP_FIN + 1024) * 4;
constexpr size_t WL_IN    = 0;
constexpr size_t WL_UQ    = WL_IN  + (size_t)2048 * 1024 * 2;
constexpr size_t WL_UKV   = WL_UQ  + (size_t)768 * 256 * 2;
constexpr size_t WL_OUT   = WL_UKV + (size_t)1024 * 256 * 2;
constexpr size_t WL_Q     = WL_OUT + (size_t)1024 * 1024 * 2;
constexpr size_t WL_SK    = WL_Q   + (size_t)1024 * 1024 * 2;
constexpr size_t WL_GM    = WL_SK  + (size_t)16 * 128 * 64 * 2;
constexpr size_t WL_SIZE  = WL_GM  + (size_t)4 * 128 * 128 * 2;
constexpr size_t WS_TABU  = WS_W + NL * WL_SIZE;
constexpr size_t WS_TABV  = WS_TABU + (size_t)NL * NEXP * DM;
constexpr size_t WS_SCU   = WS_TABV + (size_t)NL * NEXP * DM;
constexpr size_t WS_SCV   = WS_SCU  + (size_t)NL * NEXP * 4;
constexpr size_t WS_END   = WS_SCV  + (size_t)NL * NEXP * 4;

struct Params {
    const float* x; const int* pos; const float* norm_mix; const float* w_in; const float* gm_v_norm; const float* gm_ws; const float* gm_b; const float* gm_out_norm;
    const float* mla_q_norm; const float* mla_w_uq; const float* mla_kv_norm; const float* mla_w_ukv; const float* mla_out_norm; const float* hg_lb_logits; const float* hg_out_norm;
    const float* w_out; const float* norm_ffn; const float* peer_w_q; const float* peer_sub_keys; const float* peer_u; const float* peer_v; const float* norm_final;
    float* out; unsigned char* ws;
    int ph_lo, ph_hi;
};

#define XB_TMO      128
#define XB_XCNT(j)  (256  + 64 * (j))
#define XB_XSUB(j)  (1280 + 64 * (j))
#define XB_XGEN(j)  (2304 + 64 * (j))
#define XB_TOP      3328
#define XB_TOPGEN   3392
#define XCD_BAR_WORDS 3456
#define XB_SPIN_CAP (1u << 20)
DI unsigned xb_ld(unsigned* p)              { return __hip_atomic_load(p, __ATOMIC_RELAXED, __HIP_MEMORY_SCOPE_AGENT); }
DI unsigned xb_add(unsigned* p, unsigned v) { return __hip_atomic_fetch_add(p, v, __ATOMIC_RELAXED, __HIP_MEMORY_SCOPE_AGENT); }
DI unsigned xb_xcc_id() { return (unsigned)__builtin_amdgcn_s_getreg((3 << 11) | 20) & 0xFu; }
#define XB_SPIN(cond, bar) do { unsigned _sp = 0; while (cond) { __builtin_amdgcn_s_sleep(1); \
    if ((++_sp & 255u) == 0u) { if (xb_ld(&(bar)[XB_TMO])) break; if (_sp > XB_SPIN_CAP) { atomicAdd(&(bar)[XB_TMO], 1u); break; } } } } while (0)
struct XcdBarrier { unsigned* bar; unsigned x; volatile LAS unsigned* st; int wv; };
DI XcdBarrier xcd_barrier_post(unsigned* bar, volatile LAS unsigned* st, int wv) {
    XcdBarrier b; b.bar = bar; b.x = xb_xcc_id(); b.st = st; b.wv = wv;
    if (mk_tid(wv) == 0) (void)xb_add(&bar[XB_XCNT(b.x)], 1u);
    return b;
}
DI void xcd_barrier_complete(unsigned* bar, unsigned x, unsigned& nloc, unsigned& nx) {
    const unsigned G = gridDim.x * gridDim.y * gridDim.z;
    unsigned sum, cnt, mine, sp = 0u;
    for (;;) {
        sum = 0u; cnt = 0u; mine = 0u;
#pragma unroll
        for (unsigned j = 0; j < 16; ++j) { const unsigned c = xb_ld(&bar[XB_XCNT(j)]); sum += c; cnt += (c > 0u) ? 1u : 0u; mine = (j == x) ? c : mine; }
        if (sum == G) break;
        __builtin_amdgcn_s_sleep(1);
        if ((++sp & 255u) == 0u) { if (xb_ld(&bar[XB_TMO])) break; if (sp > XB_SPIN_CAP) { atomicAdd(&bar[XB_TMO], 1u); break; } }
    }
    nloc = mine > 0u ? mine : 1u; nx = cnt > 0u ? cnt : 1u;
}
DI void xcd_barrier(const XcdBarrier& b) {
    asm volatile("s_waitcnt vmcnt(0)" ::: "memory");
    __syncthreads();
    if (mk_tid(b.wv) == 0) {
        unsigned* bar = b.bar;
        __builtin_amdgcn_s_waitcnt(0);
        unsigned nloc = b.st[0], nx = b.st[1];
        if (nloc == 0u) { xcd_barrier_complete(bar, b.x, nloc, nx); b.st[0] = nloc; b.st[1] = nx; }
        const unsigned old = xb_add(&bar[XB_XSUB(b.x)], 1u);
        const unsigned gen = old / nloc;
        if (old + 1u == (gen + 1u) * nloc) {
            __builtin_amdgcn_fence(__ATOMIC_RELEASE, "agent");
            asm volatile("s_waitcnt vmcnt(0)" ::: "memory");
            const unsigned og = xb_add(&bar[XB_TOP], 1u);
            const unsigned tg = og / nx;
            if (og + 1u == (tg + 1u) * nx) xb_add(&bar[XB_TOPGEN], 1u);
            else XB_SPIN(xb_ld(&bar[XB_TOPGEN]) == tg, bar);
            __builtin_amdgcn_fence(__ATOMIC_ACQUIRE, "agent");
            xb_add(&bar[XB_XGEN(b.x)], 1u);
            asm volatile("s_waitcnt vmcnt(0)" ::: "memory");
        } else {
            XB_SPIN(xb_ld(&bar[XB_XGEN(b.x)]) == gen, bar);
            __builtin_amdgcn_fence(__ATOMIC_ACQUIRE, "agent");
            asm volatile("s_waitcnt vmcnt(0)" ::: "memory");
        }
    }
    __syncthreads();
}

template <int MODE>
DI int srccol(int n) {
    if (MODE == 1) { return n < 928 ? n : (n < 1024 ? -1 : n - 96); }
    if (MODE == 2) { return n < 512 ? ((n >> 6) * 128 + (n & 63)) : (((n - 512) >> 6) * 128 + 64 + ((n - 512) & 63)); }
    return n;
}
template <int MODE>
DI void conv_tile(int t, const float* __restrict__ src, int ld_src, const float* __restrict__ gain, bfu* __restrict__ dst, int K, int n0, int k0, float* tile, int ksrc = 1 << 30) {
    float ld[8];
#pragma unroll
    for (int i = 0; i < 8; ++i) {
        const int kk = (t >> 6) + i * 8, nn = t & 63;
        const int sc = srccol<MODE>(n0 + nn);
        const int kr = k0 + kk < ksrc ? k0 + kk : 0;
        ld[i] = src[(size_t)kr * ld_src + (sc >= 0 ? sc : 0)] * (gain ? gain[kr] : 1.f);
    }
#pragma unroll
    for (int i = 0; i < 8; ++i) {
        const int kk = (t >> 6) + i * 8, nn = t & 63;
        const int sc = srccol<MODE>(n0 + nn);
        tile[kk * 65 + nn] = (sc >= 0 && k0 + kk < ksrc) ? ld[i] : 0.f;
    }
    __syncthreads();
#pragma unroll
    for (int i = 0; i < 8; ++i) {
        const int nn = (t >> 6) + i * 8, kk = t & 63;
        dst[(size_t)(n0 + nn) * K + k0 + kk] = f2bf(tile[kk * 65 + nn]);
    }
    __syncthreads();
}

DI void phase_prologue(const Params& p, LAS char* smem, int wv) {
    const int tid = mk_tid(wv), bid = blockIdx.x, nb = gridDim.x; smem = opql(smem);
    const int w = tid >> 6, lane = tid & 63;
    unsigned char* ws = opq(p.ws);
    {
        bfu* xb = (bfu*)(ws + WS_XB); float* ssp = (float*)(ws + WS_SSP);
        for (int t0 = (bid * 8 + w) * 4; t0 < T; t0 += nb * 8 * 4) {
            float4 xv[4][4];
#pragma unroll
            for (int q = 0; q < 4; ++q)
#pragma unroll
                for (int i = 0; i < 4; ++i) xv[q][i] = ((const float4*)(p.x + (size_t)(t0 + q) * DM))[i * 64 + lane];
#pragma unroll
            for (int q = 0; q < 4; ++q) { const int t = t0 + q;
                float ss = 0.f;
#pragma unroll
                for (int i = 0; i < 4; ++i) {
                    const float4 v = xv[q][i];
                    ss += v.x * v.x + v.y * v.y + v.z * v.z + v.w * v.w;
                    u32x2 o; o[0] = pk2(v.x, v.y); o[1] = pk2(v.z, v.w);
                    *(u32x2*)(xb + (size_t)t * DM + (i * 64 + lane) * 4) = o;
                }
                ss = wave_sum(ss);
                if (lane < 8) ssp[(size_t)t * 8 + lane] = lane == 0 ? ss : 0.f;
            }
        }
    }
    {
        float* tile = (float*)smem;
        for (int u = bid; u < NL * 1136; u += nb) {
            const int l = u / 1136; int r = u % 1136;
            unsigned char* wl = ws + WS_W + (size_t)l * WL_SIZE;
            if (r < 512) { conv_tile<1>(tid, p.w_in + (size_t)l * 1024 * 1952, 1952, p.norm_mix + l * 1024, (bfu*)(wl + WL_IN), 1024, (r >> 4) * 64, (r & 15) * 64, tile); continue; }
            r -= 512;
            if (r < 48) { conv_tile<0>(tid, p.mla_w_uq + (size_t)l * 256 * 768, 768, p.mla_q_norm + l * 256, (bfu*)(wl + WL_UQ), 256, (r >> 2) * 64, (r & 3) * 64, tile); continue; }
            r -= 48;
            if (r < 64) { conv_tile<2>(tid, p.mla_w_ukv + (size_t)l * 128 * 1024, 1024, p.mla_kv_norm + l * 128, (bfu*)(wl + WL_UKV), 256, (r >> 2) * 64, (r & 3) * 64, tile, 128); continue; }
            r -= 64;
            if (r < 256) { conv_tile<0>(tid, p.w_out + (size_t)l * 1024 * 1024, 1024, nullptr, (bfu*)(wl + WL_OUT), 1024, (r >> 4) * 64, (r & 15) * 64, tile); continue; }
            r -= 256;
            conv_tile<0>(tid, p.peer_w_q + (size_t)l * 1024 * 1024, 1024, p.norm_ffn + l * 1024, (bfu*)(wl + WL_Q), 1024, (r >> 4) * 64, (r & 15) * 64, tile);
        }
    }
    const size_t gtid = (size_t)bid * 512 + tid, gsz = (size_t)nb * 512;
    for (size_t e = gtid; e < (size_t)NL * 16 * 128 * 64; e += gsz) {
        const int l = (int)(e / (16 * 128 * 64)); const size_t r = e % (16 * 128 * 64);
        ((bfu*)(ws + WS_W + (size_t)l * WL_SIZE + WL_SK))[r] = f2bf(p.peer_sub_keys[e]);
    }
    for (size_t e = gtid; e < (size_t)NL * 4 * 128 * 128; e += gsz) {
        const int l = (int)(e / (4 * 128 * 128)); const size_t r = e % (4 * 128 * 128);
        const int tt = (int)((r >> 7) & 127), s = (int)(r & 127);
        ((bfu*)(ws + WS_W + (size_t)l * WL_SIZE + WL_GM))[r] = f2bf(s <= tt ? p.gm_ws[e] : 0.f);
    }
    {
        const int nrows = NL * NEXP;
        for (int rr0 = (bid * 8 + w) * 4; rr0 < 2 * nrows; rr0 += nb * 8 * 4) {
            f32x4 v[4][4];
#pragma unroll
            for (int q = 0; q < 4; ++q) { const int rr = rr0 + q; const int tab = rr >= nrows, row = tab ? rr - nrows : rr;
                const float* src = (tab ? p.peer_v : p.peer_u) + (size_t)row * DM;
#pragma unroll
                for (int i = 0; i < 4; ++i) v[q][i] = *(const f32x4*)(src + 256 * i + 4 * lane); }
#pragma unroll
            for (int q = 0; q < 4; ++q) { const int rr = rr0 + q; const int tab = rr >= nrows, row = tab ? rr - nrows : rr;
                float am = 0.f;
#pragma unroll
                for (int i = 0; i < 4; ++i) am = fmaxf(am, fmaxf(fmaxf(fabsf(v[q][i][0]), fabsf(v[q][i][1])), fmaxf(fabsf(v[q][i][2]), fabsf(v[q][i][3]))));
                am = rdlane_f(dpp_max63(am), 63);
                const bool i8 = !tab;
                const float qmax = i8 ? 127.f : 440.f;
                const float sc = am > 0.f ? qmax / am : 0.f;
                u32x4 o;
#pragma unroll
                for (int i = 0; i < 4; ++i) {
                    if (i8) o[i] = pack_i8x4(v[q][i][0] * sc, v[q][i][1] * sc, v[q][i][2] * sc, v[q][i][3] * sc);
                    else { int wd = 0; wd = __builtin_amdgcn_cvt_pk_fp8_f32(v[q][i][0] * sc, v[q][i][1] * sc, wd, false); wd = __builtin_amdgcn_cvt_pk_fp8_f32(v[q][i][2] * sc, v[q][i][3] * sc, wd, true); o[i] = (unsigned)wd; }
                }
                const int ly = row / NEXP, rw = row % NEXP;
                *(u32x4*)(ws + (tab ? WS_TABV : WS_TABU) + (size_t)ly * NEXP * DM + (size_t)(lane >> 3) * NEXP * 128 + (size_t)rw * 128 + 16 * (lane & 7)) = o;
                if (lane == 0) ((float*)(ws + (tab ? WS_SCV : WS_SCU)))[row] = am / qmax;
            }
        }
    }
    {
        float* ct = (float*)(ws + WS_COS); float* st = (float*)(ws + WS_SIN);
        for (size_t e = gtid; e < (size_t)T * 16; e += gsz) {
            const int t = (int)(e >> 4), i = (int)(e & 15);
            const float inv = expf(-9.210340371976184f * (float)i * (1.f / 16.f));
            const float ang = (float)p.pos[t] * inv;
            const float kq = rintf(ang * 0.15915494309189535f);
            float rr = fmaf(-kq, 6.2831854820251465f, ang); rr = fmaf(-kq, -1.7484555e-7f, rr);
            ct[e] = __cosf(rr); st[e] = __sinf(rr);
        }
    }
    {
        float* sp = (float*)(ws + WS_SP);
        for (int e = (int)gtid; e < NL * SP_STRIDE + 1024; e += (int)gsz) {
            float v = 0.f;
            if (e >= SP_FIN) v = p.norm_final[e - SP_FIN];
            else { const int l = e / SP_STRIDE, r = e % SP_STRIDE;
                if (r < SP_GMB) v = p.gm_v_norm[l * 256 + r];
                else if (r < SP_GMO) v = p.gm_b[l * 512 + r - SP_GMB];
                else if (r < SP_MLO) v = p.gm_out_norm[l * 256 + r - SP_GMO];
                else if (r < SP_HGO) v = p.mla_out_norm[l * 512 + r - SP_MLO];
                else if (r < SP_NFF) v = p.hg_out_norm[l * 256 + r - SP_HGO];
                else if (r < SP_NFF + 1024) v = p.norm_ffn[l * 1024 + r - SP_NFF]; }
            sp[e] = v;
        }
    }
    if (bid == 0 && tid < 256) {
        float lg[NL], mx = -1e30f;
#pragma unroll
        for (int l = 0; l < NL; ++l) { lg[l] = p.hg_lb_logits[l * 256 + tid]; mx = fmaxf(mx, lg[l]); }
        float sum = 0.f; for (int l = 0; l < NL; ++l) { lg[l] = expf(lg[l] - mx); sum += lg[l]; }
        float cum = 0.f; const float p0 = lg[0] / sum;
        for (int l = 0; l < NL; ++l) { cum += lg[l] / sum; ((float*)(ws + WS_LB))[l * 256 + tid] = cum - p0; }
    }
}

constexpr int BM = 256, BK = 64, HALF = 128, HTB = HALF * BK * 2, STAGE_BYTES = 8 * HTB;
constexpr int LDS_RS = STAGE_BYTES;
constexpr int LDS_TOTAL = 163840;
constexpr int LDS_BAR = LDS_TOTAL - 16;
DI int lds_byte(int r, int c) { const int st = (r >> 4) * 2 + (c >> 5), rr = r & 15, cc = c & 31, ob = rr * 64 + cc * 2; return st * 1024 + (ob ^ (((ob >> 9) & 1) << 5)); }
DI void stage_rc(int b, int& R, int& C) { const int st = b / 1024, sb = b % 1024, swz = sb ^ (((sb >> 9) & 1) << 5); R = (st >> 1) * 16 + swz / 64; C = (st & 1) * 32 + (swz % 64) / 2; }
DI int perm32(int rho) { const int n = rho >> 4, i = rho & 15; return 8 * (i >> 2) + 4 * n + (i & 3); }
struct Unit { int pm, pn, idx; };
struct Gemm { const bfu* A; const bfu* Bt; int lda, ldb, K; };
struct XSched {
    int nN, nunits, G, c, wv;
    DI bool next(int i, Unit& u) const { const int L = i * G + c; if (L >= nunits) return false; const int xcd = L & 7, slot = L >> 3; u.pm = (slot / nN) * 8 + xcd; u.pn = slot % nN; u.idx = i; return true; }
    DI void a_ready(const Unit&) const {}
    DI void done(const Unit&) const {}
};
template <class Epi, class Sched, bool STAMP = false>
DI void gemm_phase(LAS unsigned char* lds, const Gemm g, const Sched& S, const Epi& E, unsigned long long* stamps = nullptr) {
    int tid_ = mk_tid(S.wv);
    const int tid = tid_, wid = __builtin_amdgcn_readfirstlane(tid >> 6), lane = tid & 63, wr = wid >> 2, wc = wid & 3, fr = lane & 15, fq = lane >> 4;
    const int K = g.K, nt = K / BK, lda = g.lda, ldb = g.ldb;
    int ts_lo = 0, ts_hi = 0, nts = 0; const unsigned long long rt_entry = STAMP ? (unsigned long long)wall_clock64() : 0ull;
#define PG8_STAMP() do { if (STAMP && wid == 0 && nts < 64) { const unsigned long long _c = (unsigned long long)clock64(); \
        ts_lo = (lane == nts) ? (int)(unsigned)_c : ts_lo; ts_hi = (lane == nts) ? (int)(unsigned)(_c >> 32) : ts_hi; ++nts; } } while (0)
    PG8_STAMP();
    unsigned voffA[2], voffB[2];
#pragma unroll
    for (int i = 0; i < 2; ++i) { int R, C; stage_rc(tid * 16 + i * 8192, R, C); const int Rb = Epi::PERM ? ((R & ~31) + perm32(R & 31)) : R;
        voffA[i] = (unsigned)(R * lda + C) * 2u; voffB[i] = (unsigned)(Rb * ldb + C) * 2u; }
    const size_t kstep = (size_t)(BK * 2);
    const size_t hstepA = (size_t)HALF * lda * 2, hstepB = (size_t)HALF * ldb * 2;
    const size_t tstepA = 2 * hstepA, tstepB = 2 * hstepB;
    const unsigned ldsw = (unsigned)wid * 1024u;
    const int aoff = lds_byte(wr * 64 + fr, fq * 8), boff = lds_byte(wc * 32 + fr, fq * 8);
#define PG8_SA(b, h) (((b) * 2 + (h)) * HTB)
#define PG8_SB(b, h) ((4 + (b) * 2 + (h)) * HTB)
#define PG8_STAGE(bufoff, gbase, voff) do { _Pragma("unroll") for (int _i = 0; _i < 2; ++_i) \
        __builtin_amdgcn_global_load_lds((const unsigned*)((const char*)(gbase) + (voff)[_i]), (LAS unsigned*)(lds + (bufoff) + ldsw + _i * 8192), 16, 0, 0); } while (0)
#define PG8_LDA(dst, b, h) do { _Pragma("unroll") for (int m = 0; m < 4; ++m) _Pragma("unroll") for (int k = 0; k < 2; ++k) dst[m][k] = *(const LAS bf16x8*)(lds + PG8_SA(b, h) + aoff + m * 2048 + k * 1024); } while (0)
#define PG8_LDB(dst, b, h) do { _Pragma("unroll") for (int n = 0; n < 2; ++n) _Pragma("unroll") for (int k = 0; k < 2; ++k) dst[n][k] = *(const LAS bf16x8*)(lds + PG8_SB(b, h) + boff + n * 2048 + k * 1024); } while (0)
#define PG8_MMA(ai, bj, At, Bt) do { __builtin_amdgcn_s_setprio(1); _Pragma("unroll") for (int m = 0; m < 4; ++m) _Pragma("unroll") for (int n = 0; n < 2; ++n) _Pragma("unroll") for (int k = 0; k < 2; ++k) \
        acc[ai][bj][m][n] = __builtin_amdgcn_mfma_f32_16x16x32_bf16(Bt[n][k], At[m][k], acc[ai][bj][m][n], 0, 0, 0); __builtin_amdgcn_s_setprio(0); } while (0)
#define PG8_WAIT_V(n) asm volatile("s_waitcnt vmcnt(" #n ")" ::: "memory")
#define PG8_WAIT_L(n) asm volatile("s_waitcnt lgkmcnt(" #n ")" ::: "memory")
#define PG8_BAR __builtin_amdgcn_s_barrier()
#define PG8_SCHED __builtin_amdgcn_sched_barrier(0)
    Unit cur, nxt; int ui = 0;
    if (!S.next(0, cur)) return;
    f32x4 acc[2][2][4][2]; { const f32x4 zz = zero4_opaque();
#pragma unroll
    for (int a = 0; a < 2; ++a)
#pragma unroll
        for (int b = 0; b < 2; ++b)
#pragma unroll
            for (int m = 0; m < 4; ++m)
#pragma unroll
                for (int n = 0; n < 2; ++n) acc[a][b][m][n] = zz; }
    bf16x8 At[4][2], B0[2][2], B1[2][2];
    const char* cA = (const char*)g.A + (size_t)cur.pm * tstepA; const char* cB = (const char*)g.Bt + (size_t)cur.pn * tstepB;
    S.a_ready(cur);
    PG8_STAGE(PG8_SB(0, 0), cB, voffB); PG8_STAGE(PG8_SA(0, 0), cA, voffA); PG8_STAGE(PG8_SB(0, 1), cB + hstepB, voffB); PG8_STAGE(PG8_SA(0, 1), cA + hstepA, voffA);
    if (wr == 1) PG8_BAR;
    PG8_WAIT_V(4); PG8_BAR;
    PG8_STAGE(PG8_SB(1, 0), cB + kstep, voffB); PG8_STAGE(PG8_SA(1, 0), cA + kstep, voffA); PG8_STAGE(PG8_SB(1, 1), cB + hstepB + kstep, voffB);
    PG8_WAIT_V(6); PG8_BAR;
    PG8_STAMP();
    for (;;) {
        const bool has_next = S.next(ui + 1, nxt);
        const char* nA = has_next ? (const char*)g.A + (size_t)nxt.pm * tstepA : cA; const char* nB = has_next ? (const char*)g.Bt + (size_t)nxt.pn * tstepB : cB;
        for (int t = 0; t < nt; t += 2) {
            const bool last = (t == nt - 2);
            const char* a1 = cA + (size_t)(t + 1) * kstep;
            const char* a2 = last ? nA : cA + (size_t)(t + 2) * kstep; const char* b2 = last ? nB : cB + (size_t)(t + 2) * kstep;
            const char* a3 = a2 + kstep; const char* b3 = b2 + kstep;
            if (last && has_next) S.a_ready(nxt);
            PG8_LDB(B0, 0, 0); PG8_SCHED; PG8_LDA(At, 0, 0); PG8_STAGE(PG8_SA(1, 1), a1 + hstepA, voffA);
            PG8_WAIT_L(8); PG8_BAR; PG8_WAIT_L(0); PG8_MMA(0, 0, At, B0); PG8_BAR; PG8_SCHED;
            PG8_LDB(B1, 0, 1); PG8_STAGE(PG8_SB(0, 0), b2, voffB);
            PG8_BAR; PG8_WAIT_L(0); PG8_MMA(0, 1, At, B1); PG8_BAR;
            PG8_LDA(At, 0, 1); PG8_STAGE(PG8_SA(0, 0), a2, voffA);
            PG8_BAR; PG8_WAIT_L(0); PG8_MMA(1, 0, At, B0); PG8_BAR; PG8_SCHED;
            PG8_STAGE(PG8_SB(0, 1), b2 + hstepB, voffB);
            PG8_WAIT_V(6); PG8_BAR; PG8_MMA(1, 1, At, B1); PG8_BAR;
            PG8_LDB(B0, 1, 0); PG8_SCHED; PG8_LDA(At, 1, 0); PG8_STAGE(PG8_SA(0, 1), a2 + hstepA, voffA);
            PG8_WAIT_L(8); PG8_BAR; PG8_WAIT_L(0); PG8_MMA(0, 0, At, B0); PG8_BAR; PG8_SCHED;
            PG8_LDB(B1, 1, 1); PG8_STAGE(PG8_SB(1, 0), b3, voffB);
            PG8_BAR; PG8_WAIT_L(0); PG8_MMA(0, 1, At, B1); PG8_BAR;
            PG8_LDA(At, 1, 1); PG8_STAGE(PG8_SA(1, 0), a3, voffA);
            PG8_BAR; PG8_WAIT_L(0); PG8_MMA(1, 0, At, B0); PG8_BAR; PG8_SCHED;
            PG8_STAGE(PG8_SB(1, 1), b3 + hstepB, voffB);
            PG8_WAIT_V(6); PG8_BAR; PG8_MMA(1, 1, At, B1); PG8_BAR;
        }
        PG8_STAMP();
        if constexpr (!Epi::AFTER_DRAIN) { E(acc, cur, wr, wc, fr, fq); S.done(cur); }
        PG8_STAMP();
        if (!has_next) break;
        { const f32x4 zz = zero4_opaque();
#pragma unroll
        for (int a = 0; a < 2; ++a)
#pragma unroll
            for (int b = 0; b < 2; ++b)
#pragma unroll
                for (int m = 0; m < 4; ++m)
#pragma unroll
                    for (int n = 0; n < 2; ++n) acc[a][b][m][n] = zz; }
        cur = nxt; cA = nA; cB = nB; ++ui;
    }
    PG8_WAIT_V(0);
    if (wr == 0) PG8_BAR;
    PG8_BAR;
    if constexpr (Epi::AFTER_DRAIN) { E.fused(acc, cur, wr, wc, fr, fq, lds, wid, lane); S.done(cur); }
    PG8_STAMP();
    if (STAMP && wid == 0) { stamps[lane] = lane < nts ? (((unsigned long long)(unsigned)ts_hi << 32) | (unsigned)ts_lo) : 0ull;
        if (lane == 62) stamps[62] = rt_entry; if (lane == 63) stamps[63] = (unsigned long long)wall_clock64(); }
#undef PG8_STAMP
#undef PG8_SA
#undef PG8_SB
#undef PG8_STAGE
#undef PG8_LDA
#undef PG8_LDB
#undef PG8_MMA
#undef PG8_WAIT_V
#undef PG8_WAIT_L
#undef PG8_BAR
#undef PG8_SCHED
}

template <int NC>
DI void rows_rstd_lds(const bfu* __restrict__ A, int lda, int brow, LAS float* rs, int wv, float* gout = nullptr) {
    int tid = mk_tid(wv);
    const int w = tid >> 6, lane = tid & 63;
    if constexpr (NC == 1024) {
        for (int i0 = 0; i0 < 32; i0 += 8) {
            u32x4 va[8], vb[8];
#pragma unroll
            for (int i = 0; i < 8; ++i) { const bfu* row = A + (size_t)(brow + w * 32 + i0 + i) * lda; va[i] = *(const u32x4*)(row + lane * 8); vb[i] = *(const u32x4*)(row + 512 + lane * 8); }
#pragma unroll
            for (int i = 0; i < 8; ++i) {
                float ss = 0.f;
#pragma unroll
                for (int j = 0; j < 4; ++j) { const float x0 = bflo(va[i][j]), x1 = bfhi(va[i][j]), y0 = bflo(vb[i][j]), y1 = bfhi(vb[i][j]); ss += x0 * x0 + x1 * x1 + y0 * y0 + y1 * y1; }
                ss = rdlane_f(dpp_sum63(ss), 63);
                const int r = w * 32 + i0 + i;
                if (lane == 0) { const float rv = rsqrtf(ss * (1.f / NC) + EPS); rs[r] = rv; if (gout) gout[brow + r] = rv; }
            }
        }
    } else {
        constexpr int PER = NC / 64;
        for (int i0 = 0; i0 < 32; i0 += 16) {
            u32x2 v[16];
#pragma unroll
            for (int i = 0; i < 16; ++i) { const bfu* row = A + (size_t)(brow + w * 32 + i0 + i) * lda;
                if constexpr (PER == 4) v[i] = *(const u32x2*)(row + lane * 4); else { v[i][0] = *(const unsigned*)(row + lane * 2); v[i][1] = 0u; } }
#pragma unroll
            for (int i = 0; i < 16; ++i) {
                const float x0 = bflo(v[i][0]), x1 = bfhi(v[i][0]), y0 = bflo(v[i][1]), y1 = bfhi(v[i][1]);
                const float ss = rdlane_f(dpp_sum63(x0 * x0 + x1 * x1 + y0 * y0 + y1 * y1), 63);
                const int r = w * 32 + i0 + i;
                if (lane == 0) { const float rv = rsqrtf(ss * (1.f / NC) + EPS); rs[r] = rv; if (gout) gout[brow + r] = rv; }
            }
        }
    }
}
DI u32x2 pack4(f32x4 v) { u32x2 o; o[0] = pk2(v[0], v[1]); o[1] = pk2(v[2], v[3]); return o; }

DI void rope_perm(f32x4& a, f32x4& b, const float* ct, const float* st, size_t row, int fq) {
    const int i0 = 8 * (fq & 1);
    const f32x4 c0 = *(const f32x4*)(ct + row * 16 + i0), c1 = *(const f32x4*)(ct + row * 16 + i0 + 4), s0 = *(const f32x4*)(st + row * 16 + i0), s1 = *(const f32x4*)(st + row * 16 + i0 + 4);
    f32x4 pa, pb;
#pragma unroll
    for (int j = 0; j < 4; ++j) { pa[j] = swap32(a[j]); pb[j] = swap32(b[j]); }
    const float sg = fq < 2 ? -1.f : 1.f;
    a = a * c0 + pa * s0 * sg; b = b * c1 + pb * s1 * sg;
}
struct EpiProj {
    static constexpr bool PERM = true, AFTER_DRAIN = false;
    const float* rs; bfu* out; const float* ct; const float* st;
    DI void operator()(const f32x4 (&acc)[2][2][4][2], const Unit& u, int wr, int wc, int fr_, int fq_) const {
        int tz = mk_tid(wr * 4 + wc); const int fr = tz & 15, fq = (tz >> 4) & 3;
        const int row0 = u.pm * BM + wr * 64 + fr, colg = u.pn * BM + wc * 32;
        float sv[2][4];
        { f32x4 q0[2][4], q1[2][4];
#pragma unroll
          for (int ai = 0; ai < 2; ++ai)
#pragma unroll
            for (int m = 0; m < 4; ++m) { const int row = row0 + ai * HALF + m * 16; q0[ai][m] = *(const f32x4*)(rs + (size_t)row * 8); q1[ai][m] = *(const f32x4*)(rs + (size_t)row * 8 + 4); }
#pragma unroll
          for (int ai = 0; ai < 2; ++ai)
#pragma unroll
            for (int m = 0; m < 4; ++m) sv[ai][m] = rsqrtf((((q0[ai][m][0] + q0[ai][m][1]) + (q0[ai][m][2] + q0[ai][m][3])) + ((q1[ai][m][0] + q1[ai][m][1]) + (q1[ai][m][2] + q1[ai][m][3]))) * (1.f / DM) + EPS); }
#pragma unroll
        for (int ai = 0; ai < 2; ++ai)
#pragma unroll
            for (int m = 0; m < 4; ++m) {
                const int row = row0 + ai * HALF + m * 16; const float s = sv[ai][m];
#pragma unroll
                for (int bj = 0; bj < 2; ++bj) {
                    const int cg = colg + bj * HALF;
                    f32x4 a = acc[ai][bj][m][0] * s, b = acc[ai][bj][m][1] * s;
                    if (cg == PC_KR) rope_perm(a, b, ct, st, (size_t)row, fq);
                    u32x4 w4; w4[0] = pk2(a[0], a[1]); w4[1] = pk2(a[2], a[3]); w4[2] = pk2(b[0], b[1]); w4[3] = pk2(b[2], b[3]);
                    *(u32x4*)(out + (size_t)row * PW + cg + 8 * fq) = w4;
                }
            }
    }
};
template <bool ROPE>
struct EpiScaled {
    static constexpr bool PERM = true, AFTER_DRAIN = false;
    const LAS float* rs; bfu* out; int ld; const float* ct; const float* st; float scale;
    DI void operator()(const f32x4 (&acc)[2][2][4][2], const Unit& u, int wr, int wc, int fr_, int fq_) const {
        int tz = mk_tid(wr * 4 + wc); const int fr = tz & 15, fq = (tz >> 4) & 3;
        const int lrow0 = wr * 64 + fr, colg = u.pn * BM + wc * 32;
#pragma unroll
        for (int ai = 0; ai < 2; ++ai)
#pragma unroll
            for (int m = 0; m < 4; ++m) {
                const int lrow = lrow0 + ai * HALF + m * 16; const int row = u.pm * BM + lrow; const float s = rs[u.idx * 256 + lrow] * scale;
#pragma unroll
                for (int bj = 0; bj < 2; ++bj) {
                    const int cg = colg + bj * HALF;
                    f32x4 a = acc[ai][bj][m][0] * s, b = acc[ai][bj][m][1] * s;
                    if constexpr (ROPE) { if (((cg >> 5) % 3) == 2) rope_perm(a, b, ct, st, (size_t)row, fq); }
                    u32x4 w4; w4[0] = pk2(a[0], a[1]); w4[1] = pk2(a[2], a[3]); w4[2] = pk2(b[0], b[1]); w4[3] = pk2(b[2], b[3]);
                    *(u32x4*)(out + (size_t)row * ld + cg + 8 * fq) = w4;
                }
            }
    }
};
struct EpiResid {
    static constexpr bool PERM = true, AFTER_DRAIN = false;
    bfu* x;
    DI void operator()(const f32x4 (&acc)[2][2][4][2], const Unit& u, int wr, int wc, int fr_, int fq_) const {
        int tz = mk_tid(wr * 4 + wc); const int fr = tz & 15, fq = (tz >> 4) & 3;
        const int row0 = u.pm * BM + wr * 64 + fr, colg = u.pn * BM + wc * 32 + 8 * fq;
#pragma unroll
        for (int ai = 0; ai < 2; ++ai) {
            u32x4 old[4][2];
#pragma unroll
            for (int m = 0; m < 4; ++m)
#pragma unroll
                for (int bj = 0; bj < 2; ++bj) old[m][bj] = *(const u32x4*)(x + (size_t)(row0 + ai * HALF + m * 16) * DM + colg + bj * HALF);
#pragma unroll
            for (int m = 0; m < 4; ++m)
#pragma unroll
                for (int bj = 0; bj < 2; ++bj) {
                    const u32x4 od = old[m][bj]; const f32x4 v0 = acc[ai][bj][m][0], v1 = acc[ai][bj][m][1];
                    u32x4 o; o[0] = pk2(bflo(od[0]) + v0[0], bfhi(od[0]) + v0[1]); o[1] = pk2(bflo(od[1]) + v0[2], bfhi(od[1]) + v0[3]);
                    o[2] = pk2(bflo(od[2]) + v1[0], bfhi(od[2]) + v1[1]); o[3] = pk2(bflo(od[3]) + v1[2], bfhi(od[3]) + v1[3]);
                    *(u32x4*)(x + (size_t)(row0 + ai * HALF + m * 16) * DM + colg + bj * HALF) = o;
                }
        }
    }
};

constexpr int AT_KS = 208;
constexpr int AT_VS = 192;
constexpr int AT_KB = 64 * AT_KS, AT_VB = 64 * AT_VS, AT_BUF = AT_KB + AT_VB;

DI void attn_unit(const Params& p, unsigned char* ws, int l, int b, int h, int qt, LAS char* smem, int tid) {
    const int w = tid >> 6, lane = tid & 63, r = lane & 31, hh = lane >> 5;
    const bfu* Q = (const bfu*)(ws + WS_Q); const bfu* KV = (const bfu*)(ws + WS_KV); const bfu* PR = (const bfu*)(ws + WS_PROJ);
    const size_t tok0 = (size_t)b * SEQ;
    const int q0 = qt * 256 + w * 32;
    bf16x8 qf[6];
    { const bfu* qrow = Q + (tok0 + q0 + r) * 768 + h * 96 + 8 * hh;
#pragma unroll
      for (int ks = 0; ks < 6; ++ks) qf[ks] = *(const bf16x8*)(qrow + 16 * ks); }
    f32x16 o0 = zero16(), o1 = zero16();
    float mrun = -1e30f, lsum = 0.f;
    const int nkt = qt * 4 + 4, my_last = qt * 4 + (w >> 1);
    const int skey = tid >> 3, sch = tid & 7, rkey = (tid & 255) >> 2, rch = tid & 3;
    u32x4 gk, gv, gr;
    auto gload = [&](int kt) {
        const size_t t1 = tok0 + (size_t)kt * 64 + skey;
        gk = *(const u32x4*)(KV + t1 * 1024 + h * 64 + sch * 8);
        gv = *(const u32x4*)(KV + t1 * 1024 + 512 + h * 64 + sch * 8);
        if (tid < 256) gr = *(const u32x4*)(PR + (tok0 + (size_t)kt * 64 + rkey) * PW + PC_KR + rch * 8);
    };
    auto lstore = [&](int buf) {
        LAS char* kb = smem + buf * AT_BUF; LAS char* vb = kb + AT_KB;
        *(LAS u32x4*)(kb + skey * AT_KS + sch * 16) = gk;
        *(LAS u32x4*)(vb + skey * AT_VS + sch * 16) = gv;
        if (tid < 256) *(LAS u32x4*)(kb + rkey * AT_KS + 128 + rch * 16) = gr;
    };
    gload(0);
    __syncthreads();
    lstore(0);
    __syncthreads();
    const int i16 = lane & 15, q4 = i16 >> 2, p4 = i16 & 3, blk = (lane >> 4) & 1;
    for (int kt = 0; kt < nkt; ++kt) {
        const int cur = kt & 1;
        if (kt + 1 < nkt) gload(kt + 1);
        auto tile = [&](auto maskc) {
            constexpr bool MASK = decltype(maskc)::value;
            const LAS char* kb = smem + cur * AT_BUF; const LAS char* vb = kb + AT_KB;
            f32x16 s0 = zero16(), s1 = zero16();
#pragma unroll
            for (int ks = 0; ks < 6; ++ks) {
                const bf16x8 a0 = *(const LAS bf16x8*)(kb + r * AT_KS + ks * 32 + hh * 16);
                const bf16x8 a1 = *(const LAS bf16x8*)(kb + (32 + r) * AT_KS + ks * 32 + hh * 16);
                s0 = mfma32(a0, qf[ks], s0); s1 = mfma32(a1, qf[ks], s1);
            }
            if constexpr (MASK) {
                const int qa = q0 + r, kbase = kt * 64 + 4 * hh;
#pragma unroll
                for (int i = 0; i < 16; ++i) { const int kk = kbase + (i & 3) + 8 * (i >> 2); if (kk > qa) s0[i] = -1e30f; if (kk + 32 > qa) s1[i] = -1e30f; }
            }
            float mx = s0[0];
#pragma unroll
            for (int i = 1; i < 16; ++i) mx = fmaxf(mx, s0[i]);
#pragma unroll
            for (int i = 0; i < 16; ++i) mx = fmaxf(mx, s1[i]);
            mx = fmaxf(mx, swap32(mx));
            const float mnew = fmaxf(mrun, mx);
            if (__any(mnew > mrun)) {
                const float alpha = __builtin_amdgcn_exp2f(mrun - mnew);
                lsum *= alpha;
#pragma unroll
                for (int i = 0; i < 16; ++i) { o0[i] *= alpha; o1[i] *= alpha; }
                mrun = mnew;
            }
            float ps = 0.f;
#pragma unroll
            for (int i = 0; i < 16; ++i) { s0[i] = __builtin_amdgcn_exp2f(s0[i] - mrun); s1[i] = __builtin_amdgcn_exp2f(s1[i] - mrun); ps += s0[i] + s1[i]; }
            lsum += ps;
#pragma unroll
            for (int kk = 0; kk < 2; ++kk)
#pragma unroll
                for (int s = 0; s < 2; ++s) {
                    const bf16x8 pf = pack8(kk == 0 ? s0 : s1, s);
                    const int key0 = 32 * kk + 16 * s + 4 * hh + q4;
#pragma unroll
                    for (int vt = 0; vt < 2; ++vt) {
                        const LAS char* a = vb + key0 * AT_VS + (32 * vt + 16 * blk) * 2 + 8 * p4;
                        const bf16x8 vf = cat4(ldtr(a), ldtr(a + 8 * AT_VS));
                        if (vt == 0) o0 = mfma32(vf, pf, o0); else o1 = mfma32(vf, pf, o1);
                    }
                }
        };
        if (kt < my_last) tile(std::false_type{});
        else if (kt == my_last) tile(std::true_type{});
        if (kt + 1 < nkt) lstore(cur ^ 1);
        __syncthreads();
    }
    const float ltot = lsum + swap32(lsum);
    const float inv = 1.f / ltot;
    float ss = 0.f;
#pragma unroll
    for (int i = 0; i < 16; ++i) { o0[i] *= inv; o1[i] *= inv; ss += o0[i] * o0[i] + o1[i] * o1[i]; }
    ss += swap32(ss);
    const float rstd = rsqrtf(ss * (1.f / 64.f) + EPS);
    const float* gain = (const float*)(ws + WS_SP) + l * SP_STRIDE + SP_MLO + h * 64;
    bfu* yrow = (bfu*)(ws + WS_YCAT) + (tok0 + q0 + r) * 1024 + 256 + h * 64;
#pragma unroll
    for (int vt = 0; vt < 2; ++vt)
#pragma unroll
        for (int g = 0; g < 4; ++g) {
            const int v0 = 32 * vt + 8 * g + 4 * hh;
            const f32x4 gn = *(const f32x4*)(gain + v0);
            f32x4 ov;
#pragma unroll
            for (int i = 0; i < 4; ++i) ov[i] = (vt == 0 ? o0[4 * g + i] : o1[4 * g + i]) * rstd * gn[i];
            *(u32x2*)(yrow + v0) = pack4(ov);
        }
}

DI void attn_phase(const Params& p, int l, LAS char* smem, int wv) {
    int tid = mk_tid(wv); smem = opql(smem);
    unsigned char* ws = opq(p.ws);
    for (int pi = blockIdx.x; pi < 512; pi += gridDim.x) {
        const int bh = pi >> 2, j = pi & 3;
        attn_unit(p, ws, l, bh >> 3, bh & 7, 7 - j, smem, tid);
        attn_unit(p, ws, l, bh >> 3, bh & 7, j, smem, tid);
    }
}

constexpr int GM_VS = 576;

DI void gmlp_phase(const Params& p, int l, LAS char* smem, int wv) {
    int tid = mk_tid(wv); smem = opql(smem);
    const int w = tid >> 6, lane = tid & 63, r = lane & 31, hh = lane >> 5;
    unsigned char* ws = opq(p.ws);
    const bfu* PR = (const bfu*)(ws + WS_PROJ);
    bfu* YC = (bfu*)(ws + WS_YCAT);
    const bfu* WC = (const bfu*)(ws + WS_W + (size_t)l * WL_SIZE + WL_GM);
    for (int c = blockIdx.x; c < T / 128; c += gridDim.x) {
        const size_t tok0 = (size_t)c * 128;
        __syncthreads();
        {
            const f32x4 gn = *(const f32x4*)((const float*)(ws + WS_SP) + l * SP_STRIDE + SP_GMV + lane * 4);
            u32x2 vraw[16];
#pragma unroll
            for (int i = 0; i < 16; ++i) vraw[i] = *(const u32x2*)(PR + (tok0 + w * 16 + i) * PW + PC_V + lane * 4);
#pragma unroll
            for (int i = 0; i < 16; ++i) {
                const int s = w * 16 + i;
                const u32x2 raw = vraw[i];
                f32x4 v; v[0] = geluf(bflo(raw[0])); v[1] = geluf(bfhi(raw[0])); v[2] = geluf(bflo(raw[1])); v[3] = geluf(bfhi(raw[1]));
                float ss = v[0] * v[0] + v[1] * v[1] + v[2] * v[2] + v[3] * v[3];
                ss = sum16(ss);
                const float rstd = rsqrtf(ss * (1.f / 64.f) + EPS);
                f32x4 o; for (int j = 0; j < 4; ++j) o[j] = v[j] * rstd * gn[j];
                *(LAS u32x2*)(smem + s * GM_VS + lane * 8) = pack4(o);
            }
        }
        __syncthreads();
        const int h = w >> 1, th = w & 1;
        const int i16 = lane & 15, q4 = i16 >> 2, p4 = i16 & 3, blk = (lane >> 4) & 1;
        f32x16 acc[2][2];
#pragma unroll
        for (int a = 0; a < 2; ++a)
#pragma unroll
            for (int b2 = 0; b2 < 2; ++b2) acc[a][b2] = zero16();
        const bfu* wrow = WC + ((size_t)h * 128 + 64 * th + r) * 128 + 8 * hh;
#pragma unroll
        for (int ks = 0; ks < 8; ++ks) {
            bf16x8 af[2];
#pragma unroll
            for (int mt = 0; mt < 2; ++mt) {
                const LAS char* a = smem + (16 * ks + 8 * hh + q4) * GM_VS + (h * 64 + 32 * mt + 16 * blk) * 2 + 8 * p4;
                af[mt] = cat4(ldtr(a), ldtr(a + 4 * GM_VS));
            }
#pragma unroll
            for (int nt = 0; nt < 2; ++nt) {
                if (ks <= 4 * th + 2 * nt + 1) {
                    const bf16x8 bfr = *(const bf16x8*)(wrow + (size_t)nt * 32 * 128 + 16 * ks);
                    acc[0][nt] = mfma32(af[0], bfr, acc[0][nt]); acc[1][nt] = mfma32(af[1], bfr, acc[1][nt]);
                }
            }
        }
        const float* og = (const float*)(ws + WS_SP) + l * SP_STRIDE + SP_GMO + h * 64;
#pragma unroll
        for (int nt = 0; nt < 2; ++nt) {
            const int tl = 64 * th + 32 * nt + r;
            const float bv = ((const float*)(ws + WS_SP))[l * SP_STRIDE + SP_GMB + h * 128 + tl];
            const bfu* urow = PR + (tok0 + tl) * PW + PC_U + h * 64;
            f32x4 y[2][4]; float ss = 0.f;
#pragma unroll
            for (int mt = 0; mt < 2; ++mt)
#pragma unroll
                for (int g = 0; g < 4; ++g) {
                    const int d0 = 32 * mt + 8 * g + 4 * hh;
                    const u32x2 raw = *(const u32x2*)(urow + d0);
                    f32x4 u; u[0] = geluf(bflo(raw[0])); u[1] = geluf(bfhi(raw[0])); u[2] = geluf(bflo(raw[1])); u[3] = geluf(bfhi(raw[1]));
#pragma unroll
                    for (int i = 0; i < 4; ++i) { const float yy = u[i] * (acc[mt][nt][4 * g + i] + bv); y[mt][g][i] = yy; ss += yy * yy; }
                }
            ss += swap32(ss);
            const float rstd = rsqrtf(ss * (1.f / 64.f) + EPS);
            bfu* yrow = YC + (tok0 + tl) * 1024 + h * 64;
#pragma unroll
            for (int mt = 0; mt < 2; ++mt)
#pragma unroll
                for (int g = 0; g < 4; ++g) {
                    const int d0 = 32 * mt + 8 * g + 4 * hh;
                    const f32x4 gn = *(const f32x4*)(og + d0);
                    f32x4 o; for (int i = 0; i < 4; ++i) o[i] = y[mt][g][i] * rstd * gn[i];
                    *(u32x2*)(yrow + d0) = pack4(o);
                }
        }
    }
}

constexpr int HG_RS = 528;
constexpr int HG_TS = 576;
constexpr float HG_CLAMP = 80.f;

struct HgScan { float cum[32]; float kf[32]; float tot0, tot1; };
DI void hg_scan_pre(const unsigned short (&hfr)[32], int ch, int half, float lb, LAS float* xch, HgScan& S) {
    float run = 0.f;
#pragma unroll
    for (int i = 0; i < 32; ++i) {
        const float fx = bf2f(hfr[i]);
        const float sg = sigmoidf(fx);
        const float f = lb + (1.f - lb) * sg;
        run += __logf(fmaxf(f, 1e-20f));
        S.cum[i] = run; S.kf[i] = (1.f - lb) * (1.f - sg);
    }
    xch[half * 256 + ch] = run;
    __syncthreads();
    S.tot0 = xch[ch]; S.tot1 = xch[256 + ch];
}

DI void hg_local_phase(const Params& p, int l, LAS char* smem, int wv) {
    int tid = mk_tid(wv); smem = opql(smem);
    const int w = tid >> 6, lane = tid & 63, r = lane & 31, hh = lane >> 5;
    const int ch = tid & 255, half = tid >> 8;
    unsigned char* ws = opq(p.ws);
    const bfu* PR = (const bfu*)(ws + WS_PROJ);
    float* HST = (float*)(ws + WS_HST); float* HDEC = (float*)(ws + WS_HDEC);
    const float lb = ((const float*)(ws + WS_LB))[l * 256 + ch];
    LAS char* Kt = smem;
    LAS char* Vn = smem + 64 * HG_TS;
    LAS float* xch = (LAS float*)(smem + 2 * 64 * HG_TS);
    for (int uc = blockIdx.x; uc < 512; uc += gridDim.x) {
        const size_t tok0 = (size_t)uc * 64;
        unsigned short hfr[32];
#pragma unroll
        for (int i = 0; i < 32; ++i) hfr[i] = PR[(tok0 + 32 * half + i) * PW + PC_HF + ch];
        u32x4 vch[4];
#pragma unroll
        for (int i = 0; i < 4; ++i) { const int e = tid + i * 512, s = e >> 5, cch = e & 31; vch[i] = *(const u32x4*)(PR + (tok0 + s) * PW + PC_HI + cch * 8); }
        __syncthreads();
        HgScan S; hg_scan_pre(hfr, ch, half, lb, xch, S);
        const float btot = S.tot0 + S.tot1;
        const float e0 = half == 0 ? btot : S.tot1;
#pragma unroll
        for (int i = 0; i < 32; ++i) {
            const float kv = S.kf[i] * __expf(e0 - S.cum[i]);
            *(LAS bfu*)(Kt + (32 * half + i) * HG_TS + ch * 2) = f2bf(kv);
        }
        if (half == 0) HDEC[(size_t)uc * 256 + ch] = __expf(btot);
#pragma unroll
        for (int i = 0; i < 4; ++i) { const int e = tid + i * 512, s = e >> 5, cch = e & 31; *(LAS u32x4*)(Vn + s * HG_TS + cch * 16) = vch[i]; }
        __syncthreads();
        const int h = w >> 1, vh = w & 1;
        const int i16 = lane & 15, q4 = i16 >> 2, p4 = i16 & 3, blk = (lane >> 4) & 1;
        f32x16 acc0 = zero16(), acc1 = zero16();
#pragma unroll
        for (int ks = 0; ks < 4; ++ks) {
            const int srow = 16 * ks + 8 * hh + q4;
            const LAS char* a = Vn + srow * HG_TS + (h * 64 + 32 * vh + 16 * blk) * 2 + 8 * p4;
            const bf16x8 af = cat4(ldtr(a), ldtr(a + 4 * HG_TS));
            const LAS char* b0 = Kt + srow * HG_TS + (h * 64 + 16 * blk) * 2 + 8 * p4;
            const bf16x8 bf0 = cat4(ldtr(b0), ldtr(b0 + 4 * HG_TS));
            const bf16x8 bf1 = cat4(ldtr(b0 + 64), ldtr(b0 + 64 + 4 * HG_TS));
            acc0 = mfma32(af, bf0, acc0); acc1 = mfma32(af, bf1, acc1);
        }
        float* out = HST + ((size_t)uc * 4 + h) * 4096;
#pragma unroll
        for (int i = 0; i < 16; ++i) {
            const int v = 32 * vh + crow(i, hh);
            out[v * 64 + r] = acc0[i]; out[v * 64 + 32 + r] = acc1[i];
        }
    }
}

DI void hg_prefix_phase(const Params& p, int wv) {
    unsigned char* ws = opq(p.ws);
    float* HST = (float*)(ws + WS_HST); const float* HDEC = (const float*)(ws + WS_HDEC);
    int tid = mk_tid(wv);
    const int gsz = gridDim.x * 512;
    for (int e = blockIdx.x * 512 + tid; e < 64 * 4096; e += gsz) {
        const int bh = e >> 12, idx = e & 4095, b = bh >> 2, h = bh & 3;
        float S = 0.f;
        for (int c0 = 0; c0 < 32; c0 += 8) {
            float g8[8], d8[8];
#pragma unroll
            for (int k = 0; k < 8; ++k) { const size_t uc = (size_t)b * 32 + c0 + k; g8[k] = HST[(uc * 4 + h) * 4096 + idx]; d8[k] = HDEC[uc * 256 + h * 64 + (idx & 63)]; }
#pragma unroll
            for (int k = 0; k < 8; ++k) { const size_t uc = (size_t)b * 32 + c0 + k; HST[(uc * 4 + h) * 4096 + idx] = S; S = d8[k] * S + g8[k]; }
        }
    }
}

DI void hg_out_phase(const Params& p, int l, LAS char* smem, int wv) {
    int tid = mk_tid(wv); smem = opql(smem);
    const int w = tid >> 6, lane = tid & 63, r = lane & 31, hh = lane >> 5;
    const int ch = tid & 255, half = tid >> 8;
    unsigned char* ws = opq(p.ws);
    const bfu* PR = (const bfu*)(ws + WS_PROJ);
    const float* HST = (const float*)(ws + WS_HST);
    bfu* YC = (bfu*)(ws + WS_YCAT);
    const float lb = ((const float*)(ws + WS_LB))[l * 256 + ch];
    LAS char* Qe = smem;
    LAS char* Qm = smem + 64 * HG_RS;
    LAS char* Km = smem + 2 * 64 * HG_RS;
    LAS char* Vn = smem + 3 * 64 * HG_RS;
    LAS float* xch = (LAS float*)(smem + 3 * 64 * HG_RS + 64 * HG_TS);
    for (int uc = blockIdx.x; uc < 512; uc += gridDim.x) {
        const size_t tok0 = (size_t)uc * 64;
        const int h = w >> 1, th = w & 1;
        unsigned short hfr[32], hqr[32];
#pragma unroll
        for (int i = 0; i < 32; ++i) { const bfu* pp = PR + (tok0 + 32 * half + i) * PW + ch; hfr[i] = pp[PC_HF]; hqr[i] = pp[PC_HQ]; }
        u32x4 vch[4];
#pragma unroll
        for (int i = 0; i < 4; ++i) { const int e = tid + i * 512, s = e >> 5, cch = e & 31; vch[i] = *(const u32x4*)(PR + (tok0 + s) * PW + PC_HI + cch * 8); }
        const size_t tok = tok0 + 32 * th + r;
        u32x2 graw[2][4];
#pragma unroll
        for (int vt = 0; vt < 2; ++vt)
#pragma unroll
            for (int g = 0; g < 4; ++g) graw[vt][g] = *(const u32x2*)(PR + tok * PW + PC_HG + h * 64 + 32 * vt + 8 * g + 4 * hh);
        __syncthreads();
        HgScan S; hg_scan_pre(hfr, ch, half, lb, xch, S);
        f32x4 hs[2][4][2];
        { const float* st = HST + ((size_t)uc * 4 + h) * 4096;
#pragma unroll
          for (int vt = 0; vt < 2; ++vt)
#pragma unroll
            for (int ks = 0; ks < 4; ++ks) { const float* sp = st + (32 * vt + r) * 64 + 16 * ks + 8 * hh; hs[vt][ks][0] = *(const f32x4*)sp; hs[vt][ks][1] = *(const f32x4*)(sp + 4); } }
#pragma unroll
        for (int i = 0; i < 32; ++i) {
            const int s = 32 * half + i;
            const float q = siluf(bf2f(hqr[i]));
            const float b = half == 0 ? S.cum[i] : S.tot0 + S.cum[i];
            const float bm = half == 0 ? S.cum[i] - S.tot0 : S.cum[i];
            const float qe = q * __expf(b);
            const float qm = q * __expf(fminf(bm, HG_CLAMP));
            const float km = S.kf[i] * __expf(fminf(-bm, HG_CLAMP));
            *(LAS bfu*)(Qe + s * HG_RS + ch * 2) = f2bf(qe);
            *(LAS bfu*)(Qm + s * HG_RS + ch * 2) = f2bf(qm);
            *(LAS bfu*)(Km + s * HG_RS + ch * 2) = f2bf(km);
        }
#pragma unroll
        for (int i = 0; i < 4; ++i) { const int e = tid + i * 512, s = e >> 5, cch = e & 31; *(LAS u32x4*)(Vn + s * HG_TS + cch * 16) = vch[i]; }
        __syncthreads();
        const int i16 = lane & 15, q4 = i16 >> 2, p4 = i16 & 3, blk = (lane >> 4) & 1;
        f32x16 o0 = zero16(), o1 = zero16();
        {
#pragma unroll
            for (int ks = 0; ks < 4; ++ks) {
                const bf16x8 bq = *(const LAS bf16x8*)(Qe + (32 * th + r) * HG_RS + (h * 64 + 16 * ks + 8 * hh) * 2);
#pragma unroll
                for (int vt = 0; vt < 2; ++vt) {
                    const f32x4 s0 = hs[vt][ks][0], s1 = hs[vt][ks][1];
                    u32x4 pa; pa[0] = pk2(s0[0], s0[1]); pa[1] = pk2(s0[2], s0[3]); pa[2] = pk2(s1[0], s1[1]); pa[3] = pk2(s1[2], s1[3]);
                    const bf16x8 af = __builtin_bit_cast(bf16x8, pa);
                    if (vt == 0) o0 = mfma32(af, bq, o0); else o1 = mfma32(af, bq, o1);
                }
            }
        }
#pragma unroll
        for (int st_ = 0; st_ < 2; ++st_) {
            if (st_ <= th) {
                f32x16 x = zero16();
#pragma unroll
                for (int ks = 0; ks < 4; ++ks) {
                    const bf16x8 ak = *(const LAS bf16x8*)(Km + (32 * st_ + r) * HG_RS + (h * 64 + 16 * ks + 8 * hh) * 2);
                    const bf16x8 bq = *(const LAS bf16x8*)(Qm + (32 * th + r) * HG_RS + (h * 64 + 16 * ks + 8 * hh) * 2);
                    x = mfma32(ak, bq, x);
                }
                if (st_ == th) {
#pragma unroll
                    for (int i = 0; i < 16; ++i) if (crow(i, hh) > r) x[i] = 0.f;
                }
#pragma unroll
                for (int s2 = 0; s2 < 2; ++s2) {
                    const bf16x8 pf = pack8(x, s2);
                    const int srow = 32 * st_ + 16 * s2 + 4 * hh + q4;
#pragma unroll
                    for (int vt = 0; vt < 2; ++vt) {
                        const LAS char* a = Vn + srow * HG_TS + (h * 64 + 32 * vt + 16 * blk) * 2 + 8 * p4;
                        const bf16x8 vf = cat4(ldtr(a), ldtr(a + 8 * HG_TS));
                        if (vt == 0) o0 = mfma32(vf, pf, o0); else o1 = mfma32(vf, pf, o1);
                    }
                }
            }
        }
        float ss = 0.f;
#pragma unroll
        for (int i = 0; i < 16; ++i) ss += o0[i] * o0[i] + o1[i] * o1[i];
        ss += swap32(ss);
        const float rstd = rsqrtf(ss * (1.f / 64.f) + EPS);
        bfu* yrow = YC + tok * 1024 + 768 + h * 64;
        const float* og = (const float*)(ws + WS_SP) + l * SP_STRIDE + SP_HGO + h * 64;
#pragma unroll
        for (int vt = 0; vt < 2; ++vt)
#pragma unroll
            for (int g = 0; g < 4; ++g) {
                const int v0 = 32 * vt + 8 * g + 4 * hh;
                const u32x2 raw = graw[vt][g];
                const f32x4 gn = *(const f32x4*)(og + v0);
                f32x4 gg; gg[0] = siluf(bflo(raw[0])); gg[1] = siluf(bfhi(raw[0])); gg[2] = siluf(bflo(raw[1])); gg[3] = siluf(bfhi(raw[1]));
                f32x4 ov;
#pragma unroll
                for (int i = 0; i < 4; ++i) ov[i] = (vt == 0 ? o0[4 * g + i] : o1[4 * g + i]) * rstd * gn[i] * gg[i];
                *(u32x2*)(yrow + v0) = pack4(ov);
            }
    }
}

DI void ins16(float (&a)[16], float v) {
#pragma unroll
    for (int j = 15; j >= 1; --j) a[j] = __builtin_amdgcn_fmed3f(a[j - 1], a[j], v);
    a[0] = fmaxf(a[0], v);
}
DI void peer_topk_phase(const Params& p, int l, LAS char* smem, int wv) {
    int tid = mk_tid(wv); smem = opql(smem);
    const int w = tid >> 6, lane = tid & 63, r = lane & 31, hh = lane >> 5;
    unsigned char* ws = opq(p.ws);
    const bfu* PQ = (const bfu*)(ws + WS_PQ);
    const bfu* SK = (const bfu*)(ws + WS_W + (size_t)l * WL_SIZE + WL_SK);
    int* IDS = (int*)(ws + WS_IDS); float* GATE = (float*)(ws + WS_GATE);
    for (int u = blockIdx.x; u < T / 32; u += gridDim.x) {
        const size_t tok = (size_t)u * 32 + r;
        float lst[2][16];
        bf16x8 qf[2][4];
#pragma unroll
        for (int pp = 0; pp < 2; ++pp)
#pragma unroll
            for (int ks = 0; ks < 4; ++ks) qf[pp][ks] = *(const bf16x8*)(PQ + tok * 1024 + w * 128 + pp * 64 + 16 * ks + 8 * hh);
        const bfu* skb = SK + ((size_t)(w * 2) * 128 + r) * 64 + 8 * hh;
        bf16x8 af[2][4];
#pragma unroll
        for (int ks = 0; ks < 4; ++ks) af[0][ks] = *(const bf16x8*)(skb + 16 * ks);
        float a[16];
#pragma unroll
        for (int st = 0; st < 8; ++st) {
            const int pp = st >> 2, kt = st & 3;
            if (kt == 0) {
#pragma unroll
                for (int j = 0; j < 16; ++j) a[j] = -3.0e38f;
            }
            f32x16 acc = zero16();
#pragma unroll
            for (int ks = 0; ks < 4; ++ks) acc = mfma32(af[st & 1][ks], qf[pp][ks], acc);
            if (st < 7) {
                const int np = (st + 1) >> 2, nk = (st + 1) & 3;
#pragma unroll
                for (int ks = 0; ks < 4; ++ks) af[(st + 1) & 1][ks] = *(const bf16x8*)(skb + (size_t)np * 128 * 64 + (size_t)nk * 32 * 64 + 16 * ks);
            }
#pragma unroll
            for (int i = 0; i < 16; ++i) {
                const unsigned key = 32 * kt + (i & 3) + 8 * (i >> 2) + 4 * hh;
                ins16(a, __uint_as_float((__float_as_uint(acc[i]) & 0xffffff80u) | key));
            }
            if (kt == 3) {
                float ob[16];
#pragma unroll
                for (int j = 0; j < 16; ++j) ob[j] = swap32(a[j]);
#pragma unroll
                for (int j = 0; j < 16; ++j) ins16(a, ob[j]);
#pragma unroll
                for (int j = 0; j < 16; ++j) lst[pp][j] = a[j];
            }
        }
        float c[16];
#pragma unroll
        for (int j = 0; j < 16; ++j) c[j] = lst[0][0] + lst[1][j];
#pragma unroll
        for (int i = 1; i < 16; ++i)
#pragma unroll
            for (int j = 0; j < 16; ++j) if ((i + 1) * (j + 1) <= 16) ins16(c, lst[0][i] + lst[1][j]);
        const float thr = c[15], mx = c[0];
        float den = 0.f;
#pragma unroll
        for (int j = 0; j < 16; ++j) den += __expf(c[j] - mx);
        const float rden = 1.f / den;
        int cnt = 0;
        int* idp = IDS + tok * 128 + w * 16; float* gp = GATE + tok * 128 + w * 16;
        if (hh == 0) {
#pragma unroll
            for (int i = 0; i < 16; ++i)
#pragma unroll
                for (int j = 0; j < 16; ++j) if ((i + 1) * (j + 1) <= 16) {
                    const float s = lst[0][i] + lst[1][j];
                    if (s >= thr && cnt < 16) {
                        idp[cnt] = (int)((__float_as_uint(lst[0][i]) & 127u) * 128u + (__float_as_uint(lst[1][j]) & 127u));
                        gp[cnt] = __expf(s - mx) * rden;
                        ++cnt;
                    }
                }
            for (int k = cnt; k < 16; ++k) { idp[k] = 0; gp[k] = 0.f; }
        }
    }
}

#ifndef PGQT
#define PGQT 512
#endif
constexpr int PGQ_TILE = PGQT, PGQ_ITEMS = T / PGQ_TILE;
constexpr int LDS_PGQ = 160 * 1024 - 64;
DI f32x2 fp8lo(unsigned w) { return __builtin_amdgcn_cvt_pk_f32_fp8(w, false); }
DI f32x2 fp8hi(unsigned w) { return __builtin_amdgcn_cvt_pk_f32_fp8(w, true); }
typedef _Float16 h2_t __attribute__((ext_vector_type(2)));
constexpr float PGV_CSCALE = 1024.f;
DI unsigned* pgq_counter(unsigned char* ws, int l, int ph, int slice) { return (unsigned*)(ws + WS_CTL + 16384) + ((l * 4 + ph) * 8 + slice) * 64; }
DI bool pgq_pop(unsigned char* ws, int l, int ph, int home, int& kdone, LAS int* bc, int tid, int& slice, int& tile) {
    __syncthreads();
    if (tid == 0) {
        int k = kdone, s = -1, ti = 0;
        while (k < 8) {
            s = (home + k) & 7;
            ti = (int)__hip_atomic_fetch_add(pgq_counter(ws, l, ph, s), 1u, __ATOMIC_RELAXED, __HIP_MEMORY_SCOPE_AGENT);
            if (ti < PGQ_ITEMS) break;
            ++k;
        }
        bc[0] = k < 8 ? s : -1; bc[1] = ti; bc[2] = k;
    }
    __syncthreads();
    slice = __builtin_amdgcn_readfirstlane(bc[0]); tile = __builtin_amdgcn_readfirstlane(bc[1]); kdone = __builtin_amdgcn_readfirstlane(bc[2]);
    return slice >= 0;
}
template <int CTRL> DI float dpp_perm(float v) { return __builtin_bit_cast(float, __builtin_amdgcn_update_dpp(0, __builtin_bit_cast(int, v), CTRL, 0xf, 0xf, false)); }
DI float sum8(float v) { v += dpp_perm<0xB1>(v); v += dpp_perm<0x4E>(v); v += dpp_perm<0x141>(v); return v; }

#ifndef PGVR
#define PGVR 16
#endif
constexpr int PGV_STRIDE = 129;
DI void peer_u_phase(const Params& p, int l, LAS char* smem, int wv, int qid = 0) {
    int tid = mk_tid(wv); smem = opql(smem);
    const int w = tid >> 6, lane = tid & 63, g = lane >> 3, j = lane & 7;
    unsigned char* ws = opq(p.ws);
    const bfu* XB = (const bfu*)(ws + WS_XB);
    const int* IDS = (const int*)(ws + WS_IDS);
    const GAS unsigned char* TU = (const GAS unsigned char*)(ws + WS_TABU + (size_t)l * NEXP * DM);
    const float* RSTF = (const float*)(ws + WS_RSTF);
    float* PART = (float*)(ws + WS_PROJ);
    const float* gn = (const float*)(ws + WS_SP) + l * SP_STRIDE + SP_NFF;
    LAS int* bc = (LAS int*)(smem + LDS_PGQ);
    LAS int* idl = (LAS int*)smem + w * (2 * 8 * PGV_STRIDE) + g * PGV_STRIDE;
    const int home = (int)xb_xcc_id() & 7;
    int kdone = 0, x, tile;
    while (pgq_pop(ws, l, qid, home, kdone, bc, tid, x, tile)) {
      u32x4 nids[4]; u32x2 nx[4]; float nrstd; f32x4 gv[4];
#define PGU_FETCH(tt) { _Pragma("unroll") for (int k = 0; k < 4; ++k) nids[k] = *(const u32x4*)(IDS + (size_t)(tt) * 128 + 16 * j + 4 * k); nrstd = RSTF[tt]; \
        _Pragma("unroll") for (int i = 0; i < 4; ++i) nx[i] = *(const u32x2*)(XB + (size_t)(tt) * DM + 32 * x + 4 * j + 256 * i); }
      PGU_FETCH(tile * PGQ_TILE + w * 8 + g)
#pragma unroll
      for (int i = 0; i < 4; ++i) gv[i] = *(const f32x4*)(gn + 256 * i + 32 * x + 4 * j);
      for (int sub = 0; sub < PGQ_TILE / 64; ++sub) {
        const int t = tile * PGQ_TILE + sub * 64 + w * 8 + g;
#pragma unroll
        for (int k = 0; k < 4; ++k)
#pragma unroll
            for (int c = 0; c < 4; ++c) idl[16 * j + 4 * k + c] = (int)nids[k][c];
        const float rstd = nrstd;
        u32x2 xr[4];
#pragma unroll
        for (int i = 0; i < 4; ++i) xr[i] = nx[i];
        if (sub + 1 < PGQ_TILE / 64) PGU_FETCH(t + 64)
        f32x4 xf[4]; float am = 0.f;
#pragma unroll
        for (int i = 0; i < 4; ++i) { const u32x2 raw = xr[i];
            xf[i][0] = bflo(raw[0]) * rstd * gv[i][0]; xf[i][1] = bfhi(raw[0]) * rstd * gv[i][1]; xf[i][2] = bflo(raw[1]) * rstd * gv[i][2]; xf[i][3] = bfhi(raw[1]) * rstd * gv[i][3];
            am = fmaxf(am, fmaxf(fmaxf(fabsf(xf[i][0]), fabsf(xf[i][1])), fmaxf(fabsf(xf[i][2]), fabsf(xf[i][3])))); }
        am = fmaxf(am, dpp_perm<0xB1>(am)); am = fmaxf(am, dpp_perm<0x4E>(am)); am = fmaxf(am, dpp_perm<0x141>(am));
        const float qs = am > 0.f ? 127.f / am : 0.f, sx = am * (1.f / 127.f);
        unsigned xq[4];
#pragma unroll
        for (int i = 0; i < 4; ++i) xq[i] = pack_i8x4(xf[i][0] * qs, xf[i][1] * qs, xf[i][2] * qs, xf[i][3] * qs);
        const GAS unsigned char* tux = TU + (size_t)x * NEXP * 128;
        float* prow = PART + ((size_t)x * T + t) * 128 + 2 * j;
        {
            u32x4 r[16];
#define PGU_ISSUE(k, e) { const unsigned off_ = (unsigned)idl[e] * 128u + 16u * (unsigned)j; r[k] = *(const GAS u32x4*)(tux + off_); }
#define PGU_DOT(k) { int di_ = 0; _Pragma("unroll") for (int i = 0; i < 4; ++i) di_ = __builtin_amdgcn_sdot4((int)r[k][i], (int)xq[i], di_, false); dk[(k) & 7] = di_; }
#define PGU_REDUCE(OUT) { int a_[4], b_[2]; \
                _Pragma("unroll") for (int m = 0; m < 4; ++m) { const int snd = lo4 ? dk[4 + m] : dk[m], kp = lo4 ? dk[m] : dk[4 + m]; a_[m] = kp + __builtin_amdgcn_update_dpp(0, snd, 0x141, 0xf, 0xf, false); } \
                _Pragma("unroll") for (int n = 0; n < 2; ++n) { const int snd = b2 ? a_[n] : a_[2 + n], kp = b2 ? a_[2 + n] : a_[n]; b_[n] = kp + __builtin_amdgcn_update_dpp(0, snd, 0x4E, 0xf, 0xf, false); } \
                { const int snd = b1 ? b_[0] : b_[1], kp = b1 ? b_[1] : b_[0]; OUT = (float)(kp + __builtin_amdgcn_update_dpp(0, snd, 0xB1, 0xf, 0xf, false)) * sx; } }
            const bool lo4 = j < 4, b2 = (j & 2) != 0, b1 = (j & 1) != 0;
            int dk[8];
#pragma unroll
            for (int k = 0; k < 16; ++k) PGU_ISSUE(k, k)
#pragma unroll 1
            for (int e0 = 0; e0 < 128; e0 += 16) {
                float p0, p1;
                if (e0 + 16 < 128) {
#pragma unroll
                    for (int k = 0; k < 8; ++k) { PGU_DOT(k) PGU_ISSUE(k, e0 + 16 + k) }
                    PGU_REDUCE(p0)
#pragma unroll
                    for (int k = 8; k < 16; ++k) { PGU_DOT(k) PGU_ISSUE(k, e0 + 16 + k) }
                    PGU_REDUCE(p1)
                } else {
#pragma unroll
                    for (int k = 0; k < 8; ++k) { PGU_DOT(k) }
                    PGU_REDUCE(p0)
#pragma unroll
                    for (int k = 8; k < 16; ++k) { PGU_DOT(k) }
                    PGU_REDUCE(p1)
                }
                *(f32x2*)(prow + e0) = (f32x2){p0, p1};
            }
#undef PGU_DOT
#undef PGU_REDUCE
#undef PGU_ISSUE
        }
      }
    }
}
DI void peer_c_phase(const Params& p, int l, int wv) {
    int tid = mk_tid(wv);
    const int w = tid >> 6, lane = tid & 63;
    unsigned char* ws = opq(p.ws);
    const int* IDS = (const int*)(ws + WS_IDS); const float* GATE = (const float*)(ws + WS_GATE);
    const float* SCU = (const float*)(ws + WS_SCU) + l * NEXP; const float* SCV = (const float*)(ws + WS_SCV) + l * NEXP;
    const float* PART = (const float*)(ws + WS_PROJ); float* COEF = (float*)(ws + WS_COEF);
    for (int t0 = (blockIdx.x * 8 + w) * 4; t0 < T; t0 += gridDim.x * 8 * 4) {
        const int e0 = 16 * (lane >> 3) + (lane & 7);
        f32x2 pr[4][8]; int id0[4], id1[4]; float g0[4], g1[4];
#pragma unroll
        for (int q = 0; q < 4; ++q) { const int t = t0 + q;
#pragma unroll
            for (int x = 0; x < 8; ++x) pr[q][x] = *(const f32x2*)(PART + ((size_t)x * T + t) * 128 + 2 * lane);
            id0[q] = IDS[(size_t)t * 128 + e0]; id1[q] = IDS[(size_t)t * 128 + e0 + 8]; g0[q] = GATE[(size_t)t * 128 + e0]; g1[q] = GATE[(size_t)t * 128 + e0 + 8]; }
#pragma unroll
        for (int q = 0; q < 4; ++q) { const int t = t0 + q;
            f32x2 s = pr[q][0];
#pragma unroll
            for (int x = 1; x < 8; ++x) s += pr[q][x];
            COEF[(size_t)t * 128 + e0] = geluf(s.x * SCU[id0[q]]) * g0[q] * SCV[id0[q]];
            COEF[(size_t)t * 128 + e0 + 8] = geluf(s.y * SCU[id1[q]]) * g1[q] * SCV[id1[q]];
        }
    }
}

DI void peer_v_phase(const Params& p, int l, LAS char* smem, int wv, int qid = 1) {
    int tid = mk_tid(wv); smem = opql(smem);
    const int w = tid >> 6, lane = tid & 63, g = lane >> 3, j = lane & 7;
    unsigned char* ws = opq(p.ws);
    bfu* XB = (bfu*)(ws + WS_XB);
    const int* IDS = (const int*)(ws + WS_IDS); const float* COEF = (const float*)(ws + WS_COEF);
    const GAS unsigned char* TV = (const GAS unsigned char*)(ws + WS_TABV + (size_t)l * NEXP * DM);
    float* SSP = (float*)(ws + WS_SSP);
    LAS int* bc = (LAS int*)(smem + LDS_PGQ);
    LAS int* idl = (LAS int*)smem + w * (2 * 8 * PGV_STRIDE) + g * PGV_STRIDE;
    LAS float* cfl = (LAS float*)idl + 8 * PGV_STRIDE;
    const int home = (int)xb_xcc_id() & 7;
    int kdone = 0, x, tile;
    while (pgq_pop(ws, l, qid, home, kdone, bc, tid, x, tile)) {
      u32x4 nids[4]; f32x4 ncf[4]; u32x2 nx[4];
#define PGV_FETCH(tt) { _Pragma("unroll") for (int k = 0; k < 4; ++k) { nids[k] = *(const u32x4*)(IDS + (size_t)(tt) * 128 + 16 * j + 4 * k); ncf[k] = *(const f32x4*)(COEF + (size_t)(tt) * 128 + 16 * j + 4 * k); } \
        _Pragma("unroll") for (int i = 0; i < 4; ++i) nx[i] = *(const u32x2*)(XB + (size_t)(tt) * DM + 32 * x + 4 * j + 256 * i); }
      PGV_FETCH(tile * PGQ_TILE + w * 8 + g)
      for (int sub = 0; sub < PGQ_TILE / 64; ++sub) {
        const int t = tile * PGQ_TILE + sub * 64 + w * 8 + g;
#pragma unroll
        for (int k = 0; k < 4; ++k)
#pragma unroll
            for (int c = 0; c < 4; ++c) { idl[16 * j + 4 * k + c] = (int)nids[k][c]; const _Float16 hc = (_Float16)(ncf[k][c] * PGV_CSCALE); const h2_t hp = {hc, hc}; cfl[16 * j + 4 * k + c] = __builtin_bit_cast(float, hp); }
        u32x2 xold[4];
#pragma unroll
        for (int i = 0; i < 4; ++i) xold[i] = nx[i];
        if (sub + 1 < PGQ_TILE / 64) PGV_FETCH(t + 64)
        h2_t acc[8];
#pragma unroll
        for (int c = 0; c < 8; ++c) acc[c] = (h2_t){(_Float16)0.f, (_Float16)0.f};
        const GAS unsigned char* tvx = TV + (size_t)x * NEXP * 128;
        {
            u32x4 r[PGVR]; float cf[PGVR];
#define PGV_ISSUE(k, e) { const unsigned off_ = (unsigned)idl[e] * 128u + 16u * (unsigned)j; cf[k] = cfl[e]; r[k] = *(const GAS u32x4*)(tvx + off_); }
#define PGV_USE(k) { const h2_t c2 = __builtin_bit_cast(h2_t, cf[k]); _Pragma("unroll") for (int i = 0; i < 4; ++i) { const unsigned wd = r[k][i]; \
                acc[2 * i] = __builtin_elementwise_fma(c2, __builtin_bit_cast(h2_t, __builtin_amdgcn_cvt_scalef32_pk_f16_fp8(wd, 1.0f, false)), acc[2 * i]); \
                acc[2 * i + 1] = __builtin_elementwise_fma(c2, __builtin_bit_cast(h2_t, __builtin_amdgcn_cvt_scalef32_pk_f16_fp8(wd, 1.0f, true)), acc[2 * i + 1]); } }
#pragma unroll
            for (int k = 0; k < PGVR; ++k) PGV_ISSUE(k, k)
            for (int e0 = PGVR; e0 < 128; e0 += PGVR) {
#pragma unroll
                for (int k = 0; k < PGVR; ++k) { PGV_USE(k) PGV_ISSUE(k, e0 + k) }
            }
#pragma unroll
            for (int k = 0; k < PGVR; ++k) PGV_USE(k)
#undef PGV_ISSUE
#undef PGV_USE
#undef PGV_FETCH
        }
        bfu* xrow = XB + (size_t)t * DM + 32 * x + 4 * j;
        float s2 = 0.f;
#pragma unroll
        for (int i = 0; i < 4; ++i) {
            u32x2* px = (u32x2*)(xrow + 256 * i); const u32x2 old = xold[i];
            const float us = 1.f / PGV_CSCALE;
            const float y0 = bflo(old[0]) + (float)acc[2 * i].x * us, y1 = bfhi(old[0]) + (float)acc[2 * i].y * us, y2 = bflo(old[1]) + (float)acc[2 * i + 1].x * us, y3 = bfhi(old[1]) + (float)acc[2 * i + 1].y * us;
            u32x2 o; o[0] = pk2(y0, y1); o[1] = pk2(y2, y3); *px = o;
            const float z0 = bflo(o[0]), z1 = bfhi(o[0]), z2 = bflo(o[1]), z3 = bfhi(o[1]);
            s2 += z0 * z0 + z1 * z1 + z2 * z2 + z3 * z3;
        }
        s2 = sum8(s2);
        if (j == 0) SSP[(size_t)t * 8 + x] = s2;
      }
    }
}

DI void final_norm_phase(const Params& p, int wv) {
    int tid = mk_tid(wv);
    const int w = tid >> 6, lane = tid & 63;
    unsigned char* ws = opq(p.ws);
    const bfu* XB = (const bfu*)(ws + WS_XB); const float* SSP = (const float*)(ws + WS_SSP);
    const float* gfin = (const float*)(ws + WS_SP) + SP_FIN;
    f32x4 g[4];
#pragma unroll
    for (int i = 0; i < 4; ++i) g[i] = *(const f32x4*)(gfin + 256 * i + 4 * lane);
    for (int t0 = (blockIdx.x * 8 + w) * 4; t0 < T; t0 += gridDim.x * 8 * 4) {
        f32x4 q0[4], q1[4]; u32x2 raw[4][4];
#pragma unroll
        for (int q = 0; q < 4; ++q) { const int t = t0 + q; q0[q] = *(const f32x4*)(SSP + (size_t)t * 8); q1[q] = *(const f32x4*)(SSP + (size_t)t * 8 + 4);
#pragma unroll
            for (int i = 0; i < 4; ++i) raw[q][i] = *(const u32x2*)(XB + (size_t)t * DM + 256 * i + 4 * lane); }
#pragma unroll
        for (int q = 0; q < 4; ++q) { const int t = t0 + q;
            const float r2 = rsqrtf((((q0[q][0] + q0[q][1]) + (q0[q][2] + q0[q][3])) + ((q1[q][0] + q1[q][1]) + (q1[q][2] + q1[q][3]))) * (1.f / DM) + EPS);
            float* orow = p.out + (size_t)t * DM;
#pragma unroll
            for (int i = 0; i < 4; ++i) {
                f32x4 o; o[0] = bflo(raw[q][i][0]) * r2 * g[i][0]; o[1] = bfhi(raw[q][i][0]) * r2 * g[i][1]; o[2] = bflo(raw[q][i][1]) * r2 * g[i][2]; o[3] = bfhi(raw[q][i][1]) * r2 * g[i][3];
                *(f32x4*)(orow + 256 * i + 4 * lane) = o; }
        }
    }
}

constexpr int PPL = 10, NPH = 2 + PPL * NL;
__global__ void __launch_bounds__(512, 2) hymba_fwd(Params p) {
    extern __shared__ __attribute__((aligned(16))) char smem_raw[];
    LAS char* smem0 = (LAS char*)smem_raw;
    const int wv = __builtin_amdgcn_readfirstlane((int)(threadIdx.x >> 6));
    if (mk_tid(wv) < 4) ((LAS unsigned*)(smem0 + LDS_BAR))[mk_tid(wv)] = 0u;
    __syncthreads();
    XcdBarrier bar = xcd_barrier_post((unsigned*)(p.ws + WS_CTL), (volatile LAS unsigned*)(smem0 + LDS_BAR), wv);
    const int lo = p.ph_lo, hi = p.ph_hi;
#define IN(k) (lo <= (k) && (k) < hi)
#define SEAM(k) do { if (IN(k) && IN((k) + 1)) xcd_barrier(bar); } while (0)
#define PHASE_HDR const int G = opqi((int)gridDim.x), bid = opqi((int)blockIdx.x); LAS char* smem = opql(smem0); LAS unsigned char* smemu = (LAS unsigned char*)smem; unsigned char* ws = opq(p.ws); \
        const unsigned char* wl = ws + WS_W + (size_t)l * WL_SIZE; const float* ct = (const float*)(ws + WS_COS); const float* st = (const float*)(ws + WS_SIN); (void)wl; (void)ct; (void)st; (void)G; (void)bid; (void)smemu;
    if (IN(0)) { phase_prologue(p, smem0, wv); }
    SEAM(0);
    for (int l = 0; l < NL; ++l) {
        const int pb = 1 + PPL * l;
        if (IN(pb + 0)) {
            PHASE_HDR
            EpiProj e{(const float*)(ws + WS_SSP), (bfu*)(ws + WS_PROJ), ct, st};
            XSched s{8, 128 * 8, G, bid, wv};
            gemm_phase(smemu, Gemm{(const bfu*)(ws + WS_XB), (const bfu*)(wl + WL_IN), 1024, 1024, 1024}, s, e);
        }
        SEAM(pb + 0);
        if (IN(pb + 1)) {
            PHASE_HDR
            {
                XSched s{3, 128 * 3, G, bid, wv};
                Unit u; __syncthreads();
                for (int i = 0; s.next(i, u); ++i) rows_rstd_lds<256>((const bfu*)(ws + WS_PROJ) + PC_CQ, PW, u.pm * 256, (LAS float*)(smem + LDS_RS) + i * 256, wv);
                __syncthreads();
                EpiScaled<true> e{(const LAS float*)(smem + LDS_RS), (bfu*)(ws + WS_Q), 768, ct, st, 0.10206207261596577f * 1.4426950408889634f};
                gemm_phase(smemu, Gemm{(const bfu*)(ws + WS_PROJ) + PC_CQ, (const bfu*)(wl + WL_UQ), PW, 256, 256}, s, e);
            }
            {
                XSched s{4, 128 * 4, G, (bid + 128) % G, wv};
                Unit u; __syncthreads();
                for (int i = 0; s.next(i, u); ++i) rows_rstd_lds<128>((const bfu*)(ws + WS_PROJ) + PC_CKV, PW, u.pm * 256, (LAS float*)(smem + LDS_RS) + i * 256, wv);
                __syncthreads();
                EpiScaled<false> e{(const LAS float*)(smem + LDS_RS), (bfu*)(ws + WS_KV), 1024, ct, st, 1.f};
                gemm_phase(smemu, Gemm{(const bfu*)(ws + WS_PROJ) + PC_CKV, (const bfu*)(wl + WL_UKV), PW, 256, 256}, s, e);
            }
            gmlp_phase(p, l, smem0, wv);
            hg_local_phase(p, l, smem0, wv);
        }
        SEAM(pb + 1);
        if (IN(pb + 2)) { attn_phase(p, l, smem0, wv);
            hg_prefix_phase(p, wv); }
        SEAM(pb + 2);
        if (IN(pb + 3)) { hg_out_phase(p, l, smem0, wv);
        }
        SEAM(pb + 3);
        if (IN(pb + 4)) {
            PHASE_HDR
            EpiResid e{(bfu*)(ws + WS_XB)};
            XSched s{4, 128 * 4, G, bid, wv};
            __syncthreads();
            gemm_phase(smemu, Gemm{(const bfu*)(ws + WS_YCAT), (const bfu*)(wl + WL_OUT), 1024, 1024, 1024}, s, e);
        }
        SEAM(pb + 4);
        if (IN(pb + 5)) {
            PHASE_HDR
            XSched s{4, 128 * 4, G, bid, wv};
            Unit u; __syncthreads();
            for (int i = 0; s.next(i, u); ++i) rows_rstd_lds<1024>((const bfu*)(ws + WS_XB), DM, u.pm * 256, (LAS float*)(smem + LDS_RS) + i * 256, wv, (float*)(ws + WS_RSTF));
            __syncthreads();
            EpiScaled<false> e{(const LAS float*)(smem + LDS_RS), (bfu*)(ws + WS_PQ), 1024, ct, st, 1.f};
            gemm_phase(smemu, Gemm{(const bfu*)(ws + WS_XB), (const bfu*)(wl + WL_Q), 1024, 1024, 1024}, s, e);
        }
        SEAM(pb + 5);
        if (IN(pb + 6)) { peer_topk_phase(p, l, smem0, wv);
        }
        SEAM(pb + 6);
        if (IN(pb + 7)) { peer_u_phase(p, l, smem0, wv);
        }
        SEAM(pb + 7);
        if (IN(pb + 8)) { peer_c_phase(p, l, wv);
        }
        SEAM(pb + 8);
        if (IN(pb + 9)) { peer_v_phase(p, l, smem0, wv); }
        SEAM(pb + 9);
    }
    if (IN(NPH - 1)) { final_norm_phase(p, wv); }
#undef PHASE_HDR
#undef IN
#undef SEAM
}

extern "C" void kernel_launch(void* const* d_in, const int* in_sizes, int n_in, void* d_out, int out_size, void* d_ws, size_t ws_size, hipStream_t stream) {
    static int grid = 0;
    if (grid == 0) {
        if (n_in != 22 || in_sizes[0] != T * DM || out_size != T * DM || ws_size < WS_END) {
            fprintf(stderr, "kernel_launch: unexpected shapes (n_in %d, in0 %d, out %d, ws %zu, need %zu)\n", n_in, n_in > 0 ? in_sizes[0] : -1, out_size, ws_size, (size_t)WS_END); grid = -1; return; }
        int dev = 0, cus = 0, per_cu = 0;
        if (hipGetDevice(&dev) != hipSuccess || hipDeviceGetAttribute(&cus, hipDeviceAttributeMultiprocessorCount, dev) != hipSuccess) { grid = -1; return; }
        if (hipFuncSetAttribute((const void*)hymba_fwd, hipFuncAttributeMaxDynamicSharedMemorySize, LDS_TOTAL) != hipSuccess) { fprintf(stderr, "kernel_launch: hipFuncSetAttribute failed\n"); grid = -1; return; }
        if (hipOccupancyMaxActiveBlocksPerMultiprocessor(&per_cu, (const void*)hymba_fwd, 512, LDS_TOTAL) != hipSuccess || per_cu < 1) fprintf(stderr, "kernel_launch: occupancy query says %d\n", per_cu);
        (void)hipGetLastError();
        grid = cus;
    }
    if (grid < 0) return;
    (void)hipMemsetAsync((char*)d_ws + WS_CTL, 0, 65536, stream);
    Params p{};
    p.x = (const float*)d_in[0]; p.pos = (const int*)d_in[1]; p.norm_mix = (const float*)d_in[2]; p.w_in = (const float*)d_in[3]; p.gm_v_norm = (const float*)d_in[4];
    p.gm_ws = (const float*)d_in[5]; p.gm_b = (const float*)d_in[6]; p.gm_out_norm = (const float*)d_in[7]; p.mla_q_norm = (const float*)d_in[8]; p.mla_w_uq = (const float*)d_in[9];
    p.mla_kv_norm = (const float*)d_in[10]; p.mla_w_ukv = (const float*)d_in[11]; p.mla_out_norm = (const float*)d_in[12]; p.hg_lb_logits = (const float*)d_in[13];
    p.hg_out_norm = (const float*)d_in[14]; p.w_out = (const float*)d_in[15]; p.norm_ffn = (const float*)d_in[16]; p.peer_w_q = (const float*)d_in[17];
    p.peer_sub_keys = (const float*)d_in[18]; p.peer_u = (const float*)d_in[19]; p.peer_v = (const float*)d_in[20]; p.norm_final = (const float*)d_in[21];
    p.out = (float*)d_out; p.ws = (unsigned char*)d_ws;
    p.ph_lo = 0; p.ph_hi = NPH;
    hipLaunchKernelGGL(hymba_fwd, dim3(grid), dim3(512), LDS_TOTAL, stream, p);
}
```

```cpp
#include <hip/hip_runtime.h>
#include <cstdio>
#include <cstdint>
#include <cmath>
#include <type_traits>

constexpr int T = 32768, DM = 1024, NL = 4, SEQ = 2048;
constexpr int PW = 2048;
constexpr int PC_U = 0, PC_V = 256, PC_CQ = 512, PC_CKV = 768, PC_KR = 896, PC_HQ = 1024, PC_HF = 1280, PC_HI = 1536, PC_HG = 1792;
constexpr int NEXP = 16384;
constexpr float EPS = 1e-6f;

typedef unsigned short bfu;
typedef __attribute__((ext_vector_type(8))) short bf16x8;
typedef __attribute__((ext_vector_type(4))) short s16x4;
typedef __attribute__((ext_vector_type(4))) float f32x4;
typedef __attribute__((ext_vector_type(16))) float f32x16;
typedef __attribute__((ext_vector_type(2))) __bf16 bf2_t;
typedef __attribute__((ext_vector_type(2))) float f2_t;
typedef __attribute__((ext_vector_type(4))) unsigned u32x4;
typedef __attribute__((ext_vector_type(2))) unsigned u32x2;
typedef short v4i16_t __attribute__((ext_vector_type(4)));
#define DI __device__ __forceinline__
#define LAS __attribute__((address_space(3)))

DI float bf2f(bfu v) { return __uint_as_float((unsigned)v << 16); }
DI float bflo(unsigned u) { return __uint_as_float(u << 16); }
DI float bfhi(unsigned u) { return __uint_as_float(u & 0xffff0000u); }
DI unsigned pk2(float a, float b) { f2_t v = {a, b}; bf2_t r = __builtin_convertvector(v, bf2_t); return __builtin_bit_cast(unsigned, r); }
DI bfu f2bf(float a) { return (bfu)(pk2(a, 0.f) & 0xffffu); }
DI f32x16 mfma32(bf16x8 a, bf16x8 b, f32x16 c) { return __builtin_amdgcn_mfma_f32_32x32x16_bf16(a, b, c, 0, 0, 0); }
DI int crow(int r, int hi) { return (r & 3) + 8 * (r >> 2) + 4 * hi; }
DI f32x16 zero16() { f32x16 z; for (int i = 0; i < 16; ++i) z[i] = 0.f; return z; }
DI bf16x8 pack8(const f32x16& x, int s) {
    u32x4 p; p[0] = pk2(x[8 * s], x[8 * s + 1]); p[1] = pk2(x[8 * s + 2], x[8 * s + 3]); p[2] = pk2(x[8 * s + 4], x[8 * s + 5]); p[3] = pk2(x[8 * s + 6], x[8 * s + 7]);
    return __builtin_bit_cast(bf16x8, p);
}
DI float swap32(float v) { return __shfl_xor(v, 32); }
DI float wave_sum(float v) {
    v += __shfl_xor(v, 1); v += __shfl_xor(v, 2); v += __shfl_xor(v, 4); v += __shfl_xor(v, 8); v += __shfl_xor(v, 16); v += __shfl_xor(v, 32); return v;
}
DI float sum16(float v) { v += __shfl_xor(v, 1); v += __shfl_xor(v, 2); v += __shfl_xor(v, 4); v += __shfl_xor(v, 8); return v; }
DI float fast_exp(float x) { return __expf(x); }
DI float sigmoidf(float x) { return 1.f / (1.f + __expf(-x)); }
DI float geluf(float x) { const float u = 1.5957691216057308f * (x + 0.044715f * x * x * x); return x / (1.f + __expf(-u)); }
DI float siluf(float x) { return x / (1.f + __expf(-x)); }
DI s16x4 ldtr(const LAS char* p) { return __builtin_bit_cast(s16x4, __builtin_amdgcn_ds_read_tr16_b64_v4i16((LAS v4i16_t*)p)); }
DI bf16x8 cat4(s16x4 a, s16x4 b) { return __builtin_shufflevector(a, b, 0, 1, 2, 3, 4, 5, 6, 7); }
DI int mk_tid(int wv) { int ln; asm volatile("v_mbcnt_lo_u32_b32 %0, -1, 0\n\tv_mbcnt_hi_u32_b32 %0, -1, %0" : "=v"(ln)); return wv * 64 + ln; }
DI unsigned char* opq(unsigned char* q) { asm volatile("" : "+s"(q)); return q; }
DI LAS char* opql(LAS char* q) { unsigned v = (unsigned)(size_t)q; asm volatile("" : "+s"(v)); return (LAS char*)(size_t)v; }
DI int opqi(int v) { asm volatile("" : "+s"(v)); return v; }
DI f32x4 zero4_opaque() { float z; asm volatile("v_mov_b32 %0, 0" : "=v"(z)); return (f32x4){z, z, z, z}; }
DI float dot2u(unsigned a, unsigned b, float c) { return __builtin_amdgcn_fdot2_f32_bf16(__builtin_bit_cast(bf2_t, a), __builtin_bit_cast(bf2_t, b), c, false); }
#define GAS __attribute__((address_space(1)))
typedef __attribute__((ext_vector_type(2))) float f32x2;
template <int CTRL, int ROWMASK> DI float dpp_get(float v) { return __builtin_bit_cast(float, __builtin_amdgcn_update_dpp(0, __builtin_bit_cast(int, v), CTRL, ROWMASK, 0xf, false)); }
DI float dpp_sum63(float v) {
    v += dpp_get<0x111, 0xf>(v); v += dpp_get<0x112, 0xf>(v); v += dpp_get<0x114, 0xf>(v); v += dpp_get<0x118, 0xf>(v);
    v += dpp_get<0x142, 0xa>(v); v += dpp_get<0x143, 0xc>(v); return v;
}
DI float dpp_max63(float v) {
    v = fmaxf(v, dpp_get<0x111, 0xf>(v)); v = fmaxf(v, dpp_get<0x112, 0xf>(v)); v = fmaxf(v, dpp_get<0x114, 0xf>(v)); v = fmaxf(v, dpp_get<0x118, 0xf>(v));
    v = fmaxf(v, dpp_get<0x142, 0xa>(v)); v = fmaxf(v, dpp_get<0x143, 0xc>(v)); return v;
}
DI float rdlane_f(float v, int l) { return __builtin_bit_cast(float, __builtin_amdgcn_readlane(__builtin_bit_cast(int, v), l)); }
DI unsigned pack_i8x4(float a, float b, float c, float d) {
    const int q0 = (int)__builtin_rintf(fminf(fmaxf(a, -127.f), 127.f)), q1 = (int)__builtin_rintf(fminf(fmaxf(b, -127.f), 127.f));
    const int q2 = (int)__builtin_rintf(fminf(fmaxf(c, -127.f), 127.f)), q3 = (int)__builtin_rintf(fminf(fmaxf(d, -127.f), 127.f));
    return (unsigned)(q0 & 0xff) | ((unsigned)(q1 & 0xff) << 8) | ((unsigned)(q2 & 0xff) << 16) | ((unsigned)(q3 & 0xff) << 24);
}

constexpr size_t WS_CTL   = 0;
constexpr size_t WS_XB    = 65536;
constexpr size_t WS_PROJ  = WS_XB   + (size_t)T * DM * 2;
constexpr size_t WS_Q     = WS_PROJ + (size_t)T * PW * 2;
constexpr size_t WS_KV    = WS_Q    + (size_t)T * 768 * 2;
constexpr size_t WS_YCAT  = WS_KV   + (size_t)T * 1024 * 2;
constexpr size_t WS_PQ    = WS_YCAT + (size_t)T * 1024 * 2;
constexpr size_t WS_IDS   = WS_PQ   + (size_t)T * 1024 * 2;
constexpr size_t WS_GATE  = WS_IDS  + (size_t)T * 128 * 4;
constexpr size_t WS_HST   = WS_GATE + (size_t)T * 128 * 4;
constexpr size_t WS_HDEC  = WS_HST  + (size_t)2048 * 4096 * 4;
constexpr size_t WS_COS   = WS_HDEC + (size_t)512 * 256 * 4;
constexpr size_t WS_SIN   = WS_COS  + (size_t)T * 16 * 4;
constexpr size_t WS_SSP   = WS_SIN  + (size_t)T * 16 * 4;
constexpr size_t WS_RSTF  = WS_SSP  + (size_t)T * 8 * 4;
constexpr size_t WS_COEF  = WS_RSTF + (size_t)T * 4;
constexpr size_t WS_LB    = WS_COEF + (size_t)T * 128 * 4;
constexpr size_t WS_SP    = WS_LB   + 4096;
constexpr int SP_GMV = 0, SP_GMB = 256, SP_GMO = 768, SP_MLO = 1024, SP_HGO = 1536, SP_NFF = 1792, SP_STRIDE = 3072, SP_FIN = NL * SP_STRIDE;
constexpr size_t WS_W     = WS_SP   + (size_t)(SP_FIN + 1024) * 4;
constexpr size_t WL_IN    = 0;
constexpr size_t WL_UQ    = WL_IN  + (size_t)2048 * 1024 * 2;
constexpr size_t WL_UKV   = WL_UQ  + (size_t)768 * 256 * 2;
constexpr size_t WL_OUT   = WL_UKV + (size_t)1024 * 256 * 2;
constexpr size_t WL_Q     = WL_OUT + (size_t)1024 * 1024 * 2;
constexpr size_t WL_SK    = WL_Q   + (size_t)1024 * 1024 * 2;
constexpr size_t WL_GM    = WL_SK  + (size_t)16 * 128 * 64 * 2;
constexpr size_t WL_SIZE  = WL_GM  + (size_t)4 * 128 * 128 * 2;
constexpr size_t WS_TABU  = WS_W + NL * WL_SIZE;
constexpr size_t WS_TABV  = WS_TABU + (size_t)NL * NEXP * DM;
constexpr size_t WS_SCU   = WS_TABV + (size_t)NL * NEXP * DM;
constexpr size_t WS_SCV   = WS_SCU  + (size_t)NL * NEXP * 4;
constexpr size_t WS_END   = WS_SCV  + (size_t)NL * NEXP * 4;

struct Params {
    const float* x; const int* pos; const float* norm_mix; const float* w_in; const float* gm_v_norm; const float* gm_ws; const float* gm_b; const float* gm_out_norm;
    const float* mla_q_norm; const float* mla_w_uq; const float* mla_kv_norm; const float* mla_w_ukv; const float* mla_out_norm; const float* hg_lb_logits; const float* hg_out_norm;
    const float* w_out; const float* norm_ffn; const float* peer_w_q; const float* peer_sub_keys; const float* peer_u; const float* peer_v; const float* norm_final;
    float* out; unsigned char* ws;
};

#define XB_TMO      128
#define XB_XCNT(j)  (256  + 64 * (j))
#define XB_XSUB(j)  (1280 + 64 * (j))
#define XB_XGEN(j)  (2304 + 64 * (j))
#define XB_TOP      3328
#define XB_TOPGEN   3392
#define XCD_BAR_WORDS 3456
#define XB_SPIN_CAP (1u << 20)
DI unsigned xb_ld(unsigned* p)              { return __hip_atomic_load(p, __ATOMIC_RELAXED, __HIP_MEMORY_SCOPE_AGENT); }
DI unsigned xb_add(unsigned* p, unsigned v) { return __hip_atomic_fetch_add(p, v, __ATOMIC_RELAXED, __HIP_MEMORY_SCOPE_AGENT); }
DI unsigned xb_xcc_id() { return (unsigned)__builtin_amdgcn_s_getreg((3 << 11) | 20) & 0xFu; }
#define XB_SPIN(cond, bar) do { unsigned _sp = 0; while (cond) { __builtin_amdgcn_s_sleep(1); \
    if ((++_sp & 255u) == 0u) { if (xb_ld(&(bar)[XB_TMO])) break; if (_sp > XB_SPIN_CAP) { atomicAdd(&(bar)[XB_TMO], 1u); break; } } } } while (0)
struct XcdBarrier { unsigned* bar; unsigned x; volatile LAS unsigned* st; int wv; };
DI XcdBarrier xcd_barrier_post(unsigned* bar, volatile LAS unsigned* st, int wv) {
    XcdBarrier b; b.bar = bar; b.x = xb_xcc_id(); b.st = st; b.wv = wv;
    if (mk_tid(wv) == 0) (void)xb_add(&bar[XB_XCNT(b.x)], 1u);
    return b;
}
DI void xcd_barrier_complete(unsigned* bar, unsigned x, unsigned& nloc, unsigned& nx) {
    const unsigned G = gridDim.x * gridDim.y * gridDim.z;
    unsigned sum, cnt, mine, sp = 0u;
    for (;;) {
        sum = 0u; cnt = 0u; mine = 0u;
#pragma unroll
        for (unsigned j = 0; j < 16; ++j) { const unsigned c = xb_ld(&bar[XB_XCNT(j)]); sum += c; cnt += (c > 0u) ? 1u : 0u; }
        if (sum == G) { mine = xb_ld(&bar[XB_XCNT(x)]); break; }
        __builtin_amdgcn_s_sleep(1);
        if ((++sp & 255u) == 0u) { if (xb_ld(&bar[XB_TMO])) break; if (sp > XB_SPIN_CAP) { atomicAdd(&bar[XB_TMO], 1u); break; } }
    }
    nloc = mine > 0u ? mine : 1u; nx = cnt > 0u ? cnt : 1u;
}
DI void xcd_barrier(const XcdBarrier& b) {
    asm volatile("s_waitcnt vmcnt(0)" ::: "memory");
    __syncthreads();
    if (mk_tid(b.wv) == 0) {
        unsigned* bar = b.bar; unsigned bx = b.x;
        asm volatile("" : "+s"(bar), "+s"(bx));
        __builtin_amdgcn_s_waitcnt(0);
        unsigned nloc = b.st[0], nx = b.st[1];
        if (nloc == 0u) { xcd_barrier_complete(bar, bx, nloc, nx); b.st[0] = nloc; b.st[1] = nx; }
        const unsigned old = xb_add(&bar[XB_XSUB(bx)], 1u);
        const unsigned gen = old / nloc;
        if (old + 1u == (gen + 1u) * nloc) {
            __builtin_amdgcn_fence(__ATOMIC_RELEASE, "agent");
            asm volatile("s_waitcnt vmcnt(0)" ::: "memory");
            const unsigned og = xb_add(&bar[XB_TOP], 1u);
            const unsigned tg = og / nx;
            if (og + 1u == (tg + 1u) * nx) xb_add(&bar[XB_TOPGEN], 1u);
            else XB_SPIN(xb_ld(&bar[XB_TOPGEN]) == tg, bar);
            __builtin_amdgcn_fence(__ATOMIC_ACQUIRE, "agent");
            xb_add(&bar[XB_XGEN(bx)], 1u);
            asm volatile("s_waitcnt vmcnt(0)" ::: "memory");
        } else {
            XB_SPIN(xb_ld(&bar[XB_XGEN(bx)]) == gen, bar);
            __builtin_amdgcn_fence(__ATOMIC_ACQUIRE, "agent");
            asm volatile("s_waitcnt vmcnt(0)" ::: "memory");
        }
    }
    __syncthreads();
}

template <int MODE>
DI int srccol(int n) {
    if (MODE == 1) { return n < 928 ? n : (n < 1024 ? -1 : n - 96); }
    if (MODE == 2) { return n < 512 ? ((n >> 6) * 128 + (n & 63)) : (((n - 512) >> 6) * 128 + 64 + ((n - 512) & 63)); }
    return n;
}
template <int MODE>
DI void conv_tile(int t, const float* __restrict__ src, int ld_src, const float* __restrict__ gain, bfu* __restrict__ dst, int K, int n0, int k0, float* tile, int ksrc = 1 << 30) {
    float ld[8];
#pragma unroll
    for (int i = 0; i < 8; ++i) {
        const int kk = (t >> 6) + i * 8, nn = t & 63;
        const int sc = srccol<MODE>(n0 + nn);
        const int kr = k0 + kk < ksrc ? k0 + kk : 0;
        ld[i] = src[(size_t)kr * ld_src + (sc >= 0 ? sc : 0)] * (gain ? gain[kr] : 1.f);
    }
#pragma unroll
    for (int i = 0; i < 8; ++i) {
        const int kk = (t >> 6) + i * 8, nn = t & 63;
        const int sc = srccol<MODE>(n0 + nn);
        tile[kk * 65 + nn] = (sc >= 0 && k0 + kk < ksrc) ? ld[i] : 0.f;
    }
    __syncthreads();
#pragma unroll
    for (int i = 0; i < 8; ++i) {
        const int nn = (t >> 6) + i * 8, kk = t & 63;
        dst[(size_t)(n0 + nn) * K + k0 + kk] = f2bf(tile[kk * 65 + nn]);
    }
    __syncthreads();
}

DI void phase_prologue(const Params& p, LAS char* smem, int wv) {
    const int tid = mk_tid(wv), bid = blockIdx.x, nb = gridDim.x; smem = opql(smem);
    const int w = tid >> 6, lane = tid & 63;
    unsigned char* ws = opq(p.ws);
    {
        bfu* xb = (bfu*)(ws + WS_XB); float* ssp = (float*)(ws + WS_SSP);
        for (int t0 = (bid * 8 + w) * 4; t0 < T; t0 += nb * 8 * 4) {
            float4 xv[4][4];
#pragma unroll
            for (int q = 0; q < 4; ++q)
#pragma unroll
                for (int i = 0; i < 4; ++i) xv[q][i] = ((const float4*)(p.x + (size_t)(t0 + q) * DM))[i * 64 + lane];
#pragma unroll
            for (int q = 0; q < 4; ++q) { const int t = t0 + q;
                float ss = 0.f;
#pragma unroll
                for (int i = 0; i < 4; ++i) {
                    const float4 v = xv[q][i];
                    ss += v.x * v.x + v.y * v.y + v.z * v.z + v.w * v.w;
                    u32x2 o; o[0] = pk2(v.x, v.y); o[1] = pk2(v.z, v.w);
                    *(u32x2*)(xb + (size_t)t * DM + (i * 64 + lane) * 4) = o;
                }
                ss = wave_sum(ss);
                if (lane < 8) ssp[(size_t)t * 8 + lane] = lane == 0 ? ss : 0.f;
            }
        }
    }
    {
        float* tile = (float*)smem;
        for (int u = bid; u < NL * 1136; u += nb) {
            const int l = u / 1136; int r = u % 1136;
            unsigned char* wl = ws + WS_W + (size_t)l * WL_SIZE;
            if (r < 512) { conv_tile<1>(tid, p.w_in + (size_t)l * 1024 * 1952, 1952, p.norm_mix + l * 1024, (bfu*)(wl + WL_IN), 1024, (r >> 4) * 64, (r & 15) * 64, tile); continue; }
            r -= 512;
            if (r < 48) { conv_tile<0>(tid, p.mla_w_uq + (size_t)l * 256 * 768, 768, p.mla_q_norm + l * 256, (bfu*)(wl + WL_UQ), 256, (r >> 2) * 64, (r & 3) * 64, tile); continue; }
            r -= 48;
            if (r < 64) { conv_tile<2>(tid, p.mla_w_ukv + (size_t)l * 128 * 1024, 1024, p.mla_kv_norm + l * 128, (bfu*)(wl + WL_UKV), 256, (r >> 2) * 64, (r & 3) * 64, tile, 128); continue; }
            r -= 64;
            if (r < 256) { conv_tile<0>(tid, p.w_out + (size_t)l * 1024 * 1024, 1024, nullptr, (bfu*)(wl + WL_OUT), 1024, (r >> 4) * 64, (r & 15) * 64, tile); continue; }
            r -= 256;
            conv_tile<0>(tid, p.peer_w_q + (size_t)l * 1024 * 1024, 1024, p.norm_ffn + l * 1024, (bfu*)(wl + WL_Q), 1024, (r >> 4) * 64, (r & 15) * 64, tile);
        }
    }
    const size_t gtid = (size_t)bid * 512 + tid, gsz = (size_t)nb * 512;
    for (size_t e = gtid; e < (size_t)NL * 16 * 128 * 64; e += gsz) {
        const int l = (int)(e / (16 * 128 * 64)); const size_t r = e % (16 * 128 * 64);
        ((bfu*)(ws + WS_W + (size_t)l * WL_SIZE + WL_SK))[r] = f2bf(p.peer_sub_keys[e]);
    }
    for (size_t e = gtid; e < (size_t)NL * 4 * 128 * 128; e += gsz) {
        const int l = (int)(e / (4 * 128 * 128)); const size_t r = e % (4 * 128 * 128);
        const int tt = (int)((r >> 7) & 127), s = (int)(r & 127);
        ((bfu*)(ws + WS_W + (size_t)l * WL_SIZE + WL_GM))[r] = f2bf(s <= tt ? p.gm_ws[e] : 0.f);
    }
    {
        const int nrows = NL * NEXP;
        for (int rr0 = (bid * 8 + w) * 4; rr0 < 2 * nrows; rr0 += nb * 8 * 4) {
            f32x4 v[4][4];
#pragma unroll
            for (int q = 0; q < 4; ++q) { const int rr = rr0 + q; const int tab = rr >= nrows, row = tab ? rr - nrows : rr;
                const float* src = (tab ? p.peer_v : p.peer_u) + (size_t)row * DM;
#pragma unroll
                for (int i = 0; i < 4; ++i) v[q][i] = *(const f32x4*)(src + 256 * i + 4 * lane); }
#pragma unroll
            for (int q = 0; q < 4; ++q) { const int rr = rr0 + q; const int tab = rr >= nrows, row = tab ? rr - nrows : rr;
                float am = 0.f;
#pragma unroll
                for (int i = 0; i < 4; ++i) am = fmaxf(am, fmaxf(fmaxf(fabsf(v[q][i][0]), fabsf(v[q][i][1])), fmaxf(fabsf(v[q][i][2]), fabsf(v[q][i][3]))));
                am = rdlane_f(dpp_max63(am), 63);
                const bool i8 = !tab;
                const float qmax = i8 ? 127.f : 440.f;
                const float sc = am > 0.f ? qmax / am : 0.f;
                u32x4 o;
#pragma unroll
                for (int i = 0; i < 4; ++i) {
                    if (i8) o[i] = pack_i8x4(v[q][i][0] * sc, v[q][i][1] * sc, v[q][i][2] * sc, v[q][i][3] * sc);
                    else { int wd = 0; wd = __builtin_amdgcn_cvt_pk_fp8_f32(v[q][i][0] * sc, v[q][i][1] * sc, wd, false); wd = __builtin_amdgcn_cvt_pk_fp8_f32(v[q][i][2] * sc, v[q][i][3] * sc, wd, true); o[i] = (unsigned)wd; }
                }
                const int ly = row / NEXP, rw = row % NEXP;
                *(u32x4*)(ws + (tab ? WS_TABV : WS_TABU) + (size_t)ly * NEXP * DM + (size_t)(lane >> 3) * NEXP * 128 + (size_t)rw * 128 + 16 * (lane & 7)) = o;
                if (lane == 0) ((float*)(ws + (tab ? WS_SCV : WS_SCU)))[row] = am / qmax;
            }
        }
    }
    {
        float* ct = (float*)(ws + WS_COS); float* st = (float*)(ws + WS_SIN);
        for (size_t e = gtid; e < (size_t)T * 16; e += gsz) {
            const int t = (int)(e >> 4), i = (int)(e & 15);
            const float inv = expf(-9.210340371976184f * (float)i * (1.f / 16.f));
            const float ang = (float)p.pos[t] * inv;
            const float kq = rintf(ang * 0.15915494309189535f);
            float rr = fmaf(-kq, 6.2831854820251465f, ang); rr = fmaf(-kq, -1.7484555e-7f, rr);
            ct[e] = __cosf(rr); st[e] = __sinf(rr);
        }
    }
    {
        float* sp = (float*)(ws + WS_SP);
        for (int e = (int)gtid; e < NL * SP_STRIDE + 1024; e += (int)gsz) {
            float v = 0.f;
            if (e >= SP_FIN) v = p.norm_final[e - SP_FIN];
            else { const int l = e / SP_STRIDE, r = e % SP_STRIDE;
                if (r < SP_GMB) v = p.gm_v_norm[l * 256 + r];
                else if (r < SP_GMO) v = p.gm_b[l * 512 + r - SP_GMB];
                else if (r < SP_MLO) v = p.gm_out_norm[l * 256 + r - SP_GMO];
                else if (r < SP_HGO) v = p.mla_out_norm[l * 512 + r - SP_MLO];
                else if (r < SP_NFF) v = p.hg_out_norm[l * 256 + r - SP_HGO];
                else if (r < SP_NFF + 1024) v = p.norm_ffn[l * 1024 + r - SP_NFF]; }
            sp[e] = v;
        }
    }
    if (bid == 0 && tid < 256) {
        float lg[NL], mx = -1e30f;
#pragma unroll
        for (int l = 0; l < NL; ++l) { lg[l] = p.hg_lb_logits[l * 256 + tid]; mx = fmaxf(mx, lg[l]); }
        float sum = 0.f; for (int l = 0; l < NL; ++l) { lg[l] = expf(lg[l] - mx); sum += lg[l]; }
        float cum = 0.f; const float p0 = lg[0] / sum;
        for (int l = 0; l < NL; ++l) { cum += lg[l] / sum; ((float*)(ws + WS_LB))[l * 256 + tid] = cum - p0; }
    }
}

constexpr int BM = 256, BK = 64, HALF = 128, HTB = HALF * BK * 2, STAGE_BYTES = 8 * HTB;
constexpr int LDS_RS = STAGE_BYTES;
constexpr int LDS_TOTAL = 163840;
constexpr int LDS_BAR = LDS_TOTAL - 16;
DI int lds_byte(int r, int c) { const int st = (r >> 4) * 2 + (c >> 5), rr = r & 15, cc = c & 31, ob = rr * 64 + cc * 2; return st * 1024 + (ob ^ (((ob >> 9) & 1) << 5)); }
DI void stage_rc(int b, int& R, int& C) { const int st = b / 1024, sb = b % 1024, swz = sb ^ (((sb >> 9) & 1) << 5); R = (st >> 1) * 16 + swz / 64; C = (st & 1) * 32 + (swz % 64) / 2; }
DI int perm32(int rho) { const int n = rho >> 4, i = rho & 15; return 8 * (i >> 2) + 4 * n + (i & 3); }
struct Unit { int pm, pn, idx; };
struct Gemm { const bfu* A; const bfu* Bt; int lda, ldb, K; };
struct XSched {
    int nN, nunits, G, c, wv;
    DI bool next(int i, Unit& u) const { const int L = i * G + c; if (L >= nunits) return false; const int xcd = L & 7, slot = L >> 3; u.pm = (slot / nN) * 8 + xcd; u.pn = slot % nN; u.idx = i; return true; }
    DI void a_ready(const Unit&) const {}
    DI void done(const Unit&) const {}
};
template <class Epi, class Sched, bool STAMP = false>
DI void gemm_phase(LAS unsigned char* lds, const Gemm g, const Sched& S, const Epi& E, unsigned long long* stamps = nullptr) {
    int tid_ = mk_tid(S.wv);
    const int tid = tid_, wid = __builtin_amdgcn_readfirstlane(tid >> 6), lane = tid & 63, wr = wid >> 2, wc = wid & 3, fr = lane & 15, fq = lane >> 4;
    const int K = g.K, nt = K / BK, lda = g.lda, ldb = g.ldb;
    int ts_lo = 0, ts_hi = 0, nts = 0; const unsigned long long rt_entry = STAMP ? (unsigned long long)wall_clock64() : 0ull;
#define PG8_STAMP() do { if (STAMP && wid == 0 && nts < 64) { const unsigned long long _c = (unsigned long long)clock64(); \
        ts_lo = (lane == nts) ? (int)(unsigned)_c : ts_lo; ts_hi = (lane == nts) ? (int)(unsigned)(_c >> 32) : ts_hi; ++nts; } } while (0)
    PG8_STAMP();
    unsigned voffA[2], voffB[2];
#pragma unroll
    for (int i = 0; i < 2; ++i) { int R, C; stage_rc(tid * 16 + i * 8192, R, C); const int Rb = Epi::PERM ? ((R & ~31) + perm32(R & 31)) : R;
        voffA[i] = (unsigned)(R * lda + C) * 2u; voffB[i] = (unsigned)(Rb * ldb + C) * 2u; }
    const size_t kstep = (size_t)(BK * 2);
    const size_t hstepA = (size_t)HALF * lda * 2, hstepB = (size_t)HALF * ldb * 2;
    const size_t tstepA = 2 * hstepA, tstepB = 2 * hstepB;
    const unsigned ldsw = (unsigned)wid * 1024u;
    const int aoff = lds_byte(wr * 64 + fr, fq * 8), boff = lds_byte(wc * 32 + fr, fq * 8);
#define PG8_SA(b, h) (((b) * 2 + (h)) * HTB)
#define PG8_SB(b, h) ((4 + (b) * 2 + (h)) * HTB)
#define PG8_STAGE(bufoff, gbase, voff) do { _Pragma("unroll") for (int _i = 0; _i < 2; ++_i) \
        __builtin_amdgcn_global_load_lds((const unsigned*)((const char*)(gbase) + (voff)[_i]), (LAS unsigned*)(lds + (bufoff) + ldsw + _i * 8192), 16, 0, 0); } while (0)
#define PG8_LDA(dst, b, h) do { _Pragma("unroll") for (int m = 0; m < 4; ++m) _Pragma("unroll") for (int k = 0; k < 2; ++k) dst[m][k] = *(const LAS bf16x8*)(lds + PG8_SA(b, h) + aoff + m * 2048 + k * 1024); } while (0)
#define PG8_LDB(dst, b, h) do { _Pragma("unroll") for (int n = 0; n < 2; ++n) _Pragma("unroll") for (int k = 0; k < 2; ++k) dst[n][k] = *(const LAS bf16x8*)(lds + PG8_SB(b, h) + boff + n * 2048 + k * 1024); } while (0)
#define PG8_MMA(ai, bj, At, Bt) do { __builtin_amdgcn_s_setprio(1); _Pragma("unroll") for (int m = 0; m < 4; ++m) _Pragma("unroll") for (int n = 0; n < 2; ++n) _Pragma("unroll") for (int k = 0; k < 2; ++k) \
        acc[ai][bj][m][n] = __builtin_amdgcn_mfma_f32_16x16x32_bf16(Bt[n][k], At[m][k], acc[ai][bj][m][n], 0, 0, 0); __builtin_amdgcn_s_setprio(0); } while (0)
#define PG8_WAIT_V(n) asm volatile("s_waitcnt vmcnt(" #n ")" ::: "memory")
#define PG8_WAIT_L(n) asm volatile("s_waitcnt lgkmcnt(" #n ")" ::: "memory")
#define PG8_BAR __builtin_amdgcn_s_barrier()
#define PG8_SCHED __builtin_amdgcn_sched_barrier(0)
    Unit cur, nxt; int ui = 0;
    if (!S.next(0, cur)) return;
    f32x4 acc[2][2][4][2]; { const f32x4 zz = zero4_opaque();
#pragma unroll
    for (int a = 0; a < 2; ++a)
#pragma unroll
        for (int b = 0; b < 2; ++b)
#pragma unroll
            for (int m = 0; m < 4; ++m)
#pragma unroll
                for (int n = 0; n < 2; ++n) acc[a][b][m][n] = zz; }
    bf16x8 At[4][2], B0[2][2], B1[2][2];
    const char* cA = (const char*)g.A + (size_t)cur.pm * tstepA; const char* cB = (const char*)g.Bt + (size_t)cur.pn * tstepB;
    S.a_ready(cur);
    PG8_STAGE(PG8_SB(0, 0), cB, voffB); PG8_STAGE(PG8_SA(0, 0), cA, voffA); PG8_STAGE(PG8_SB(0, 1), cB + hstepB, voffB); PG8_STAGE(PG8_SA(0, 1), cA + hstepA, voffA);
    if (wr == 1) PG8_BAR;
    PG8_WAIT_V(4); PG8_BAR;
    PG8_STAGE(PG8_SB(1, 0), cB + kstep, voffB); PG8_STAGE(PG8_SA(1, 0), cA + kstep, voffA); PG8_STAGE(PG8_SB(1, 1), cB + hstepB + kstep, voffB);
    PG8_WAIT_V(6); PG8_BAR;
    PG8_STAMP();
    for (;;) {
        const bool has_next = S.next(ui + 1, nxt);
        const char* nA = has_next ? (const char*)g.A + (size_t)nxt.pm * tstepA : cA; const char* nB = has_next ? (const char*)g.Bt + (size_t)nxt.pn * tstepB : cB;
        for (int t = 0; t < nt; t += 2) {
            const bool last = (t == nt - 2);
            const char* a1 = cA + (size_t)(t + 1) * kstep;
            const char* a2 = last ? nA : cA + (size_t)(t + 2) * kstep; const char* b2 = last ? nB : cB + (size_t)(t + 2) * kstep;
            const char* a3 = a2 + kstep; const char* b3 = b2 + kstep;
            if (last && has_next) S.a_ready(nxt);
            PG8_LDB(B0, 0, 0); PG8_SCHED; PG8_LDA(At, 0, 0); PG8_STAGE(PG8_SA(1, 1), a1 + hstepA, voffA);
            PG8_WAIT_L(8); PG8_BAR; PG8_WAIT_L(0); PG8_MMA(0, 0, At, B0); PG8_BAR; PG8_SCHED;
            PG8_LDB(B1, 0, 1); PG8_STAGE(PG8_SB(0, 0), b2, voffB);
            PG8_BAR; PG8_WAIT_L(0); PG8_MMA(0, 1, At, B1); PG8_BAR;
            PG8_LDA(At, 0, 1); PG8_STAGE(PG8_SA(0, 0), a2, voffA);
            PG8_BAR; PG8_WAIT_L(0); PG8_MMA(1, 0, At, B0); PG8_BAR; PG8_SCHED;
            PG8_STAGE(PG8_SB(0, 1), b2 + hstepB, voffB);
            PG8_WAIT_V(6); PG8_BAR; PG8_MMA(1, 1, At, B1); PG8_BAR;
            PG8_LDB(B0, 1, 0); PG8_SCHED; PG8_LDA(At, 1, 0); PG8_STAGE(PG8_SA(0, 1), a2 + hstepA, voffA);
            PG8_WAIT_L(8); PG8_BAR; PG8_WAIT_L(0); PG8_MMA(0, 0, At, B0); PG8_BAR; PG8_SCHED;
            PG8_LDB(B1, 1, 1); PG8_STAGE(PG8_SB(1, 0), b3, voffB);
            PG8_BAR; PG8_WAIT_L(0); PG8_MMA(0, 1, At, B1); PG8_BAR;
            PG8_LDA(At, 1, 1); PG8_STAGE(PG8_SA(1, 0), a3, voffA);
            PG8_BAR; PG8_WAIT_L(0); PG8_MMA(1, 0, At, B0); PG8_BAR; PG8_SCHED;
            PG8_STAGE(PG8_SB(1, 1), b3 + hstepB, voffB);
            PG8_WAIT_V(6); PG8_BAR; PG8_MMA(1, 1, At, B1); PG8_BAR;
        }
        PG8_STAMP();
        if constexpr (!Epi::AFTER_DRAIN) { E(acc, cur, wr, wc, fr, fq); S.done(cur); }
        PG8_STAMP();
        if (!has_next) break;
        { const f32x4 zz = zero4_opaque();
#pragma unroll
        for (int a = 0; a < 2; ++a)
#pragma unroll
            for (int b = 0; b < 2; ++b)
#pragma unroll
                for (int m = 0; m < 4; ++m)
#pragma unroll
                    for (int n = 0; n < 2; ++n) acc[a][b][m][n] = zz; }
        cur = nxt; cA = nA; cB = nB; ++ui;
    }
    PG8_WAIT_V(0);
    if (wr == 0) PG8_BAR;
    PG8_BAR;
    if constexpr (Epi::AFTER_DRAIN) { E.fused(acc, cur, wr, wc, fr, fq, lds, wid, lane); S.done(cur); }
    PG8_STAMP();
    if (STAMP && wid == 0) { stamps[lane] = lane < nts ? (((unsigned long long)(unsigned)ts_hi << 32) | (unsigned)ts_lo) : 0ull;
        if (lane == 62) stamps[62] = rt_entry; if (lane == 63) stamps[63] = (unsigned long long)wall_clock64(); }
#undef PG8_STAMP
#undef PG8_SA
#undef PG8_SB
#undef PG8_STAGE
#undef PG8_LDA
#undef PG8_LDB
#undef PG8_MMA
#undef PG8_WAIT_V
#undef PG8_WAIT_L
#undef PG8_BAR
#undef PG8_SCHED
}

template <int NC>
DI void rows_rstd_lds(const bfu* __restrict__ A, int lda, int brow, LAS float* rs, int wv, float* gout = nullptr) {
    int tid = mk_tid(wv);
    const int w = tid >> 6, lane = tid & 63;
    if constexpr (NC == 1024) {
        for (int i0 = 0; i0 < 32; i0 += 8) {
            u32x4 va[8], vb[8];
#pragma unroll
            for (int i = 0; i < 8; ++i) { const bfu* row = A + (size_t)(brow + w * 32 + i0 + i) * lda; va[i] = *(const u32x4*)(row + lane * 8); vb[i] = *(const u32x4*)(row + 512 + lane * 8); }
#pragma unroll
            for (int i = 0; i < 8; ++i) {
                float ss = 0.f;
#pragma unroll
                for (int j = 0; j < 4; ++j) { const float x0 = bflo(va[i][j]), x1 = bfhi(va[i][j]), y0 = bflo(vb[i][j]), y1 = bfhi(vb[i][j]); ss += x0 * x0 + x1 * x1 + y0 * y0 + y1 * y1; }
                ss = rdlane_f(dpp_sum63(ss), 63);
                const int r = w * 32 + i0 + i;
                if (lane == 0) { const float rv = rsqrtf(ss * (1.f / NC) + EPS); rs[r] = rv; if (gout) gout[brow + r] = rv; }
            }
        }
    } else {
        constexpr int PER = NC / 64;
        for (int i0 = 0; i0 < 32; i0 += 16) {
            u32x2 v[16];
#pragma unroll
            for (int i = 0; i < 16; ++i) { const bfu* row = A + (size_t)(brow + w * 32 + i0 + i) * lda;
                if constexpr (PER == 4) v[i] = *(const u32x2*)(row + lane * 4); else { v[i][0] = *(const unsigned*)(row + lane * 2); v[i][1] = 0u; } }
#pragma unroll
            for (int i = 0; i < 16; ++i) {
                const float x0 = bflo(v[i][0]), x1 = bfhi(v[i][0]), y0 = bflo(v[i][1]), y1 = bfhi(v[i][1]);
                const float ss = rdlane_f(dpp_sum63(x0 * x0 + x1 * x1 + y0 * y0 + y1 * y1), 63);
                const int r = w * 32 + i0 + i;
                if (lane == 0) { const float rv = rsqrtf(ss * (1.f / NC) + EPS); rs[r] = rv; if (gout) gout[brow + r] = rv; }
            }
        }
    }
}
DI u32x2 pack4(f32x4 v) { u32x2 o; o[0] = pk2(v[0], v[1]); o[1] = pk2(v[2], v[3]); return o; }

DI void rope_perm(f32x4& a, f32x4& b, const float* ct, const float* st, size_t row, int fq) {
    const int i0 = 8 * (fq & 1);
    const f32x4 c0 = *(const f32x4*)(ct + row * 16 + i0), c1 = *(const f32x4*)(ct + row * 16 + i0 + 4), s0 = *(const f32x4*)(st + row * 16 + i0), s1 = *(const f32x4*)(st + row * 16 + i0 + 4);
    f32x4 pa, pb;
#pragma unroll
    for (int j = 0; j < 4; ++j) { pa[j] = swap32(a[j]); pb[j] = swap32(b[j]); }
    const float sg = fq < 2 ? -1.f : 1.f;
    a = a * c0 + pa * s0 * sg; b = b * c1 + pb * s1 * sg;
}
struct EpiProj {
    static constexpr bool PERM = true, AFTER_DRAIN = false;
    const float* rs; bfu* out; const float* ct; const float* st;
    DI void operator()(const f32x4 (&acc)[2][2][4][2], const Unit& u, int wr, int wc, int fr_, int fq_) const {
        int tz = mk_tid(wr * 4 + wc); const int fr = tz & 15, fq = (tz >> 4) & 3;
        const int row0 = u.pm * BM + wr * 64 + fr, colg = u.pn * BM + wc * 32;
        float sv[2][4];
        { f32x4 q0[2][4], q1[2][4];
#pragma unroll
          for (int ai = 0; ai < 2; ++ai)
#pragma unroll
            for (int m = 0; m < 4; ++m) { const int row = row0 + ai * HALF + m * 16; q0[ai][m] = *(const f32x4*)(rs + (size_t)row * 8); q1[ai][m] = *(const f32x4*)(rs + (size_t)row * 8 + 4); }
#pragma unroll
          for (int ai = 0; ai < 2; ++ai)
#pragma unroll
            for (int m = 0; m < 4; ++m) sv[ai][m] = rsqrtf((((q0[ai][m][0] + q0[ai][m][1]) + (q0[ai][m][2] + q0[ai][m][3])) + ((q1[ai][m][0] + q1[ai][m][1]) + (q1[ai][m][2] + q1[ai][m][3]))) * (1.f / DM) + EPS); }
#pragma unroll
        for (int ai = 0; ai < 2; ++ai)
#pragma unroll
            for (int m = 0; m < 4; ++m) {
                const int row = row0 + ai * HALF + m * 16; const float s = sv[ai][m];
#pragma unroll
                for (int bj = 0; bj < 2; ++bj) {
                    const int cg = colg + bj * HALF;
                    f32x4 a = acc[ai][bj][m][0] * s, b = acc[ai][bj][m][1] * s;
                    if (cg == PC_KR) rope_perm(a, b, ct, st, (size_t)row, fq);
                    u32x4 w4; w4[0] = pk2(a[0], a[1]); w4[1] = pk2(a[2], a[3]); w4[2] = pk2(b[0], b[1]); w4[3] = pk2(b[2], b[3]);
                    *(u32x4*)(out + (size_t)row * PW + cg + 8 * fq) = w4;
                }
            }
    }
};
template <bool ROPE>
struct EpiScaled {
    static constexpr bool PERM = true, AFTER_DRAIN = false;
    const LAS float* rs; bfu* out; int ld; const float* ct; const float* st; float scale;
    DI void operator()(const f32x4 (&acc)[2][2][4][2], const Unit& u, int wr, int wc, int fr_, int fq_) const {
        int tz = mk_tid(wr * 4 + wc); const int fr = tz & 15, fq = (tz >> 4) & 3;
        const int lrow0 = wr * 64 + fr, colg = u.pn * BM + wc * 32;
#pragma unroll
        for (int ai = 0; ai < 2; ++ai)
#pragma unroll
            for (int m = 0; m < 4; ++m) {
                const int lrow = lrow0 + ai * HALF + m * 16; const int row = u.pm * BM + lrow; const float s = rs[u.idx * 256 + lrow] * scale;
#pragma unroll
                for (int bj = 0; bj < 2; ++bj) {
                    const int cg = colg + bj * HALF;
                    f32x4 a = acc[ai][bj][m][0] * s, b = acc[ai][bj][m][1] * s;
                    if constexpr (ROPE) { if (((cg >> 5) % 3) == 2) rope_perm(a, b, ct, st, (size_t)row, fq); }
                    u32x4 w4; w4[0] = pk2(a[0], a[1]); w4[1] = pk2(a[2], a[3]); w4[2] = pk2(b[0], b[1]); w4[3] = pk2(b[2], b[3]);
                    *(u32x4*)(out + (size_t)row * ld + cg + 8 * fq) = w4;
                }
            }
    }
};
struct EpiResid {
    static constexpr bool PERM = true, AFTER_DRAIN = false;
    bfu* x;
    DI void operator()(const f32x4 (&acc)[2][2][4][2], const Unit& u, int wr, int wc, int fr_, int fq_) const {
        int tz = mk_tid(wr * 4 + wc); const int fr = tz & 15, fq = (tz >> 4) & 3;
        const int row0 = u.pm * BM + wr * 64 + fr, colg = u.pn * BM + wc * 32 + 8 * fq;
#pragma unroll
        for (int ai = 0; ai < 2; ++ai) {
            u32x4 old[4][2];
#pragma unroll
            for (int m = 0; m < 4; ++m)
#pragma unroll
                for (int bj = 0; bj < 2; ++bj) old[m][bj] = *(const u32x4*)(x + (size_t)(row0 + ai * HALF + m * 16) * DM + colg + bj * HALF);
#pragma unroll
            for (int m = 0; m < 4; ++m)
#pragma unroll
                for (int bj = 0; bj < 2; ++bj) {
                    const u32x4 od = old[m][bj]; const f32x4 v0 = acc[ai][bj][m][0], v1 = acc[ai][bj][m][1];
                    u32x4 o; o[0] = pk2(bflo(od[0]) + v0[0], bfhi(od[0]) + v0[1]); o[1] = pk2(bflo(od[1]) + v0[2], bfhi(od[1]) + v0[3]);
                    o[2] = pk2(bflo(od[2]) + v1[0], bfhi(od[2]) + v1[1]); o[3] = pk2(bflo(od[3]) + v1[2], bfhi(od[3]) + v1[3]);
                    *(u32x4*)(x + (size_t)(row0 + ai * HALF + m * 16) * DM + colg + bj * HALF) = o;
                }
        }
    }
};

constexpr int AT_KS = 208;
constexpr int AT_VS = 192;
constexpr int AT_KB = 64 * AT_KS, AT_VB = 64 * AT_VS, AT_BUF = AT_KB + AT_VB;

DI void attn_unit(const Params& p, unsigned char* ws, int l, int b, int h, int qt, LAS char* smem, int tid) {
    const int w = tid >> 6, lane = tid & 63, r = lane & 31, hh = lane >> 5;
    const bfu* Q = (const bfu*)(ws + WS_Q); const bfu* KV = (const bfu*)(ws + WS_KV); const bfu* PR = (const bfu*)(ws + WS_PROJ);
    const size_t tok0 = (size_t)b * SEQ;
    const int q0 = qt * 256 + w * 32;
    bf16x8 qf[6];
    { const bfu* qrow = Q + (tok0 + q0 + r) * 768 + h * 96 + 8 * hh;
#pragma unroll
      for (int ks = 0; ks < 6; ++ks) qf[ks] = *(const bf16x8*)(qrow + 16 * ks); }
    f32x16 o0 = zero16(), o1 = zero16();
    float mrun = -1e30f, lsum = 0.f;
    const int nkt = qt * 4 + 4, my_last = qt * 4 + (w >> 1);
    const int skey = tid >> 3, sch = tid & 7, rkey = (tid & 255) >> 2, rch = tid & 3;
    u32x4 gk, gv, gr;
    auto gload = [&](int kt) {
        const size_t t1 = tok0 + (size_t)kt * 64 + skey;
        gk = *(const u32x4*)(KV + t1 * 1024 + h * 64 + sch * 8);
        gv = *(const u32x4*)(KV + t1 * 1024 + 512 + h * 64 + sch * 8);
        if (tid < 256) gr = *(const u32x4*)(PR + (tok0 + (size_t)kt * 64 + rkey) * PW + PC_KR + rch * 8);
    };
    auto lstore = [&](int buf) {
        LAS char* kb = smem + buf * AT_BUF; LAS char* vb = kb + AT_KB;
        *(LAS u32x4*)(kb + skey * AT_KS + sch * 16) = gk;
        *(LAS u32x4*)(vb + skey * AT_VS + sch * 16) = gv;
        if (tid < 256) *(LAS u32x4*)(kb + rkey * AT_KS + 128 + rch * 16) = gr;
    };
    gload(0);
    __syncthreads();
    lstore(0);
    __syncthreads();
    const int i16 = lane & 15, q4 = i16 >> 2, p4 = i16 & 3, blk = (lane >> 4) & 1;
    for (int kt = 0; kt < nkt; ++kt) {
        const int cur = kt & 1;
        if (kt + 1 < nkt) gload(kt + 1);
        auto tile = [&](auto maskc) {
            constexpr bool MASK = decltype(maskc)::value;
            const LAS char* kb = smem + cur * AT_BUF; const LAS char* vb = kb + AT_KB;
            f32x16 s0 = zero16(), s1 = zero16();
#pragma unroll
            for (int ks = 0; ks < 6; ++ks) {
                const bf16x8 a0 = *(const LAS bf16x8*)(kb + r * AT_KS + ks * 32 + hh * 16);
                const bf16x8 a1 = *(const LAS bf16x8*)(kb + (32 + r) * AT_KS + ks * 32 + hh * 16);
                s0 = mfma32(a0, qf[ks], s0); s1 = mfma32(a1, qf[ks], s1);
            }
            if constexpr (MASK) {
                const int qa = q0 + r, kbase = kt * 64 + 4 * hh;
#pragma unroll
                for (int i = 0; i < 16; ++i) { const int kk = kbase + (i & 3) + 8 * (i >> 2); if (kk > qa) s0[i] = -1e30f; if (kk + 32 > qa) s1[i] = -1e30f; }
            }
            float mx = s0[0];
#pragma unroll
            for (int i = 1; i < 16; ++i) mx = fmaxf(mx, s0[i]);
#pragma unroll
            for (int i = 0; i < 16; ++i) mx = fmaxf(mx, s1[i]);
            mx = fmaxf(mx, swap32(mx));
            const float mnew = fmaxf(mrun, mx);
            if (__any(mnew > mrun)) {
                const float alpha = __builtin_amdgcn_exp2f(mrun - mnew);
                lsum *= alpha;
#pragma unroll
                for (int i = 0; i < 16; ++i) { o0[i] *= alpha; o1[i] *= alpha; }
                mrun = mnew;
            }
            float ps = 0.f;
#pragma unroll
            for (int i = 0; i < 16; ++i) { s0[i] = __builtin_amdgcn_exp2f(s0[i] - mrun); s1[i] = __builtin_amdgcn_exp2f(s1[i] - mrun); ps += s0[i] + s1[i]; }
            lsum += ps;
#pragma unroll
            for (int kk = 0; kk < 2; ++kk)
#pragma unroll
                for (int s = 0; s < 2; ++s) {
                    const bf16x8 pf = pack8(kk == 0 ? s0 : s1, s);
                    const int key0 = 32 * kk + 16 * s + 4 * hh + q4;
#pragma unroll
                    for (int vt = 0; vt < 2; ++vt) {
                        const LAS char* a = vb + key0 * AT_VS + (32 * vt + 16 * blk) * 2 + 8 * p4;
                        const bf16x8 vf = cat4(ldtr(a), ldtr(a + 8 * AT_VS));
                        if (vt == 0) o0 = mfma32(vf, pf, o0); else o1 = mfma32(vf, pf, o1);
                    }
                }
        };
        if (kt < my_last) tile(std::false_type{});
        else if (kt == my_last) tile(std::true_type{});
        if (kt + 1 < nkt) lstore(cur ^ 1);
        __syncthreads();
    }
    const float ltot = lsum + swap32(lsum);
    const float inv = 1.f / ltot;
    float ss = 0.f;
#pragma unroll
    for (int i = 0; i < 16; ++i) { o0[i] *= inv; o1[i] *= inv; ss += o0[i] * o0[i] + o1[i] * o1[i]; }
    ss += swap32(ss);
    const float rstd = rsqrtf(ss * (1.f / 64.f) + EPS);
    const float* gain = (const float*)(ws + WS_SP) + l * SP_STRIDE + SP_MLO + h * 64;
    bfu* yrow = (bfu*)(ws + WS_YCAT) + (tok0 + q0 + r) * 1024 + 256 + h * 64;
#pragma unroll
    for (int vt = 0; vt < 2; ++vt)
#pragma unroll
        for (int g = 0; g < 4; ++g) {
            const int v0 = 32 * vt + 8 * g + 4 * hh;
            const f32x4 gn = *(const f32x4*)(gain + v0);
            f32x4 ov;
#pragma unroll
            for (int i = 0; i < 4; ++i) ov[i] = (vt == 0 ? o0[4 * g + i] : o1[4 * g + i]) * rstd * gn[i];
            *(u32x2*)(yrow + v0) = pack4(ov);
        }
}

DI void attn_phase(const Params& p, int l, LAS char* smem, int wv) {
    int tid = mk_tid(wv); smem = opql(smem);
    unsigned char* ws = opq(p.ws);
    for (int pi = blockIdx.x; pi < 512; pi += gridDim.x) {
        const int bh = pi >> 2, j = pi & 3;
        attn_unit(p, ws, l, bh >> 3, bh & 7, 7 - j, smem, tid);
        attn_unit(p, ws, l, bh >> 3, bh & 7, j, smem, tid);
    }
}

constexpr int GM_VS = 576;

DI void gmlp_phase(const Params& p, int l, LAS char* smem, int wv) {
    int tid = mk_tid(wv); smem = opql(smem);
    const int w = tid >> 6, lane = tid & 63, r = lane & 31, hh = lane >> 5;
    unsigned char* ws = opq(p.ws);
    const bfu* PR = (const bfu*)(ws + WS_PROJ);
    bfu* YC = (bfu*)(ws + WS_YCAT);
    const bfu* WC = (const bfu*)(ws + WS_W + (size_t)l * WL_SIZE + WL_GM);
    for (int c = blockIdx.x; c < T / 128; c += gridDim.x) {
        const size_t tok0 = (size_t)c * 128;
        __syncthreads();
        {
            const f32x4 gn = *(const f32x4*)((const float*)(ws + WS_SP) + l * SP_STRIDE + SP_GMV + lane * 4);
            u32x2 vraw[16];
#pragma unroll
            for (int i = 0; i < 16; ++i) vraw[i] = *(const u32x2*)(PR + (tok0 + w * 16 + i) * PW + PC_V + lane * 4);
#pragma unroll
            for (int i = 0; i < 16; ++i) {
                const int s = w * 16 + i;
                const u32x2 raw = vraw[i];
                f32x4 v; v[0] = geluf(bflo(raw[0])); v[1] = geluf(bfhi(raw[0])); v[2] = geluf(bflo(raw[1])); v[3] = geluf(bfhi(raw[1]));
                float ss = v[0] * v[0] + v[1] * v[1] + v[2] * v[2] + v[3] * v[3];
                ss = sum16(ss);
                const float rstd = rsqrtf(ss * (1.f / 64.f) + EPS);
                f32x4 o; for (int j = 0; j < 4; ++j) o[j] = v[j] * rstd * gn[j];
                *(LAS u32x2*)(smem + s * GM_VS + lane * 8) = pack4(o);
            }
        }
        __syncthreads();
        const int h = w >> 1, th = w & 1;
        const int i16 = lane & 15, q4 = i16 >> 2, p4 = i16 & 3, blk = (lane >> 4) & 1;
        f32x16 acc[2][2];
#pragma unroll
        for (int a = 0; a < 2; ++a)
#pragma unroll
            for (int b2 = 0; b2 < 2; ++b2) acc[a][b2] = zero16();
        const bfu* wrow = WC + ((size_t)h * 128 + 64 * th + r) * 128 + 8 * hh;
#pragma unroll
        for (int ks = 0; ks < 8; ++ks) {
            bf16x8 af[2];
#pragma unroll
            for (int mt = 0; mt < 2; ++mt) {
                const LAS char* a = smem + (16 * ks + 8 * hh + q4) * GM_VS + (h * 64 + 32 * mt + 16 * blk) * 2 + 8 * p4;
                af[mt] = cat4(ldtr(a), ldtr(a + 4 * GM_VS));
            }
#pragma unroll
            for (int nt = 0; nt < 2; ++nt) {
                if (ks <= 4 * th + 2 * nt + 1) {
                    const bf16x8 bfr = *(const bf16x8*)(wrow + (size_t)nt * 32 * 128 + 16 * ks);
                    acc[0][nt] = mfma32(af[0], bfr, acc[0][nt]); acc[1][nt] = mfma32(af[1], bfr, acc[1][nt]);
                }
            }
        }
        const float* og = (const float*)(ws + WS_SP) + l * SP_STRIDE + SP_GMO + h * 64;
#pragma unroll
        for (int nt = 0; nt < 2; ++nt) {
            const int tl = 64 * th + 32 * nt + r;
            const float bv = ((const float*)(ws + WS_SP))[l * SP_STRIDE + SP_GMB + h * 128 + tl];
            const bfu* urow = PR + (tok0 + tl) * PW + PC_U + h * 64;
            f32x4 y[2][4]; float ss = 0.f;
#pragma unroll
            for (int mt = 0; mt < 2; ++mt)
#pragma unroll
                for (int g = 0; g < 4; ++g) {
                    const int d0 = 32 * mt + 8 * g + 4 * hh;
                    const u32x2 raw = *(const u32x2*)(urow + d0);
                    f32x4 u; u[0] = geluf(bflo(raw[0])); u[1] = geluf(bfhi(raw[0])); u[2] = geluf(bflo(raw[1])); u[3] = geluf(bfhi(raw[1]));
#pragma unroll
                    for (int i = 0; i < 4; ++i) { const float yy = u[i] * (acc[mt][nt][4 * g + i] + bv); y[mt][g][i] = yy; ss += yy * yy; }
                }
            ss += swap32(ss);
            const float rstd = rsqrtf(ss * (1.f / 64.f) + EPS);
            bfu* yrow = YC + (tok0 + tl) * 1024 + h * 64;
#pragma unroll
            for (int mt = 0; mt < 2; ++mt)
#pragma unroll
                for (int g = 0; g < 4; ++g) {
                    const int d0 = 32 * mt + 8 * g + 4 * hh;
                    const f32x4 gn = *(const f32x4*)(og + d0);
                    f32x4 o; for (int i = 0; i < 4; ++i) o[i] = y[mt][g][i] * rstd * gn[i];
                    *(u32x2*)(yrow + d0) = pack4(o);
                }
        }
    }
}

constexpr int HG_RS = 528;
constexpr int HG_TS = 576;
constexpr float HG_CLAMP = 80.f;

struct HgScan { float cum[32]; float kf[32]; float tot0, tot1; };
DI void hg_scan_pre(const unsigned short (&hfr)[32], int ch, int half, float lb, LAS float* xch, HgScan& S) {
    float run = 0.f;
#pragma unroll
    for (int i = 0; i < 32; ++i) {
        const float fx = bf2f(hfr[i]);
        const float sg = sigmoidf(fx);
        const float f = lb + (1.f - lb) * sg;
        run += __logf(fmaxf(f, 1e-20f));
        S.cum[i] = run; S.kf[i] = (1.f - lb) * (1.f - sg);
    }
    xch[half * 256 + ch] = run;
    __syncthreads();
    S.tot0 = xch[ch]; S.tot1 = xch[256 + ch];
}

DI void hg_local_phase(const Params& p, int l, LAS char* smem, int wv) {
    int tid = mk_tid(wv); smem = opql(smem);
    const int w = tid >> 6, lane = tid & 63, r = lane & 31, hh = lane >> 5;
    const int ch = tid & 255, half = tid >> 8;
    unsigned char* ws = opq(p.ws);
    const bfu* PR = (const bfu*)(ws + WS_PROJ);
    float* HST = (float*)(ws + WS_HST); float* HDEC = (float*)(ws + WS_HDEC);
    const float lb = ((const float*)(ws + WS_LB))[l * 256 + ch];
    LAS char* Kt = smem;
    LAS char* Vn = smem + 64 * HG_TS;
    LAS float* xch = (LAS float*)(smem + 2 * 64 * HG_TS);
    for (int uc = blockIdx.x; uc < 512; uc += gridDim.x) {
        const size_t tok0 = (size_t)uc * 64;
        unsigned short hfr[32];
#pragma unroll
        for (int i = 0; i < 32; ++i) hfr[i] = PR[(tok0 + 32 * half + i) * PW + PC_HF + ch];
        u32x4 vch[4];
#pragma unroll
        for (int i = 0; i < 4; ++i) { const int e = tid + i * 512, s = e >> 5, cch = e & 31; vch[i] = *(const u32x4*)(PR + (tok0 + s) * PW + PC_HI + cch * 8); }
        __syncthreads();
        HgScan S; hg_scan_pre(hfr, ch, half, lb, xch, S);
        const float btot = S.tot0 + S.tot1;
        const float e0 = half == 0 ? btot : S.tot1;
#pragma unroll
        for (int i = 0; i < 32; ++i) {
            const float kv = S.kf[i] * __expf(e0 - S.cum[i]);
            *(LAS bfu*)(Kt + (32 * half + i) * HG_TS + ch * 2) = f2bf(kv);
        }
        if (half == 0) HDEC[(size_t)uc * 256 + ch] = __expf(btot);
#pragma unroll
        for (int i = 0; i < 4; ++i) { const int e = tid + i * 512, s = e >> 5, cch = e & 31; *(LAS u32x4*)(Vn + s * HG_TS + cch * 16) = vch[i]; }
        __syncthreads();
        const int h = w >> 1, vh = w & 1;
        const int i16 = lane & 15, q4 = i16 >> 2, p4 = i16 & 3, blk = (lane >> 4) & 1;
        f32x16 acc0 = zero16(), acc1 = zero16();
#pragma unroll
        for (int ks = 0; ks < 4; ++ks) {
            const int srow = 16 * ks + 8 * hh + q4;
            const LAS char* a = Vn + srow * HG_TS + (h * 64 + 32 * vh + 16 * blk) * 2 + 8 * p4;
            const bf16x8 af = cat4(ldtr(a), ldtr(a + 4 * HG_TS));
            const LAS char* b0 = Kt + srow * HG_TS + (h * 64 + 16 * blk) * 2 + 8 * p4;
            const bf16x8 bf0 = cat4(ldtr(b0), ldtr(b0 + 4 * HG_TS));
            const bf16x8 bf1 = cat4(ldtr(b0 + 64), ldtr(b0 + 64 + 4 * HG_TS));
            acc0 = mfma32(af, bf0, acc0); acc1 = mfma32(af, bf1, acc1);
        }
        float* out = HST + ((size_t)uc * 4 + h) * 4096;
#pragma unroll
        for (int i = 0; i < 16; ++i) {
            const int v = 32 * vh + crow(i, hh);
            out[v * 64 + r] = acc0[i]; out[v * 64 + 32 + r] = acc1[i];
        }
    }
}

DI void hg_prefix_phase(const Params& p, int wv) {
    unsigned char* ws = opq(p.ws);
    float* HST = (float*)(ws + WS_HST); const float* HDEC = (const float*)(ws + WS_HDEC);
    int tid = mk_tid(wv);
    const int gsz = gridDim.x * 512;
    for (int e = blockIdx.x * 512 + tid; e < 64 * 4096; e += gsz) {
        const int bh = e >> 12, idx = e & 4095, b = bh >> 2, h = bh & 3;
        float S = 0.f;
        for (int c0 = 0; c0 < 32; c0 += 8) {
            float g8[8], d8[8];
#pragma unroll
            for (int k = 0; k < 8; ++k) { const size_t uc = (size_t)b * 32 + c0 + k; g8[k] = HST[(uc * 4 + h) * 4096 + idx]; d8[k] = HDEC[uc * 256 + h * 64 + (idx & 63)]; }
#pragma unroll
            for (int k = 0; k < 8; ++k) { const size_t uc = (size_t)b * 32 + c0 + k; HST[(uc * 4 + h) * 4096 + idx] = S; S = d8[k] * S + g8[k]; }
        }
    }
}

DI void hg_out_phase(const Params& p, int l, LAS char* smem, int wv) {
    int tid = mk_tid(wv); smem = opql(smem);
    const int w = tid >> 6, lane = tid & 63, r = lane & 31, hh = lane >> 5;
    const int ch = tid & 255, half = tid >> 8;
    unsigned char* ws = opq(p.ws);
    const bfu* PR = (const bfu*)(ws + WS_PROJ);
    const float* HST = (const float*)(ws + WS_HST);
    bfu* YC = (bfu*)(ws + WS_YCAT);
    const float lb = ((const float*)(ws + WS_LB))[l * 256 + ch];
    LAS char* Qe = smem;
    LAS char* Qm = smem + 64 * HG_RS;
    LAS char* Km = smem + 2 * 64 * HG_RS;
    LAS char* Vn = smem + 3 * 64 * HG_RS;
    LAS float* xch = (LAS float*)(smem + 3 * 64 * HG_RS + 64 * HG_TS);
    for (int uc = blockIdx.x; uc < 512; uc += gridDim.x) {
        const size_t tok0 = (size_t)uc * 64;
        const int h = w >> 1, th = w & 1;
        unsigned short hfr[32], hqr[32];
#pragma unroll
        for (int i = 0; i < 32; ++i) { const bfu* pp = PR + (tok0 + 32 * half + i) * PW + ch; hfr[i] = pp[PC_HF]; hqr[i] = pp[PC_HQ]; }
        u32x4 vch[4];
#pragma unroll
        for (int i = 0; i < 4; ++i) { const int e = tid + i * 512, s = e >> 5, cch = e & 31; vch[i] = *(const u32x4*)(PR + (tok0 + s) * PW + PC_HI + cch * 8); }
        const size_t tok = tok0 + 32 * th + r;
        u32x2 graw[2][4];
#pragma unroll
        for (int vt = 0; vt < 2; ++vt)
#pragma unroll
            for (int g = 0; g < 4; ++g) graw[vt][g] = *(const u32x2*)(PR + tok * PW + PC_HG + h * 64 + 32 * vt + 8 * g + 4 * hh);
        __syncthreads();
        HgScan S; hg_scan_pre(hfr, ch, half, lb, xch, S);
        f32x4 hs[2][4][2];
        { const float* st = HST + ((size_t)uc * 4 + h) * 4096;
#pragma unroll
          for (int vt = 0; vt < 2; ++vt)
#pragma unroll
            for (int ks = 0; ks < 4; ++ks) { const float* sp = st + (32 * vt + r) * 64 + 16 * ks + 8 * hh; hs[vt][ks][0] = *(const f32x4*)sp; hs[vt][ks][1] = *(const f32x4*)(sp + 4); } }
#pragma unroll
        for (int i = 0; i < 32; ++i) {
            const int s = 32 * half + i;
            const float q = siluf(bf2f(hqr[i]));
            const float b = half == 0 ? S.cum[i] : S.tot0 + S.cum[i];
            const float bm = half == 0 ? S.cum[i] - S.tot0 : S.cum[i];
            const float qe = q * __expf(b);
            const float qm = q * __expf(fminf(bm, HG_CLAMP));
            const float km = S.kf[i] * __expf(fminf(-bm, HG_CLAMP));
            *(LAS bfu*)(Qe + s * HG_RS + ch * 2) = f2bf(qe);
            *(LAS bfu*)(Qm + s * HG_RS + ch * 2) = f2bf(qm);
            *(LAS bfu*)(Km + s * HG_RS + ch * 2) = f2bf(km);
        }
#pragma unroll
        for (int i = 0; i < 4; ++i) { const int e = tid + i * 512, s = e >> 5, cch = e & 31; *(LAS u32x4*)(Vn + s * HG_TS + cch * 16) = vch[i]; }
        __syncthreads();
        const int i16 = lane & 15, q4 = i16 >> 2, p4 = i16 & 3, blk = (lane >> 4) & 1;
        f32x16 o0 = zero16(), o1 = zero16();
        {
#pragma unroll
            for (int ks = 0; ks < 4; ++ks) {
                const bf16x8 bq = *(const LAS bf16x8*)(Qe + (32 * th + r) * HG_RS + (h * 64 + 16 * ks + 8 * hh) * 2);
#pragma unroll
                for (int vt = 0; vt < 2; ++vt) {
                    const f32x4 s0 = hs[vt][ks][0], s1 = hs[vt][ks][1];
                    u32x4 pa; pa[0] = pk2(s0[0], s0[1]); pa[1] = pk2(s0[2], s0[3]); pa[2] = pk2(s1[0], s1[1]); pa[3] = pk2(s1[2], s1[3]);
                    const bf16x8 af = __builtin_bit_cast(bf16x8, pa);
                    if (vt == 0) o0 = mfma32(af, bq, o0); else o1 = mfma32(af, bq, o1);
                }
            }
        }
#pragma unroll
        for (int st_ = 0; st_ < 2; ++st_) {
            if (st_ <= th) {
                f32x16 x = zero16();
#pragma unroll
                for (int ks = 0; ks < 4; ++ks) {
                    const bf16x8 ak = *(const LAS bf16x8*)(Km + (32 * st_ + r) * HG_RS + (h * 64 + 16 * ks + 8 * hh) * 2);
                    const bf16x8 bq = *(const LAS bf16x8*)(Qm + (32 * th + r) * HG_RS + (h * 64 + 16 * ks + 8 * hh) * 2);
                    x = mfma32(ak, bq, x);
                }
                if (st_ == th) {
#pragma unroll
                    for (int i = 0; i < 16; ++i) if (crow(i, hh) > r) x[i] = 0.f;
                }
#pragma unroll
                for (int s2 = 0; s2 < 2; ++s2) {
                    const bf16x8 pf = pack8(x, s2);
                    const int srow = 32 * st_ + 16 * s2 + 4 * hh + q4;
#pragma unroll
                    for (int vt = 0; vt < 2; ++vt) {
                        const LAS char* a = Vn + srow * HG_TS + (h * 64 + 32 * vt + 16 * blk) * 2 + 8 * p4;
                        const bf16x8 vf = cat4(ldtr(a), ldtr(a + 8 * HG_TS));
                        if (vt == 0) o0 = mfma32(vf, pf, o0); else o1 = mfma32(vf, pf, o1);
                    }
                }
            }
        }
        float ss = 0.f;
#pragma unroll
        for (int i = 0; i < 16; ++i) ss += o0[i] * o0[i] + o1[i] * o1[i];
        ss += swap32(ss);
        const float rstd = rsqrtf(ss * (1.f / 64.f) + EPS);
        bfu* yrow = YC + tok * 1024 + 768 + h * 64;
        const float* og = (const float*)(ws + WS_SP) + l * SP_STRIDE + SP_HGO + h * 64;
#pragma unroll
        for (int vt = 0; vt < 2; ++vt)
#pragma unroll
            for (int g = 0; g < 4; ++g) {
                const int v0 = 32 * vt + 8 * g + 4 * hh;
                const u32x2 raw = graw[vt][g];
                const f32x4 gn = *(const f32x4*)(og + v0);
                f32x4 gg; gg[0] = siluf(bflo(raw[0])); gg[1] = siluf(bfhi(raw[0])); gg[2] = siluf(bflo(raw[1])); gg[3] = siluf(bfhi(raw[1]));
                f32x4 ov;
#pragma unroll
                for (int i = 0; i < 4; ++i) ov[i] = (vt == 0 ? o0[4 * g + i] : o1[4 * g + i]) * rstd * gn[i] * gg[i];
                *(u32x2*)(yrow + v0) = pack4(ov);
            }
    }
}

DI void ins16(float (&a)[16], float v) {
#pragma unroll
    for (int j = 15; j >= 1; --j) a[j] = __builtin_amdgcn_fmed3f(a[j - 1], a[j], v);
    a[0] = fmaxf(a[0], v);
}
DI void peer_topk_phase(const Params& p, int l, LAS char* smem, int wv) {
    int tid = mk_tid(wv); smem = opql(smem);
    const int w = tid >> 6, lane = tid & 63, r = lane & 31, hh = lane >> 5;
    unsigned char* ws = opq(p.ws);
    const bfu* PQ = (const bfu*)(ws + WS_PQ);
    const bfu* SK = (const bfu*)(ws + WS_W + (size_t)l * WL_SIZE + WL_SK);
    unsigned short* IDS = (unsigned short*)(ws + WS_IDS); float* GATE = (float*)(ws + WS_GATE);
    for (int u = blockIdx.x; u < T / 32; u += gridDim.x) {
        const size_t tok = (size_t)u * 32 + r;
        float lst[2][16];
        bf16x8 qf[2][4];
#pragma unroll
        for (int pp = 0; pp < 2; ++pp)
#pragma unroll
            for (int ks = 0; ks < 4; ++ks) qf[pp][ks] = *(const bf16x8*)(PQ + tok * 1024 + w * 128 + pp * 64 + 16 * ks + 8 * hh);
        const bfu* skb = SK + ((size_t)(w * 2) * 128 + r) * 64 + 8 * hh;
        bf16x8 af[2][4];
#pragma unroll
        for (int ks = 0; ks < 4; ++ks) af[0][ks] = *(const bf16x8*)(skb + 16 * ks);
        float a[16];
#pragma unroll
        for (int st = 0; st < 8; ++st) {
            const int pp = st >> 2, kt = st & 3;
            if (kt == 0) {
#pragma unroll
                for (int j = 0; j < 16; ++j) a[j] = -3.0e38f;
            }
            f32x16 acc = zero16();
#pragma unroll
            for (int ks = 0; ks < 4; ++ks) acc = mfma32(af[st & 1][ks], qf[pp][ks], acc);
            if (st < 7) {
                const int np = (st + 1) >> 2, nk = (st + 1) & 3;
#pragma unroll
                for (int ks = 0; ks < 4; ++ks) af[(st + 1) & 1][ks] = *(const bf16x8*)(skb + (size_t)np * 128 * 64 + (size_t)nk * 32 * 64 + 16 * ks);
            }
#pragma unroll
            for (int i = 0; i < 16; ++i) {
                const unsigned key = 32 * kt + (i & 3) + 8 * (i >> 2) + 4 * hh;
                ins16(a, __uint_as_float((__float_as_uint(acc[i]) & 0xffffff80u) | key));
            }
            if (kt == 3) {
                float ob[16];
#pragma unroll
                for (int j = 0; j < 16; ++j) ob[j] = swap32(a[j]);
#pragma unroll
                for (int j = 0; j < 16; ++j) ins16(a, ob[j]);
#pragma unroll
                for (int j = 0; j < 16; ++j) lst[pp][j] = a[j];
            }
        }
        float c[16];
#pragma unroll
        for (int j = 0; j < 16; ++j) c[j] = lst[0][0] + lst[1][j];
#pragma unroll
        for (int i = 1; i < 16; ++i)
#pragma unroll
            for (int j = 0; j < 16; ++j) if ((i + 1) * (j + 1) <= 16) ins16(c, lst[0][i] + lst[1][j]);
        const float thr = c[15], mx = c[0];
        float den = 0.f;
#pragma unroll
        for (int j = 0; j < 16; ++j) den += __expf(c[j] - mx);
        const float rden = 1.f / den;
        int cnt = 0;
        unsigned short* idp = IDS + tok * 128 + w * 16; float* gp = GATE + tok * 128 + w * 16;
        if (hh == 0) {
#pragma unroll
            for (int i = 0; i < 16; ++i)
#pragma unroll
                for (int j = 0; j < 16; ++j) if ((i + 1) * (j + 1) <= 16) {
                    const float s = lst[0][i] + lst[1][j];
                    if (s >= thr && cnt < 16) {
                        idp[cnt] = (unsigned short)((__float_as_uint(lst[0][i]) & 127u) * 128u + (__float_as_uint(lst[1][j]) & 127u));
                        gp[cnt] = __expf(s - mx) * rden;
                        ++cnt;
                    }
                }
            if (cnt < 16) {
#pragma unroll
                for (int k = 0; k < 16; ++k) if (k >= cnt) { idp[k] = 0; gp[k] = 0.f; }
            }
        }
    }
}

#ifndef PGQT
#define PGQT 512
#endif
constexpr int PGQ_TILE = PGQT, PGQ_ITEMS = T / PGQ_TILE;
constexpr int LDS_PGQ = 160 * 1024 - 64;
DI f32x2 fp8lo(unsigned w) { return __builtin_amdgcn_cvt_pk_f32_fp8(w, false); }
DI f32x2 fp8hi(unsigned w) { return __builtin_amdgcn_cvt_pk_f32_fp8(w, true); }
typedef _Float16 h2_t __attribute__((ext_vector_type(2)));
constexpr float PGV_CSCALE = 1024.f;
DI unsigned* pgq_counter(unsigned char* ws, int l, int ph, int slice) { return (unsigned*)(ws + WS_CTL + 16384) + ((l * 4 + ph) * 8 + slice) * 64; }
DI bool pgq_pop(unsigned char* ws, int l, int ph, int home, int& kdone, LAS int* bc, int tid, int& slice, int& tile) {
    __syncthreads();
    if (tid == 0) {
        int k = kdone, s = -1, ti = 0;
        while (k < 8) {
            s = (home + k) & 7;
            ti = (int)__hip_atomic_fetch_add(pgq_counter(ws, l, ph, s), 1u, __ATOMIC_RELAXED, __HIP_MEMORY_SCOPE_AGENT);
            if (ti < PGQ_ITEMS) break;
            ++k;
        }
        bc[0] = k < 8 ? s : -1; bc[1] = ti; bc[2] = k;
    }
    __syncthreads();
    slice = __builtin_amdgcn_readfirstlane(bc[0]); tile = __builtin_amdgcn_readfirstlane(bc[1]); kdone = __builtin_amdgcn_readfirstlane(bc[2]);
    return slice >= 0;
}
template <int CTRL> DI float dpp_perm(float v) { return __builtin_bit_cast(float, __builtin_amdgcn_update_dpp(0, __builtin_bit_cast(int, v), CTRL, 0xf, 0xf, false)); }
DI float sum8(float v) { v += dpp_perm<0xB1>(v); v += dpp_perm<0x4E>(v); v += dpp_perm<0x141>(v); return v; }

#ifndef PGVR
#define PGVR 16
#endif
constexpr int PGV_STRIDE = 129;
DI void peer_u_phase(const Params& p, int l, LAS char* smem, int wv, int qid = 0) {
    int tid = mk_tid(wv); smem = opql(smem);
    const int w = tid >> 6, lane = tid & 63, g = lane >> 3, j = lane & 7;
    unsigned char* ws = opq(p.ws);
    const bfu* XB = (const bfu*)(ws + WS_XB);
    const unsigned short* IDS = (const unsigned short*)(ws + WS_IDS);
    const GAS unsigned char* TU = (const GAS unsigned char*)(ws + WS_TABU + (size_t)l * NEXP * DM);
    const float* RSTF = (const float*)(ws + WS_RSTF);
    unsigned* PART = (unsigned*)(ws + WS_PROJ);
    const float* gn = (const float*)(ws + WS_SP) + l * SP_STRIDE + SP_NFF;
    LAS int* bc = (LAS int*)(smem + LDS_PGQ);
    LAS int* idl = (LAS int*)smem + w * (2 * 8 * PGV_STRIDE) + g * PGV_STRIDE;
    const int home = (int)xb_xcc_id() & 7;
    int kdone = 0, x, tile;
    while (pgq_pop(ws, l, qid, home, kdone, bc, tid, x, tile)) {
      u32x4 nids[2]; u32x2 nx[4]; float nrstd; f32x4 gv[4];
#define PGU_FETCH(tt) { _Pragma("unroll") for (int k = 0; k < 2; ++k) nids[k] = *(const u32x4*)(IDS + (size_t)(tt) * 128 + 16 * j + 8 * k); nrstd = RSTF[tt]; \
        _Pragma("unroll") for (int i = 0; i < 4; ++i) nx[i] = *(const u32x2*)(XB + (size_t)(tt) * DM + 32 * x + 4 * j + 256 * i); }
      PGU_FETCH(tile * PGQ_TILE + w * 8 + g)
#pragma unroll
      for (int i = 0; i < 4; ++i) gv[i] = *(const f32x4*)(gn + 256 * i + 32 * x + 4 * j);
      for (int sub = 0; sub < PGQ_TILE / 64; ++sub) {
        const int t = tile * PGQ_TILE + sub * 64 + w * 8 + g;
#pragma unroll
        for (int k = 0; k < 2; ++k)
#pragma unroll
            for (int c = 0; c < 4; ++c) { idl[16 * j + 8 * k + 2 * c] = (int)(nids[k][c] & 0xffffu); idl[16 * j + 8 * k + 2 * c + 1] = (int)(nids[k][c] >> 16); }
        const float rstd = nrstd;
        u32x2 xr[4];
#pragma unroll
        for (int i = 0; i < 4; ++i) xr[i] = nx[i];
        if (sub + 1 < PGQ_TILE / 64) PGU_FETCH(t + 64)
        f32x4 xf[4]; float am = 0.f;
#pragma unroll
        for (int i = 0; i < 4; ++i) { const u32x2 raw = xr[i];
            xf[i][0] = bflo(raw[0]) * rstd * gv[i][0]; xf[i][1] = bfhi(raw[0]) * rstd * gv[i][1]; xf[i][2] = bflo(raw[1]) * rstd * gv[i][2]; xf[i][3] = bfhi(raw[1]) * rstd * gv[i][3];
            am = fmaxf(am, fmaxf(fmaxf(fabsf(xf[i][0]), fabsf(xf[i][1])), fmaxf(fabsf(xf[i][2]), fabsf(xf[i][3])))); }
        am = fmaxf(am, dpp_perm<0xB1>(am)); am = fmaxf(am, dpp_perm<0x4E>(am)); am = fmaxf(am, dpp_perm<0x141>(am));
        const float qs = am > 0.f ? 127.f / am : 0.f, sx = am * (1.f / 127.f);
        unsigned xq[4];
#pragma unroll
        for (int i = 0; i < 4; ++i) xq[i] = pack_i8x4(xf[i][0] * qs, xf[i][1] * qs, xf[i][2] * qs, xf[i][3] * qs);
        const GAS unsigned char* tux = TU + (size_t)x * NEXP * 128;
        unsigned* prow = PART + ((size_t)x * T + t) * 64 + j;
        {
            u32x4 r[16];
#define PGU_ISSUE(k, e) { const unsigned off_ = (unsigned)idl[e] * 128u + 16u * (unsigned)j; r[k] = *(const GAS u32x4*)(tux + off_); }
#define PGU_DOT(k) { int di_ = 0; _Pragma("unroll") for (int i = 0; i < 4; ++i) di_ = __builtin_amdgcn_sdot4((int)r[k][i], (int)xq[i], di_, false); dk[(k) & 7] = di_; }
#define PGU_REDUCE(OUT) { int a_[4], b_[2]; \
                _Pragma("unroll") for (int m = 0; m < 4; ++m) { const int snd = lo4 ? dk[4 + m] : dk[m], kp = lo4 ? dk[m] : dk[4 + m]; a_[m] = kp + __builtin_amdgcn_update_dpp(0, snd, 0x141, 0xf, 0xf, false); } \
                _Pragma("unroll") for (int n = 0; n < 2; ++n) { const int snd = b2 ? a_[n] : a_[2 + n], kp = b2 ? a_[2 + n] : a_[n]; b_[n] = kp + __builtin_amdgcn_update_dpp(0, snd, 0x4E, 0xf, 0xf, false); } \
                { const int snd = b1 ? b_[0] : b_[1], kp = b1 ? b_[1] : b_[0]; OUT = (float)(kp + __builtin_amdgcn_update_dpp(0, snd, 0xB1, 0xf, 0xf, false)) * sx; } }
            const bool lo4 = j < 4, b2 = (j & 2) != 0, b1 = (j & 1) != 0;
            int dk[8];
#pragma unroll
            for (int k = 0; k < 16; ++k) PGU_ISSUE(k, k)
#pragma unroll 1
            for (int e0 = 0; e0 < 128; e0 += 16) {
                float p0, p1;
                if (e0 + 16 < 128) {
#pragma unroll
                    for (int k = 0; k < 8; ++k) { PGU_DOT(k) PGU_ISSUE(k, e0 + 16 + k) }
                    PGU_REDUCE(p0)
#pragma unroll
                    for (int k = 8; k < 16; ++k) { PGU_DOT(k) PGU_ISSUE(k, e0 + 16 + k) }
                    PGU_REDUCE(p1)
                } else {
#pragma unroll
                    for (int k = 0; k < 8; ++k) { PGU_DOT(k) }
                    PGU_REDUCE(p0)
#pragma unroll
                    for (int k = 8; k < 16; ++k) { PGU_DOT(k) }
                    PGU_REDUCE(p1)
                }
                { const h2_t hp = {(_Float16)p0, (_Float16)p1}; prow[e0 >> 1] = __builtin_bit_cast(unsigned, hp); }
            }
#undef PGU_DOT
#undef PGU_REDUCE
#undef PGU_ISSUE
        }
      }
    }
}
DI void peer_c_phase(const Params& p, int l, int wv) {
    int tid = mk_tid(wv);
    const int w = tid >> 6, lane = tid & 63;
    unsigned char* ws = opq(p.ws);
    const unsigned short* IDS = (const unsigned short*)(ws + WS_IDS); const float* GATE = (const float*)(ws + WS_GATE);
    const float* SCU = (const float*)(ws + WS_SCU) + l * NEXP; const float* SCV = (const float*)(ws + WS_SCV) + l * NEXP;
    const unsigned* PART = (const unsigned*)(ws + WS_PROJ); _Float16* COEF = (_Float16*)(ws + WS_COEF);
    for (int t0 = (blockIdx.x * 8 + w) * 4; t0 < T; t0 += gridDim.x * 8 * 4) {
        const int e0 = 16 * (lane >> 3) + (lane & 7);
        unsigned pr[4][8]; int id0[4], id1[4]; float g0[4], g1[4];
#pragma unroll
        for (int q = 0; q < 4; ++q) { const int t = t0 + q;
#pragma unroll
            for (int x = 0; x < 8; ++x) pr[q][x] = PART[((size_t)x * T + t) * 64 + lane];
            id0[q] = IDS[(size_t)t * 128 + e0]; id1[q] = IDS[(size_t)t * 128 + e0 + 8]; g0[q] = GATE[(size_t)t * 128 + e0]; g1[q] = GATE[(size_t)t * 128 + e0 + 8]; }
#pragma unroll
        for (int q = 0; q < 4; ++q) { const int t = t0 + q;
            f32x2 s = {0.f, 0.f};
#pragma unroll
            for (int x = 0; x < 8; ++x) { const h2_t hp = __builtin_bit_cast(h2_t, pr[q][x]); s.x += (float)hp.x; s.y += (float)hp.y; }
            COEF[(size_t)t * 128 + e0] = (_Float16)(geluf(s.x * SCU[id0[q]]) * g0[q] * SCV[id0[q]] * PGV_CSCALE);
            COEF[(size_t)t * 128 + e0 + 8] = (_Float16)(geluf(s.y * SCU[id1[q]]) * g1[q] * SCV[id1[q]] * PGV_CSCALE);
        }
    }
}

DI void peer_v_phase(const Params& p, int l, LAS char* smem, int wv, int qid = 1) {
    int tid = mk_tid(wv); smem = opql(smem);
    const int w = tid >> 6, lane = tid & 63, g = lane >> 3, j = lane & 7;
    unsigned char* ws = opq(p.ws);
    bfu* XB = (bfu*)(ws + WS_XB);
    const unsigned short* IDS = (const unsigned short*)(ws + WS_IDS); const unsigned short* COEF = (const unsigned short*)(ws + WS_COEF);
    const GAS unsigned char* TV = (const GAS unsigned char*)(ws + WS_TABV + (size_t)l * NEXP * DM);
    float* SSP = (float*)(ws + WS_SSP);
    LAS int* bc = (LAS int*)(smem + LDS_PGQ);
    LAS int* idl = (LAS int*)smem + w * (2 * 8 * PGV_STRIDE) + g * PGV_STRIDE;
    LAS float* cfl = (LAS float*)idl + 8 * PGV_STRIDE;
    const int home = (int)xb_xcc_id() & 7;
    int kdone = 0, x, tile;
    while (pgq_pop(ws, l, qid, home, kdone, bc, tid, x, tile)) {
      u32x4 nids[2], ncf[2]; u32x2 nx[4];
#define PGV_FETCH(tt) { _Pragma("unroll") for (int k = 0; k < 2; ++k) { nids[k] = *(const u32x4*)(IDS + (size_t)(tt) * 128 + 16 * j + 8 * k); ncf[k] = *(const u32x4*)(COEF + (size_t)(tt) * 128 + 16 * j + 8 * k); } \
        _Pragma("unroll") for (int i = 0; i < 4; ++i) nx[i] = *(const u32x2*)(XB + (size_t)(tt) * DM + 32 * x + 4 * j + 256 * i); }
      PGV_FETCH(tile * PGQ_TILE + w * 8 + g)
      for (int sub = 0; sub < PGQ_TILE / 64; ++sub) {
        const int t = tile * PGQ_TILE + sub * 64 + w * 8 + g;
#pragma unroll
        for (int k = 0; k < 2; ++k)
#pragma unroll
            for (int c = 0; c < 4; ++c) { const unsigned iw = nids[k][c], cw = ncf[k][c];
                idl[16 * j + 8 * k + 2 * c] = (int)(iw & 0xffffu); idl[16 * j + 8 * k + 2 * c + 1] = (int)(iw >> 16);
                cfl[16 * j + 8 * k + 2 * c] = __uint_as_float((cw & 0xffffu) | (cw << 16)); cfl[16 * j + 8 * k + 2 * c + 1] = __uint_as_float((cw >> 16) | (cw & 0xffff0000u)); }
        u32x2 xold[4];
#pragma unroll
        for (int i = 0; i < 4; ++i) xold[i] = nx[i];
        if (sub + 1 < PGQ_TILE / 64) PGV_FETCH(t + 64)
        h2_t acc[8];
#pragma unroll
        for (int c = 0; c < 8; ++c) acc[c] = (h2_t){(_Float16)0.f, (_Float16)0.f};
        const GAS unsigned char* tvx = TV + (size_t)x * NEXP * 128;
        {
            u32x4 r[PGVR]; float cf[PGVR];
#define PGV_ISSUE(k, e) { const unsigned off_ = (unsigned)idl[e] * 128u + 16u * (unsigned)j; cf[k] = cfl[e]; r[k] = *(const GAS u32x4*)(tvx + off_); }
#define PGV_USE(k) { const h2_t c2 = __builtin_bit_cast(h2_t, cf[k]); _Pragma("unroll") for (int i = 0; i < 4; ++i) { const unsigned wd = r[k][i]; \
                acc[2 * i] = __builtin_elementwise_fma(c2, __builtin_bit_cast(h2_t, __builtin_amdgcn_cvt_scalef32_pk_f16_fp8(wd, 1.0f, false)), acc[2 * i]); \
                acc[2 * i + 1] = __builtin_elementwise_fma(c2, __builtin_bit_cast(h2_t, __builtin_amdgcn_cvt_scalef32_pk_f16_fp8(wd, 1.0f, true)), acc[2 * i + 1]); } }
#pragma unroll
            for (int k = 0; k < PGVR; ++k) PGV_ISSUE(k, k)
            for (int e0 = PGVR; e0 < 128; e0 += PGVR) {
#pragma unroll
                for (int k = 0; k < PGVR; ++k) { PGV_USE(k) PGV_ISSUE(k, e0 + k) }
            }
#pragma unroll
            for (int k = 0; k < PGVR; ++k) PGV_USE(k)
#undef PGV_ISSUE
#undef PGV_USE
#undef PGV_FETCH
        }
        bfu* xrow = XB + (size_t)t * DM + 32 * x + 4 * j;
        float s2 = 0.f;
#pragma unroll
        for (int i = 0; i < 4; ++i) {
            u32x2* px = (u32x2*)(xrow + 256 * i); const u32x2 old = xold[i];
            const float us = 1.f / PGV_CSCALE;
            const float y0 = bflo(old[0]) + (float)acc[2 * i].x * us, y1 = bfhi(old[0]) + (float)acc[2 * i].y * us, y2 = bflo(old[1]) + (float)acc[2 * i + 1].x * us, y3 = bfhi(old[1]) + (float)acc[2 * i + 1].y * us;
            u32x2 o; o[0] = pk2(y0, y1); o[1] = pk2(y2, y3); *px = o;
            const float z0 = bflo(o[0]), z1 = bfhi(o[0]), z2 = bflo(o[1]), z3 = bfhi(o[1]);
            s2 += z0 * z0 + z1 * z1 + z2 * z2 + z3 * z3;
        }
        s2 = sum8(s2);
        if (j == 0) SSP[(size_t)t * 8 + x] = s2;
      }
    }
}

DI void final_norm_phase(const Params& p, int wv) {
    int tid = mk_tid(wv);
    const int w = tid >> 6, lane = tid & 63;
    unsigned char* ws = opq(p.ws);
    const bfu* XB = (const bfu*)(ws + WS_XB); const float* SSP = (const float*)(ws + WS_SSP);
    const float* gfin = (const float*)(ws + WS_SP) + SP_FIN;
    f32x4 g[4];
#pragma unroll
    for (int i = 0; i < 4; ++i) g[i] = *(const f32x4*)(gfin + 256 * i + 4 * lane);
    for (int t0 = (blockIdx.x * 8 + w) * 4; t0 < T; t0 += gridDim.x * 8 * 4) {
        f32x4 q0[4], q1[4]; u32x2 raw[4][4];
#pragma unroll
        for (int q = 0; q < 4; ++q) { const int t = t0 + q; q0[q] = *(const f32x4*)(SSP + (size_t)t * 8); q1[q] = *(const f32x4*)(SSP + (size_t)t * 8 + 4);
#pragma unroll
            for (int i = 0; i < 4; ++i) raw[q][i] = *(const u32x2*)(XB + (size_t)t * DM + 256 * i + 4 * lane); }
#pragma unroll
        for (int q = 0; q < 4; ++q) { const int t = t0 + q;
            const float r2 = rsqrtf((((q0[q][0] + q0[q][1]) + (q0[q][2] + q0[q][3])) + ((q1[q][0] + q1[q][1]) + (q1[q][2] + q1[q][3]))) * (1.f / DM) + EPS);
            float* orow = p.out + (size_t)t * DM;
#pragma unroll
            for (int i = 0; i < 4; ++i) {
                f32x4 o; o[0] = bflo(raw[q][i][0]) * r2 * g[i][0]; o[1] = bfhi(raw[q][i][0]) * r2 * g[i][1]; o[2] = bflo(raw[q][i][1]) * r2 * g[i][2]; o[3] = bfhi(raw[q][i][1]) * r2 * g[i][3];
                *(f32x4*)(orow + 256 * i + 4 * lane) = o; }
        }
    }
}

constexpr int PPL = 10, NPH = 2 + PPL * NL;
__global__ void __launch_bounds__(512, 2) hymba_fwd(Params p) {
    extern __shared__ __attribute__((aligned(16))) char smem_raw[];
    LAS char* smem0 = (LAS char*)smem_raw;
    const int wv = __builtin_amdgcn_readfirstlane((int)(threadIdx.x >> 6));
    if (mk_tid(wv) < 4) ((LAS unsigned*)(smem0 + LDS_BAR))[mk_tid(wv)] = 0u;
    __syncthreads();
    XcdBarrier bar = xcd_barrier_post((unsigned*)(p.ws + WS_CTL), (volatile LAS unsigned*)(smem0 + LDS_BAR), wv);
#define IN(k) true
#define SEAM(k) xcd_barrier(bar)
#define PHASE_HDR const int G = opqi((int)gridDim.x), bid = opqi((int)blockIdx.x); LAS char* smem = opql(smem0); LAS unsigned char* smemu = (LAS unsigned char*)smem; unsigned char* ws = opq(p.ws); \
        const unsigned char* wl = ws + WS_W + (size_t)l * WL_SIZE; const float* ct = (const float*)(ws + WS_COS); const float* st = (const float*)(ws + WS_SIN); (void)wl; (void)ct; (void)st; (void)G; (void)bid; (void)smemu;
    if (IN(0)) { phase_prologue(p, smem0, wv); }
    SEAM(0);
#pragma unroll 1
    for (int l_ = 0; l_ < NL; ++l_) {
        const int l = opqi(l_);
        const int pb = 1 + PPL * l; (void)pb;
        if (IN(pb + 0)) {
            PHASE_HDR
            EpiProj e{(const float*)(ws + WS_SSP), (bfu*)(ws + WS_PROJ), ct, st};
            XSched s{8, 128 * 8, G, bid, wv};
            gemm_phase(smemu, Gemm{(const bfu*)(ws + WS_XB), (const bfu*)(wl + WL_IN), 1024, 1024, 1024}, s, e);
        }
        SEAM(pb + 0);
        if (IN(pb + 1)) {
            PHASE_HDR
            {
                XSched s{3, 128 * 3, G, bid, wv};
                Unit u; __syncthreads();
                for (int i = 0; s.next(i, u); ++i) rows_rstd_lds<256>((const bfu*)(ws + WS_PROJ) + PC_CQ, PW, u.pm * 256, (LAS float*)(smem + LDS_RS) + i * 256, wv);
                __syncthreads();
                EpiScaled<true> e{(const LAS float*)(smem + LDS_RS), (bfu*)(ws + WS_Q), 768, ct, st, 0.10206207261596577f * 1.4426950408889634f};
                gemm_phase(smemu, Gemm{(const bfu*)(ws + WS_PROJ) + PC_CQ, (const bfu*)(wl + WL_UQ), PW, 256, 256}, s, e);
            }
            {
                XSched s{4, 128 * 4, G, (bid + 128) % G, wv};
                Unit u; __syncthreads();
                for (int i = 0; s.next(i, u); ++i) rows_rstd_lds<128>((const bfu*)(ws + WS_PROJ) + PC_CKV, PW, u.pm * 256, (LAS float*)(smem + LDS_RS) + i * 256, wv);
                __syncthreads();
                EpiScaled<false> e{(const LAS float*)(smem + LDS_RS), (bfu*)(ws + WS_KV), 1024, ct, st, 1.f};
                gemm_phase(smemu, Gemm{(const bfu*)(ws + WS_PROJ) + PC_CKV, (const bfu*)(wl + WL_UKV), PW, 256, 256}, s, e);
            }
            gmlp_phase(p, l, smem0, wv);
            hg_local_phase(p, l, smem0, wv);
        }
        SEAM(pb + 1);
        if (IN(pb + 2)) { attn_phase(p, l, smem0, wv);
            hg_prefix_phase(p, wv); }
        SEAM(pb + 2);
        if (IN(pb + 3)) { hg_out_phase(p, l, smem0, wv);
        }
        SEAM(pb + 3);
        if (IN(pb + 4)) {
            PHASE_HDR
            EpiResid e{(bfu*)(ws + WS_XB)};
            XSched s{4, 128 * 4, G, bid, wv};
            __syncthreads();
            gemm_phase(smemu, Gemm{(const bfu*)(ws + WS_YCAT), (const bfu*)(wl + WL_OUT), 1024, 1024, 1024}, s, e);
        }
        SEAM(pb + 4);
        if (IN(pb + 5)) {
            PHASE_HDR
            XSched s{4, 128 * 4, G, bid, wv};
            Unit u; __syncthreads();
            for (int i = 0; s.next(i, u); ++i) rows_rstd_lds<1024>((const bfu*)(ws + WS_XB), DM, u.pm * 256, (LAS float*)(smem + LDS_RS) + i * 256, wv, (float*)(ws + WS_RSTF));
            __syncthreads();
            EpiScaled<false> e{(const LAS float*)(smem + LDS_RS), (bfu*)(ws + WS_PQ), 1024, ct, st, 1.f};
            gemm_phase(smemu, Gemm{(const bfu*)(ws + WS_XB), (const bfu*)(wl + WL_Q), 1024, 1024, 1024}, s, e);
        }
        SEAM(pb + 5);
        if (IN(pb + 6)) { peer_topk_phase(p, l, smem0, wv);
        }
        SEAM(pb + 6);
        if (IN(pb + 7)) { peer_u_phase(p, l, smem0, wv);
        }
        SEAM(pb + 7);
        if (IN(pb + 8)) { peer_c_phase(p, l, wv);
        }
        SEAM(pb + 8);
        if (IN(pb + 9)) { peer_v_phase(p, l, smem0, wv); }
        SEAM(pb + 9);
    }
    if (IN(NPH - 1)) { final_norm_phase(p, wv); }
#undef PHASE_HDR
#undef IN
#undef SEAM
}

extern "C" void kernel_launch(void* const* d_in, const int* in_sizes, int n_in, void* d_out, int out_size, void* d_ws, size_t ws_size, hipStream_t stream) {
    static int grid = 0;
    if (grid == 0) {
        if (n_in != 22 || in_sizes[0] != T * DM || out_size != T * DM || ws_size < WS_END) {
            fprintf(stderr, "kernel_launch: unexpected shapes (n_in %d, in0 %d, out %d, ws %zu, need %zu)\n", n_in, n_in > 0 ? in_sizes[0] : -1, out_size, ws_size, (size_t)WS_END); grid = -1; return; }
        int dev = 0, cus = 0, per_cu = 0;
        if (hipGetDevice(&dev) != hipSuccess || hipDeviceGetAttribute(&cus, hipDeviceAttributeMultiprocessorCount, dev) != hipSuccess) { grid = -1; return; }
        if (hipFuncSetAttribute((const void*)hymba_fwd, hipFuncAttributeMaxDynamicSharedMemorySize, LDS_TOTAL) != hipSuccess) { fprintf(stderr, "kernel_launch: hipFuncSetAttribute failed\n"); grid = -1; return; }
        if (hipOccupancyMaxActiveBlocksPerMultiprocessor(&per_cu, (const void*)hymba_fwd, 512, LDS_TOTAL) != hipSuccess || per_cu < 1) fprintf(stderr, "kernel_launch: occupancy query says %d\n", per_cu);
        (void)hipGetLastError();
        grid = cus;
    }
    if (grid < 0) return;
    (void)hipMemsetAsync((char*)d_ws + WS_CTL, 0, 65536, stream);
    Params p{};
    p.x = (const float*)d_in[0]; p.pos = (const int*)d_in[1]; p.norm_mix = (const float*)d_in[2]; p.w_in = (const float*)d_in[3]; p.gm_v_norm = (const float*)d_in[4];
    p.gm_ws = (const float*)d_in[5]; p.gm_b = (const float*)d_in[6]; p.gm_out_norm = (const float*)d_in[7]; p.mla_q_norm = (const float*)d_in[8]; p.mla_w_uq = (const float*)d_in[9];
    p.mla_kv_norm = (const float*)d_in[10]; p.mla_w_ukv = (const float*)d_in[11]; p.mla_out_norm = (const float*)d_in[12]; p.hg_lb_logits = (const float*)d_in[13];
    p.hg_out_norm = (const float*)d_in[14]; p.w_out = (const float*)d_in[15]; p.norm_ffn = (const float*)d_in[16]; p.peer_w_q = (const float*)d_in[17];
    p.peer_sub_keys = (const float*)d_in[18]; p.peer_u = (const float*)d_in[19]; p.peer_v = (const float*)d_in[20]; p.norm_final = (const float*)d_in[21];
    p.out = (float*)d_out; p.ws = (unsigned char*)d_ws;
    hipLaunchKernelGGL(hymba_fwd, dim3(grid), dim3(512), LDS_TOTAL, stream, p);
}
```

```cpp
#include <hip/hip_runtime.h>
#include <cstdio>
#include <cstdint>
#include <cmath>
#include <type_traits>

constexpr int T = 32768, DM = 1024, NL = 4, SEQ = 2048;
constexpr int PW = 2048;
constexpr int PC_U = 0, PC_V = 256, PC_CQ = 512, PC_CKV = 768, PC_KR = 896, PC_HQ = 1024, PC_HF = 1280, PC_HI = 1536, PC_HG = 1792;
constexpr int NEXP = 16384;
constexpr float EPS = 1e-6f;

typedef unsigned short bfu;
typedef __attribute__((ext_vector_type(8))) short bf16x8;
typedef __attribute__((ext_vector_type(4))) short s16x4;
typedef __attribute__((ext_vector_type(4))) float f32x4;
typedef __attribute__((ext_vector_type(16))) float f32x16;
typedef __attribute__((ext_vector_type(2))) __bf16 bf2_t;
typedef __attribute__((ext_vector_type(2))) float f2_t;
typedef __attribute__((ext_vector_type(4))) unsigned u32x4;
typedef __attribute__((ext_vector_type(2))) unsigned u32x2;
typedef short v4i16_t __attribute__((ext_vector_type(4)));
#define DI __device__ __forceinline__
#define LAS __attribute__((address_space(3)))

DI float bf2f(bfu v) { return __uint_as_float((unsigned)v << 16); }
DI float bflo(unsigned u) { return __uint_as_float(u << 16); }
DI float bfhi(unsigned u) { return __uint_as_float(u & 0xffff0000u); }
DI unsigned pk2(float a, float b) { f2_t v = {a, b}; bf2_t r = __builtin_convertvector(v, bf2_t); return __builtin_bit_cast(unsigned, r); }
DI bfu f2bf(float a) { return (bfu)(pk2(a, 0.f) & 0xffffu); }
DI f32x16 mfma32(bf16x8 a, bf16x8 b, f32x16 c) { return __builtin_amdgcn_mfma_f32_32x32x16_bf16(a, b, c, 0, 0, 0); }
DI int crow(int r, int hi) { return (r & 3) + 8 * (r >> 2) + 4 * hi; }
DI f32x16 zero16() { f32x16 z; for (int i = 0; i < 16; ++i) z[i] = 0.f; return z; }
DI bf16x8 pack8(const f32x16& x, int s) {
    u32x4 p; p[0] = pk2(x[8 * s], x[8 * s + 1]); p[1] = pk2(x[8 * s + 2], x[8 * s + 3]); p[2] = pk2(x[8 * s + 4], x[8 * s + 5]); p[3] = pk2(x[8 * s + 6], x[8 * s + 7]);
    return __builtin_bit_cast(bf16x8, p);
}
DI float swap32(float v) { return __shfl_xor(v, 32); }
DI float wave_sum(float v) {
    v += __shfl_xor(v, 1); v += __shfl_xor(v, 2); v += __shfl_xor(v, 4); v += __shfl_xor(v, 8); v += __shfl_xor(v, 16); v += __shfl_xor(v, 32); return v;
}
DI float sum16(float v) { v += __shfl_xor(v, 1); v += __shfl_xor(v, 2); v += __shfl_xor(v, 4); v += __shfl_xor(v, 8); return v; }
DI float fast_exp(float x) { return __expf(x); }
DI float sigmoidf(float x) { return 1.f / (1.f + __expf(-x)); }
DI float geluf(float x) { const float u = 1.5957691216057308f * (x + 0.044715f * x * x * x); return x / (1.f + __expf(-u)); }
DI float siluf(float x) { return x / (1.f + __expf(-x)); }
DI s16x4 ldtr(const LAS char* p) { return __builtin_bit_cast(s16x4, __builtin_amdgcn_ds_read_tr16_b64_v4i16((LAS v4i16_t*)p)); }
DI bf16x8 cat4(s16x4 a, s16x4 b) { return __builtin_shufflevector(a, b, 0, 1, 2, 3, 4, 5, 6, 7); }
DI int mk_tid(int wv) { int ln; asm volatile("v_mbcnt_lo_u32_b32 %0, -1, 0\n\tv_mbcnt_hi_u32_b32 %0, -1, %0" : "=v"(ln)); return wv * 64 + ln; }
DI unsigned char* opq(unsigned char* q) { asm volatile("" : "+s"(q)); return q; }
DI LAS char* opql(LAS char* q) { unsigned v = (unsigned)(size_t)q; asm volatile("" : "+s"(v)); return (LAS char*)(size_t)v; }
DI int opqi(int v) { asm volatile("" : "+s"(v)); return v; }
DI f32x4 zero4_opaque() { float z; asm volatile("v_mov_b32 %0, 0" : "=v"(z)); return (f32x4){z, z, z, z}; }
DI float dot2u(unsigned a, unsigned b, float c) { return __builtin_amdgcn_fdot2_f32_bf16(__builtin_bit_cast(bf2_t, a), __builtin_bit_cast(bf2_t, b), c, false); }
#define GAS __attribute__((address_space(1)))
typedef __attribute__((ext_vector_type(2))) float f32x2;
template <int CTRL, int ROWMASK> DI float dpp_get(float v) { return __builtin_bit_cast(float, __builtin_amdgcn_update_dpp(0, __builtin_bit_cast(int, v), CTRL, ROWMASK, 0xf, false)); }
DI float dpp_sum63(float v) {
    v += dpp_get<0x111, 0xf>(v); v += dpp_get<0x112, 0xf>(v); v += dpp_get<0x114, 0xf>(v); v += dpp_get<0x118, 0xf>(v);
    v += dpp_get<0x142, 0xa>(v); v += dpp_get<0x143, 0xc>(v); return v;
}
DI float dpp_max63(float v) {
    v = fmaxf(v, dpp_get<0x111, 0xf>(v)); v = fmaxf(v, dpp_get<0x112, 0xf>(v)); v = fmaxf(v, dpp_get<0x114, 0xf>(v)); v = fmaxf(v, dpp_get<0x118, 0xf>(v));
    v = fmaxf(v, dpp_get<0x142, 0xa>(v)); v = fmaxf(v, dpp_get<0x143, 0xc>(v)); return v;
}
DI float rdlane_f(float v, int l) { return __builtin_bit_cast(float, __builtin_amdgcn_readlane(__builtin_bit_cast(int, v), l)); }
DI unsigned pack_i8x4(float a, float b, float c, float d) {
    const int q0 = (int)__builtin_rintf(fminf(fmaxf(a, -127.f), 127.f)), q1 = (int)__builtin_rintf(fminf(fmaxf(b, -127.f), 127.f));
    const int q2 = (int)__builtin_rintf(fminf(fmaxf(c, -127.f), 127.f)), q3 = (int)__builtin_rintf(fminf(fmaxf(d, -127.f), 127.f));
    return (unsigned)(q0 & 0xff) | ((unsigned)(q1 & 0xff) << 8) | ((unsigned)(q2 & 0xff) << 16) | ((unsigned)(q3 & 0xff) << 24);
}

constexpr size_t WS_CTL   = 0;
constexpr size_t WS_XB    = 65536;
constexpr size_t WS_PROJ  = WS_XB   + (size_t)T * DM * 2;
constexpr size_t WS_Q     = WS_PROJ + (size_t)T * PW * 2;
constexpr size_t WS_KV    = WS_Q    + (size_t)T * 768 * 2;
constexpr size_t WS_YCAT  = WS_KV   + (size_t)T * 1024 * 2;
constexpr size_t WS_PQ    = WS_YCAT + (size_t)T * 1024 * 2;
constexpr size_t WS_IDS   = WS_PQ   + (size_t)T * 1024 * 2;
constexpr size_t WS_GATE  = WS_IDS  + (size_t)T * 128 * 4;
constexpr size_t WS_HST   = WS_GATE + (size_t)T * 128 * 4;
constexpr size_t WS_HDEC  = WS_HST  + (size_t)2048 * 4096 * 4;
constexpr size_t WS_COS   = WS_HDEC + (size_t)512 * 256 * 4;
constexpr size_t WS_SIN   = WS_COS  + (size_t)T * 16 * 4;
constexpr size_t WS_SSP   = WS_SIN  + (size_t)T * 16 * 4;
constexpr size_t WS_RSTF  = WS_SSP  + (size_t)T * 8 * 4;
constexpr size_t WS_COEF  = WS_RSTF + (size_t)T * 4;
constexpr size_t WS_LB    = WS_COEF + (size_t)T * 128 * 4;
constexpr size_t WS_SP    = WS_LB   + 4096;
constexpr int SP_GMV = 0, SP_GMB = 256, SP_GMO = 768, SP_MLO = 1024, SP_HGO = 1536, SP_NFF = 1792, SP_STRIDE = 3072, SP_FIN = NL * SP_STRIDE;
constexpr size_t WS_W     = WS_SP   + (size_t)(SP_FIN + 1024) * 4;
constexpr size_t WL_IN    = 0;
constexpr size_t WL_UQ    = WL_IN  + (size_t)2048 * 1024 * 2;
constexpr size_t WL_UKV   = WL_UQ  + (size_t)768 * 256 * 2;
constexpr size_t WL_OUT   = WL_UKV + (size_t)1024 * 256 * 2;
constexpr size_t WL_Q     = WL_OUT + (size_t)1024 * 1024 * 2;
constexpr size_t WL_SK    = WL_Q   + (size_t)1024 * 1024 * 2;
constexpr size_t WL_GM    = WL_SK  + (size_t)16 * 128 * 64 * 2;
constexpr size_t WL_SIZE  = WL_GM  + (size_t)4 * 128 * 128 * 2;
constexpr size_t WS_TABU  = WS_W + NL * WL_SIZE;
constexpr size_t WS_TABV  = WS_TABU + (size_t)NL * NEXP * DM;
constexpr size_t WS_SCU   = WS_TABV + (size_t)NL * NEXP * DM;
constexpr size_t WS_SCV   = WS_SCU  + (size_t)NL * NEXP * 4;
constexpr size_t WS_END   = WS_SCV  + (size_t)NL * NEXP * 4;

struct Params {
    const float* x; const int* pos; const float* norm_mix; const float* w_in; const float* gm_v_norm; const float* gm_ws; const float* gm_b; const float* gm_out_norm;
    const float* mla_q_norm; const float* mla_w_uq; const float* mla_kv_norm; const float* mla_w_ukv; const float* mla_out_norm; const float* hg_lb_logits; const float* hg_out_norm;
    const float* w_out; const float* norm_ffn; const float* peer_w_q; const float* peer_sub_keys; const float* peer_u; const float* peer_v; const float* norm_final;
    float* out; unsigned char* ws;
};

#define XB_TMO      128
#define XB_XCNT(j)  (256  + 64 * (j))
#define XB_XSUB(j)  (1280 + 64 * (j))
#define XB_XGEN(j)  (2304 + 64 * (j))
#define XB_TOP      3328
#define XB_TOPGEN   3392
#define XCD_BAR_WORDS 3456
#define XB_SPIN_CAP (1u << 20)
DI unsigned xb_ld(unsigned* p)              { return __hip_atomic_load(p, __ATOMIC_RELAXED, __HIP_MEMORY_SCOPE_AGENT); }
DI unsigned xb_add(unsigned* p, unsigned v) { return __hip_atomic_fetch_add(p, v, __ATOMIC_RELAXED, __HIP_MEMORY_SCOPE_AGENT); }
DI unsigned xb_xcc_id() { return (unsigned)__builtin_amdgcn_s_getreg((3 << 11) | 20) & 0xFu; }
#define XB_SPIN(cond, bar) do { unsigned _sp = 0; while (cond) { __builtin_amdgcn_s_sleep(1); \
    if ((++_sp & 255u) == 0u) { if (xb_ld(&(bar)[XB_TMO])) break; if (_sp > XB_SPIN_CAP) { atomicAdd(&(bar)[XB_TMO], 1u); break; } } } } while (0)
struct XcdBarrier { unsigned* bar; unsigned x; volatile LAS unsigned* st; int wv; };
DI XcdBarrier xcd_barrier_post(unsigned* bar, volatile LAS unsigned* st, int wv) {
    XcdBarrier b; b.bar = bar; b.x = xb_xcc_id(); b.st = st; b.wv = wv;
    if (mk_tid(wv) == 0) (void)xb_add(&bar[XB_XCNT(b.x)], 1u);
    return b;
}
DI void xcd_barrier_complete(unsigned* bar, unsigned x, unsigned& nloc, unsigned& nx) {
    const unsigned G = gridDim.x * gridDim.y * gridDim.z;
    unsigned sum, cnt, mine, sp = 0u;
    for (;;) {
        sum = 0u; cnt = 0u; mine = 0u;
#pragma unroll
        for (unsigned j = 0; j < 16; ++j) { const unsigned c = xb_ld(&bar[XB_XCNT(j)]); sum += c; cnt += (c > 0u) ? 1u : 0u; }
        if (sum == G) { mine = xb_ld(&bar[XB_XCNT(x)]); break; }
        __builtin_amdgcn_s_sleep(1);
        if ((++sp & 255u) == 0u) { if (xb_ld(&bar[XB_TMO])) break; if (sp > XB_SPIN_CAP) { atomicAdd(&bar[XB_TMO], 1u); break; } }
    }
    nloc = mine > 0u ? mine : 1u; nx = cnt > 0u ? cnt : 1u;
}
DI void xcd_barrier(const XcdBarrier& b) {
    asm volatile("s_waitcnt vmcnt(0)" ::: "memory");
    __syncthreads();
    if (mk_tid(b.wv) == 0) {
        unsigned* bar = b.bar; unsigned bx = b.x;
        asm volatile("" : "+s"(bar), "+s"(bx));
        __builtin_amdgcn_s_waitcnt(0);
        unsigned nloc = b.st[0], nx = b.st[1];
        if (nloc == 0u) { xcd_barrier_complete(bar, bx, nloc, nx); b.st[0] = nloc; b.st[1] = nx; }
        const unsigned old = xb_add(&bar[XB_XSUB(bx)], 1u);
        const unsigned gen = old / nloc;
        if (old + 1u == (gen + 1u) * nloc) {
            __builtin_amdgcn_fence(__ATOMIC_RELEASE, "agent");
            asm volatile("s_waitcnt vmcnt(0)" ::: "memory");
            const unsigned og = xb_add(&bar[XB_TOP], 1u);
            const unsigned tg = og / nx;
            if (og + 1u == (tg + 1u) * nx) xb_add(&bar[XB_TOPGEN], 1u);
            else XB_SPIN(xb_ld(&bar[XB_TOPGEN]) == tg, bar);
            __builtin_amdgcn_fence(__ATOMIC_ACQUIRE, "agent");
            xb_add(&bar[XB_XGEN(bx)], 1u);
            asm volatile("s_waitcnt vmcnt(0)" ::: "memory");
        } else {
            XB_SPIN(xb_ld(&bar[XB_XGEN(bx)]) == gen, bar);
            __builtin_amdgcn_fence(__ATOMIC_ACQUIRE, "agent");
            asm volatile("s_waitcnt vmcnt(0)" ::: "memory");
        }
    }
    __syncthreads();
}

template <int MODE>
DI int srccol(int n) {
    if (MODE == 1) { return n < 928 ? n : (n < 1024 ? -1 : n - 96); }
    if (MODE == 2) { return n < 512 ? ((n >> 6) * 128 + (n & 63)) : (((n - 512) >> 6) * 128 + 64 + ((n - 512) & 63)); }
    return n;
}
template <int MODE>
DI void conv_tile(int t, const float* __restrict__ src, int ld_src, const float* __restrict__ gain, bfu* __restrict__ dst, int K, int n0, int k0, float* tile, int ksrc = 1 << 30) {
    float ld[8];
#pragma unroll
    for (int i = 0; i < 8; ++i) {
        const int kk = (t >> 6) + i * 8, nn = t & 63;
        const int sc = srccol<MODE>(n0 + nn);
        const int kr = k0 + kk < ksrc ? k0 + kk : 0;
        ld[i] = src[(size_t)kr * ld_src + (sc >= 0 ? sc : 0)] * (gain ? gain[kr] : 1.f);
    }
#pragma unroll
    for (int i = 0; i < 8; ++i) {
        const int kk = (t >> 6) + i * 8, nn = t & 63;
        const int sc = srccol<MODE>(n0 + nn);
        tile[kk * 65 + nn] = (sc >= 0 && k0 + kk < ksrc) ? ld[i] : 0.f;
    }
    __syncthreads();
#pragma unroll
    for (int i = 0; i < 8; ++i) {
        const int nn = (t >> 6) + i * 8, kk = t & 63;
        dst[(size_t)(n0 + nn) * K + k0 + kk] = f2bf(tile[kk * 65 + nn]);
    }
    __syncthreads();
}

DI void phase_prologue(const Params& p, LAS char* smem, int wv) {
    const int tid = mk_tid(wv), bid = blockIdx.x, nb = gridDim.x; smem = opql(smem);
    const int w = tid >> 6, lane = tid & 63;
    unsigned char* ws = opq(p.ws);
    {
        bfu* xb = (bfu*)(ws + WS_XB); float* ssp = (float*)(ws + WS_SSP);
        for (int t0 = (bid * 8 + w) * 4; t0 < T; t0 += nb * 8 * 4) {
            float4 xv[4][4];
#pragma unroll
            for (int q = 0; q < 4; ++q)
#pragma unroll
                for (int i = 0; i < 4; ++i) xv[q][i] = ((const float4*)(p.x + (size_t)(t0 + q) * DM))[i * 64 + lane];
#pragma unroll
            for (int q = 0; q < 4; ++q) { const int t = t0 + q;
                float ss = 0.f;
#pragma unroll
                for (int i = 0; i < 4; ++i) {
                    const float4 v = xv[q][i];
                    ss += v.x * v.x + v.y * v.y + v.z * v.z + v.w * v.w;
                    u32x2 o; o[0] = pk2(v.x, v.y); o[1] = pk2(v.z, v.w);
                    *(u32x2*)(xb + (size_t)t * DM + (i * 64 + lane) * 4) = o;
                }
                ss = wave_sum(ss);
                if (lane < 8) ssp[(size_t)t * 8 + lane] = lane == 0 ? ss : 0.f;
            }
        }
    }
    {
        float* tile = (float*)smem;
        for (int u = bid; u < NL * 1136; u += nb) {
            const int l = u / 1136; int r = u % 1136;
            unsigned char* wl = ws + WS_W + (size_t)l * WL_SIZE;
            if (r < 512) { conv_tile<1>(tid, p.w_in + (size_t)l * 1024 * 1952, 1952, p.norm_mix + l * 1024, (bfu*)(wl + WL_IN), 1024, (r >> 4) * 64, (r & 15) * 64, tile); continue; }
            r -= 512;
            if (r < 48) { conv_tile<0>(tid, p.mla_w_uq + (size_t)l * 256 * 768, 768, p.mla_q_norm + l * 256, (bfu*)(wl + WL_UQ), 256, (r >> 2) * 64, (r & 3) * 64, tile); continue; }
            r -= 48;
            if (r < 64) { conv_tile<2>(tid, p.mla_w_ukv + (size_t)l * 128 * 1024, 1024, p.mla_kv_norm + l * 128, (bfu*)(wl + WL_UKV), 256, (r >> 2) * 64, (r & 3) * 64, tile, 128); continue; }
            r -= 64;
            if (r < 256) { conv_tile<0>(tid, p.w_out + (size_t)l * 1024 * 1024, 1024, nullptr, (bfu*)(wl + WL_OUT), 1024, (r >> 4) * 64, (r & 15) * 64, tile); continue; }
            r -= 256;
            conv_tile<0>(tid, p.peer_w_q + (size_t)l * 1024 * 1024, 1024, p.norm_ffn + l * 1024, (bfu*)(wl + WL_Q), 1024, (r >> 4) * 64, (r & 15) * 64, tile);
        }
    }
    const size_t gtid = (size_t)bid * 512 + tid, gsz = (size_t)nb * 512;
    for (size_t e = gtid; e < (size_t)NL * 16 * 128 * 64; e += gsz) {
        const int l = (int)(e / (16 * 128 * 64)); const size_t r = e % (16 * 128 * 64);
        ((bfu*)(ws + WS_W + (size_t)l * WL_SIZE + WL_SK))[r] = f2bf(p.peer_sub_keys[e]);
    }
    for (size_t e = gtid; e < (size_t)NL * 4 * 128 * 128; e += gsz) {
        const int l = (int)(e / (4 * 128 * 128)); const size_t r = e % (4 * 128 * 128);
        const int tt = (int)((r >> 7) & 127), s = (int)(r & 127);
        ((bfu*)(ws + WS_W + (size_t)l * WL_SIZE + WL_GM))[r] = f2bf(s <= tt ? p.gm_ws[e] : 0.f);
    }
    {
        const int nrows = NL * NEXP;
        for (int rr0 = (bid * 8 + w) * 4; rr0 < 2 * nrows; rr0 += nb * 8 * 4) {
            f32x4 v[4][4];
#pragma unroll
            for (int q = 0; q < 4; ++q) { const int rr = rr0 + q; const int tab = rr >= nrows, row = tab ? rr - nrows : rr;
                const float* src = (tab ? p.peer_v : p.peer_u) + (size_t)row * DM;
#pragma unroll
                for (int i = 0; i < 4; ++i) v[q][i] = *(const f32x4*)(src + 256 * i + 4 * lane); }
#pragma unroll
            for (int q = 0; q < 4; ++q) { const int rr = rr0 + q; const int tab = rr >= nrows, row = tab ? rr - nrows : rr;
                float am = 0.f;
#pragma unroll
                for (int i = 0; i < 4; ++i) am = fmaxf(am, fmaxf(fmaxf(fabsf(v[q][i][0]), fabsf(v[q][i][1])), fmaxf(fabsf(v[q][i][2]), fabsf(v[q][i][3]))));
                am = rdlane_f(dpp_max63(am), 63);
                const bool i8 = !tab;
                const float qmax = i8 ? 127.f : 440.f;
                const float sc = am > 0.f ? qmax / am : 0.f;
                u32x4 o;
#pragma unroll
                for (int i = 0; i < 4; ++i) {
                    if (i8) o[i] = pack_i8x4(v[q][i][0] * sc, v[q][i][1] * sc, v[q][i][2] * sc, v[q][i][3] * sc);
                    else { int wd = 0; wd = __builtin_amdgcn_cvt_pk_fp8_f32(v[q][i][0] * sc, v[q][i][1] * sc, wd, false); wd = __builtin_amdgcn_cvt_pk_fp8_f32(v[q][i][2] * sc, v[q][i][3] * sc, wd, true); o[i] = (unsigned)wd; }
                }
                const int ly = row / NEXP, rw = row % NEXP;
                *(u32x4*)(ws + (tab ? WS_TABV : WS_TABU) + (size_t)ly * NEXP * DM + (size_t)(lane >> 3) * NEXP * 128 + (size_t)rw * 128 + 16 * (lane & 7)) = o;
                if (lane == 0) ((float*)(ws + (tab ? WS_SCV : WS_SCU)))[row] = am / qmax;
            }
        }
    }
    {
        float* ct = (float*)(ws + WS_COS); float* st = (float*)(ws + WS_SIN);
        for (size_t e = gtid; e < (size_t)T * 16; e += gsz) {
            const int t = (int)(e >> 4), i = (int)(e & 15);
            const float inv = expf(-9.210340371976184f * (float)i * (1.f / 16.f));
            const float ang = (float)p.pos[t] * inv;
            const float kq = rintf(ang * 0.15915494309189535f);
            float rr = fmaf(-kq, 6.2831854820251465f, ang); rr = fmaf(-kq, -1.7484555e-7f, rr);
            ct[e] = __cosf(rr); st[e] = __sinf(rr);
        }
    }
    {
        float* sp = (float*)(ws + WS_SP);
        for (int e = (int)gtid; e < NL * SP_STRIDE + 1024; e += (int)gsz) {
            float v = 0.f;
            if (e >= SP_FIN) v = p.norm_final[e - SP_FIN];
            else { const int l = e / SP_STRIDE, r = e % SP_STRIDE;
                if (r < SP_GMB) v = p.gm_v_norm[l * 256 + r];
                else if (r < SP_GMO) v = p.gm_b[l * 512 + r - SP_GMB];
                else if (r < SP_MLO) v = p.gm_out_norm[l * 256 + r - SP_GMO];
                else if (r < SP_HGO) v = p.mla_out_norm[l * 512 + r - SP_MLO];
                else if (r < SP_NFF) v = p.hg_out_norm[l * 256 + r - SP_HGO];
                else if (r < SP_NFF + 1024) v = p.norm_ffn[l * 1024 + r - SP_NFF]; }
            sp[e] = v;
        }
    }
    if (bid == 0 && tid < 256) {
        float lg[NL], mx = -1e30f;
#pragma unroll
        for (int l = 0; l < NL; ++l) { lg[l] = p.hg_lb_logits[l * 256 + tid]; mx = fmaxf(mx, lg[l]); }
        float sum = 0.f; for (int l = 0; l < NL; ++l) { lg[l] = expf(lg[l] - mx); sum += lg[l]; }
        float cum = 0.f; const float p0 = lg[0] / sum;
        for (int l = 0; l < NL; ++l) { cum += lg[l] / sum; ((float*)(ws + WS_LB))[l * 256 + tid] = cum - p0; }
    }
}

constexpr int BM = 256, BK = 64, HALF = 128, HTB = HALF * BK * 2, STAGE_BYTES = 8 * HTB;
constexpr int LDS_RS = STAGE_BYTES;
constexpr int LDS_TOTAL = 163840;
constexpr int LDS_BAR = LDS_TOTAL - 16;
DI int lds_byte(int r, int c) { const int st = (r >> 4) * 2 + (c >> 5), rr = r & 15, cc = c & 31, ob = rr * 64 + cc * 2; return st * 1024 + (ob ^ (((ob >> 9) & 1) << 5)); }
DI void stage_rc(int b, int& R, int& C) { const int st = b / 1024, sb = b % 1024, swz = sb ^ (((sb >> 9) & 1) << 5); R = (st >> 1) * 16 + swz / 64; C = (st & 1) * 32 + (swz % 64) / 2; }
DI int perm32(int rho) { const int n = rho >> 4, i = rho & 15; return 8 * (i >> 2) + 4 * n + (i & 3); }
struct Unit { int pm, pn, idx; };
struct Gemm { const bfu* A; const bfu* Bt; int lda, ldb, K; };
struct XSched {
    int nN, nunits, G, c, wv;
    DI bool next(int i, Unit& u) const { const int L = i * G + c; if (L >= nunits) return false; const int xcd = L & 7, slot = L >> 3; u.pm = (slot / nN) * 8 + xcd; u.pn = slot % nN; u.idx = i; return true; }
    DI void a_ready(const Unit&) const {}
    DI void done(const Unit&) const {}
};
template <class Epi, class Sched, bool STAMP = false>
DI void gemm_phase(LAS unsigned char* lds, const Gemm g, const Sched& S, const Epi& E, unsigned long long* stamps = nullptr) {
    int tid_ = mk_tid(S.wv);
    const int tid = tid_, wid = __builtin_amdgcn_readfirstlane(tid >> 6), lane = tid & 63, wr = wid >> 2, wc = wid & 3, fr = lane & 15, fq = lane >> 4;
    const int K = g.K, nt = K / BK, lda = g.lda, ldb = g.ldb;
    int ts_lo = 0, ts_hi = 0, nts = 0; const unsigned long long rt_entry = STAMP ? (unsigned long long)wall_clock64() : 0ull;
#define PG8_STAMP() do { if (STAMP && wid == 0 && nts < 64) { const unsigned long long _c = (unsigned long long)clock64(); \
        ts_lo = (lane == nts) ? (int)(unsigned)_c : ts_lo; ts_hi = (lane == nts) ? (int)(unsigned)(_c >> 32) : ts_hi; ++nts; } } while (0)
    PG8_STAMP();
    unsigned voffA[2], voffB[2];
#pragma unroll
    for (int i = 0; i < 2; ++i) { int R, C; stage_rc(tid * 16 + i * 8192, R, C); const int Rb = Epi::PERM ? ((R & ~31) + perm32(R & 31)) : R;
        voffA[i] = (unsigned)(R * lda + C) * 2u; voffB[i] = (unsigned)(Rb * ldb + C) * 2u; }
    const size_t kstep = (size_t)(BK * 2);
    const size_t hstepA = (size_t)HALF * lda * 2, hstepB = (size_t)HALF * ldb * 2;
    const size_t tstepA = 2 * hstepA, tstepB = 2 * hstepB;
    const unsigned ldsw = (unsigned)wid * 1024u;
    const int aoff = lds_byte(wr * 64 + fr, fq * 8), boff = lds_byte(wc * 32 + fr, fq * 8);
#define PG8_SA(b, h) (((b) * 2 + (h)) * HTB)
#define PG8_SB(b, h) ((4 + (b) * 2 + (h)) * HTB)
#define PG8_STAGE(bufoff, gbase, voff) do { _Pragma("unroll") for (int _i = 0; _i < 2; ++_i) \
        __builtin_amdgcn_global_load_lds((const unsigned*)((const char*)(gbase) + (voff)[_i]), (LAS unsigned*)(lds + (bufoff) + ldsw + _i * 8192), 16, 0, 0); } while (0)
#define PG8_LDA(dst, b, h) do { _Pragma("unroll") for (int m = 0; m < 4; ++m) _Pragma("unroll") for (int k = 0; k < 2; ++k) dst[m][k] = *(const LAS bf16x8*)(lds + PG8_SA(b, h) + aoff + m * 2048 + k * 1024); } while (0)
#define PG8_LDB(dst, b, h) do { _Pragma("unroll") for (int n = 0; n < 2; ++n) _Pragma("unroll") for (int k = 0; k < 2; ++k) dst[n][k] = *(const LAS bf16x8*)(lds + PG8_SB(b, h) + boff + n * 2048 + k * 1024); } while (0)
#define PG8_MMA(ai, bj, At, Bt) do { __builtin_amdgcn_s_setprio(1); _Pragma("unroll") for (int m = 0; m < 4; ++m) _Pragma("unroll") for (int n = 0; n < 2; ++n) _Pragma("unroll") for (int k = 0; k < 2; ++k) \
        acc[ai][bj][m][n] = __builtin_amdgcn_mfma_f32_16x16x32_bf16(Bt[n][k], At[m][k], acc[ai][bj][m][n], 0, 0, 0); __builtin_amdgcn_s_setprio(0); } while (0)
#define PG8_WAIT_V(n) asm volatile("s_waitcnt vmcnt(" #n ")" ::: "memory")
#define PG8_WAIT_L(n) asm volatile("s_waitcnt lgkmcnt(" #n ")" ::: "memory")
#define PG8_BAR __builtin_amdgcn_s_barrier()
#define PG8_SCHED __builtin_amdgcn_sched_barrier(0)
    Unit cur, nxt; int ui = 0;
    if (!S.next(0, cur)) return;
    f32x4 acc[2][2][4][2]; { const f32x4 zz = zero4_opaque();
#pragma unroll
    for (int a = 0; a < 2; ++a)
#pragma unroll
        for (int b = 0; b < 2; ++b)
#pragma unroll
            for (int m = 0; m < 4; ++m)
#pragma unroll
                for (int n = 0; n < 2; ++n) acc[a][b][m][n] = zz; }
    bf16x8 At[4][2], B0[2][2], B1[2][2];
    const char* cA = (const char*)g.A + (size_t)cur.pm * tstepA; const char* cB = (const char*)g.Bt + (size_t)cur.pn * tstepB;
    S.a_ready(cur);
    PG8_STAGE(PG8_SB(0, 0), cB, voffB); PG8_STAGE(PG8_SA(0, 0), cA, voffA); PG8_STAGE(PG8_SB(0, 1), cB + hstepB, voffB); PG8_STAGE(PG8_SA(0, 1), cA + hstepA, voffA);
    if (wr == 1) PG8_BAR;
    PG8_WAIT_V(4); PG8_BAR;
    PG8_STAGE(PG8_SB(1, 0), cB + kstep, voffB); PG8_STAGE(PG8_SA(1, 0), cA + kstep, voffA); PG8_STAGE(PG8_SB(1, 1), cB + hstepB + kstep, voffB);
    PG8_WAIT_V(6); PG8_BAR;
    PG8_STAMP();
    for (;;) {
        const bool has_next = S.next(ui + 1, nxt);
        const char* nA = has_next ? (const char*)g.A + (size_t)nxt.pm * tstepA : cA; const char* nB = has_next ? (const char*)g.Bt + (size_t)nxt.pn * tstepB : cB;
        for (int t = 0; t < nt; t += 2) {
            const bool last = (t == nt - 2);
            const char* a1 = cA + (size_t)(t + 1) * kstep;
            const char* a2 = last ? nA : cA + (size_t)(t + 2) * kstep; const char* b2 = last ? nB : cB + (size_t)(t + 2) * kstep;
            const char* a3 = a2 + kstep; const char* b3 = b2 + kstep;
            if (last && has_next) S.a_ready(nxt);
            PG8_LDB(B0, 0, 0); PG8_SCHED; PG8_LDA(At, 0, 0); PG8_STAGE(PG8_SA(1, 1), a1 + hstepA, voffA);
            PG8_WAIT_L(8); PG8_BAR; PG8_WAIT_L(0); PG8_MMA(0, 0, At, B0); PG8_BAR; PG8_SCHED;
            PG8_LDB(B1, 0, 1); PG8_STAGE(PG8_SB(0, 0), b2, voffB);
            PG8_BAR; PG8_WAIT_L(0); PG8_MMA(0, 1, At, B1); PG8_BAR;
            PG8_LDA(At, 0, 1); PG8_STAGE(PG8_SA(0, 0), a2, voffA);
            PG8_BAR; PG8_WAIT_L(0); PG8_MMA(1, 0, At, B0); PG8_BAR; PG8_SCHED;
            PG8_STAGE(PG8_SB(0, 1), b2 + hstepB, voffB);
            PG8_WAIT_V(6); PG8_BAR; PG8_MMA(1, 1, At, B1); PG8_BAR;
            PG8_LDB(B0, 1, 0); PG8_SCHED; PG8_LDA(At, 1, 0); PG8_STAGE(PG8_SA(0, 1), a2 + hstepA, voffA);
            PG8_WAIT_L(8); PG8_BAR; PG8_WAIT_L(0); PG8_MMA(0, 0, At, B0); PG8_BAR; PG8_SCHED;
            PG8_LDB(B1, 1, 1); PG8_STAGE(PG8_SB(1, 0), b3, voffB);
            PG8_BAR; PG8_WAIT_L(0); PG8_MMA(0, 1, At, B1); PG8_BAR;
            PG8_LDA(At, 1, 1); PG8_STAGE(PG8_SA(1, 0), a3, voffA);
            PG8_BAR; PG8_WAIT_L(0); PG8_MMA(1, 0, At, B0); PG8_BAR; PG8_SCHED;
            PG8_STAGE(PG8_SB(1, 1), b3 + hstepB, voffB);
            PG8_WAIT_V(6); PG8_BAR; PG8_MMA(1, 1, At, B1); PG8_BAR;
        }
        PG8_STAMP();
        if constexpr (!Epi::AFTER_DRAIN) { E(acc, cur, wr, wc, fr, fq); S.done(cur); }
        PG8_STAMP();
        if (!has_next) break;
        { const f32x4 zz = zero4_opaque();
#pragma unroll
        for (int a = 0; a < 2; ++a)
#pragma unroll
            for (int b = 0; b < 2; ++b)
#pragma unroll
                for (int m = 0; m < 4; ++m)
#pragma unroll
                    for (int n = 0; n < 2; ++n) acc[a][b][m][n] = zz; }
        cur = nxt; cA = nA; cB = nB; ++ui;
    }
    PG8_WAIT_V(0);
    if (wr == 0) PG8_BAR;
    PG8_BAR;
    if constexpr (Epi::AFTER_DRAIN) { E.fused(acc, cur, wr, wc, fr, fq, lds, wid, lane); S.done(cur); }
    PG8_STAMP();
    if (STAMP && wid == 0) { stamps[lane] = lane < nts ? (((unsigned long long)(unsigned)ts_hi << 32) | (unsigned)ts_lo) : 0ull;
        if (lane == 62) stamps[62] = rt_entry; if (lane == 63) stamps[63] = (unsigned long long)wall_clock64(); }
#undef PG8_STAMP
#undef PG8_SA
#undef PG8_SB
#undef PG8_STAGE
#undef PG8_LDA
#undef PG8_LDB
#undef PG8_MMA
#undef PG8_WAIT_V
#undef PG8_WAIT_L
#undef PG8_BAR
#undef PG8_SCHED
}

template <int NC>
DI void rows_rstd_lds(const bfu* __restrict__ A, int lda, int brow, LAS float* rs, int wv, float* gout = nullptr) {
    int tid = mk_tid(wv);
    const int w = tid >> 6, lane = tid & 63;
    if constexpr (NC == 1024) {
        for (int i0 = 0; i0 < 32; i0 += 8) {
            u32x4 va[8], vb[8];
#pragma unroll
            for (int i = 0; i < 8; ++i) { const bfu* row = A + (size_t)(brow + w * 32 + i0 + i) * lda; va[i] = *(const u32x4*)(row + lane * 8); vb[i] = *(const u32x4*)(row + 512 + lane * 8); }
#pragma unroll
            for (int i = 0; i < 8; ++i) {
                float ss = 0.f;
#pragma unroll
                for (int j = 0; j < 4; ++j) { const float x0 = bflo(va[i][j]), x1 = bfhi(va[i][j]), y0 = bflo(vb[i][j]), y1 = bfhi(vb[i][j]); ss += x0 * x0 + x1 * x1 + y0 * y0 + y1 * y1; }
                ss = rdlane_f(dpp_sum63(ss), 63);
                const int r = w * 32 + i0 + i;
                if (lane == 0) { const float rv = rsqrtf(ss * (1.f / NC) + EPS); rs[r] = rv; if (gout) gout[brow + r] = rv; }
            }
        }
    } else {
        constexpr int PER = NC / 64;
        for (int i0 = 0; i0 < 32; i0 += 16) {
            u32x2 v[16];
#pragma unroll
            for (int i = 0; i < 16; ++i) { const bfu* row = A + (size_t)(brow + w * 32 + i0 + i) * lda;
                if constexpr (PER == 4) v[i] = *(const u32x2*)(row + lane * 4); else { v[i][0] = *(const unsigned*)(row + lane * 2); v[i][1] = 0u; } }
#pragma unroll
            for (int i = 0; i < 16; ++i) {
                const float x0 = bflo(v[i][0]), x1 = bfhi(v[i][0]), y0 = bflo(v[i][1]), y1 = bfhi(v[i][1]);
                const float ss = rdlane_f(dpp_sum63(x0 * x0 + x1 * x1 + y0 * y0 + y1 * y1), 63);
                const int r = w * 32 + i0 + i;
                if (lane == 0) { const float rv = rsqrtf(ss * (1.f / NC) + EPS); rs[r] = rv; if (gout) gout[brow + r] = rv; }
            }
        }
    }
}
DI u32x2 pack4(f32x4 v) { u32x2 o; o[0] = pk2(v[0], v[1]); o[1] = pk2(v[2], v[3]); return o; }

DI void rope_perm(f32x4& a, f32x4& b, const float* ct, const float* st, size_t row, int fq) {
    const int i0 = 8 * (fq & 1);
    const f32x4 c0 = *(const f32x4*)(ct + row * 16 + i0), c1 = *(const f32x4*)(ct + row * 16 + i0 + 4), s0 = *(const f32x4*)(st + row * 16 + i0), s1 = *(const f32x4*)(st + row * 16 + i0 + 4);
    f32x4 pa, pb;
#pragma unroll
    for (int j = 0; j < 4; ++j) { pa[j] = swap32(a[j]); pb[j] = swap32(b[j]); }
    const float sg = fq < 2 ? -1.f : 1.f;
    a = a * c0 + pa * s0 * sg; b = b * c1 + pb * s1 * sg;
}
struct EpiProj {
    static constexpr bool PERM = true, AFTER_DRAIN = false;
    const float* rs; bfu* out; const float* ct; const float* st;
    DI void operator()(const f32x4 (&acc)[2][2][4][2], const Unit& u, int wr, int wc, int fr_, int fq_) const {
        int tz = mk_tid(wr * 4 + wc); const int fr = tz & 15, fq = (tz >> 4) & 3;
        const int row0 = u.pm * BM + wr * 64 + fr, colg = u.pn * BM + wc * 32;
        float sv[2][4];
        { f32x4 q0[2][4], q1[2][4];
#pragma unroll
          for (int ai = 0; ai < 2; ++ai)
#pragma unroll
            for (int m = 0; m < 4; ++m) { const int row = row0 + ai * HALF + m * 16; q0[ai][m] = *(const f32x4*)(rs + (size_t)row * 8); q1[ai][m] = *(const f32x4*)(rs + (size_t)row * 8 + 4); }
#pragma unroll
          for (int ai = 0; ai < 2; ++ai)
#pragma unroll
            for (int m = 0; m < 4; ++m) sv[ai][m] = rsqrtf((((q0[ai][m][0] + q0[ai][m][1]) + (q0[ai][m][2] + q0[ai][m][3])) + ((q1[ai][m][0] + q1[ai][m][1]) + (q1[ai][m][2] + q1[ai][m][3]))) * (1.f / DM) + EPS); }
#pragma unroll
        for (int ai = 0; ai < 2; ++ai)
#pragma unroll
            for (int m = 0; m < 4; ++m) {
                const int row = row0 + ai * HALF + m * 16; const float s = sv[ai][m];
#pragma unroll
                for (int bj = 0; bj < 2; ++bj) {
                    const int cg = colg + bj * HALF;
                    f32x4 a = acc[ai][bj][m][0] * s, b = acc[ai][bj][m][1] * s;
                    if (cg == PC_KR) rope_perm(a, b, ct, st, (size_t)row, fq);
                    u32x4 w4; w4[0] = pk2(a[0], a[1]); w4[1] = pk2(a[2], a[3]); w4[2] = pk2(b[0], b[1]); w4[3] = pk2(b[2], b[3]);
                    *(u32x4*)(out + (size_t)row * PW + cg + 8 * fq) = w4;
                }
            }
    }
};
template <bool ROPE>
struct EpiScaled {
    static constexpr bool PERM = true, AFTER_DRAIN = false;
    const LAS float* rs; bfu* out; int ld; const float* ct; const float* st; float scale;
    DI void operator()(const f32x4 (&acc)[2][2][4][2], const Unit& u, int wr, int wc, int fr_, int fq_) const {
        int tz = mk_tid(wr * 4 + wc); const int fr = tz & 15, fq = (tz >> 4) & 3;
        const int lrow0 = wr * 64 + fr, colg = u.pn * BM + wc * 32;
#pragma unroll
        for (int ai = 0; ai < 2; ++ai)
#pragma unroll
            for (int m = 0; m < 4; ++m) {
                const int lrow = lrow0 + ai * HALF + m * 16; const int row = u.pm * BM + lrow; const float s = rs[u.idx * 256 + lrow] * scale;
#pragma unroll
                for (int bj = 0; bj < 2; ++bj) {
                    const int cg = colg + bj * HALF;
                    f32x4 a = acc[ai][bj][m][0] * s, b = acc[ai][bj][m][1] * s;
                    if constexpr (ROPE) { if (((cg >> 5) % 3) == 2) rope_perm(a, b, ct, st, (size_t)row, fq); }
                    u32x4 w4; w4[0] = pk2(a[0], a[1]); w4[1] = pk2(a[2], a[3]); w4[2] = pk2(b[0], b[1]); w4[3] = pk2(b[2], b[3]);
                    *(u32x4*)(out + (size_t)row * ld + cg + 8 * fq) = w4;
                }
            }
    }
};
struct EpiResid {
    static constexpr bool PERM = true, AFTER_DRAIN = false;
    bfu* x;
#ifdef REP_G3
    bfu* xo;
#endif
    DI void operator()(const f32x4 (&acc)[2][2][4][2], const Unit& u, int wr, int wc, int fr_, int fq_) const {
        int tz = mk_tid(wr * 4 + wc); const int fr = tz & 15, fq = (tz >> 4) & 3;
        const int row0 = u.pm * BM + wr * 64 + fr, colg = u.pn * BM + wc * 32 + 8 * fq;
#ifndef REP_G3
        bfu* const xo = x;
#endif
#pragma unroll
        for (int ai = 0; ai < 2; ++ai) {
            u32x4 old[4][2];
#pragma unroll
            for (int m = 0; m < 4; ++m)
#pragma unroll
                for (int bj = 0; bj < 2; ++bj) old[m][bj] = *(const u32x4*)(x + (size_t)(row0 + ai * HALF + m * 16) * DM + colg + bj * HALF);
#pragma unroll
            for (int m = 0; m < 4; ++m)
#pragma unroll
                for (int bj = 0; bj < 2; ++bj) {
                    const u32x4 od = old[m][bj]; const f32x4 v0 = acc[ai][bj][m][0], v1 = acc[ai][bj][m][1];
                    u32x4 o; o[0] = pk2(bflo(od[0]) + v0[0], bfhi(od[0]) + v0[1]); o[1] = pk2(bflo(od[1]) + v0[2], bfhi(od[1]) + v0[3]);
                    o[2] = pk2(bflo(od[2]) + v1[0], bfhi(od[2]) + v1[1]); o[3] = pk2(bflo(od[3]) + v1[2], bfhi(od[3]) + v1[3]);
                    *(u32x4*)(xo + (size_t)(row0 + ai * HALF + m * 16) * DM + colg + bj * HALF) = o;
                }
        }
    }
};

constexpr int AT_KS = 208;
constexpr int AT_VS = 192;
constexpr int AT_KB = 64 * AT_KS, AT_VB = 64 * AT_VS, AT_BUF = AT_KB + AT_VB;

DI void attn_unit(const Params& p, unsigned char* ws, int l, int b, int h, int qt, LAS char* smem, int tid) {
    const int w = tid >> 6, lane = tid & 63, r = lane & 31, hh = lane >> 5;
    const bfu* Q = (const bfu*)(ws + WS_Q); const bfu* KV = (const bfu*)(ws + WS_KV); const bfu* PR = (const bfu*)(ws + WS_PROJ);
    const size_t tok0 = (size_t)b * SEQ;
    const int q0 = qt * 256 + w * 32;
    bf16x8 qf[6];
    { const bfu* qrow = Q + (tok0 + q0 + r) * 768 + h * 96 + 8 * hh;
#pragma unroll
      for (int ks = 0; ks < 6; ++ks) qf[ks] = *(const bf16x8*)(qrow + 16 * ks); }
    f32x16 o0 = zero16(), o1 = zero16();
    float mrun = -1e30f, lsum = 0.f;
    const int nkt = qt * 4 + 4, my_last = qt * 4 + (w >> 1);
    const int skey = tid >> 3, sch = tid & 7, rkey = (tid & 255) >> 2, rch = tid & 3;
    u32x4 gk, gv, gr;
    auto gload = [&](int kt) {
        const size_t t1 = tok0 + (size_t)kt * 64 + skey;
        gk = *(const u32x4*)(KV + t1 * 1024 + h * 64 + sch * 8);
        gv = *(const u32x4*)(KV + t1 * 1024 + 512 + h * 64 + sch * 8);
        if (tid < 256) gr = *(const u32x4*)(PR + (tok0 + (size_t)kt * 64 + rkey) * PW + PC_KR + rch * 8);
    };
    auto lstore = [&](int buf) {
        LAS char* kb = smem + buf * AT_BUF; LAS char* vb = kb + AT_KB;
        *(LAS u32x4*)(kb + skey * AT_KS + sch * 16) = gk;
        *(LAS u32x4*)(vb + skey * AT_VS + sch * 16) = gv;
        if (tid < 256) *(LAS u32x4*)(kb + rkey * AT_KS + 128 + rch * 16) = gr;
    };
    gload(0);
    __syncthreads();
    lstore(0);
    __syncthreads();
    const int i16 = lane & 15, q4 = i16 >> 2, p4 = i16 & 3, blk = (lane >> 4) & 1;
    for (int kt = 0; kt < nkt; ++kt) {
        const int cur = kt & 1;
        if (kt + 1 < nkt) gload(kt + 1);
        auto tile = [&](auto maskc) {
            constexpr bool MASK = decltype(maskc)::value;
            const LAS char* kb = smem + cur * AT_BUF; const LAS char* vb = kb + AT_KB;
            f32x16 s0 = zero16(), s1 = zero16();
#pragma unroll
            for (int ks = 0; ks < 6; ++ks) {
                const bf16x8 a0 = *(const LAS bf16x8*)(kb + r * AT_KS + ks * 32 + hh * 16);
                const bf16x8 a1 = *(const LAS bf16x8*)(kb + (32 + r) * AT_KS + ks * 32 + hh * 16);
                s0 = mfma32(a0, qf[ks], s0); s1 = mfma32(a1, qf[ks], s1);
            }
            if constexpr (MASK) {
                const int qa = q0 + r, kbase = kt * 64 + 4 * hh;
#pragma unroll
                for (int i = 0; i < 16; ++i) { const int kk = kbase + (i & 3) + 8 * (i >> 2); if (kk > qa) s0[i] = -1e30f; if (kk + 32 > qa) s1[i] = -1e30f; }
            }
            float mx = s0[0];
#pragma unroll
            for (int i = 1; i < 16; ++i) mx = fmaxf(mx, s0[i]);
#pragma unroll
            for (int i = 0; i < 16; ++i) mx = fmaxf(mx, s1[i]);
            mx = fmaxf(mx, swap32(mx));
            const float mnew = fmaxf(mrun, mx);
            if (__any(mnew > mrun)) {
                const float alpha = __builtin_amdgcn_exp2f(mrun - mnew);
                lsum *= alpha;
#pragma unroll
                for (int i = 0; i < 16; ++i) { o0[i] *= alpha; o1[i] *= alpha; }
                mrun = mnew;
            }
            float ps = 0.f;
#pragma unroll
            for (int i = 0; i < 16; ++i) { s0[i] = __builtin_amdgcn_exp2f(s0[i] - mrun); s1[i] = __builtin_amdgcn_exp2f(s1[i] - mrun); ps += s0[i] + s1[i]; }
            lsum += ps;
#pragma unroll
            for (int kk = 0; kk < 2; ++kk)
#pragma unroll
                for (int s = 0; s < 2; ++s) {
                    const bf16x8 pf = pack8(kk == 0 ? s0 : s1, s);
                    const int key0 = 32 * kk + 16 * s + 4 * hh + q4;
#pragma unroll
                    for (int vt = 0; vt < 2; ++vt) {
                        const LAS char* a = vb + key0 * AT_VS + (32 * vt + 16 * blk) * 2 + 8 * p4;
                        const bf16x8 vf = cat4(ldtr(a), ldtr(a + 8 * AT_VS));
                        if (vt == 0) o0 = mfma32(vf, pf, o0); else o1 = mfma32(vf, pf, o1);
                    }
                }
        };
        if (kt < my_last) tile(std::false_type{});
        else if (kt == my_last) tile(std::true_type{});
        if (kt + 1 < nkt) lstore(cur ^ 1);
        __syncthreads();
    }
    const float ltot = lsum + swap32(lsum);
    const float inv = 1.f / ltot;
    float ss = 0.f;
#pragma unroll
    for (int i = 0; i < 16; ++i) { o0[i] *= inv; o1[i] *= inv; ss += o0[i] * o0[i] + o1[i] * o1[i]; }
    ss += swap32(ss);
    const float rstd = rsqrtf(ss * (1.f / 64.f) + EPS);
    const float* gain = (const float*)(ws + WS_SP) + l * SP_STRIDE + SP_MLO + h * 64;
    bfu* yrow = (bfu*)(ws + WS_YCAT) + (tok0 + q0 + r) * 1024 + 256 + h * 64;
#pragma unroll
    for (int vt = 0; vt < 2; ++vt)
#pragma unroll
        for (int g = 0; g < 4; ++g) {
            const int v0 = 32 * vt + 8 * g + 4 * hh;
            const f32x4 gn = *(const f32x4*)(gain + v0);
            f32x4 ov;
#pragma unroll
            for (int i = 0; i < 4; ++i) ov[i] = (vt == 0 ? o0[4 * g + i] : o1[4 * g + i]) * rstd * gn[i];
            *(u32x2*)(yrow + v0) = pack4(ov);
        }
}

DI void attn_phase(const Params& p, int l, LAS char* smem, int wv) {
    int tid = mk_tid(wv); smem = opql(smem);
    unsigned char* ws = opq(p.ws);
    for (int pi = blockIdx.x; pi < 512; pi += gridDim.x) {
        const int bh = pi >> 2, j = pi & 3;
        attn_unit(p, ws, l, bh >> 3, bh & 7, 7 - j, smem, tid);
        attn_unit(p, ws, l, bh >> 3, bh & 7, j, smem, tid);
    }
}

constexpr int GM_VS = 576;

DI void gmlp_phase(const Params& p, int l, LAS char* smem, int wv) {
    int tid = mk_tid(wv); smem = opql(smem);
    const int w = tid >> 6, lane = tid & 63, r = lane & 31, hh = lane >> 5;
    unsigned char* ws = opq(p.ws);
    const bfu* PR = (const bfu*)(ws + WS_PROJ);
    bfu* YC = (bfu*)(ws + WS_YCAT);
    const bfu* WC = (const bfu*)(ws + WS_W + (size_t)l * WL_SIZE + WL_GM);
    for (int c = blockIdx.x; c < T / 128; c += gridDim.x) {
        const size_t tok0 = (size_t)c * 128;
        __syncthreads();
        {
            const f32x4 gn = *(const f32x4*)((const float*)(ws + WS_SP) + l * SP_STRIDE + SP_GMV + lane * 4);
            u32x2 vraw[16];
#pragma unroll
            for (int i = 0; i < 16; ++i) vraw[i] = *(const u32x2*)(PR + (tok0 + w * 16 + i) * PW + PC_V + lane * 4);
#pragma unroll
            for (int i = 0; i < 16; ++i) {
                const int s = w * 16 + i;
                const u32x2 raw = vraw[i];
                f32x4 v; v[0] = geluf(bflo(raw[0])); v[1] = geluf(bfhi(raw[0])); v[2] = geluf(bflo(raw[1])); v[3] = geluf(bfhi(raw[1]));
                float ss = v[0] * v[0] + v[1] * v[1] + v[2] * v[2] + v[3] * v[3];
                ss = sum16(ss);
                const float rstd = rsqrtf(ss * (1.f / 64.f) + EPS);
                f32x4 o; for (int j = 0; j < 4; ++j) o[j] = v[j] * rstd * gn[j];
                *(LAS u32x2*)(smem + s * GM_VS + lane * 8) = pack4(o);
            }
        }
        __syncthreads();
        const int h = w >> 1, th = w & 1;
        const int i16 = lane & 15, q4 = i16 >> 2, p4 = i16 & 3, blk = (lane >> 4) & 1;
        f32x16 acc[2][2];
#pragma unroll
        for (int a = 0; a < 2; ++a)
#pragma unroll
            for (int b2 = 0; b2 < 2; ++b2) acc[a][b2] = zero16();
        const bfu* wrow = WC + ((size_t)h * 128 + 64 * th + r) * 128 + 8 * hh;
#pragma unroll
        for (int ks = 0; ks < 8; ++ks) {
            bf16x8 af[2];
#pragma unroll
            for (int mt = 0; mt < 2; ++mt) {
                const LAS char* a = smem + (16 * ks + 8 * hh + q4) * GM_VS + (h * 64 + 32 * mt + 16 * blk) * 2 + 8 * p4;
                af[mt] = cat4(ldtr(a), ldtr(a + 4 * GM_VS));
            }
#pragma unroll
            for (int nt = 0; nt < 2; ++nt) {
                if (ks <= 4 * th + 2 * nt + 1) {
                    const bf16x8 bfr = *(const bf16x8*)(wrow + (size_t)nt * 32 * 128 + 16 * ks);
                    acc[0][nt] = mfma32(af[0], bfr, acc[0][nt]); acc[1][nt] = mfma32(af[1], bfr, acc[1][nt]);
                }
            }
        }
        const float* og = (const float*)(ws + WS_SP) + l * SP_STRIDE + SP_GMO + h * 64;
#pragma unroll
        for (int nt = 0; nt < 2; ++nt) {
            const int tl = 64 * th + 32 * nt + r;
            const float bv = ((const float*)(ws + WS_SP))[l * SP_STRIDE + SP_GMB + h * 128 + tl];
            const bfu* urow = PR + (tok0 + tl) * PW + PC_U + h * 64;
            f32x4 y[2][4]; float ss = 0.f;
#pragma unroll
            for (int mt = 0; mt < 2; ++mt)
#pragma unroll
                for (int g = 0; g < 4; ++g) {
                    const int d0 = 32 * mt + 8 * g + 4 * hh;
                    const u32x2 raw = *(const u32x2*)(urow + d0);
                    f32x4 u; u[0] = geluf(bflo(raw[0])); u[1] = geluf(bfhi(raw[0])); u[2] = geluf(bflo(raw[1])); u[3] = geluf(bfhi(raw[1]));
#pragma unroll
                    for (int i = 0; i < 4; ++i) { const float yy = u[i] * (acc[mt][nt][4 * g + i] + bv); y[mt][g][i] = yy; ss += yy * yy; }
                }
            ss += swap32(ss);
            const float rstd = rsqrtf(ss * (1.f / 64.f) + EPS);
            bfu* yrow = YC + (tok0 + tl) * 1024 + h * 64;
#pragma unroll
            for (int mt = 0; mt < 2; ++mt)
#pragma unroll
                for (int g = 0; g < 4; ++g) {
                    const int d0 = 32 * mt + 8 * g + 4 * hh;
                    const f32x4 gn = *(const f32x4*)(og + d0);
                    f32x4 o; for (int i = 0; i < 4; ++i) o[i] = y[mt][g][i] * rstd * gn[i];
                    *(u32x2*)(yrow + d0) = pack4(o);
                }
        }
    }
}

constexpr int HG_RS = 528;
constexpr int HG_TS = 576;
constexpr float HG_CLAMP = 80.f;

struct HgScan { float cum[32]; float kf[32]; float tot0, tot1; };
DI void hg_scan_pre(const unsigned short (&hfr)[32], int ch, int half, float lb, LAS float* xch, HgScan& S) {
    float run = 0.f;
#pragma unroll
    for (int i = 0; i < 32; ++i) {
        const float fx = bf2f(hfr[i]);
        const float sg = sigmoidf(fx);
        const float f = lb + (1.f - lb) * sg;
        run += __logf(fmaxf(f, 1e-20f));
        S.cum[i] = run; S.kf[i] = (1.f - lb) * (1.f - sg);
    }
    xch[half * 256 + ch] = run;
    __syncthreads();
    S.tot0 = xch[ch]; S.tot1 = xch[256 + ch];
}

DI void hg_local_phase(const Params& p, int l, LAS char* smem, int wv) {
    int tid = mk_tid(wv); smem = opql(smem);
    const int w = tid >> 6, lane = tid & 63, r = lane & 31, hh = lane >> 5;
    const int ch = tid & 255, half = tid >> 8;
    unsigned char* ws = opq(p.ws);
    const bfu* PR = (const bfu*)(ws + WS_PROJ);
    float* HST = (float*)(ws + WS_HST); float* HDEC = (float*)(ws + WS_HDEC);
    const float lb = ((const float*)(ws + WS_LB))[l * 256 + ch];
    LAS char* Kt = smem;
    LAS char* Vn = smem + 64 * HG_TS;
    LAS float* xch = (LAS float*)(smem + 2 * 64 * HG_TS);
    const int nb = gridDim.x, bid = blockIdx.x;
    const bool skew = nb == 256;
    const int u_lo = skew ? (bid < 128 ? bid : 128 + (bid - 128) * 3) : bid, u_n = skew ? (bid < 128 ? 1 : 3) : (512 - bid + nb - 1) / nb, u_st = skew ? 1 : nb;
    for (int ui = 0; ui < u_n; ++ui) {
        const int uc = u_lo + ui * u_st;
        const size_t tok0 = (size_t)uc * 64;
        unsigned short hfr[32];
#pragma unroll
        for (int i = 0; i < 32; ++i) hfr[i] = PR[(tok0 + 32 * half + i) * PW + PC_HF + ch];
        u32x4 vch[4];
#pragma unroll
        for (int i = 0; i < 4; ++i) { const int e = tid + i * 512, s = e >> 5, cch = e & 31; vch[i] = *(const u32x4*)(PR + (tok0 + s) * PW + PC_HI + cch * 8); }
        __syncthreads();
        HgScan S; hg_scan_pre(hfr, ch, half, lb, xch, S);
        const float btot = S.tot0 + S.tot1;
        const float e0 = half == 0 ? btot : S.tot1;
#pragma unroll
        for (int i = 0; i < 32; ++i) {
            const float kv = S.kf[i] * __expf(e0 - S.cum[i]);
            *(LAS bfu*)(Kt + (32 * half + i) * HG_TS + ch * 2) = f2bf(kv);
        }
        if (half == 0) HDEC[(size_t)uc * 256 + ch] = __expf(btot);
#pragma unroll
        for (int i = 0; i < 4; ++i) { const int e = tid + i * 512, s = e >> 5, cch = e & 31; *(LAS u32x4*)(Vn + s * HG_TS + cch * 16) = vch[i]; }
        __syncthreads();
        const int h = w >> 1, vh = w & 1;
        const int i16 = lane & 15, q4 = i16 >> 2, p4 = i16 & 3, blk = (lane >> 4) & 1;
        f32x16 acc0 = zero16(), acc1 = zero16();
#pragma unroll
        for (int ks = 0; ks < 4; ++ks) {
            const int srow = 16 * ks + 8 * hh + q4;
            const LAS char* a = Vn + srow * HG_TS + (h * 64 + 32 * vh + 16 * blk) * 2 + 8 * p4;
            const bf16x8 af = cat4(ldtr(a), ldtr(a + 4 * HG_TS));
            const LAS char* b0 = Kt + srow * HG_TS + (h * 64 + 16 * blk) * 2 + 8 * p4;
            const bf16x8 bf0 = cat4(ldtr(b0), ldtr(b0 + 4 * HG_TS));
            const bf16x8 bf1 = cat4(ldtr(b0 + 64), ldtr(b0 + 64 + 4 * HG_TS));
            acc0 = mfma32(af, bf0, acc0); acc1 = mfma32(af, bf1, acc1);
        }
        float* out = HST + ((size_t)uc * 4 + h) * 4096;
#pragma unroll
        for (int i = 0; i < 16; ++i) {
            const int v = 32 * vh + crow(i, hh);
            out[v * 64 + r] = acc0[i]; out[v * 64 + 32 + r] = acc1[i];
        }
    }
}

DI void hg_prefix_phase(const Params& p, int wv) {
    unsigned char* ws = opq(p.ws);
    float* HST = (float*)(ws + WS_HST); const float* HDEC = (const float*)(ws + WS_HDEC);
    int tid = mk_tid(wv);
    const int gsz = gridDim.x * 512;
    for (int e = blockIdx.x * 512 + tid; e < 64 * 4096; e += gsz) {
        const int bh = e >> 12, idx = e & 4095, b = bh >> 2, h = bh & 3;
        float S = 0.f;
        for (int c0 = 0; c0 < 32; c0 += 8) {
            float g8[8], d8[8];
#pragma unroll
            for (int k = 0; k < 8; ++k) { const size_t uc = (size_t)b * 32 + c0 + k; g8[k] = HST[(uc * 4 + h) * 4096 + idx]; d8[k] = HDEC[uc * 256 + h * 64 + (idx & 63)]; }
#pragma unroll
            for (int k = 0; k < 8; ++k) { const size_t uc = (size_t)b * 32 + c0 + k; HST[(uc * 4 + h) * 4096 + idx] = S; S = d8[k] * S + g8[k]; }
        }
    }
}

DI void hg_out_phase(const Params& p, int l, LAS char* smem, int wv) {
    int tid = mk_tid(wv); smem = opql(smem);
    const int w = tid >> 6, lane = tid & 63, r = lane & 31, hh = lane >> 5;
    const int ch = tid & 255, half = tid >> 8;
    unsigned char* ws = opq(p.ws);
    const bfu* PR = (const bfu*)(ws + WS_PROJ);
    const float* HST = (const float*)(ws + WS_HST);
    bfu* YC = (bfu*)(ws + WS_YCAT);
    const float lb = ((const float*)(ws + WS_LB))[l * 256 + ch];
    LAS char* Qe = smem;
    LAS char* Qm = smem + 64 * HG_RS;
    LAS char* Km = smem + 2 * 64 * HG_RS;
    LAS char* Vn = smem + 3 * 64 * HG_RS;
    LAS float* xch = (LAS float*)(smem + 3 * 64 * HG_RS + 64 * HG_TS);
    for (int uc = blockIdx.x; uc < 512; uc += gridDim.x) {
        const size_t tok0 = (size_t)uc * 64;
        const int h = w >> 1, th = w & 1;
        unsigned short hfr[32], hqr[32];
#pragma unroll
        for (int i = 0; i < 32; ++i) { const bfu* pp = PR + (tok0 + 32 * half + i) * PW + ch; hfr[i] = pp[PC_HF]; hqr[i] = pp[PC_HQ]; }
        u32x4 vch[4];
#pragma unroll
        for (int i = 0; i < 4; ++i) { const int e = tid + i * 512, s = e >> 5, cch = e & 31; vch[i] = *(const u32x4*)(PR + (tok0 + s) * PW + PC_HI + cch * 8); }
        const size_t tok = tok0 + 32 * th + r;
        u32x2 graw[2][4];
#pragma unroll
        for (int vt = 0; vt < 2; ++vt)
#pragma unroll
            for (int g = 0; g < 4; ++g) graw[vt][g] = *(const u32x2*)(PR + tok * PW + PC_HG + h * 64 + 32 * vt + 8 * g + 4 * hh);
        __syncthreads();
        HgScan S; hg_scan_pre(hfr, ch, half, lb, xch, S);
        f32x4 hs[2][4][2];
        { const float* st = HST + ((size_t)uc * 4 + h) * 4096;
#pragma unroll
          for (int vt = 0; vt < 2; ++vt)
#pragma unroll
            for (int ks = 0; ks < 4; ++ks) { const float* sp = st + (32 * vt + r) * 64 + 16 * ks + 8 * hh; hs[vt][ks][0] = *(const f32x4*)sp; hs[vt][ks][1] = *(const f32x4*)(sp + 4); } }
        const float em = __expf(S.tot0);
#pragma unroll
        for (int i = 0; i < 32; ++i) {
            const int s = 32 * half + i;
            const float q = siluf(bf2f(hqr[i]));
            const float bm = half == 0 ? S.cum[i] - S.tot0 : S.cum[i];
            const float ebm = __expf(fminf(fmaxf(bm, -HG_CLAMP), HG_CLAMP));
            const float qm = q * ebm;
            const float qe = qm * em;
            const float km = S.kf[i] * __builtin_amdgcn_rcpf(ebm);
            *(LAS bfu*)(Qe + s * HG_RS + ch * 2) = f2bf(qe);
            *(LAS bfu*)(Qm + s * HG_RS + ch * 2) = f2bf(qm);
            *(LAS bfu*)(Km + s * HG_RS + ch * 2) = f2bf(km);
        }
#pragma unroll
        for (int i = 0; i < 4; ++i) { const int e = tid + i * 512, s = e >> 5, cch = e & 31; *(LAS u32x4*)(Vn + s * HG_TS + cch * 16) = vch[i]; }
        __syncthreads();
        const int i16 = lane & 15, q4 = i16 >> 2, p4 = i16 & 3, blk = (lane >> 4) & 1;
        f32x16 o0 = zero16(), o1 = zero16();
        {
#pragma unroll
            for (int ks = 0; ks < 4; ++ks) {
                const bf16x8 bq = *(const LAS bf16x8*)(Qe + (32 * th + r) * HG_RS + (h * 64 + 16 * ks + 8 * hh) * 2);
#pragma unroll
                for (int vt = 0; vt < 2; ++vt) {
                    const f32x4 s0 = hs[vt][ks][0], s1 = hs[vt][ks][1];
                    u32x4 pa; pa[0] = pk2(s0[0], s0[1]); pa[1] = pk2(s0[2], s0[3]); pa[2] = pk2(s1[0], s1[1]); pa[3] = pk2(s1[2], s1[3]);
                    const bf16x8 af = __builtin_bit_cast(bf16x8, pa);
                    if (vt == 0) o0 = mfma32(af, bq, o0); else o1 = mfma32(af, bq, o1);
                }
            }
        }
#pragma unroll
        for (int st_ = 0; st_ < 2; ++st_) {
            if (st_ <= th) {
                f32x16 x = zero16();
#pragma unroll
                for (int ks = 0; ks < 4; ++ks) {
                    const bf16x8 ak = *(const LAS bf16x8*)(Km + (32 * st_ + r) * HG_RS + (h * 64 + 16 * ks + 8 * hh) * 2);
                    const bf16x8 bq = *(const LAS bf16x8*)(Qm + (32 * th + r) * HG_RS + (h * 64 + 16 * ks + 8 * hh) * 2);
                    x = mfma32(ak, bq, x);
                }
                if (st_ == th) {
#pragma unroll
                    for (int i = 0; i < 16; ++i) if (crow(i, hh) > r) x[i] = 0.f;
                }
#pragma unroll
                for (int s2 = 0; s2 < 2; ++s2) {
                    const bf16x8 pf = pack8(x, s2);
                    const int srow = 32 * st_ + 16 * s2 + 4 * hh + q4;
#pragma unroll
                    for (int vt = 0; vt < 2; ++vt) {
                        const LAS char* a = Vn + srow * HG_TS + (h * 64 + 32 * vt + 16 * blk) * 2 + 8 * p4;
                        const bf16x8 vf = cat4(ldtr(a), ldtr(a + 8 * HG_TS));
                        if (vt == 0) o0 = mfma32(vf, pf, o0); else o1 = mfma32(vf, pf, o1);
                    }
                }
            }
        }
        float ss = 0.f;
#pragma unroll
        for (int i = 0; i < 16; ++i) ss += o0[i] * o0[i] + o1[i] * o1[i];
        ss += swap32(ss);
        const float rstd = rsqrtf(ss * (1.f / 64.f) + EPS);
        bfu* yrow = YC + tok * 1024 + 768 + h * 64;
        const float* og = (const float*)(ws + WS_SP) + l * SP_STRIDE + SP_HGO + h * 64;
#pragma unroll
        for (int vt = 0; vt < 2; ++vt)
#pragma unroll
            for (int g = 0; g < 4; ++g) {
                const int v0 = 32 * vt + 8 * g + 4 * hh;
                const u32x2 raw = graw[vt][g];
                const f32x4 gn = *(const f32x4*)(og + v0);
                f32x4 gg; gg[0] = siluf(bflo(raw[0])); gg[1] = siluf(bfhi(raw[0])); gg[2] = siluf(bflo(raw[1])); gg[3] = siluf(bfhi(raw[1]));
                f32x4 ov;
#pragma unroll
                for (int i = 0; i < 4; ++i) ov[i] = (vt == 0 ? o0[4 * g + i] : o1[4 * g + i]) * rstd * gn[i] * gg[i];
                *(u32x2*)(yrow + v0) = pack4(ov);
            }
    }
}

DI void ins16(float (&a)[16], float v) {
#pragma unroll
    for (int j = 15; j >= 1; --j) a[j] = __builtin_amdgcn_fmed3f(a[j - 1], a[j], v);
    a[0] = fmaxf(a[0], v);
}
DI void peer_topk_phase(const Params& p, int l, LAS char* smem, int wv) {
    int tid = mk_tid(wv); smem = opql(smem);
    const int w = tid >> 6, lane = tid & 63, r = lane & 31, hh = lane >> 5;
    unsigned char* ws = opq(p.ws);
    const bfu* PQ = (const bfu*)(ws + WS_PQ);
    const bfu* SK = (const bfu*)(ws + WS_W + (size_t)l * WL_SIZE + WL_SK);
    unsigned short* IDS = (unsigned short*)(ws + WS_IDS); float* GATE = (float*)(ws + WS_GATE);
    for (int u = blockIdx.x; u < T / 32; u += gridDim.x) {
        const size_t tok = (size_t)u * 32 + r;
        float lst[2][16];
        bf16x8 qf[2][4];
#pragma unroll
        for (int pp = 0; pp < 2; ++pp)
#pragma unroll
            for (int ks = 0; ks < 4; ++ks) qf[pp][ks] = *(const bf16x8*)(PQ + tok * 1024 + w * 128 + pp * 64 + 16 * ks + 8 * hh);
        const bfu* skb = SK + ((size_t)(w * 2) * 128 + r) * 64 + 8 * hh;
        bf16x8 af[2][4];
#pragma unroll
        for (int ks = 0; ks < 4; ++ks) af[0][ks] = *(const bf16x8*)(skb + 16 * ks);
        float a[16];
#pragma unroll
        for (int st = 0; st < 8; ++st) {
            const int pp = st >> 2, kt = st & 3;
            if (kt == 0) {
#pragma unroll
                for (int j = 0; j < 16; ++j) a[j] = -3.0e38f;
            }
            f32x16 acc = zero16();
#pragma unroll
            for (int ks = 0; ks < 4; ++ks) acc = mfma32(af[st & 1][ks], qf[pp][ks], acc);
            if (st < 7) {
                const int np = (st + 1) >> 2, nk = (st + 1) & 3;
#pragma unroll
                for (int ks = 0; ks < 4; ++ks) af[(st + 1) & 1][ks] = *(const bf16x8*)(skb + (size_t)np * 128 * 64 + (size_t)nk * 32 * 64 + 16 * ks);
            }
#pragma unroll
            for (int i = 0; i < 16; ++i) {
                const unsigned key = 32 * kt + (i & 3) + 8 * (i >> 2) + 4 * hh;
                ins16(a, __uint_as_float((__float_as_uint(acc[i]) & 0xffffff80u) | key));
            }
            if (kt == 3) {
                float ob[16];
#pragma unroll
                for (int j = 0; j < 16; ++j) ob[j] = swap32(a[j]);
#pragma unroll
                for (int j = 0; j < 16; ++j) ins16(a, ob[j]);
#pragma unroll
                for (int j = 0; j < 16; ++j) lst[pp][j] = a[j];
            }
        }
        float c[16];
#pragma unroll
        for (int j = 0; j < 16; ++j) c[j] = lst[0][0] + lst[1][j];
#pragma unroll
        for (int i = 1; i < 16; ++i)
#pragma unroll
            for (int j = 0; j < 16; ++j) if ((i + 1) * (j + 1) <= 16) ins16(c, lst[0][i] + lst[1][j]);
        const float thr = c[15], mx = c[0];
        float den = 0.f;
#pragma unroll
        for (int j = 0; j < 16; ++j) den += __expf(c[j] - mx);
        const float rden = 1.f / den;
        int cnt = 0;
        unsigned short* idp = IDS + tok * 128 + w * 16; float* gp = GATE + tok * 128 + w * 16;
        if (hh == 0) {
#pragma unroll
            for (int i = 0; i < 16; ++i)
#pragma unroll
                for (int j = 0; j < 16; ++j) if ((i + 1) * (j + 1) <= 16) {
                    const float s = lst[0][i] + lst[1][j];
                    if (s >= thr && cnt < 16) {
                        idp[cnt] = (unsigned short)((__float_as_uint(lst[0][i]) & 127u) * 128u + (__float_as_uint(lst[1][j]) & 127u));
                        gp[cnt] = __expf(s - mx) * rden;
                        ++cnt;
                    }
                }
            if (cnt < 16) {
#pragma unroll
                for (int k = 0; k < 16; ++k) if (k >= cnt) { idp[k] = 0; gp[k] = 0.f; }
            }
        }
    }
}

#ifndef PGQT
#define PGQT 512
#endif
constexpr int PGQ_TILE = PGQT, PGQ_ITEMS = T / PGQ_TILE;
constexpr int LDS_PGQ = 160 * 1024 - 64;
DI f32x2 fp8lo(unsigned w) { return __builtin_amdgcn_cvt_pk_f32_fp8(w, false); }
DI f32x2 fp8hi(unsigned w) { return __builtin_amdgcn_cvt_pk_f32_fp8(w, true); }
typedef _Float16 h2_t __attribute__((ext_vector_type(2)));
constexpr float PGV_CSCALE = 1024.f;
DI unsigned* pgq_counter(unsigned char* ws, int l, int ph, int slice) { return (unsigned*)(ws + WS_CTL + 16384) + ((l * 4 + ph) * 8 + slice) * 64; }
DI bool pgq_pop(unsigned char* ws, int l, int ph, int home, int& kdone, LAS int* bc, int tid, int& slice, int& tile) {
    __syncthreads();
    if (tid == 0) {
        int k = kdone, s = -1, ti = 0;
        while (k < 8) {
            s = (home + k) & 7;
            ti = (int)__hip_atomic_fetch_add(pgq_counter(ws, l, ph, s), 1u, __ATOMIC_RELAXED, __HIP_MEMORY_SCOPE_AGENT);
            if (ti < PGQ_ITEMS) break;
            ++k;
        }
        bc[0] = k < 8 ? s : -1; bc[1] = ti; bc[2] = k;
    }
    __syncthreads();
    slice = __builtin_amdgcn_readfirstlane(bc[0]); tile = __builtin_amdgcn_readfirstlane(bc[1]); kdone = __builtin_amdgcn_readfirstlane(bc[2]);
    return slice >= 0;
}
template <int CTRL> DI float dpp_perm(float v) { return __builtin_bit_cast(float, __builtin_amdgcn_update_dpp(0, __builtin_bit_cast(int, v), CTRL, 0xf, 0xf, false)); }
DI float sum8(float v) { v += dpp_perm<0xB1>(v); v += dpp_perm<0x4E>(v); v += dpp_perm<0x141>(v); return v; }

#ifndef PGVR
#define PGVR 16
#endif
constexpr int PGV_STRIDE = 129;
DI void peer_u_phase(const Params& p, int l, LAS char* smem, int wv, int qid = 0) {
    int tid = mk_tid(wv); smem = opql(smem);
    const int w = tid >> 6, lane = tid & 63, g = lane >> 3, j = lane & 7;
    unsigned char* ws = opq(p.ws);
    const bfu* XB = (const bfu*)(ws + WS_XB);
    const unsigned short* IDS = (const unsigned short*)(ws + WS_IDS);
    const GAS unsigned char* TU = (const GAS unsigned char*)(ws + WS_TABU + (size_t)l * NEXP * DM);
    const float* RSTF = (const float*)(ws + WS_RSTF);
    unsigned* PART = (unsigned*)(ws + WS_PROJ);
    const float* gn = (const float*)(ws + WS_SP) + l * SP_STRIDE + SP_NFF;
    LAS int* bc = (LAS int*)(smem + LDS_PGQ);
    LAS int* idl = (LAS int*)smem + w * (2 * 8 * PGV_STRIDE) + g * PGV_STRIDE;
    const int home = (int)xb_xcc_id() & 7;
    int kdone = 0, x, tile;
    while (pgq_pop(ws, l, qid, home, kdone, bc, tid, x, tile)) {
      u32x4 nids[2]; u32x2 nx[4]; float nrstd; f32x4 gv[4];
#define PGU_FETCH(tt) { _Pragma("unroll") for (int k = 0; k < 2; ++k) nids[k] = *(const u32x4*)(IDS + (size_t)(tt) * 128 + 16 * j + 8 * k); nrstd = RSTF[tt]; \
        _Pragma("unroll") for (int i = 0; i < 4; ++i) nx[i] = *(const u32x2*)(XB + (size_t)(tt) * DM + 32 * x + 4 * j + 256 * i); }
      PGU_FETCH(tile * PGQ_TILE + w * 8 + g)
#pragma unroll
      for (int i = 0; i < 4; ++i) gv[i] = *(const f32x4*)(gn + 256 * i + 32 * x + 4 * j);
      for (int sub = 0; sub < PGQ_TILE / 64; ++sub) {
        const int t = tile * PGQ_TILE + sub * 64 + w * 8 + g;
#pragma unroll
        for (int k = 0; k < 2; ++k)
#pragma unroll
            for (int c = 0; c < 4; ++c) { idl[16 * j + 8 * k + 2 * c] = (int)(nids[k][c] & 0xffffu); idl[16 * j + 8 * k + 2 * c + 1] = (int)(nids[k][c] >> 16); }
        const float rstd = nrstd;
        u32x2 xr[4];
#pragma unroll
        for (int i = 0; i < 4; ++i) xr[i] = nx[i];
        if (sub + 1 < PGQ_TILE / 64) PGU_FETCH(t + 64)
        f32x4 xf[4]; float am = 0.f;
#pragma unroll
        for (int i = 0; i < 4; ++i) { const u32x2 raw = xr[i];
            xf[i][0] = bflo(raw[0]) * rstd * gv[i][0]; xf[i][1] = bfhi(raw[0]) * rstd * gv[i][1]; xf[i][2] = bflo(raw[1]) * rstd * gv[i][2]; xf[i][3] = bfhi(raw[1]) * rstd * gv[i][3];
            am = fmaxf(am, fmaxf(fmaxf(fabsf(xf[i][0]), fabsf(xf[i][1])), fmaxf(fabsf(xf[i][2]), fabsf(xf[i][3])))); }
        am = fmaxf(am, dpp_perm<0xB1>(am)); am = fmaxf(am, dpp_perm<0x4E>(am)); am = fmaxf(am, dpp_perm<0x141>(am));
        const float qs = am > 0.f ? 127.f / am : 0.f, sx = am * (1.f / 127.f);
        unsigned xq[4];
#pragma unroll
        for (int i = 0; i < 4; ++i) xq[i] = pack_i8x4(xf[i][0] * qs, xf[i][1] * qs, xf[i][2] * qs, xf[i][3] * qs);
        const GAS unsigned char* tux = TU + (size_t)x * NEXP * 128;
        unsigned* prow = PART + ((size_t)x * T + t) * 64 + j;
        {
            u32x4 r[16];
#define PGU_ISSUE(k, e) { const unsigned off_ = (unsigned)idl[e] * 128u + 16u * (unsigned)j; r[k] = *(const GAS u32x4*)(tux + off_); }
#define PGU_DOT(k) { int di_ = 0; _Pragma("unroll") for (int i = 0; i < 4; ++i) di_ = __builtin_amdgcn_sdot4((int)r[k][i], (int)xq[i], di_, false); dk[(k) & 7] = di_; }
#define PGU_REDUCE(OUT) { int a_[4], b_[2]; \
                _Pragma("unroll") for (int m = 0; m < 4; ++m) { const int snd = lo4 ? dk[4 + m] : dk[m], kp = lo4 ? dk[m] : dk[4 + m]; a_[m] = kp + __builtin_amdgcn_update_dpp(0, snd, 0x141, 0xf, 0xf, false); } \
                _Pragma("unroll") for (int n = 0; n < 2; ++n) { const int snd = b2 ? a_[n] : a_[2 + n], kp = b2 ? a_[2 + n] : a_[n]; b_[n] = kp + __builtin_amdgcn_update_dpp(0, snd, 0x4E, 0xf, 0xf, false); } \
                { const int snd = b1 ? b_[0] : b_[1], kp = b1 ? b_[1] : b_[0]; OUT = (float)(kp + __builtin_amdgcn_update_dpp(0, snd, 0xB1, 0xf, 0xf, false)) * sx; } }
            const bool lo4 = j < 4, b2 = (j & 2) != 0, b1 = (j & 1) != 0;
            int dk[8];
#pragma unroll
            for (int k = 0; k < 16; ++k) PGU_ISSUE(k, k)
#pragma unroll 1
            for (int e0 = 0; e0 < 128; e0 += 16) {
                float p0, p1;
                if (e0 + 16 < 128) {
#pragma unroll
                    for (int k = 0; k < 8; ++k) { PGU_DOT(k) PGU_ISSUE(k, e0 + 16 + k) }
                    PGU_REDUCE(p0)
#pragma unroll
                    for (int k = 8; k < 16; ++k) { PGU_DOT(k) PGU_ISSUE(k, e0 + 16 + k) }
                    PGU_REDUCE(p1)
                } else {
#pragma unroll
                    for (int k = 0; k < 8; ++k) { PGU_DOT(k) }
                    PGU_REDUCE(p0)
#pragma unroll
                    for (int k = 8; k < 16; ++k) { PGU_DOT(k) }
                    PGU_REDUCE(p1)
                }
                { const h2_t hp = {(_Float16)p0, (_Float16)p1}; prow[e0 >> 1] = __builtin_bit_cast(unsigned, hp); }
            }
#undef PGU_DOT
#undef PGU_REDUCE
#undef PGU_ISSUE
        }
      }
    }
}
DI void peer_c_phase(const Params& p, int l, int wv) {
    int tid = mk_tid(wv);
    const int w = tid >> 6, lane = tid & 63;
    unsigned char* ws = opq(p.ws);
    const unsigned short* IDS = (const unsigned short*)(ws + WS_IDS); const float* GATE = (const float*)(ws + WS_GATE);
    const float* SCU = (const float*)(ws + WS_SCU) + l * NEXP; const float* SCV = (const float*)(ws + WS_SCV) + l * NEXP;
    const unsigned* PART = (const unsigned*)(ws + WS_PROJ); _Float16* COEF = (_Float16*)(ws + WS_COEF);
    for (int t0 = (blockIdx.x * 8 + w) * 4; t0 < T; t0 += gridDim.x * 8 * 4) {
        const int e0 = 16 * (lane >> 3) + (lane & 7);
        unsigned pr[4][8]; int id0[4], id1[4]; float g0[4], g1[4];
#pragma unroll
        for (int q = 0; q < 4; ++q) { const int t = t0 + q;
#pragma unroll
            for (int x = 0; x < 8; ++x) pr[q][x] = PART[((size_t)x * T + t) * 64 + lane];
            id0[q] = IDS[(size_t)t * 128 + e0]; id1[q] = IDS[(size_t)t * 128 + e0 + 8]; g0[q] = GATE[(size_t)t * 128 + e0]; g1[q] = GATE[(size_t)t * 128 + e0 + 8]; }
#pragma unroll
        for (int q = 0; q < 4; ++q) { const int t = t0 + q;
            f32x2 s = {0.f, 0.f};
#pragma unroll
            for (int x = 0; x < 8; ++x) { const h2_t hp = __builtin_bit_cast(h2_t, pr[q][x]); s.x += (float)hp.x; s.y += (float)hp.y; }
            COEF[(size_t)t * 128 + e0] = (_Float16)(geluf(s.x * SCU[id0[q]]) * g0[q] * SCV[id0[q]] * PGV_CSCALE);
            COEF[(size_t)t * 128 + e0 + 8] = (_Float16)(geluf(s.y * SCU[id1[q]]) * g1[q] * SCV[id1[q]] * PGV_CSCALE);
        }
    }
}

DI void peer_v_phase(const Params& p, int l, LAS char* smem, int wv, int qid = 1, bool dummy = false) {
    int tid = mk_tid(wv); smem = opql(smem);
    const int w = tid >> 6, lane = tid & 63, g = lane >> 3, j = lane & 7;
    unsigned char* ws = opq(p.ws);
    bfu* XB = (bfu*)(ws + WS_XB);
    bfu* XO = dummy ? (bfu*)(ws + WS_PQ) : XB;
    const unsigned short* IDS = (const unsigned short*)(ws + WS_IDS); const unsigned short* COEF = (const unsigned short*)(ws + WS_COEF);
    const GAS unsigned char* TV = (const GAS unsigned char*)(ws + WS_TABV + (size_t)l * NEXP * DM);
    float* SSP = dummy ? (float*)(ws + WS_GATE) : (float*)(ws + WS_SSP);
    LAS int* bc = (LAS int*)(smem + LDS_PGQ);
    LAS int* idl = (LAS int*)smem + w * (2 * 8 * PGV_STRIDE) + g * PGV_STRIDE;
    LAS float* cfl = (LAS float*)idl + 8 * PGV_STRIDE;
    const int home = (int)xb_xcc_id() & 7;
    int kdone = 0, x, tile;
    while (pgq_pop(ws, l, qid, home, kdone, bc, tid, x, tile)) {
      u32x4 nids[2], ncf[2]; u32x2 nx[4];
#define PGV_FETCH(tt) { _Pragma("unroll") for (int k = 0; k < 2; ++k) { nids[k] = *(const u32x4*)(IDS + (size_t)(tt) * 128 + 16 * j + 8 * k); ncf[k] = *(const u32x4*)(COEF + (size_t)(tt) * 128 + 16 * j + 8 * k); } \
        _Pragma("unroll") for (int i = 0; i < 4; ++i) nx[i] = *(const u32x2*)(XB + (size_t)(tt) * DM + 32 * x + 4 * j + 256 * i); }
      PGV_FETCH(tile * PGQ_TILE + w * 8 + g)
      for (int sub = 0; sub < PGQ_TILE / 64; ++sub) {
        const int t = tile * PGQ_TILE + sub * 64 + w * 8 + g;
#pragma unroll
        for (int k = 0; k < 2; ++k)
#pragma unroll
            for (int c = 0; c < 4; ++c) { const unsigned iw = nids[k][c], cw = ncf[k][c];
                idl[16 * j + 8 * k + 2 * c] = (int)(iw & 0xffffu); idl[16 * j + 8 * k + 2 * c + 1] = (int)(iw >> 16);
                cfl[16 * j + 8 * k + 2 * c] = __uint_as_float((cw & 0xffffu) | (cw << 16)); cfl[16 * j + 8 * k + 2 * c + 1] = __uint_as_float((cw >> 16) | (cw & 0xffff0000u)); }
        u32x2 xold[4];
#pragma unroll
        for (int i = 0; i < 4; ++i) xold[i] = nx[i];
        if (sub + 1 < PGQ_TILE / 64) PGV_FETCH(t + 64)
        h2_t acc[8];
#pragma unroll
        for (int c = 0; c < 8; ++c) acc[c] = (h2_t){(_Float16)0.f, (_Float16)0.f};
        const GAS unsigned char* tvx = TV + (size_t)x * NEXP * 128;
        {
            u32x4 r[PGVR]; float cf[PGVR];
#define PGV_ISSUE(k, e) { const unsigned off_ = (unsigned)idl[e] * 128u + 16u * (unsigned)j; cf[k] = cfl[e]; r[k] = *(const GAS u32x4*)(tvx + off_); }
#define PGV_USE(k) { const h2_t c2 = __builtin_bit_cast(h2_t, cf[k]); _Pragma("unroll") for (int i = 0; i < 4; ++i) { const unsigned wd = r[k][i]; \
                acc[2 * i] = __builtin_elementwise_fma(c2, __builtin_bit_cast(h2_t, __builtin_amdgcn_cvt_scalef32_pk_f16_fp8(wd, 1.0f, false)), acc[2 * i]); \
                acc[2 * i + 1] = __builtin_elementwise_fma(c2, __builtin_bit_cast(h2_t, __builtin_amdgcn_cvt_scalef32_pk_f16_fp8(wd, 1.0f, true)), acc[2 * i + 1]); } }
#pragma unroll
            for (int k = 0; k < PGVR; ++k) PGV_ISSUE(k, k)
            for (int e0 = PGVR; e0 < 128; e0 += PGVR) {
#pragma unroll
                for (int k = 0; k < PGVR; ++k) { PGV_USE(k) PGV_ISSUE(k, e0 + k) }
            }
#pragma unroll
            for (int k = 0; k < PGVR; ++k) PGV_USE(k)
#undef PGV_ISSUE
#undef PGV_USE
#undef PGV_FETCH
        }
        bfu* xrow = XO + (size_t)t * DM + 32 * x + 4 * j;
        float s2 = 0.f;
#pragma unroll
        for (int i = 0; i < 4; ++i) {
            u32x2* px = (u32x2*)(xrow + 256 * i); const u32x2 old = xold[i];
            const float us = 1.f / PGV_CSCALE;
            const float y0 = bflo(old[0]) + (float)acc[2 * i].x * us, y1 = bfhi(old[0]) + (float)acc[2 * i].y * us, y2 = bflo(old[1]) + (float)acc[2 * i + 1].x * us, y3 = bfhi(old[1]) + (float)acc[2 * i + 1].y * us;
            u32x2 o; o[0] = pk2(y0, y1); o[1] = pk2(y2, y3); *px = o;
            const float z0 = bflo(o[0]), z1 = bfhi(o[0]), z2 = bflo(o[1]), z3 = bfhi(o[1]);
            s2 += z0 * z0 + z1 * z1 + z2 * z2 + z3 * z3;
        }
        s2 = sum8(s2);
        if (j == 0) SSP[(size_t)t * 8 + x] = s2;
      }
    }
}

DI void final_norm_phase(const Params& p, int wv) {
    int tid = mk_tid(wv);
    const int w = tid >> 6, lane = tid & 63;
    unsigned char* ws = opq(p.ws);
    const bfu* XB = (const bfu*)(ws + WS_XB); const float* SSP = (const float*)(ws + WS_SSP);
    const float* gfin = (const float*)(ws + WS_SP) + SP_FIN;
    f32x4 g[4];
#pragma unroll
    for (int i = 0; i < 4; ++i) g[i] = *(const f32x4*)(gfin + 256 * i + 4 * lane);
    for (int t0 = (blockIdx.x * 8 + w) * 4; t0 < T; t0 += gridDim.x * 8 * 4) {
        f32x4 q0[4], q1[4]; u32x2 raw[4][4];
#pragma unroll
        for (int q = 0; q < 4; ++q) { const int t = t0 + q; q0[q] = *(const f32x4*)(SSP + (size_t)t * 8); q1[q] = *(const f32x4*)(SSP + (size_t)t * 8 + 4);
#pragma unroll
            for (int i = 0; i < 4; ++i) raw[q][i] = *(const u32x2*)(XB + (size_t)t * DM + 256 * i + 4 * lane); }
#pragma unroll
        for (int q = 0; q < 4; ++q) { const int t = t0 + q;
            const float r2 = rsqrtf((((q0[q][0] + q0[q][1]) + (q0[q][2] + q0[q][3])) + ((q1[q][0] + q1[q][1]) + (q1[q][2] + q1[q][3]))) * (1.f / DM) + EPS);
            float* orow = p.out + (size_t)t * DM;
#pragma unroll
            for (int i = 0; i < 4; ++i) {
                f32x4 o; o[0] = bflo(raw[q][i][0]) * r2 * g[i][0]; o[1] = bfhi(raw[q][i][0]) * r2 * g[i][1]; o[2] = bflo(raw[q][i][1]) * r2 * g[i][2]; o[3] = bfhi(raw[q][i][1]) * r2 * g[i][3];
                *(f32x4*)(orow + 256 * i + 4 * lane) = o; }
        }
    }
}

constexpr int PPL = 10, NPH = 2 + PPL * NL;
__global__ void __launch_bounds__(512, 2) hymba_fwd(Params p) {
    extern __shared__ __attribute__((aligned(16))) char smem_raw[];
    LAS char* smem0 = (LAS char*)smem_raw;
    const int wv = __builtin_amdgcn_readfirstlane((int)(threadIdx.x >> 6));
    if (mk_tid(wv) < 4) ((LAS unsigned*)(smem0 + LDS_BAR))[mk_tid(wv)] = 0u;
    __syncthreads();
    XcdBarrier bar = xcd_barrier_post((unsigned*)(p.ws + WS_CTL), (volatile LAS unsigned*)(smem0 + LDS_BAR), wv);
#define IN(k) true
#ifdef REP_BAR
#define SEAM(k) do { xcd_barrier(bar); xcd_barrier(bar); } while (0)
#else
#define SEAM(k) xcd_barrier(bar)
#endif
#define PHASE_HDR const int G = opqi((int)gridDim.x), bid = opqi((int)blockIdx.x); LAS char* smem = opql(smem0); LAS unsigned char* smemu = (LAS unsigned char*)smem; unsigned char* ws = opq(p.ws); \
        const unsigned char* wl = ws + WS_W + (size_t)l * WL_SIZE; const float* ct = (const float*)(ws + WS_COS); const float* st = (const float*)(ws + WS_SIN); (void)wl; (void)ct; (void)st; (void)G; (void)bid; (void)smemu;
    if (IN(0)) { phase_prologue(p, smem0, wv);
#ifdef REP_PRO
        __syncthreads(); phase_prologue(p, smem0, wv);
#endif
    }
    SEAM(0);
#pragma unroll 1
    for (int l_ = 0; l_ < NL; ++l_) {
        const int l = opqi(l_);
        const int pb = 1 + PPL * l; (void)pb;
        if (IN(pb + 0)) {
            PHASE_HDR
            EpiProj e{(const float*)(ws + WS_SSP), (bfu*)(ws + WS_PROJ), ct, st};
            XSched s{8, 128 * 8, G, bid, wv};
            gemm_phase(smemu, Gemm{(const bfu*)(ws + WS_XB), (const bfu*)(wl + WL_IN), 1024, 1024, 1024}, s, e);
#ifdef REP_G1
            __syncthreads(); gemm_phase(smemu, Gemm{(const bfu*)(ws + WS_XB), (const bfu*)(wl + WL_IN), 1024, 1024, 1024}, s, e);
#endif
        }
        SEAM(pb + 0);
        if (IN(pb + 1)) {
            PHASE_HDR
#ifdef REP_G2
            for (int rep = 0; rep < 2; ++rep)
#endif
            {
            {
                XSched s{3, 128 * 3, G, bid, wv};
                Unit u; __syncthreads();
                for (int i = 0; s.next(i, u); ++i) rows_rstd_lds<256>((const bfu*)(ws + WS_PROJ) + PC_CQ, PW, u.pm * 256, (LAS float*)(smem + LDS_RS) + i * 256, wv);
                __syncthreads();
#ifdef REP_G2A
                for (int i = 0; s.next(i, u); ++i) rows_rstd_lds<256>((const bfu*)(ws + WS_PROJ) + PC_CQ, PW, u.pm * 256, (LAS float*)(smem + LDS_RS) + i * 256, wv);
                __syncthreads();
#endif
                EpiScaled<true> e{(const LAS float*)(smem + LDS_RS), (bfu*)(ws + WS_Q), 768, ct, st, 0.10206207261596577f * 1.4426950408889634f};
                gemm_phase(smemu, Gemm{(const bfu*)(ws + WS_PROJ) + PC_CQ, (const bfu*)(wl + WL_UQ), PW, 256, 256}, s, e);
#ifdef REP_G2Q
                __syncthreads(); gemm_phase(smemu, Gemm{(const bfu*)(ws + WS_PROJ) + PC_CQ, (const bfu*)(wl + WL_UQ), PW, 256, 256}, s, e);
#endif
            }
            {
                XSched s{4, 128 * 4, G, (bid + 128) % G, wv};
                Unit u; __syncthreads();
                for (int i = 0; s.next(i, u); ++i) rows_rstd_lds<128>((const bfu*)(ws + WS_PROJ) + PC_CKV, PW, u.pm * 256, (LAS float*)(smem + LDS_RS) + i * 256, wv);
                __syncthreads();
#ifdef REP_G2A
                for (int i = 0; s.next(i, u); ++i) rows_rstd_lds<128>((const bfu*)(ws + WS_PROJ) + PC_CKV, PW, u.pm * 256, (LAS float*)(smem + LDS_RS) + i * 256, wv);
                __syncthreads();
#endif
                EpiScaled<false> e{(const LAS float*)(smem + LDS_RS), (bfu*)(ws + WS_KV), 1024, ct, st, 1.f};
                gemm_phase(smemu, Gemm{(const bfu*)(ws + WS_PROJ) + PC_CKV, (const bfu*)(wl + WL_UKV), PW, 256, 256}, s, e);
#ifdef REP_G2K
                __syncthreads(); gemm_phase(smemu, Gemm{(const bfu*)(ws + WS_PROJ) + PC_CKV, (const bfu*)(wl + WL_UKV), PW, 256, 256}, s, e);
#endif
            }
            }
            gmlp_phase(p, l, smem0, wv);
#ifdef REP_GM
            gmlp_phase(p, l, smem0, wv);
#endif
            hg_local_phase(p, l, smem0, wv);
#ifdef REP_H1
            hg_local_phase(p, l, smem0, wv);
#endif
        }
        SEAM(pb + 1);
        if (IN(pb + 2)) { attn_phase(p, l, smem0, wv);
#ifdef REP_ATT
            attn_phase(p, l, smem0, wv);
#endif
            hg_prefix_phase(p, wv); }
        SEAM(pb + 2);
        if (IN(pb + 3)) { hg_out_phase(p, l, smem0, wv);
#ifdef REP_H3
            hg_out_phase(p, l, smem0, wv);
#endif
        }
        SEAM(pb + 3);
        if (IN(pb + 4)) {
            PHASE_HDR
#ifdef REP_G3
            EpiResid e{(bfu*)(ws + WS_XB), (bfu*)(ws + WS_XB)};
            XSched s{4, 128 * 4, G, bid, wv};
            __syncthreads();
            { EpiResid e2{(bfu*)(ws + WS_XB), (bfu*)(ws + WS_PQ)}; gemm_phase(smemu, Gemm{(const bfu*)(ws + WS_YCAT), (const bfu*)(wl + WL_OUT), 1024, 1024, 1024}, s, e2); __syncthreads(); }
#else
            EpiResid e{(bfu*)(ws + WS_XB)};
            XSched s{4, 128 * 4, G, bid, wv};
            __syncthreads();
#endif
            gemm_phase(smemu, Gemm{(const bfu*)(ws + WS_YCAT), (const bfu*)(wl + WL_OUT), 1024, 1024, 1024}, s, e);
        }
        SEAM(pb + 4);
        if (IN(pb + 5)) {
            PHASE_HDR
            XSched s{4, 128 * 4, G, bid, wv};
            Unit u; __syncthreads();
            for (int i = 0; s.next(i, u); ++i) rows_rstd_lds<1024>((const bfu*)(ws + WS_XB), DM, u.pm * 256, (LAS float*)(smem + LDS_RS) + i * 256, wv, (float*)(ws + WS_RSTF));
            __syncthreads();
            EpiScaled<false> e{(const LAS float*)(smem + LDS_RS), (bfu*)(ws + WS_PQ), 1024, ct, st, 1.f};
            gemm_phase(smemu, Gemm{(const bfu*)(ws + WS_XB), (const bfu*)(wl + WL_Q), 1024, 1024, 1024}, s, e);
#ifdef REP_G4
            __syncthreads(); gemm_phase(smemu, Gemm{(const bfu*)(ws + WS_XB), (const bfu*)(wl + WL_Q), 1024, 1024, 1024}, s, e);
#endif
        }
        SEAM(pb + 5);
        if (IN(pb + 6)) { peer_topk_phase(p, l, smem0, wv);
#ifdef REP_PK
            peer_topk_phase(p, l, smem0, wv);
#endif
        }
        SEAM(pb + 6);
        if (IN(pb + 7)) { peer_u_phase(p, l, smem0, wv);
#ifdef REP_PU
            __syncthreads(); peer_u_phase(p, l, smem0, wv, 2);
#endif
        }
        SEAM(pb + 7);
        if (IN(pb + 8)) { peer_c_phase(p, l, wv);
#ifdef REP_PC
            peer_c_phase(p, l, wv);
#endif
        }
        SEAM(pb + 8);
        if (IN(pb + 9)) {
#ifdef REP_PV
            peer_v_phase(p, l, smem0, wv, 3, true); __syncthreads();
#endif
            peer_v_phase(p, l, smem0, wv); }
        SEAM(pb + 9);
    }
    if (IN(NPH - 1)) { final_norm_phase(p, wv);
#ifdef REP_FIN
        final_norm_phase(p, wv);
#endif
    }
#undef PHASE_HDR
#undef IN
#undef SEAM
}

extern "C" void kernel_launch(void* const* d_in, const int* in_sizes, int n_in, void* d_out, int out_size, void* d_ws, size_t ws_size, hipStream_t stream) {
    static int grid = 0;
    if (grid == 0) {
        if (n_in != 22 || in_sizes[0] != T * DM || out_size != T * DM || ws_size < WS_END) {
            fprintf(stderr, "kernel_launch: unexpected shapes (n_in %d, in0 %d, out %d, ws %zu, need %zu)\n", n_in, n_in > 0 ? in_sizes[0] : -1, out_size, ws_size, (size_t)WS_END); grid = -1; return; }
        int dev = 0, cus = 0, per_cu = 0;
        if (hipGetDevice(&dev) != hipSuccess || hipDeviceGetAttribute(&cus, hipDeviceAttributeMultiprocessorCount, dev) != hipSuccess) { grid = -1; return; }
        if (hipFuncSetAttribute((const void*)hymba_fwd, hipFuncAttributeMaxDynamicSharedMemorySize, LDS_TOTAL) != hipSuccess) { fprintf(stderr, "kernel_launch: hipFuncSetAttribute failed\n"); grid = -1; return; }
        if (hipOccupancyMaxActiveBlocksPerMultiprocessor(&per_cu, (const void*)hymba_fwd, 512, LDS_TOTAL) != hipSuccess || per_cu < 1) fprintf(stderr, "kernel_launch: occupancy query says %d\n", per_cu);
        (void)hipGetLastError();
        grid = cus;
    }
    if (grid < 0) return;
    (void)hipMemsetAsync((char*)d_ws + WS_CTL, 0, 65536, stream);
    Params p{};
    p.x = (const float*)d_in[0]; p.pos = (const int*)d_in[1]; p.norm_mix = (const float*)d_in[2]; p.w_in = (const float*)d_in[3]; p.gm_v_norm = (const float*)d_in[4];
    p.gm_ws = (const float*)d_in[5]; p.gm_b = (const float*)d_in[6]; p.gm_out_norm = (const float*)d_in[7]; p.mla_q_norm = (const float*)d_in[8]; p.mla_w_uq = (const float*)d_in[9];
    p.mla_kv_norm = (const float*)d_in[10]; p.mla_w_ukv = (const float*)d_in[11]; p.mla_out_norm = (const float*)d_in[12]; p.hg_lb_logits = (const float*)d_in[13];
    p.hg_out_norm = (const float*)d_in[14]; p.w_out = (const float*)d_in[15]; p.norm_ffn = (const float*)d_in[16]; p.peer_w_q = (const float*)d_in[17];
    p.peer_sub_keys = (const float*)d_in[18]; p.peer_u = (const float*)d_in[19]; p.peer_v = (const float*)d_in[20]; p.norm_final = (const float*)d_in[21];
    p.out = (float*)d_out; p.ws = (unsigned char*)d_ws;
    hipLaunchKernelGGL(hymba_fwd, dim3(grid), dim3(512), LDS_TOTAL, stream, p);
}
```

```cpp
#include <hip/hip_runtime.h>
#include <cstdio>
#include <cstdint>
#include <cmath>
#include <type_traits>

constexpr int T = 32768, DM = 1024, NL = 4, SEQ = 2048;
constexpr int PW = 2048;
constexpr int PC_U = 0, PC_V = 256, PC_CQ = 512, PC_CKV = 768, PC_KR = 896, PC_HQ = 1024, PC_HF = 1280, PC_HI = 1536, PC_HG = 1792;
constexpr int NEXP = 16384;
constexpr float EPS = 1e-6f;

typedef unsigned short bfu;
typedef __attribute__((ext_vector_type(8))) short bf16x8;
typedef __attribute__((ext_vector_type(4))) short s16x4;
typedef __attribute__((ext_vector_type(4))) float f32x4;
typedef __attribute__((ext_vector_type(16))) float f32x16;
typedef __attribute__((ext_vector_type(2))) __bf16 bf2_t;
typedef __attribute__((ext_vector_type(2))) float f2_t;
typedef __attribute__((ext_vector_type(4))) unsigned u32x4;
typedef __attribute__((ext_vector_type(2))) unsigned u32x2;
typedef short v4i16_t __attribute__((ext_vector_type(4)));
#define DI __device__ __forceinline__
#define LAS __attribute__((address_space(3)))
#define GAS __attribute__((address_space(1)))

DI float bf2f(bfu v) { return __uint_as_float((unsigned)v << 16); }
DI float bflo(unsigned u) { return __uint_as_float(u << 16); }
DI float bfhi(unsigned u) { return __uint_as_float(u & 0xffff0000u); }
DI unsigned pk2(float a, float b) { f2_t v = {a, b}; bf2_t r = __builtin_convertvector(v, bf2_t); return __builtin_bit_cast(unsigned, r); }
DI bfu f2bf(float a) { return (bfu)(pk2(a, 0.f) & 0xffffu); }
DI f32x16 mfma32(bf16x8 a, bf16x8 b, f32x16 c) { return __builtin_amdgcn_mfma_f32_32x32x16_bf16(a, b, c, 0, 0, 0); }
DI int crow(int r, int hi) { return (r & 3) + 8 * (r >> 2) + 4 * hi; }
DI f32x16 zero16() { f32x16 z; for (int i = 0; i < 16; ++i) z[i] = 0.f; return z; }
DI bf16x8 pack8(const f32x16& x, int s) {
    u32x4 p; p[0] = pk2(x[8 * s], x[8 * s + 1]); p[1] = pk2(x[8 * s + 2], x[8 * s + 3]); p[2] = pk2(x[8 * s + 4], x[8 * s + 5]); p[3] = pk2(x[8 * s + 6], x[8 * s + 7]);
    return __builtin_bit_cast(bf16x8, p);
}
DI float swap32(float v) { return __shfl_xor(v, 32); }
DI float wave_sum(float v) {
    v += __shfl_xor(v, 1); v += __shfl_xor(v, 2); v += __shfl_xor(v, 4); v += __shfl_xor(v, 8); v += __shfl_xor(v, 16); v += __shfl_xor(v, 32); return v;
}
DI float sum16(float v) { v += __shfl_xor(v, 1); v += __shfl_xor(v, 2); v += __shfl_xor(v, 4); v += __shfl_xor(v, 8); return v; }
DI float fast_exp(float x) { return __expf(x); }
DI float sigmoidf(float x) { return 1.f / (1.f + __expf(-x)); }
DI float geluf(float x) { const float u = 1.5957691216057308f * (x + 0.044715f * x * x * x); return x / (1.f + __expf(-u)); }
DI float siluf(float x) { return x / (1.f + __expf(-x)); }
DI s16x4 ldtr(const LAS char* p) { return __builtin_bit_cast(s16x4, __builtin_amdgcn_ds_read_tr16_b64_v4i16((LAS v4i16_t*)p)); }
DI bf16x8 cat4(s16x4 a, s16x4 b) { return __builtin_shufflevector(a, b, 0, 1, 2, 3, 4, 5, 6, 7); }
DI int mk_tid(int wv) { int ln; asm volatile("v_mbcnt_lo_u32_b32 %0, -1, 0\n\tv_mbcnt_hi_u32_b32 %0, -1, %0" : "=v"(ln)); return wv * 64 + ln; }
DI unsigned char* opq(unsigned char* q) { GAS unsigned char* g = (GAS unsigned char*)q; asm volatile("" : "+s"(g)); return (unsigned char*)g; }
DI LAS char* opql(LAS char* q) { unsigned v = (unsigned)(size_t)q; asm volatile("" : "+s"(v)); return (LAS char*)(size_t)v; }
DI int opqi(int v) { asm volatile("" : "+s"(v)); return v; }
DI f32x4 zero4_opaque() { float z; asm volatile("v_mov_b32 %0, 0" : "=v"(z)); return (f32x4){z, z, z, z}; }
DI float dot2u(unsigned a, unsigned b, float c) { return __builtin_amdgcn_fdot2_f32_bf16(__builtin_bit_cast(bf2_t, a), __builtin_bit_cast(bf2_t, b), c, false); }
typedef __attribute__((ext_vector_type(2))) float f32x2;
template <int CTRL, int ROWMASK> DI float dpp_get(float v) { return __builtin_bit_cast(float, __builtin_amdgcn_update_dpp(0, __builtin_bit_cast(int, v), CTRL, ROWMASK, 0xf, false)); }
DI float dpp_sum63(float v) {
    v += dpp_get<0x111, 0xf>(v); v += dpp_get<0x112, 0xf>(v); v += dpp_get<0x114, 0xf>(v); v += dpp_get<0x118, 0xf>(v);
    v += dpp_get<0x142, 0xa>(v); v += dpp_get<0x143, 0xc>(v); return v;
}
DI float dpp_max63(float v) {
    v = fmaxf(v, dpp_get<0x111, 0xf>(v)); v = fmaxf(v, dpp_get<0x112, 0xf>(v)); v = fmaxf(v, dpp_get<0x114, 0xf>(v)); v = fmaxf(v, dpp_get<0x118, 0xf>(v));
    v = fmaxf(v, dpp_get<0x142, 0xa>(v)); v = fmaxf(v, dpp_get<0x143, 0xc>(v)); return v;
}
DI float rdlane_f(float v, int l) { return __builtin_bit_cast(float, __builtin_amdgcn_readlane(__builtin_bit_cast(int, v), l)); }
DI unsigned pack_i8x4(float a, float b, float c, float d) {
    const int q0 = (int)__builtin_rintf(fminf(fmaxf(a, -127.f), 127.f)), q1 = (int)__builtin_rintf(fminf(fmaxf(b, -127.f), 127.f));
    const int q2 = (int)__builtin_rintf(fminf(fmaxf(c, -127.f), 127.f)), q3 = (int)__builtin_rintf(fminf(fmaxf(d, -127.f), 127.f));
    return (unsigned)(q0 & 0xff) | ((unsigned)(q1 & 0xff) << 8) | ((unsigned)(q2 & 0xff) << 16) | ((unsigned)(q3 & 0xff) << 24);
}

constexpr size_t WS_CTL   = 0;
constexpr size_t WS_XB    = 65536;
constexpr size_t WS_PROJ  = WS_XB   + (size_t)T * DM * 2;
constexpr size_t WS_Q     = WS_PROJ + (size_t)T * PW * 2;
constexpr size_t WS_KV    = WS_Q    + (size_t)T * 768 * 2;
constexpr size_t WS_YCAT  = WS_KV   + (size_t)T * 1024 * 2;
constexpr size_t WS_PQ    = WS_YCAT + (size_t)T * 1024 * 2;
constexpr size_t WS_IDS   = WS_PQ   + (size_t)T * 1024 * 2;
constexpr size_t WS_GATE  = WS_IDS  + (size_t)T * 128 * 4;
constexpr size_t WS_HST   = WS_GATE + (size_t)T * 128 * 4;
constexpr size_t WS_HDEC  = WS_HST  + (size_t)2048 * 4096 * 4;
constexpr size_t WS_COS   = WS_HDEC + (size_t)512 * 256 * 4;
constexpr size_t WS_SIN   = WS_COS  + (size_t)T * 16 * 4;
constexpr size_t WS_SSP   = WS_SIN  + (size_t)T * 16 * 4;
constexpr size_t WS_RSTF  = WS_SSP  + (size_t)T * 8 * 4;
constexpr size_t WS_COEF  = WS_RSTF + (size_t)T * 4;
constexpr size_t WS_LB    = WS_COEF + (size_t)T * 128 * 4;
constexpr size_t WS_SP    = WS_LB   + 4096;
constexpr int SP_GMV = 0, SP_GMB = 256, SP_GMO = 768, SP_MLO = 1024, SP_HGO = 1536, SP_NFF = 1792, SP_STRIDE = 3072, SP_FIN = NL * SP_STRIDE;
constexpr size_t WS_W     = WS_SP   + (size_t)(SP_FIN + 1024) * 4;
constexpr size_t WL_IN    = 0;
constexpr size_t WL_UQ    = WL_IN  + (size_t)2048 * 1024 * 2;
constexpr size_t WL_UKV   = WL_UQ  + (size_t)768 * 256 * 2;
constexpr size_t WL_OUT   = WL_UKV + (size_t)1024 * 256 * 2;
constexpr size_t WL_Q     = WL_OUT + (size_t)1024 * 1024 * 2;
constexpr size_t WL_SK    = WL_Q   + (size_t)1024 * 1024 * 2;
constexpr size_t WL_GM    = WL_SK  + (size_t)16 * 128 * 64 * 2;
constexpr size_t WL_SIZE  = WL_GM  + (size_t)4 * 128 * 128 * 2;
constexpr size_t WS_TABU  = WS_W + NL * WL_SIZE;
constexpr size_t WS_TABV  = WS_TABU + (size_t)NL * NEXP * DM;
constexpr size_t WS_SCU   = WS_TABV + (size_t)NL * NEXP * DM;
constexpr size_t WS_SCV   = WS_SCU  + (size_t)NL * NEXP * 4;
constexpr size_t WS_END   = WS_SCV  + (size_t)NL * NEXP * 4;

struct Params {
    const float* x; const int* pos; const float* norm_mix; const float* w_in; const float* gm_v_norm; const float* gm_ws; const float* gm_b; const float* gm_out_norm;
    const float* mla_q_norm; const float* mla_w_uq; const float* mla_kv_norm; const float* mla_w_ukv; const float* mla_out_norm; const float* hg_lb_logits; const float* hg_out_norm;
    const float* w_out; const float* norm_ffn; const float* peer_w_q; const float* peer_sub_keys; const float* peer_u; const float* peer_v; const float* norm_final;
    float* out; unsigned char* ws;
};

#define XB_TMO      128
#define XB_XCNT(j)  (256  + 64 * (j))
#define XB_XSUB(j)  (1280 + 64 * (j))
#define XB_XGEN(j)  (2304 + 64 * (j))
#define XB_TOP      3328
#define XB_TOPGEN   3392
#define XCD_BAR_WORDS 3456
#define XB_SPIN_CAP (1u << 20)
DI unsigned xb_ld(unsigned* p)              { return __hip_atomic_load(p, __ATOMIC_RELAXED, __HIP_MEMORY_SCOPE_AGENT); }
DI unsigned xb_add(unsigned* p, unsigned v) { return __hip_atomic_fetch_add(p, v, __ATOMIC_RELAXED, __HIP_MEMORY_SCOPE_AGENT); }
DI unsigned xb_xcc_id() { return (unsigned)__builtin_amdgcn_s_getreg((3 << 11) | 20) & 0xFu; }
#define XB_SPIN(cond, bar) do { unsigned _sp = 0; while (cond) { __builtin_amdgcn_s_sleep(1); \
    if ((++_sp & 255u) == 0u) { if (xb_ld(&(bar)[XB_TMO])) break; if (_sp > XB_SPIN_CAP) { atomicAdd(&(bar)[XB_TMO], 1u); break; } } } } while (0)
struct XcdBarrier { unsigned* bar; unsigned x; volatile LAS unsigned* st; int wv; };
DI XcdBarrier xcd_barrier_post(unsigned* bar, volatile LAS unsigned* st, int wv) {
    XcdBarrier b; b.bar = bar; b.x = xb_xcc_id(); b.st = st; b.wv = wv;
    if (mk_tid(wv) == 0) (void)xb_add(&bar[XB_XCNT(b.x)], 1u);
    return b;
}
DI void xcd_barrier_complete(unsigned* bar, unsigned x, unsigned& nloc, unsigned& nx) {
    const unsigned G = gridDim.x * gridDim.y * gridDim.z;
    unsigned sum, cnt, mine, sp = 0u;
    for (;;) {
        sum = 0u; cnt = 0u; mine = 0u;
#pragma unroll
        for (unsigned j = 0; j < 16; ++j) { const unsigned c = xb_ld(&bar[XB_XCNT(j)]); sum += c; cnt += (c > 0u) ? 1u : 0u; }
        if (sum == G) { mine = xb_ld(&bar[XB_XCNT(x)]); break; }
        __builtin_amdgcn_s_sleep(1);
        if ((++sp & 255u) == 0u) { if (xb_ld(&bar[XB_TMO])) break; if (sp > XB_SPIN_CAP) { atomicAdd(&bar[XB_TMO], 1u); break; } }
    }
    nloc = mine > 0u ? mine : 1u; nx = cnt > 0u ? cnt : 1u;
}
DI void xcd_barrier(const XcdBarrier& b) {
    asm volatile("s_waitcnt vmcnt(0)" ::: "memory");
    __syncthreads();
    if (mk_tid(b.wv) == 0) {
        unsigned* bar = b.bar; unsigned bx = b.x;
        asm volatile("" : "+s"(bar), "+s"(bx));
        __builtin_amdgcn_s_waitcnt(0);
        unsigned nloc = b.st[0], nx = b.st[1];
        if (nloc == 0u) { xcd_barrier_complete(bar, bx, nloc, nx); b.st[0] = nloc; b.st[1] = nx; }
        const unsigned old = xb_add(&bar[XB_XSUB(bx)], 1u);
        const unsigned gen = old / nloc;
        if (old + 1u == (gen + 1u) * nloc) {
            __builtin_amdgcn_fence(__ATOMIC_RELEASE, "agent");
            asm volatile("s_waitcnt vmcnt(0)" ::: "memory");
            const unsigned og = xb_add(&bar[XB_TOP], 1u);
            const unsigned tg = og / nx;
            if (og + 1u == (tg + 1u) * nx) xb_add(&bar[XB_TOPGEN], 1u);
            else XB_SPIN(xb_ld(&bar[XB_TOPGEN]) == tg, bar);
            __builtin_amdgcn_fence(__ATOMIC_ACQUIRE, "agent");
            xb_add(&bar[XB_XGEN(bx)], 1u);
            asm volatile("s_waitcnt vmcnt(0)" ::: "memory");
        } else {
            XB_SPIN(xb_ld(&bar[XB_XGEN(bx)]) == gen, bar);
            __builtin_amdgcn_fence(__ATOMIC_ACQUIRE, "agent");
            asm volatile("s_waitcnt vmcnt(0)" ::: "memory");
        }
    }
    __syncthreads();
}

template <int MODE>
DI int srccol(int n) {
    if (MODE == 1) { return n < 928 ? n : (n < 1024 ? -1 : n - 96); }
    if (MODE == 2) { return n < 512 ? ((n >> 6) * 128 + (n & 63)) : (((n - 512) >> 6) * 128 + 64 + ((n - 512) & 63)); }
    return n;
}
template <int MODE>
DI void conv_tile(int t, const float* __restrict__ src, int ld_src, const float* __restrict__ gain, bfu* __restrict__ dst, int K, int n0, int k0, float* tile, int ksrc = 1 << 30) {
    float ld[8];
#pragma unroll
    for (int i = 0; i < 8; ++i) {
        const int kk = (t >> 6) + i * 8, nn = t & 63;
        const int sc = srccol<MODE>(n0 + nn);
        const int kr = k0 + kk < ksrc ? k0 + kk : 0;
        ld[i] = src[(size_t)kr * ld_src + (sc >= 0 ? sc : 0)] * (gain ? gain[kr] : 1.f);
    }
#pragma unroll
    for (int i = 0; i < 8; ++i) {
        const int kk = (t >> 6) + i * 8, nn = t & 63;
        const int sc = srccol<MODE>(n0 + nn);
        tile[kk * 65 + nn] = (sc >= 0 && k0 + kk < ksrc) ? ld[i] : 0.f;
    }
    __syncthreads();
#pragma unroll
    for (int i = 0; i < 8; ++i) {
        const int nn = (t >> 6) + i * 8, kk = t & 63;
        dst[(size_t)(n0 + nn) * K + k0 + kk] = f2bf(tile[kk * 65 + nn]);
    }
    __syncthreads();
}

DI void phase_prologue(const Params& p, LAS char* smem, int wv) {
    const int tid = mk_tid(wv), bid = blockIdx.x, nb = gridDim.x; smem = opql(smem);
    const int w = tid >> 6, lane = tid & 63;
    unsigned char* ws = opq(p.ws);
    {
        bfu* xb = (bfu*)(ws + WS_XB); float* ssp = (float*)(ws + WS_SSP);
        for (int t0 = (bid * 8 + w) * 4; t0 < T; t0 += nb * 8 * 4) {
            float4 xv[4][4];
#pragma unroll
            for (int q = 0; q < 4; ++q)
#pragma unroll
                for (int i = 0; i < 4; ++i) xv[q][i] = ((const float4*)(p.x + (size_t)(t0 + q) * DM))[i * 64 + lane];
#pragma unroll
            for (int q = 0; q < 4; ++q) { const int t = t0 + q;
                float ss = 0.f;
#pragma unroll
                for (int i = 0; i < 4; ++i) {
                    const float4 v = xv[q][i];
                    ss += v.x * v.x + v.y * v.y + v.z * v.z + v.w * v.w;
                    u32x2 o; o[0] = pk2(v.x, v.y); o[1] = pk2(v.z, v.w);
                    *(u32x2*)(xb + (size_t)t * DM + (i * 64 + lane) * 4) = o;
                }
                ss = wave_sum(ss);
                if (lane < 8) ssp[(size_t)t * 8 + lane] = lane == 0 ? ss : 0.f;
            }
        }
    }
    {
        float* tile = (float*)smem;
        for (int u = bid; u < NL * 1136; u += nb) {
            const int l = u / 1136; int r = u % 1136;
            unsigned char* wl = ws + WS_W + (size_t)l * WL_SIZE;
            if (r < 512) { conv_tile<1>(tid, p.w_in + (size_t)l * 1024 * 1952, 1952, p.norm_mix + l * 1024, (bfu*)(wl + WL_IN), 1024, (r >> 4) * 64, (r & 15) * 64, tile); continue; }
            r -= 512;
            if (r < 48) { conv_tile<0>(tid, p.mla_w_uq + (size_t)l * 256 * 768, 768, p.mla_q_norm + l * 256, (bfu*)(wl + WL_UQ), 256, (r >> 2) * 64, (r & 3) * 64, tile); continue; }
            r -= 48;
            if (r < 64) { conv_tile<2>(tid, p.mla_w_ukv + (size_t)l * 128 * 1024, 1024, p.mla_kv_norm + l * 128, (bfu*)(wl + WL_UKV), 256, (r >> 2) * 64, (r & 3) * 64, tile, 128); continue; }
            r -= 64;
            if (r < 256) { conv_tile<0>(tid, p.w_out + (size_t)l * 1024 * 1024, 1024, nullptr, (bfu*)(wl + WL_OUT), 1024, (r >> 4) * 64, (r & 15) * 64, tile); continue; }
            r -= 256;
            conv_tile<0>(tid, p.peer_w_q + (size_t)l * 1024 * 1024, 1024, p.norm_ffn + l * 1024, (bfu*)(wl + WL_Q), 1024, (r >> 4) * 64, (r & 15) * 64, tile);
        }
    }
    const size_t gtid = (size_t)bid * 512 + tid, gsz = (size_t)nb * 512;
    for (size_t e = gtid; e < (size_t)NL * 16 * 128 * 64; e += gsz) {
        const int l = (int)(e / (16 * 128 * 64)); const size_t r = e % (16 * 128 * 64);
        ((bfu*)(ws + WS_W + (size_t)l * WL_SIZE + WL_SK))[r] = f2bf(p.peer_sub_keys[e]);
    }
    for (size_t e = gtid; e < (size_t)NL * 4 * 128 * 128; e += gsz) {
        const int l = (int)(e / (4 * 128 * 128)); const size_t r = e % (4 * 128 * 128);
        const int tt = (int)((r >> 7) & 127), s = (int)(r & 127);
        ((bfu*)(ws + WS_W + (size_t)l * WL_SIZE + WL_GM))[r] = f2bf(s <= tt ? p.gm_ws[e] : 0.f);
    }
    {
        const int nrows = NL * NEXP;
        for (int rr0 = (bid * 8 + w) * 4; rr0 < 2 * nrows; rr0 += nb * 8 * 4) {
            f32x4 v[4][4];
#pragma unroll
            for (int q = 0; q < 4; ++q) { const int rr = rr0 + q; const int tab = rr >= nrows, row = tab ? rr - nrows : rr;
                const float* src = (tab ? p.peer_v : p.peer_u) + (size_t)row * DM;
#pragma unroll
                for (int i = 0; i < 4; ++i) v[q][i] = *(const f32x4*)(src + 256 * i + 4 * lane); }
#pragma unroll
            for (int q = 0; q < 4; ++q) { const int rr = rr0 + q; const int tab = rr >= nrows, row = tab ? rr - nrows : rr;
                float am = 0.f;
#pragma unroll
                for (int i = 0; i < 4; ++i) am = fmaxf(am, fmaxf(fmaxf(fabsf(v[q][i][0]), fabsf(v[q][i][1])), fmaxf(fabsf(v[q][i][2]), fabsf(v[q][i][3]))));
                am = rdlane_f(dpp_max63(am), 63);
                const bool i8 = !tab;
                const float qmax = i8 ? 127.f : 440.f;
                const float sc = am > 0.f ? qmax / am : 0.f;
                u32x4 o;
#pragma unroll
                for (int i = 0; i < 4; ++i) {
                    if (i8) o[i] = pack_i8x4(v[q][i][0] * sc, v[q][i][1] * sc, v[q][i][2] * sc, v[q][i][3] * sc);
                    else { int wd = 0; wd = __builtin_amdgcn_cvt_pk_fp8_f32(v[q][i][0] * sc, v[q][i][1] * sc, wd, false); wd = __builtin_amdgcn_cvt_pk_fp8_f32(v[q][i][2] * sc, v[q][i][3] * sc, wd, true); o[i] = (unsigned)wd; }
                }
                const int ly = row / NEXP, rw = row % NEXP;
                *(u32x4*)(ws + (tab ? WS_TABV : WS_TABU) + (size_t)ly * NEXP * DM + (size_t)(lane >> 3) * NEXP * 128 + (size_t)rw * 128 + 16 * (lane & 7)) = o;
                if (lane == 0) ((float*)(ws + (tab ? WS_SCV : WS_SCU)))[row] = am / qmax;
            }
        }
    }
    {
        float* ct = (float*)(ws + WS_COS); float* st = (float*)(ws + WS_SIN);
        for (size_t e = gtid; e < (size_t)T * 16; e += gsz) {
            const int t = (int)(e >> 4), i = (int)(e & 15);
            const float inv = expf(-9.210340371976184f * (float)i * (1.f / 16.f));
            const float ang = (float)p.pos[t] * inv;
            const float kq = rintf(ang * 0.15915494309189535f);
            float rr = fmaf(-kq, 6.2831854820251465f, ang); rr = fmaf(-kq, -1.7484555e-7f, rr);
            ct[e] = __cosf(rr); st[e] = __sinf(rr);
        }
    }
    {
        float* sp = (float*)(ws + WS_SP);
        for (int e = (int)gtid; e < NL * SP_STRIDE + 1024; e += (int)gsz) {
            float v = 0.f;
            if (e >= SP_FIN) v = p.norm_final[e - SP_FIN];
            else { const int l = e / SP_STRIDE, r = e % SP_STRIDE;
                if (r < SP_GMB) v = p.gm_v_norm[l * 256 + r];
                else if (r < SP_GMO) v = p.gm_b[l * 512 + r - SP_GMB];
                else if (r < SP_MLO) v = p.gm_out_norm[l * 256 + r - SP_GMO];
                else if (r < SP_HGO) v = p.mla_out_norm[l * 512 + r - SP_MLO];
                else if (r < SP_NFF) v = p.hg_out_norm[l * 256 + r - SP_HGO];
                else if (r < SP_NFF + 1024) v = p.norm_ffn[l * 1024 + r - SP_NFF]; }
            sp[e] = v;
        }
    }
    if (bid == 0 && tid < 256) {
        float lg[NL], mx = -1e30f;
#pragma unroll
        for (int l = 0; l < NL; ++l) { lg[l] = p.hg_lb_logits[l * 256 + tid]; mx = fmaxf(mx, lg[l]); }
        float sum = 0.f; for (int l = 0; l < NL; ++l) { lg[l] = expf(lg[l] - mx); sum += lg[l]; }
        float cum = 0.f; const float p0 = lg[0] / sum;
        for (int l = 0; l < NL; ++l) { cum += lg[l] / sum; ((float*)(ws + WS_LB))[l * 256 + tid] = cum - p0; }
    }
}

constexpr int BM = 256, BK = 64, HALF = 128, HTB = HALF * BK * 2, STAGE_BYTES = 8 * HTB;
constexpr int LDS_RS = STAGE_BYTES;
constexpr int LDS_TOTAL = 163840;
constexpr int LDS_BAR = LDS_TOTAL - 16;
DI int lds_byte(int r, int c) { const int st = (r >> 4) * 2 + (c >> 5), rr = r & 15, cc = c & 31, ob = rr * 64 + cc * 2; return st * 1024 + (ob ^ (((ob >> 9) & 1) << 5)); }
DI void stage_rc(int b, int& R, int& C) { const int st = b / 1024, sb = b % 1024, swz = sb ^ (((sb >> 9) & 1) << 5); R = (st >> 1) * 16 + swz / 64; C = (st & 1) * 32 + (swz % 64) / 2; }
DI int perm32(int rho) { const int n = rho >> 4, i = rho & 15; return 8 * (i >> 2) + 4 * n + (i & 3); }
struct Unit { int pm, pn, idx; };
struct Gemm { const bfu* A; const bfu* Bt; int lda, ldb, K; };
struct XSched {
    int nN, nunits, G, c, wv;
    DI bool next(int i, Unit& u) const { const int L = i * G + c; if (L >= nunits) return false; const int xcd = L & 7, slot = L >> 3; u.pm = (slot / nN) * 8 + xcd; u.pn = slot % nN; u.idx = i; return true; }
    DI void a_ready(const Unit&) const {}
    DI void done(const Unit&) const {}
};
template <class Epi, class Sched, bool STAMP = false>
DI void gemm_phase(LAS unsigned char* lds, const Gemm g, const Sched& S, const Epi& E, unsigned long long* stamps = nullptr) {
    int tid_ = mk_tid(S.wv);
    const int tid = tid_, wid = __builtin_amdgcn_readfirstlane(tid >> 6), lane = tid & 63, wr = wid >> 2, wc = wid & 3, fr = lane & 15, fq = lane >> 4;
    const int K = g.K, nt = K / BK, lda = g.lda, ldb = g.ldb;
    int ts_lo = 0, ts_hi = 0, nts = 0; const unsigned long long rt_entry = STAMP ? (unsigned long long)wall_clock64() : 0ull;
#define PG8_STAMP() do { if (STAMP && wid == 0 && nts < 64) { const unsigned long long _c = (unsigned long long)clock64(); \
        ts_lo = (lane == nts) ? (int)(unsigned)_c : ts_lo; ts_hi = (lane == nts) ? (int)(unsigned)(_c >> 32) : ts_hi; ++nts; } } while (0)
    PG8_STAMP();
    unsigned voffA[2], voffB[2];
#pragma unroll
    for (int i = 0; i < 2; ++i) { int R, C; stage_rc(tid * 16 + i * 8192, R, C); const int Rb = Epi::PERM ? ((R & ~31) + perm32(R & 31)) : R;
        voffA[i] = (unsigned)(R * lda + C) * 2u; voffB[i] = (unsigned)(Rb * ldb + C) * 2u; }
    const size_t kstep = (size_t)(BK * 2);
    const size_t hstepA = (size_t)HALF * lda * 2, hstepB = (size_t)HALF * ldb * 2;
    const size_t tstepA = 2 * hstepA, tstepB = 2 * hstepB;
    const unsigned ldsw = (unsigned)wid * 1024u;
    const int aoff = lds_byte(wr * 64 + fr, fq * 8), boff = lds_byte(wc * 32 + fr, fq * 8);
#define PG8_SA(b, h) (((b) * 2 + (h)) * HTB)
#define PG8_SB(b, h) ((4 + (b) * 2 + (h)) * HTB)
#define PG8_STAGE(bufoff, gbase, voff) do { _Pragma("unroll") for (int _i = 0; _i < 2; ++_i) \
        __builtin_amdgcn_global_load_lds((const unsigned*)((const char*)(gbase) + (voff)[_i]), (LAS unsigned*)(lds + (bufoff) + ldsw + _i * 8192), 16, 0, 0); } while (0)
#define PG8_LDA(dst, b, h) do { _Pragma("unroll") for (int m = 0; m < 4; ++m) _Pragma("unroll") for (int k = 0; k < 2; ++k) dst[m][k] = *(const LAS bf16x8*)(lds + PG8_SA(b, h) + aoff + m * 2048 + k * 1024); } while (0)
#define PG8_LDB(dst, b, h) do { _Pragma("unroll") for (int n = 0; n < 2; ++n) _Pragma("unroll") for (int k = 0; k < 2; ++k) dst[n][k] = *(const LAS bf16x8*)(lds + PG8_SB(b, h) + boff + n * 2048 + k * 1024); } while (0)
#define PG8_MMA(ai, bj, At, Bt) do { __builtin_amdgcn_s_setprio(1); _Pragma("unroll") for (int m = 0; m < 4; ++m) _Pragma("unroll") for (int n = 0; n < 2; ++n) _Pragma("unroll") for (int k = 0; k < 2; ++k) \
        acc[ai][bj][m][n] = __builtin_amdgcn_mfma_f32_16x16x32_bf16(Bt[n][k], At[m][k], acc[ai][bj][m][n], 0, 0, 0); __builtin_amdgcn_s_setprio(0); } while (0)
#define PG8_WAIT_V(n) asm volatile("s_waitcnt vmcnt(" #n ")" ::: "memory")
#define PG8_WAIT_L(n) asm volatile("s_waitcnt lgkmcnt(" #n ")" ::: "memory")
#define PG8_BAR __builtin_amdgcn_s_barrier()
#define PG8_SCHED __builtin_amdgcn_sched_barrier(0)
    Unit cur, nxt; int ui = 0;
    if (!S.next(0, cur)) return;
    f32x4 acc[2][2][4][2]; { const f32x4 zz = zero4_opaque();
#pragma unroll
    for (int a = 0; a < 2; ++a)
#pragma unroll
        for (int b = 0; b < 2; ++b)
#pragma unroll
            for (int m = 0; m < 4; ++m)
#pragma unroll
                for (int n = 0; n < 2; ++n) acc[a][b][m][n] = zz; }
    bf16x8 At[4][2], B0[2][2], B1[2][2];
    const char* cA = (const char*)g.A + (size_t)cur.pm * tstepA; const char* cB = (const char*)g.Bt + (size_t)cur.pn * tstepB;
    S.a_ready(cur);
    PG8_STAGE(PG8_SB(0, 0), cB, voffB); PG8_STAGE(PG8_SA(0, 0), cA, voffA); PG8_STAGE(PG8_SB(0, 1), cB + hstepB, voffB); PG8_STAGE(PG8_SA(0, 1), cA + hstepA, voffA);
    if (wr == 1) PG8_BAR;
    PG8_WAIT_V(4); PG8_BAR;
    PG8_STAGE(PG8_SB(1, 0), cB + kstep, voffB); PG8_STAGE(PG8_SA(1, 0), cA + kstep, voffA); PG8_STAGE(PG8_SB(1, 1), cB + hstepB + kstep, voffB);
    PG8_WAIT_V(6); PG8_BAR;
    PG8_STAMP();
    for (;;) {
        const bool has_next = S.next(ui + 1, nxt);
        const char* nA = has_next ? (const char*)g.A + (size_t)nxt.pm * tstepA : cA; const char* nB = has_next ? (const char*)g.Bt + (size_t)nxt.pn * tstepB : cB;
        for (int t = 0; t < nt; t += 2) {
            const bool last = (t == nt - 2);
            const char* a1 = cA + (size_t)(t + 1) * kstep;
            const char* a2 = last ? nA : cA + (size_t)(t + 2) * kstep; const char* b2 = last ? nB : cB + (size_t)(t + 2) * kstep;
            const char* a3 = a2 + kstep; const char* b3 = b2 + kstep;
            if (last && has_next) S.a_ready(nxt);
            PG8_LDB(B0, 0, 0); PG8_SCHED; PG8_LDA(At, 0, 0); PG8_STAGE(PG8_SA(1, 1), a1 + hstepA, voffA);
            PG8_WAIT_L(8); PG8_BAR; PG8_WAIT_L(0); PG8_MMA(0, 0, At, B0); PG8_BAR; PG8_SCHED;
            PG8_LDB(B1, 0, 1); PG8_STAGE(PG8_SB(0, 0), b2, voffB);
            PG8_BAR; PG8_WAIT_L(0); PG8_MMA(0, 1, At, B1); PG8_BAR;
            PG8_LDA(At, 0, 1); PG8_STAGE(PG8_SA(0, 0), a2, voffA);
            PG8_BAR; PG8_WAIT_L(0); PG8_MMA(1, 0, At, B0); PG8_BAR; PG8_SCHED;
            PG8_STAGE(PG8_SB(0, 1), b2 + hstepB, voffB);
            PG8_WAIT_V(6); PG8_BAR; PG8_MMA(1, 1, At, B1); PG8_BAR;
            PG8_LDB(B0, 1, 0); PG8_SCHED; PG8_LDA(At, 1, 0); PG8_STAGE(PG8_SA(0, 1), a2 + hstepA, voffA);
            PG8_WAIT_L(8); PG8_BAR; PG8_WAIT_L(0); PG8_MMA(0, 0, At, B0); PG8_BAR; PG8_SCHED;
            PG8_LDB(B1, 1, 1); PG8_STAGE(PG8_SB(1, 0), b3, voffB);
            PG8_BAR; PG8_WAIT_L(0); PG8_MMA(0, 1, At, B1); PG8_BAR;
            PG8_LDA(At, 1, 1); PG8_STAGE(PG8_SA(1, 0), a3, voffA);
            PG8_BAR; PG8_WAIT_L(0); PG8_MMA(1, 0, At, B0); PG8_BAR; PG8_SCHED;
            PG8_STAGE(PG8_SB(1, 1), b3 + hstepB, voffB);
            PG8_WAIT_V(6); PG8_BAR; PG8_MMA(1, 1, At, B1); PG8_BAR;
        }
        PG8_STAMP();
        if constexpr (!Epi::AFTER_DRAIN) { E(acc, cur, wr, wc, fr, fq); S.done(cur); }
        PG8_STAMP();
        if (!has_next) break;
        { const f32x4 zz = zero4_opaque();
#pragma unroll
        for (int a = 0; a < 2; ++a)
#pragma unroll
            for (int b = 0; b < 2; ++b)
#pragma unroll
                for (int m = 0; m < 4; ++m)
#pragma unroll
                    for (int n = 0; n < 2; ++n) acc[a][b][m][n] = zz; }
        cur = nxt; cA = nA; cB = nB; ++ui;
    }
    PG8_WAIT_V(0);
    if (wr == 0) PG8_BAR;
    PG8_BAR;
    if constexpr (Epi::AFTER_DRAIN) { E.fused(acc, cur, wr, wc, fr, fq, lds, wid, lane); S.done(cur); }
    PG8_STAMP();
    if (STAMP && wid == 0) { stamps[lane] = lane < nts ? (((unsigned long long)(unsigned)ts_hi << 32) | (unsigned)ts_lo) : 0ull;
        if (lane == 62) stamps[62] = rt_entry; if (lane == 63) stamps[63] = (unsigned long long)wall_clock64(); }
#undef PG8_STAMP
#undef PG8_SA
#undef PG8_SB
#undef PG8_STAGE
#undef PG8_LDA
#undef PG8_LDB
#undef PG8_MMA
#undef PG8_WAIT_V
#undef PG8_WAIT_L
#undef PG8_BAR
#undef PG8_SCHED
}

template <int NC>
DI void rows_rstd_lds(const bfu* __restrict__ A, int lda, int brow, LAS float* rs, int wv, float* gout = nullptr) {
    int tid = mk_tid(wv);
    const int w = tid >> 6, lane = tid & 63;
    if constexpr (NC == 1024) {
        for (int i0 = 0; i0 < 32; i0 += 8) {
            u32x4 va[8], vb[8];
#pragma unroll
            for (int i = 0; i < 8; ++i) { const bfu* row = A + (size_t)(brow + w * 32 + i0 + i) * lda; va[i] = *(const u32x4*)(row + lane * 8); vb[i] = *(const u32x4*)(row + 512 + lane * 8); }
#pragma unroll
            for (int i = 0; i < 8; ++i) {
                float ss = 0.f;
#pragma unroll
                for (int j = 0; j < 4; ++j) { const float x0 = bflo(va[i][j]), x1 = bfhi(va[i][j]), y0 = bflo(vb[i][j]), y1 = bfhi(vb[i][j]); ss += x0 * x0 + x1 * x1 + y0 * y0 + y1 * y1; }
                ss = rdlane_f(dpp_sum63(ss), 63);
                const int r = w * 32 + i0 + i;
                if (lane == 0) { const float rv = rsqrtf(ss * (1.f / NC) + EPS); rs[r] = rv; if (gout) gout[brow + r] = rv; }
            }
        }
    } else {
        constexpr int PER = NC / 64;
        for (int i0 = 0; i0 < 32; i0 += 16) {
            u32x2 v[16];
#pragma unroll
            for (int i = 0; i < 16; ++i) { const bfu* row = A + (size_t)(brow + w * 32 + i0 + i) * lda;
                if constexpr (PER == 4) v[i] = *(const u32x2*)(row + lane * 4); else { v[i][0] = *(const unsigned*)(row + lane * 2); v[i][1] = 0u; } }
#pragma unroll
            for (int i = 0; i < 16; ++i) {
                const float x0 = bflo(v[i][0]), x1 = bfhi(v[i][0]), y0 = bflo(v[i][1]), y1 = bfhi(v[i][1]);
                const float ss = rdlane_f(dpp_sum63(x0 * x0 + x1 * x1 + y0 * y0 + y1 * y1), 63);
                const int r = w * 32 + i0 + i;
                if (lane == 0) { const float rv = rsqrtf(ss * (1.f / NC) + EPS); rs[r] = rv; if (gout) gout[brow + r] = rv; }
            }
        }
    }
}
DI u32x2 pack4(f32x4 v) { u32x2 o; o[0] = pk2(v[0], v[1]); o[1] = pk2(v[2], v[3]); return o; }

DI void rope_perm(f32x4& a, f32x4& b, const float* ct, const float* st, size_t row, int fq) {
    const int i0 = 8 * (fq & 1);
    const f32x4 c0 = *(const f32x4*)(ct + row * 16 + i0), c1 = *(const f32x4*)(ct + row * 16 + i0 + 4), s0 = *(const f32x4*)(st + row * 16 + i0), s1 = *(const f32x4*)(st + row * 16 + i0 + 4);
    f32x4 pa, pb;
#pragma unroll
    for (int j = 0; j < 4; ++j) { pa[j] = swap32(a[j]); pb[j] = swap32(b[j]); }
    const float sg = fq < 2 ? -1.f : 1.f;
    a = a * c0 + pa * s0 * sg; b = b * c1 + pb * s1 * sg;
}
struct EpiProj {
    static constexpr bool PERM = true, AFTER_DRAIN = false;
    const float* rs; bfu* out; const float* ct; const float* st;
    DI void operator()(const f32x4 (&acc)[2][2][4][2], const Unit& u, int wr, int wc, int fr_, int fq_) const {
        int tz = mk_tid(wr * 4 + wc); const int fr = tz & 15, fq = (tz >> 4) & 3;
        const int row0 = u.pm * BM + wr * 64 + fr, colg = u.pn * BM + wc * 32;
        float sv[2][4];
        { f32x4 q0[2][4], q1[2][4];
#pragma unroll
          for (int ai = 0; ai < 2; ++ai)
#pragma unroll
            for (int m = 0; m < 4; ++m) { const int row = row0 + ai * HALF + m * 16; q0[ai][m] = *(const f32x4*)(rs + (size_t)row * 8); q1[ai][m] = *(const f32x4*)(rs + (size_t)row * 8 + 4); }
#pragma unroll
          for (int ai = 0; ai < 2; ++ai)
#pragma unroll
            for (int m = 0; m < 4; ++m) sv[ai][m] = rsqrtf((((q0[ai][m][0] + q0[ai][m][1]) + (q0[ai][m][2] + q0[ai][m][3])) + ((q1[ai][m][0] + q1[ai][m][1]) + (q1[ai][m][2] + q1[ai][m][3]))) * (1.f / DM) + EPS); }
#pragma unroll
        for (int ai = 0; ai < 2; ++ai)
#pragma unroll
            for (int m = 0; m < 4; ++m) {
                const int row = row0 + ai * HALF + m * 16; const float s = sv[ai][m];
#pragma unroll
                for (int bj = 0; bj < 2; ++bj) {
                    const int cg = colg + bj * HALF;
                    f32x4 a = acc[ai][bj][m][0] * s, b = acc[ai][bj][m][1] * s;
                    if (cg == PC_KR) rope_perm(a, b, ct, st, (size_t)row, fq);
                    u32x4 w4; w4[0] = pk2(a[0], a[1]); w4[1] = pk2(a[2], a[3]); w4[2] = pk2(b[0], b[1]); w4[3] = pk2(b[2], b[3]);
                    *(u32x4*)(out + (size_t)row * PW + cg + 8 * fq) = w4;
                }
            }
    }
};
template <bool ROPE>
struct EpiScaled {
    static constexpr bool PERM = true, AFTER_DRAIN = false;
    const LAS float* rs; bfu* out; int ld; const float* ct; const float* st; float scale;
    DI void operator()(const f32x4 (&acc)[2][2][4][2], const Unit& u, int wr, int wc, int fr_, int fq_) const {
        int tz = mk_tid(wr * 4 + wc); const int fr = tz & 15, fq = (tz >> 4) & 3;
        const int lrow0 = wr * 64 + fr, colg = u.pn * BM + wc * 32;
#pragma unroll
        for (int ai = 0; ai < 2; ++ai)
#pragma unroll
            for (int m = 0; m < 4; ++m) {
                const int lrow = lrow0 + ai * HALF + m * 16; const int row = u.pm * BM + lrow; const float s = rs[u.idx * 256 + lrow] * scale;
#pragma unroll
                for (int bj = 0; bj < 2; ++bj) {
                    const int cg = colg + bj * HALF;
                    f32x4 a = acc[ai][bj][m][0] * s, b = acc[ai][bj][m][1] * s;
                    if constexpr (ROPE) { if (((cg >> 5) % 3) == 2) rope_perm(a, b, ct, st, (size_t)row, fq); }
                    u32x4 w4; w4[0] = pk2(a[0], a[1]); w4[1] = pk2(a[2], a[3]); w4[2] = pk2(b[0], b[1]); w4[3] = pk2(b[2], b[3]);
                    *(u32x4*)(out + (size_t)row * ld + cg + 8 * fq) = w4;
                }
            }
    }
};
struct EpiResid {
    static constexpr bool PERM = true, AFTER_DRAIN = false;
    bfu* x;
#ifdef REP_G3
    bfu* xo;
#endif
    DI void operator()(const f32x4 (&acc)[2][2][4][2], const Unit& u, int wr, int wc, int fr_, int fq_) const {
        int tz = mk_tid(wr * 4 + wc); const int fr = tz & 15, fq = (tz >> 4) & 3;
        const int row0 = u.pm * BM + wr * 64 + fr, colg = u.pn * BM + wc * 32 + 8 * fq;
#ifndef REP_G3
        bfu* const xo = x;
#endif
#pragma unroll
        for (int ai = 0; ai < 2; ++ai) {
            u32x4 old[4][2];
#pragma unroll
            for (int m = 0; m < 4; ++m)
#pragma unroll
                for (int bj = 0; bj < 2; ++bj) old[m][bj] = *(const u32x4*)(x + (size_t)(row0 + ai * HALF + m * 16) * DM + colg + bj * HALF);
#pragma unroll
            for (int m = 0; m < 4; ++m)
#pragma unroll
                for (int bj = 0; bj < 2; ++bj) {
                    const u32x4 od = old[m][bj]; const f32x4 v0 = acc[ai][bj][m][0], v1 = acc[ai][bj][m][1];
                    u32x4 o; o[0] = pk2(bflo(od[0]) + v0[0], bfhi(od[0]) + v0[1]); o[1] = pk2(bflo(od[1]) + v0[2], bfhi(od[1]) + v0[3]);
                    o[2] = pk2(bflo(od[2]) + v1[0], bfhi(od[2]) + v1[1]); o[3] = pk2(bflo(od[3]) + v1[2], bfhi(od[3]) + v1[3]);
                    *(u32x4*)(xo + (size_t)(row0 + ai * HALF + m * 16) * DM + colg + bj * HALF) = o;
                }
        }
    }
};

constexpr int AT_KS = 208;
constexpr int AT_VS = 192;
constexpr int AT_KB = 64 * AT_KS, AT_VB = 64 * AT_VS, AT_BUF = AT_KB + AT_VB;

DI void attn_unit(const Params& p, unsigned char* ws, int l, int b, int h, int qt, LAS char* smem, int tid) {
    const int w = tid >> 6, lane = tid & 63, r = lane & 31, hh = lane >> 5;
    const bfu* Q = (const bfu*)(ws + WS_Q); const bfu* KV = (const bfu*)(ws + WS_KV); const bfu* PR = (const bfu*)(ws + WS_PROJ);
    const size_t tok0 = (size_t)b * SEQ;
    const int q0 = qt * 256 + w * 32;
    bf16x8 qf[6];
    { const bfu* qrow = Q + (tok0 + q0 + r) * 768 + h * 96 + 8 * hh;
#pragma unroll
      for (int ks = 0; ks < 6; ++ks) qf[ks] = *(const bf16x8*)(qrow + 16 * ks); }
    f32x16 o0 = zero16(), o1 = zero16();
    float mrun = -1e30f, lsum = 0.f;
    const int nkt = qt * 4 + 4, my_last = qt * 4 + (w >> 1);
    const int skey = tid >> 3, sch = tid & 7, rkey = (tid & 255) >> 2, rch = tid & 3;
    u32x4 gk, gv, gr;
    auto gload = [&](int kt) {
        const size_t t1 = tok0 + (size_t)kt * 64 + skey;
        gk = *(const u32x4*)(KV + t1 * 1024 + h * 64 + sch * 8);
        gv = *(const u32x4*)(KV + t1 * 1024 + 512 + h * 64 + sch * 8);
        if (tid < 256) gr = *(const u32x4*)(PR + (tok0 + (size_t)kt * 64 + rkey) * PW + PC_KR + rch * 8);
    };
    auto lstore = [&](int buf) {
        LAS char* kb = smem + buf * AT_BUF; LAS char* vb = kb + AT_KB;
        *(LAS u32x4*)(kb + skey * AT_KS + sch * 16) = gk;
        *(LAS u32x4*)(vb + skey * AT_VS + sch * 16) = gv;
        if (tid < 256) *(LAS u32x4*)(kb + rkey * AT_KS + 128 + rch * 16) = gr;
    };
    gload(0);
    __syncthreads();
    lstore(0);
    __syncthreads();
    const int i16 = lane & 15, q4 = i16 >> 2, p4 = i16 & 3, blk = (lane >> 4) & 1;
    for (int kt = 0; kt < nkt; ++kt) {
        const int cur = kt & 1;
        if (kt + 1 < nkt) gload(kt + 1);
        auto tile = [&](auto maskc) {
            constexpr bool MASK = decltype(maskc)::value;
            const LAS char* kb = smem + cur * AT_BUF; const LAS char* vb = kb + AT_KB;
            f32x16 s0 = zero16(), s1 = zero16();
#pragma unroll
            for (int ks = 0; ks < 6; ++ks) {
                const bf16x8 a0 = *(const LAS bf16x8*)(kb + r * AT_KS + ks * 32 + hh * 16);
                const bf16x8 a1 = *(const LAS bf16x8*)(kb + (32 + r) * AT_KS + ks * 32 + hh * 16);
                s0 = mfma32(a0, qf[ks], s0); s1 = mfma32(a1, qf[ks], s1);
            }
            if constexpr (MASK) {
                const int qa = q0 + r, kbase = kt * 64 + 4 * hh;
#pragma unroll
                for (int i = 0; i < 16; ++i) { const int kk = kbase + (i & 3) + 8 * (i >> 2); if (kk > qa) s0[i] = -1e30f; if (kk + 32 > qa) s1[i] = -1e30f; }
            }
            float mx = s0[0];
#pragma unroll
            for (int i = 1; i < 16; ++i) mx = fmaxf(mx, s0[i]);
#pragma unroll
            for (int i = 0; i < 16; ++i) mx = fmaxf(mx, s1[i]);
            mx = fmaxf(mx, swap32(mx));
            const float mnew = fmaxf(mrun, mx);
            if (__any(mnew > mrun)) {
                const float alpha = __builtin_amdgcn_exp2f(mrun - mnew);
                lsum *= alpha;
#pragma unroll
                for (int i = 0; i < 16; ++i) { o0[i] *= alpha; o1[i] *= alpha; }
                mrun = mnew;
            }
            float ps = 0.f;
#pragma unroll
            for (int i = 0; i < 16; ++i) { s0[i] = __builtin_amdgcn_exp2f(s0[i] - mrun); s1[i] = __builtin_amdgcn_exp2f(s1[i] - mrun); ps += s0[i] + s1[i]; }
            lsum += ps;
#pragma unroll
            for (int kk = 0; kk < 2; ++kk)
#pragma unroll
                for (int s = 0; s < 2; ++s) {
                    const bf16x8 pf = pack8(kk == 0 ? s0 : s1, s);
                    const int key0 = 32 * kk + 16 * s + 4 * hh + q4;
#pragma unroll
                    for (int vt = 0; vt < 2; ++vt) {
                        const LAS char* a = vb + key0 * AT_VS + (32 * vt + 16 * blk) * 2 + 8 * p4;
                        const bf16x8 vf = cat4(ldtr(a), ldtr(a + 8 * AT_VS));
                        if (vt == 0) o0 = mfma32(vf, pf, o0); else o1 = mfma32(vf, pf, o1);
                    }
                }
        };
        if (kt < my_last) tile(std::false_type{});
        else if (kt == my_last) tile(std::true_type{});
        if (kt + 1 < nkt) lstore(cur ^ 1);
        __syncthreads();
    }
    const float ltot = lsum + swap32(lsum);
    const float inv = 1.f / ltot;
    float ss = 0.f;
#pragma unroll
    for (int i = 0; i < 16; ++i) { o0[i] *= inv; o1[i] *= inv; ss += o0[i] * o0[i] + o1[i] * o1[i]; }
    ss += swap32(ss);
    const float rstd = rsqrtf(ss * (1.f / 64.f) + EPS);
    const float* gain = (const float*)(ws + WS_SP) + l * SP_STRIDE + SP_MLO + h * 64;
    bfu* yrow = (bfu*)(ws + WS_YCAT) + (tok0 + q0 + r) * 1024 + 256 + h * 64;
#pragma unroll
    for (int vt = 0; vt < 2; ++vt)
#pragma unroll
        for (int g = 0; g < 4; ++g) {
            const int v0 = 32 * vt + 8 * g + 4 * hh;
            const f32x4 gn = *(const f32x4*)(gain + v0);
            f32x4 ov;
#pragma unroll
            for (int i = 0; i < 4; ++i) ov[i] = (vt == 0 ? o0[4 * g + i] : o1[4 * g + i]) * rstd * gn[i];
            *(u32x2*)(yrow + v0) = pack4(ov);
        }
}

DI void attn_phase(const Params& p, int l, LAS char* smem, int wv) {
    int tid = mk_tid(wv); smem = opql(smem);
    unsigned char* ws = opq(p.ws);
    for (int pi = blockIdx.x; pi < 512; pi += gridDim.x) {
        const int xx = pi & 7, mm = pi >> 3, j = mm & 3, bh = (mm >> 2) * 8 + xx;
        attn_unit(p, ws, l, bh >> 3, bh & 7, 7 - j, smem, tid);
        attn_unit(p, ws, l, bh >> 3, bh & 7, j, smem, tid);
    }
}

constexpr int GM_VS = 576;

DI void gmlp_phase(const Params& p, int l, LAS char* smem, int wv) {
    int tid = mk_tid(wv); smem = opql(smem);
    const int w = tid >> 6, lane = tid & 63, r = lane & 31, hh = lane >> 5;
    unsigned char* ws = opq(p.ws);
    const bfu* PR = (const bfu*)(ws + WS_PROJ);
    bfu* YC = (bfu*)(ws + WS_YCAT);
    const bfu* WC = (const bfu*)(ws + WS_W + (size_t)l * WL_SIZE + WL_GM);
    for (int c = blockIdx.x; c < T / 128; c += gridDim.x) {
        const size_t tok0 = (size_t)c * 128;
        __syncthreads();
        {
            const f32x4 gn = *(const f32x4*)((const float*)(ws + WS_SP) + l * SP_STRIDE + SP_GMV + lane * 4);
            u32x2 vraw[16];
#pragma unroll
            for (int i = 0; i < 16; ++i) vraw[i] = *(const u32x2*)(PR + (tok0 + w * 16 + i) * PW + PC_V + lane * 4);
#pragma unroll
            for (int i = 0; i < 16; ++i) {
                const int s = w * 16 + i;
                const u32x2 raw = vraw[i];
                f32x4 v; v[0] = geluf(bflo(raw[0])); v[1] = geluf(bfhi(raw[0])); v[2] = geluf(bflo(raw[1])); v[3] = geluf(bfhi(raw[1]));
                float ss = v[0] * v[0] + v[1] * v[1] + v[2] * v[2] + v[3] * v[3];
                ss = sum16(ss);
                const float rstd = rsqrtf(ss * (1.f / 64.f) + EPS);
                f32x4 o; for (int j = 0; j < 4; ++j) o[j] = v[j] * rstd * gn[j];
                *(LAS u32x2*)(smem + s * GM_VS + lane * 8) = pack4(o);
            }
        }
        __syncthreads();
        const int h = w >> 1, th = w & 1;
        const int i16 = lane & 15, q4 = i16 >> 2, p4 = i16 & 3, blk = (lane >> 4) & 1;
        f32x16 acc[2][2];
#pragma unroll
        for (int a = 0; a < 2; ++a)
#pragma unroll
            for (int b2 = 0; b2 < 2; ++b2) acc[a][b2] = zero16();
        const bfu* wrow = WC + ((size_t)h * 128 + 64 * th + r) * 128 + 8 * hh;
#pragma unroll
        for (int ks = 0; ks < 8; ++ks) {
            bf16x8 af[2];
#pragma unroll
            for (int mt = 0; mt < 2; ++mt) {
                const LAS char* a = smem + (16 * ks + 8 * hh + q4) * GM_VS + (h * 64 + 32 * mt + 16 * blk) * 2 + 8 * p4;
                af[mt] = cat4(ldtr(a), ldtr(a + 4 * GM_VS));
            }
#pragma unroll
            for (int nt = 0; nt < 2; ++nt) {
                if (ks <= 4 * th + 2 * nt + 1) {
                    const bf16x8 bfr = *(const bf16x8*)(wrow + (size_t)nt * 32 * 128 + 16 * ks);
                    acc[0][nt] = mfma32(af[0], bfr, acc[0][nt]); acc[1][nt] = mfma32(af[1], bfr, acc[1][nt]);
                }
            }
        }
        const float* og = (const float*)(ws + WS_SP) + l * SP_STRIDE + SP_GMO + h * 64;
#pragma unroll
        for (int nt = 0; nt < 2; ++nt) {
            const int tl = 64 * th + 32 * nt + r;
            const float bv = ((const float*)(ws + WS_SP))[l * SP_STRIDE + SP_GMB + h * 128 + tl];
            const bfu* urow = PR + (tok0 + tl) * PW + PC_U + h * 64;
            f32x4 y[2][4]; float ss = 0.f;
#pragma unroll
            for (int mt = 0; mt < 2; ++mt)
#pragma unroll
                for (int g = 0; g < 4; ++g) {
                    const int d0 = 32 * mt + 8 * g + 4 * hh;
                    const u32x2 raw = *(const u32x2*)(urow + d0);
                    f32x4 u; u[0] = geluf(bflo(raw[0])); u[1] = geluf(bfhi(raw[0])); u[2] = geluf(bflo(raw[1])); u[3] = geluf(bfhi(raw[1]));
#pragma unroll
                    for (int i = 0; i < 4; ++i) { const float yy = u[i] * (acc[mt][nt][4 * g + i] + bv); y[mt][g][i] = yy; ss += yy * yy; }
                }
            ss += swap32(ss);
            const float rstd = rsqrtf(ss * (1.f / 64.f) + EPS);
            bfu* yrow = YC + (tok0 + tl) * 1024 + h * 64;
#pragma unroll
            for (int mt = 0; mt < 2; ++mt)
#pragma unroll
                for (int g = 0; g < 4; ++g) {
                    const int d0 = 32 * mt + 8 * g + 4 * hh;
                    const f32x4 gn = *(const f32x4*)(og + d0);
                    f32x4 o; for (int i = 0; i < 4; ++i) o[i] = y[mt][g][i] * rstd * gn[i];
                    *(u32x2*)(yrow + d0) = pack4(o);
                }
        }
    }
}

constexpr int HG_RS = 528;
constexpr int HG_TS = 576;
constexpr float HG_CLAMP = 80.f;

struct HgScan { float cum[32]; float kf[32]; float tot0, tot1; };
DI void hg_scan_pre(const unsigned short (&hfr)[32], int ch, int half, float lb, LAS float* xch, HgScan& S) {
    float run = 0.f;
#pragma unroll
    for (int i = 0; i < 32; ++i) {
        const float fx = bf2f(hfr[i]);
        const float sg = sigmoidf(fx);
        const float f = lb + (1.f - lb) * sg;
        run += __logf(fmaxf(f, 1e-20f));
        S.cum[i] = run; S.kf[i] = (1.f - lb) * (1.f - sg);
    }
    xch[half * 256 + ch] = run;
    __syncthreads();
    S.tot0 = xch[ch]; S.tot1 = xch[256 + ch];
}

DI void hg_local_phase(const Params& p, int l, LAS char* smem, int wv) {
    int tid = mk_tid(wv); smem = opql(smem);
    const int w = tid >> 6, lane = tid & 63, r = lane & 31, hh = lane >> 5;
    const int ch = tid & 255, half = tid >> 8;
    unsigned char* ws = opq(p.ws);
    const bfu* PR = (const bfu*)(ws + WS_PROJ);
    float* HST = (float*)(ws + WS_HST); float* HDEC = (float*)(ws + WS_HDEC);
    const float lb = ((const float*)(ws + WS_LB))[l * 256 + ch];
    LAS char* Kt = smem;
    LAS char* Vn = smem + 64 * HG_TS;
    LAS float* xch = (LAS float*)(smem + 2 * 64 * HG_TS);
    const int nb = gridDim.x, bid = blockIdx.x;
    const bool skew = nb == 256;
    const int u_lo = skew ? (bid < 128 ? bid : 128 + (bid - 128) * 3) : bid, u_n = skew ? (bid < 128 ? 1 : 3) : (512 - bid + nb - 1) / nb, u_st = skew ? 1 : nb;
    for (int ui = 0; ui < u_n; ++ui) {
        const int uc = u_lo + ui * u_st;
        const size_t tok0 = (size_t)uc * 64;
        unsigned short hfr[32];
#pragma unroll
        for (int i = 0; i < 32; ++i) hfr[i] = PR[(tok0 + 32 * half + i) * PW + PC_HF + ch];
        u32x4 vch[4];
#pragma unroll
        for (int i = 0; i < 4; ++i) { const int e = tid + i * 512, s = e >> 5, cch = e & 31; vch[i] = *(const u32x4*)(PR + (tok0 + s) * PW + PC_HI + cch * 8); }
        __syncthreads();
        HgScan S; hg_scan_pre(hfr, ch, half, lb, xch, S);
        const float btot = S.tot0 + S.tot1;
        const float e0 = half == 0 ? btot : S.tot1;
#pragma unroll
        for (int i = 0; i < 32; ++i) {
            const float kv = S.kf[i] * __expf(e0 - S.cum[i]);
            *(LAS bfu*)(Kt + (32 * half + i) * HG_TS + ch * 2) = f2bf(kv);
        }
        if (half == 0) HDEC[(size_t)uc * 256 + ch] = __expf(btot);
#pragma unroll
        for (int i = 0; i < 4; ++i) { const int e = tid + i * 512, s = e >> 5, cch = e & 31; *(LAS u32x4*)(Vn + s * HG_TS + cch * 16) = vch[i]; }
        __syncthreads();
        const int h = w >> 1, vh = w & 1;
        const int i16 = lane & 15, q4 = i16 >> 2, p4 = i16 & 3, blk = (lane >> 4) & 1;
        f32x16 acc0 = zero16(), acc1 = zero16();
#pragma unroll
        for (int ks = 0; ks < 4; ++ks) {
            const int srow = 16 * ks + 8 * hh + q4;
            const LAS char* a = Vn + srow * HG_TS + (h * 64 + 32 * vh + 16 * blk) * 2 + 8 * p4;
            const bf16x8 af = cat4(ldtr(a), ldtr(a + 4 * HG_TS));
            const LAS char* b0 = Kt + srow * HG_TS + (h * 64 + 16 * blk) * 2 + 8 * p4;
            const bf16x8 bf0 = cat4(ldtr(b0), ldtr(b0 + 4 * HG_TS));
            const bf16x8 bf1 = cat4(ldtr(b0 + 64), ldtr(b0 + 64 + 4 * HG_TS));
            acc0 = mfma32(af, bf0, acc0); acc1 = mfma32(af, bf1, acc1);
        }
        float* out = HST + ((size_t)uc * 4 + h) * 4096;
#pragma unroll
        for (int i = 0; i < 16; ++i) {
            const int v = 32 * vh + crow(i, hh);
            out[v * 64 + r] = acc0[i]; out[v * 64 + 32 + r] = acc1[i];
        }
    }
}

DI void hg_prefix_phase(const Params& p, int wv) {
    unsigned char* ws = opq(p.ws);
    float* HST = (float*)(ws + WS_HST); const float* HDEC = (const float*)(ws + WS_HDEC);
    int tid = mk_tid(wv);
    const int gsz = gridDim.x * 512;
    for (int e = blockIdx.x * 512 + tid; e < 64 * 4096; e += gsz) {
        const int bh = e >> 12, idx = e & 4095, b = bh >> 2, h = bh & 3;
        float S = 0.f;
        for (int c0 = 0; c0 < 32; c0 += 8) {
            float g8[8], d8[8];
#pragma unroll
            for (int k = 0; k < 8; ++k) { const size_t uc = (size_t)b * 32 + c0 + k; g8[k] = HST[(uc * 4 + h) * 4096 + idx]; d8[k] = HDEC[uc * 256 + h * 64 + (idx & 63)]; }
#pragma unroll
            for (int k = 0; k < 8; ++k) { const size_t uc = (size_t)b * 32 + c0 + k; HST[(uc * 4 + h) * 4096 + idx] = S; S = d8[k] * S + g8[k]; }
        }
    }
}

DI void hg_out_phase(const Params& p, int l, LAS char* smem, int wv) {
    int tid = mk_tid(wv); smem = opql(smem);
    const int w = tid >> 6, lane = tid & 63, r = lane & 31, hh = lane >> 5;
    const int ch = tid & 255, half = tid >> 8;
    unsigned char* ws = opq(p.ws);
    const bfu* PR = (const bfu*)(ws + WS_PROJ);
    const float* HST = (const float*)(ws + WS_HST);
    bfu* YC = (bfu*)(ws + WS_YCAT);
    const float lb = ((const float*)(ws + WS_LB))[l * 256 + ch];
    LAS char* Qe = smem;
    LAS char* Qm = smem + 64 * HG_RS;
    LAS char* Km = smem + 2 * 64 * HG_RS;
    LAS char* Vn = smem + 3 * 64 * HG_RS;
    LAS float* xch = (LAS float*)(smem + 3 * 64 * HG_RS + 64 * HG_TS);
    for (int uc = blockIdx.x; uc < 512; uc += gridDim.x) {
        const size_t tok0 = (size_t)uc * 64;
        const int h = w >> 1, th = w & 1;
        unsigned short hfr[32], hqr[32];
#pragma unroll
        for (int i = 0; i < 32; ++i) { const bfu* pp = PR + (tok0 + 32 * half + i) * PW + ch; hfr[i] = pp[PC_HF]; hqr[i] = pp[PC_HQ]; }
        u32x4 vch[4];
#pragma unroll
        for (int i = 0; i < 4; ++i) { const int e = tid + i * 512, s = e >> 5, cch = e & 31; vch[i] = *(const u32x4*)(PR + (tok0 + s) * PW + PC_HI + cch * 8); }
        const size_t tok = tok0 + 32 * th + r;
        u32x2 graw[2][4];
#pragma unroll
        for (int vt = 0; vt < 2; ++vt)
#pragma unroll
            for (int g = 0; g < 4; ++g) graw[vt][g] = *(const u32x2*)(PR + tok * PW + PC_HG + h * 64 + 32 * vt + 8 * g + 4 * hh);
        __syncthreads();
        HgScan S; hg_scan_pre(hfr, ch, half, lb, xch, S);
        f32x4 hs[2][4][2];
        { const float* st = HST + ((size_t)uc * 4 + h) * 4096;
#pragma unroll
          for (int vt = 0; vt < 2; ++vt)
#pragma unroll
            for (int ks = 0; ks < 4; ++ks) { const float* sp = st + (32 * vt + r) * 64 + 16 * ks + 8 * hh; hs[vt][ks][0] = *(const f32x4*)sp; hs[vt][ks][1] = *(const f32x4*)(sp + 4); } }
        const float em = __expf(S.tot0);
#pragma unroll
        for (int i = 0; i < 32; ++i) {
            const int s = 32 * half + i;
            const float q = siluf(bf2f(hqr[i]));
            const float bm = half == 0 ? S.cum[i] - S.tot0 : S.cum[i];
            const float ebm = __expf(fminf(fmaxf(bm, -HG_CLAMP), HG_CLAMP));
            const float qm = q * ebm;
            const float qe = qm * em;
            const float km = S.kf[i] * __builtin_amdgcn_rcpf(ebm);
            *(LAS bfu*)(Qe + s * HG_RS + ch * 2) = f2bf(qe);
            *(LAS bfu*)(Qm + s * HG_RS + ch * 2) = f2bf(qm);
            *(LAS bfu*)(Km + s * HG_RS + ch * 2) = f2bf(km);
        }
#pragma unroll
        for (int i = 0; i < 4; ++i) { const int e = tid + i * 512, s = e >> 5, cch = e & 31; *(LAS u32x4*)(Vn + s * HG_TS + cch * 16) = vch[i]; }
        __syncthreads();
        const int i16 = lane & 15, q4 = i16 >> 2, p4 = i16 & 3, blk = (lane >> 4) & 1;
        f32x16 o0 = zero16(), o1 = zero16();
        {
#pragma unroll
            for (int ks = 0; ks < 4; ++ks) {
                const bf16x8 bq = *(const LAS bf16x8*)(Qe + (32 * th + r) * HG_RS + (h * 64 + 16 * ks + 8 * hh) * 2);
#pragma unroll
                for (int vt = 0; vt < 2; ++vt) {
                    const f32x4 s0 = hs[vt][ks][0], s1 = hs[vt][ks][1];
                    u32x4 pa; pa[0] = pk2(s0[0], s0[1]); pa[1] = pk2(s0[2], s0[3]); pa[2] = pk2(s1[0], s1[1]); pa[3] = pk2(s1[2], s1[3]);
                    const bf16x8 af = __builtin_bit_cast(bf16x8, pa);
                    if (vt == 0) o0 = mfma32(af, bq, o0); else o1 = mfma32(af, bq, o1);
                }
            }
        }
#pragma unroll
        for (int st_ = 0; st_ < 2; ++st_) {
            if (st_ <= th) {
                f32x16 x = zero16();
#pragma unroll
                for (int ks = 0; ks < 4; ++ks) {
                    const bf16x8 ak = *(const LAS bf16x8*)(Km + (32 * st_ + r) * HG_RS + (h * 64 + 16 * ks + 8 * hh) * 2);
                    const bf16x8 bq = *(const LAS bf16x8*)(Qm + (32 * th + r) * HG_RS + (h * 64 + 16 * ks + 8 * hh) * 2);
                    x = mfma32(ak, bq, x);
                }
                if (st_ == th) {
#pragma unroll
                    for (int i = 0; i < 16; ++i) if (crow(i, hh) > r) x[i] = 0.f;
                }
#pragma unroll
                for (int s2 = 0; s2 < 2; ++s2) {
                    const bf16x8 pf = pack8(x, s2);
                    const int srow = 32 * st_ + 16 * s2 + 4 * hh + q4;
#pragma unroll
                    for (int vt = 0; vt < 2; ++vt) {
                        const LAS char* a = Vn + srow * HG_TS + (h * 64 + 32 * vt + 16 * blk) * 2 + 8 * p4;
                        const bf16x8 vf = cat4(ldtr(a), ldtr(a + 8 * HG_TS));
                        if (vt == 0) o0 = mfma32(vf, pf, o0); else o1 = mfma32(vf, pf, o1);
                    }
                }
            }
        }
        float ss = 0.f;
#pragma unroll
        for (int i = 0; i < 16; ++i) ss += o0[i] * o0[i] + o1[i] * o1[i];
        ss += swap32(ss);
        const float rstd = rsqrtf(ss * (1.f / 64.f) + EPS);
        bfu* yrow = YC + tok * 1024 + 768 + h * 64;
        const float* og = (const float*)(ws + WS_SP) + l * SP_STRIDE + SP_HGO + h * 64;
#pragma unroll
        for (int vt = 0; vt < 2; ++vt)
#pragma unroll
            for (int g = 0; g < 4; ++g) {
                const int v0 = 32 * vt + 8 * g + 4 * hh;
                const u32x2 raw = graw[vt][g];
                const f32x4 gn = *(const f32x4*)(og + v0);
                f32x4 gg; gg[0] = siluf(bflo(raw[0])); gg[1] = siluf(bfhi(raw[0])); gg[2] = siluf(bflo(raw[1])); gg[3] = siluf(bfhi(raw[1]));
                f32x4 ov;
#pragma unroll
                for (int i = 0; i < 4; ++i) ov[i] = (vt == 0 ? o0[4 * g + i] : o1[4 * g + i]) * rstd * gn[i] * gg[i];
                *(u32x2*)(yrow + v0) = pack4(ov);
            }
    }
}

DI void ins16(float (&a)[16], float v) {
#pragma unroll
    for (int j = 15; j >= 1; --j) a[j] = __builtin_amdgcn_fmed3f(a[j - 1], a[j], v);
    a[0] = fmaxf(a[0], v);
}
DI void peer_topk_phase(const Params& p, int l, LAS char* smem, int wv) {
    int tid = mk_tid(wv); smem = opql(smem);
    const int w = tid >> 6, lane = tid & 63, r = lane & 31, hh = lane >> 5;
    unsigned char* ws = opq(p.ws);
    const bfu* PQ = (const bfu*)(ws + WS_PQ);
    const bfu* SK = (const bfu*)(ws + WS_W + (size_t)l * WL_SIZE + WL_SK);
    unsigned short* IDS = (unsigned short*)(ws + WS_IDS); float* GATE = (float*)(ws + WS_GATE);
    for (int u = blockIdx.x; u < T / 32; u += gridDim.x) {
        const size_t tok = (size_t)u * 32 + r;
        float lst[2][16];
        bf16x8 qf[2][4];
#pragma unroll
        for (int pp = 0; pp < 2; ++pp)
#pragma unroll
            for (int ks = 0; ks < 4; ++ks) qf[pp][ks] = *(const bf16x8*)(PQ + tok * 1024 + w * 128 + pp * 64 + 16 * ks + 8 * hh);
        const bfu* skb = SK + ((size_t)(w * 2) * 128 + r) * 64 + 8 * hh;
        bf16x8 af[2][4];
#pragma unroll
        for (int ks = 0; ks < 4; ++ks) af[0][ks] = *(const bf16x8*)(skb + 16 * ks);
        float a[16];
#pragma unroll
        for (int st = 0; st < 8; ++st) {
            const int pp = st >> 2, kt = st & 3;
            if (kt == 0) {
#pragma unroll
                for (int j = 0; j < 16; ++j) a[j] = -3.0e38f;
            }
            f32x16 acc = zero16();
#pragma unroll
            for (int ks = 0; ks < 4; ++ks) acc = mfma32(af[st & 1][ks], qf[pp][ks], acc);
            if (st < 7) {
                const int np = (st + 1) >> 2, nk = (st + 1) & 3;
#pragma unroll
                for (int ks = 0; ks < 4; ++ks) af[(st + 1) & 1][ks] = *(const bf16x8*)(skb + (size_t)np * 128 * 64 + (size_t)nk * 32 * 64 + 16 * ks);
            }
#pragma unroll
            for (int i = 0; i < 16; ++i) {
                const unsigned key = 32 * kt + (i & 3) + 8 * (i >> 2) + 4 * hh;
                ins16(a, __uint_as_float((__float_as_uint(acc[i]) & 0xffffff80u) | key));
            }
            if (kt == 3) {
                float ob[16];
#pragma unroll
                for (int j = 0; j < 16; ++j) ob[j] = swap32(a[j]);
#pragma unroll
                for (int j = 0; j < 16; ++j) ins16(a, ob[j]);
#pragma unroll
                for (int j = 0; j < 16; ++j) lst[pp][j] = a[j];
            }
        }
        float c[16];
#pragma unroll
        for (int j = 0; j < 16; ++j) c[j] = lst[0][0] + lst[1][j];
#pragma unroll
        for (int i = 1; i < 16; ++i)
#pragma unroll
            for (int j = 0; j < 16; ++j) if ((i + 1) * (j + 1) <= 16) ins16(c, lst[0][i] + lst[1][j]);
        const float thr = c[15], mx = c[0];
        float den = 0.f;
#pragma unroll
        for (int j = 0; j < 16; ++j) den += __expf(c[j] - mx);
        const float rden = 1.f / den;
        int cnt = 0;
        unsigned short* idp = IDS + tok * 128 + w * 16; float* gp = GATE + tok * 128 + w * 16;
        if (hh == 0) {
#pragma unroll
            for (int i = 0; i < 16; ++i)
#pragma unroll
                for (int j = 0; j < 16; ++j) if ((i + 1) * (j + 1) <= 16) {
                    const float s = lst[0][i] + lst[1][j];
                    if (s >= thr && cnt < 16) {
                        idp[cnt] = (unsigned short)((__float_as_uint(lst[0][i]) & 127u) * 128u + (__float_as_uint(lst[1][j]) & 127u));
                        gp[cnt] = __expf(s - mx) * rden;
                        ++cnt;
                    }
                }
            if (cnt < 16) {
#pragma unroll
                for (int k = 0; k < 16; ++k) if (k >= cnt) { idp[k] = 0; gp[k] = 0.f; }
            }
        }
    }
}

#ifndef PGQT
#define PGQT 512
#endif
constexpr int PGQ_TILE = PGQT, PGQ_ITEMS = T / PGQ_TILE;
constexpr int LDS_PGQ = 160 * 1024 - 64;
DI f32x2 fp8lo(unsigned w) { return __builtin_amdgcn_cvt_pk_f32_fp8(w, false); }
DI f32x2 fp8hi(unsigned w) { return __builtin_amdgcn_cvt_pk_f32_fp8(w, true); }
typedef _Float16 h2_t __attribute__((ext_vector_type(2)));
constexpr float PGV_CSCALE = 1024.f;
DI unsigned* pgq_counter(unsigned char* ws, int l, int ph, int slice) { return (unsigned*)(ws + WS_CTL + 16384) + ((l * 4 + ph) * 8 + slice) * 64; }
DI bool pgq_pop(unsigned char* ws, int l, int ph, int home, int& kdone, LAS int* bc, int tid, int& slice, int& tile) {
    __syncthreads();
    if (tid == 0) {
        int k = kdone, s = -1, ti = 0;
        while (k < 8) {
            s = (home + k) & 7;
            ti = (int)__hip_atomic_fetch_add(pgq_counter(ws, l, ph, s), 1u, __ATOMIC_RELAXED, __HIP_MEMORY_SCOPE_AGENT);
            if (ti < PGQ_ITEMS) break;
            ++k;
        }
        bc[0] = k < 8 ? s : -1; bc[1] = ti; bc[2] = k;
    }
    __syncthreads();
    slice = __builtin_amdgcn_readfirstlane(bc[0]); tile = __builtin_amdgcn_readfirstlane(bc[1]); kdone = __builtin_amdgcn_readfirstlane(bc[2]);
    return slice >= 0;
}
template <int CTRL> DI float dpp_perm(float v) { return __builtin_bit_cast(float, __builtin_amdgcn_update_dpp(0, __builtin_bit_cast(int, v), CTRL, 0xf, 0xf, false)); }
DI float sum8(float v) { v += dpp_perm<0xB1>(v); v += dpp_perm<0x4E>(v); v += dpp_perm<0x141>(v); return v; }

#ifndef PGVR
#define PGVR 16
#endif
constexpr int PGV_STRIDE = 129;
DI void peer_u_phase(const Params& p, int l, LAS char* smem, int wv, int qid = 0) {
    int tid = mk_tid(wv); smem = opql(smem);
    const int w = tid >> 6, lane = tid & 63, g = lane >> 3, j = lane & 7;
    unsigned char* ws = opq(p.ws);
    const bfu* XB = (const bfu*)(ws + WS_XB);
    const unsigned short* IDS = (const unsigned short*)(ws + WS_IDS);
    const GAS unsigned char* TU = (const GAS unsigned char*)(ws + WS_TABU + (size_t)l * NEXP * DM);
    const float* RSTF = (const float*)(ws + WS_RSTF);
    unsigned* PART = (unsigned*)(ws + WS_PROJ);
    const float* gn = (const float*)(ws + WS_SP) + l * SP_STRIDE + SP_NFF;
    LAS int* bc = (LAS int*)(smem + LDS_PGQ);
    LAS int* idl = (LAS int*)smem + w * (2 * 8 * PGV_STRIDE) + g * PGV_STRIDE;
    const int home = (int)xb_xcc_id() & 7;
    int kdone = 0, x, tile;
    while (pgq_pop(ws, l, qid, home, kdone, bc, tid, x, tile)) {
      u32x4 nids[2]; u32x2 nx[4]; float nrstd; f32x4 gv[4];
#define PGU_FETCH(tt) { _Pragma("unroll") for (int k = 0; k < 2; ++k) nids[k] = *(const u32x4*)(IDS + (size_t)(tt) * 128 + 16 * j + 8 * k); nrstd = RSTF[tt]; \
        _Pragma("unroll") for (int i = 0; i < 4; ++i) nx[i] = *(const u32x2*)(XB + (size_t)(tt) * DM + 32 * x + 4 * j + 256 * i); }
      PGU_FETCH(tile * PGQ_TILE + w * 8 + g)
#pragma unroll
      for (int i = 0; i < 4; ++i) gv[i] = *(const f32x4*)(gn + 256 * i + 32 * x + 4 * j);
      for (int sub = 0; sub < PGQ_TILE / 64; ++sub) {
        const int t = tile * PGQ_TILE + sub * 64 + w * 8 + g;
#pragma unroll
        for (int k = 0; k < 2; ++k)
#pragma unroll
            for (int c = 0; c < 4; ++c) { idl[16 * j + 8 * k + 2 * c] = (int)(nids[k][c] & 0xffffu); idl[16 * j + 8 * k + 2 * c + 1] = (int)(nids[k][c] >> 16); }
        const float rstd = nrstd;
        u32x2 xr[4];
#pragma unroll
        for (int i = 0; i < 4; ++i) xr[i] = nx[i];
        if (sub + 1 < PGQ_TILE / 64) PGU_FETCH(t + 64)
        f32x4 xf[4]; float am = 0.f;
#pragma unroll
        for (int i = 0; i < 4; ++i) { const u32x2 raw = xr[i];
            xf[i][0] = bflo(raw[0]) * rstd * gv[i][0]; xf[i][1] = bfhi(raw[0]) * rstd * gv[i][1]; xf[i][2] = bflo(raw[1]) * rstd * gv[i][2]; xf[i][3] = bfhi(raw[1]) * rstd * gv[i][3];
            am = fmaxf(am, fmaxf(fmaxf(fabsf(xf[i][0]), fabsf(xf[i][1])), fmaxf(fabsf(xf[i][2]), fabsf(xf[i][3])))); }
        am = fmaxf(am, dpp_perm<0xB1>(am)); am = fmaxf(am, dpp_perm<0x4E>(am)); am = fmaxf(am, dpp_perm<0x141>(am));
        const float qs = am > 0.f ? 127.f / am : 0.f, sx = am * (1.f / 127.f);
        unsigned xq[4];
#pragma unroll
        for (int i = 0; i < 4; ++i) xq[i] = pack_i8x4(xf[i][0] * qs, xf[i][1] * qs, xf[i][2] * qs, xf[i][3] * qs);
        const GAS unsigned char* tux = TU + (size_t)x * NEXP * 128;
        unsigned* prow = PART + ((size_t)x * T + t) * 64 + j;
        {
            u32x4 r[16];
#define PGU_ISSUE(k, e) { const unsigned off_ = (unsigned)idl[e] * 128u + 16u * (unsigned)j; r[k] = *(const GAS u32x4*)(tux + off_); }
#define PGU_DOT(k) { int di_ = 0; _Pragma("unroll") for (int i = 0; i < 4; ++i) di_ = __builtin_amdgcn_sdot4((int)r[k][i], (int)xq[i], di_, false); dk[(k) & 7] = di_; }
#define PGU_REDUCE(OUT) { int a_[4], b_[2]; \
                _Pragma("unroll") for (int m = 0; m < 4; ++m) { const int snd = lo4 ? dk[4 + m] : dk[m], kp = lo4 ? dk[m] : dk[4 + m]; a_[m] = kp + __builtin_amdgcn_update_dpp(0, snd, 0x141, 0xf, 0xf, false); } \
                _Pragma("unroll") for (int n = 0; n < 2; ++n) { const int snd = b2 ? a_[n] : a_[2 + n], kp = b2 ? a_[2 + n] : a_[n]; b_[n] = kp + __builtin_amdgcn_update_dpp(0, snd, 0x4E, 0xf, 0xf, false); } \
                { const int snd = b1 ? b_[0] : b_[1], kp = b1 ? b_[1] : b_[0]; OUT = (float)(kp + __builtin_amdgcn_update_dpp(0, snd, 0xB1, 0xf, 0xf, false)) * sx; } }
            const bool lo4 = j < 4, b2 = (j & 2) != 0, b1 = (j & 1) != 0;
            int dk[8];
#pragma unroll
            for (int k = 0; k < 16; ++k) PGU_ISSUE(k, k)
#pragma unroll 1
            for (int e0 = 0; e0 < 128; e0 += 16) {
                float p0, p1;
                if (e0 + 16 < 128) {
#pragma unroll
                    for (int k = 0; k < 8; ++k) { PGU_DOT(k) PGU_ISSUE(k, e0 + 16 + k) }
                    PGU_REDUCE(p0)
#pragma unroll
                    for (int k = 8; k < 16; ++k) { PGU_DOT(k) PGU_ISSUE(k, e0 + 16 + k) }
                    PGU_REDUCE(p1)
                } else {
#pragma unroll
                    for (int k = 0; k < 8; ++k) { PGU_DOT(k) }
                    PGU_REDUCE(p0)
#pragma unroll
                    for (int k = 8; k < 16; ++k) { PGU_DOT(k) }
                    PGU_REDUCE(p1)
                }
                { const h2_t hp = {(_Float16)p0, (_Float16)p1}; prow[e0 >> 1] = __builtin_bit_cast(unsigned, hp); }
            }
#undef PGU_DOT
#undef PGU_REDUCE
#undef PGU_ISSUE
        }
      }
    }
}
DI void peer_c_phase(const Params& p, int l, int wv) {
    int tid = mk_tid(wv);
    const int w = tid >> 6, lane = tid & 63;
    unsigned char* ws = opq(p.ws);
    const unsigned short* IDS = (const unsigned short*)(ws + WS_IDS); const float* GATE = (const float*)(ws + WS_GATE);
    const float* SCU = (const float*)(ws + WS_SCU) + l * NEXP; const float* SCV = (const float*)(ws + WS_SCV) + l * NEXP;
    const unsigned* PART = (const unsigned*)(ws + WS_PROJ); _Float16* COEF = (_Float16*)(ws + WS_COEF);
    for (int t0 = (blockIdx.x * 8 + w) * 4; t0 < T; t0 += gridDim.x * 8 * 4) {
        const int e0 = 16 * (lane >> 3) + (lane & 7);
        unsigned pr[4][8]; int id0[4], id1[4]; float g0[4], g1[4];
#pragma unroll
        for (int q = 0; q < 4; ++q) { const int t = t0 + q;
#pragma unroll
            for (int x = 0; x < 8; ++x) pr[q][x] = PART[((size_t)x * T + t) * 64 + lane];
            id0[q] = IDS[(size_t)t * 128 + e0]; id1[q] = IDS[(size_t)t * 128 + e0 + 8]; g0[q] = GATE[(size_t)t * 128 + e0]; g1[q] = GATE[(size_t)t * 128 + e0 + 8]; }
#pragma unroll
        for (int q = 0; q < 4; ++q) { const int t = t0 + q;
            f32x2 s = {0.f, 0.f};
#pragma unroll
            for (int x = 0; x < 8; ++x) { const h2_t hp = __builtin_bit_cast(h2_t, pr[q][x]); s.x += (float)hp.x; s.y += (float)hp.y; }
            COEF[(size_t)t * 128 + e0] = (_Float16)(geluf(s.x * SCU[id0[q]]) * g0[q] * SCV[id0[q]] * PGV_CSCALE);
            COEF[(size_t)t * 128 + e0 + 8] = (_Float16)(geluf(s.y * SCU[id1[q]]) * g1[q] * SCV[id1[q]] * PGV_CSCALE);
        }
    }
}

DI void peer_v_phase(const Params& p, int l, LAS char* smem, int wv, int qid = 1, bool dummy = false) {
    int tid = mk_tid(wv); smem = opql(smem);
    const int w = tid >> 6, lane = tid & 63, g = lane >> 3, j = lane & 7;
    unsigned char* ws = opq(p.ws);
    bfu* XB = (bfu*)(ws + WS_XB);
    bfu* XO = dummy ? (bfu*)(ws + WS_PQ) : XB;
    const unsigned short* IDS = (const unsigned short*)(ws + WS_IDS); const unsigned short* COEF = (const unsigned short*)(ws + WS_COEF);
    const GAS unsigned char* TV = (const GAS unsigned char*)(ws + WS_TABV + (size_t)l * NEXP * DM);
    float* SSP = dummy ? (float*)(ws + WS_GATE) : (float*)(ws + WS_SSP);
    LAS int* bc = (LAS int*)(smem + LDS_PGQ);
    LAS int* idl = (LAS int*)smem + w * (2 * 8 * PGV_STRIDE) + g * PGV_STRIDE;
    LAS float* cfl = (LAS float*)idl + 8 * PGV_STRIDE;
    const int home = (int)xb_xcc_id() & 7;
    int kdone = 0, x, tile;
    while (pgq_pop(ws, l, qid, home, kdone, bc, tid, x, tile)) {
      u32x4 nids[2], ncf[2]; u32x2 nx[4];
#define PGV_FETCH(tt) { _Pragma("unroll") for (int k = 0; k < 2; ++k) { nids[k] = *(const u32x4*)(IDS + (size_t)(tt) * 128 + 16 * j + 8 * k); ncf[k] = *(const u32x4*)(COEF + (size_t)(tt) * 128 + 16 * j + 8 * k); } \
        _Pragma("unroll") for (int i = 0; i < 4; ++i) nx[i] = *(const u32x2*)(XB + (size_t)(tt) * DM + 32 * x + 4 * j + 256 * i); }
      PGV_FETCH(tile * PGQ_TILE + w * 8 + g)
      for (int sub = 0; sub < PGQ_TILE / 64; ++sub) {
        const int t = tile * PGQ_TILE + sub * 64 + w * 8 + g;
#pragma unroll
        for (int k = 0; k < 2; ++k)
#pragma unroll
            for (int c = 0; c < 4; ++c) { const unsigned iw = nids[k][c], cw = ncf[k][c];
                idl[16 * j + 8 * k + 2 * c] = (int)(iw & 0xffffu); idl[16 * j + 8 * k + 2 * c + 1] = (int)(iw >> 16);
                cfl[16 * j + 8 * k + 2 * c] = __uint_as_float((cw & 0xffffu) | (cw << 16)); cfl[16 * j + 8 * k + 2 * c + 1] = __uint_as_float((cw >> 16) | (cw & 0xffff0000u)); }
        u32x2 xold[4];
#pragma unroll
        for (int i = 0; i < 4; ++i) xold[i] = nx[i];
        if (sub + 1 < PGQ_TILE / 64) PGV_FETCH(t + 64)
        h2_t acc[8];
#pragma unroll
        for (int c = 0; c < 8; ++c) acc[c] = (h2_t){(_Float16)0.f, (_Float16)0.f};
        const GAS unsigned char* tvx = TV + (size_t)x * NEXP * 128;
        {
            u32x4 r[PGVR]; float cf[PGVR];
#define PGV_ISSUE(k, e) { const unsigned off_ = (unsigned)idl[e] * 128u + 16u * (unsigned)j; cf[k] = cfl[e]; r[k] = *(const GAS u32x4*)(tvx + off_); }
#define PGV_USE(k) { const h2_t c2 = __builtin_bit_cast(h2_t, cf[k]); _Pragma("unroll") for (int i = 0; i < 4; ++i) { const unsigned wd = r[k][i]; \
                acc[2 * i] = __builtin_elementwise_fma(c2, __builtin_bit_cast(h2_t, __builtin_amdgcn_cvt_scalef32_pk_f16_fp8(wd, 1.0f, false)), acc[2 * i]); \
                acc[2 * i + 1] = __builtin_elementwise_fma(c2, __builtin_bit_cast(h2_t, __builtin_amdgcn_cvt_scalef32_pk_f16_fp8(wd, 1.0f, true)), acc[2 * i + 1]); } }
#pragma unroll
            for (int k = 0; k < PGVR; ++k) PGV_ISSUE(k, k)
            for (int e0 = PGVR; e0 < 128; e0 += PGVR) {
#pragma unroll
                for (int k = 0; k < PGVR; ++k) { PGV_USE(k) PGV_ISSUE(k, e0 + k) }
            }
#pragma unroll
            for (int k = 0; k < PGVR; ++k) PGV_USE(k)
#undef PGV_ISSUE
#undef PGV_USE
#undef PGV_FETCH
        }
        bfu* xrow = XO + (size_t)t * DM + 32 * x + 4 * j;
        float s2 = 0.f;
#pragma unroll
        for (int i = 0; i < 4; ++i) {
            u32x2* px = (u32x2*)(xrow + 256 * i); const u32x2 old = xold[i];
            const float us = 1.f / PGV_CSCALE;
            const float y0 = bflo(old[0]) + (float)acc[2 * i].x * us, y1 = bfhi(old[0]) + (float)acc[2 * i].y * us, y2 = bflo(old[1]) + (float)acc[2 * i + 1].x * us, y3 = bfhi(old[1]) + (float)acc[2 * i + 1].y * us;
            u32x2 o; o[0] = pk2(y0, y1); o[1] = pk2(y2, y3); *px = o;
            const float z0 = bflo(o[0]), z1 = bfhi(o[0]), z2 = bflo(o[1]), z3 = bfhi(o[1]);
            s2 += z0 * z0 + z1 * z1 + z2 * z2 + z3 * z3;
        }
        s2 = sum8(s2);
        if (j == 0) SSP[(size_t)t * 8 + x] = s2;
      }
    }
}

DI void final_norm_phase(const Params& p, int wv) {
    int tid = mk_tid(wv);
    const int w = tid >> 6, lane = tid & 63;
    unsigned char* ws = opq(p.ws);
    const bfu* XB = (const bfu*)(ws + WS_XB); const float* SSP = (const float*)(ws + WS_SSP);
    const float* gfin = (const float*)(ws + WS_SP) + SP_FIN;
    f32x4 g[4];
#pragma unroll
    for (int i = 0; i < 4; ++i) g[i] = *(const f32x4*)(gfin + 256 * i + 4 * lane);
    for (int t0 = (blockIdx.x * 8 + w) * 4; t0 < T; t0 += gridDim.x * 8 * 4) {
        f32x4 q0[4], q1[4]; u32x2 raw[4][4];
#pragma unroll
        for (int q = 0; q < 4; ++q) { const int t = t0 + q; q0[q] = *(const f32x4*)(SSP + (size_t)t * 8); q1[q] = *(const f32x4*)(SSP + (size_t)t * 8 + 4);
#pragma unroll
            for (int i = 0; i < 4; ++i) raw[q][i] = *(const u32x2*)(XB + (size_t)t * DM + 256 * i + 4 * lane); }
#pragma unroll
        for (int q = 0; q < 4; ++q) { const int t = t0 + q;
            const float r2 = rsqrtf((((q0[q][0] + q0[q][1]) + (q0[q][2] + q0[q][3])) + ((q1[q][0] + q1[q][1]) + (q1[q][2] + q1[q][3]))) * (1.f / DM) + EPS);
            float* orow = p.out + (size_t)t * DM;
#pragma unroll
            for (int i = 0; i < 4; ++i) {
                f32x4 o; o[0] = bflo(raw[q][i][0]) * r2 * g[i][0]; o[1] = bfhi(raw[q][i][0]) * r2 * g[i][1]; o[2] = bflo(raw[q][i][1]) * r2 * g[i][2]; o[3] = bfhi(raw[q][i][1]) * r2 * g[i][3];
                *(f32x4*)(orow + 256 * i + 4 * lane) = o; }
        }
    }
}

constexpr int PPL = 10, NPH = 2 + PPL * NL;
__global__ void __launch_bounds__(512, 2) hymba_fwd(Params p) {
    extern __shared__ __attribute__((aligned(16))) char smem_raw[];
    LAS char* smem0 = (LAS char*)smem_raw;
    const int wv = __builtin_amdgcn_readfirstlane((int)(threadIdx.x >> 6));
    if (mk_tid(wv) < 4) ((LAS unsigned*)(smem0 + LDS_BAR))[mk_tid(wv)] = 0u;
    __syncthreads();
    XcdBarrier bar = xcd_barrier_post((unsigned*)(p.ws + WS_CTL), (volatile LAS unsigned*)(smem0 + LDS_BAR), wv);
#define IN(k) true
#ifdef REP_BAR
#define SEAM(k) do { xcd_barrier(bar); xcd_barrier(bar); } while (0)
#else
#define SEAM(k) xcd_barrier(bar)
#endif
#define PHASE_HDR const int G = opqi((int)gridDim.x), bid = opqi((int)blockIdx.x); LAS char* smem = opql(smem0); LAS unsigned char* smemu = (LAS unsigned char*)smem; unsigned char* ws = opq(p.ws); \
        const unsigned char* wl = ws + WS_W + (size_t)l * WL_SIZE; const float* ct = (const float*)(ws + WS_COS); const float* st = (const float*)(ws + WS_SIN); (void)wl; (void)ct; (void)st; (void)G; (void)bid; (void)smemu;
    if (IN(0)) { phase_prologue(p, smem0, wv);
#ifdef REP_PRO
        __syncthreads(); phase_prologue(p, smem0, wv);
#endif
    }
    SEAM(0);
#pragma unroll 1
    for (int l_ = 0; l_ < NL; ++l_) {
        const int l = opqi(l_);
        const int pb = 1 + PPL * l; (void)pb;
        if (IN(pb + 0)) {
            PHASE_HDR
            EpiProj e{(const float*)(ws + WS_SSP), (bfu*)(ws + WS_PROJ), ct, st};
            XSched s{8, 128 * 8, G, bid, wv};
            gemm_phase(smemu, Gemm{(const bfu*)(ws + WS_XB), (const bfu*)(wl + WL_IN), 1024, 1024, 1024}, s, e);
#ifdef REP_G1
            __syncthreads(); gemm_phase(smemu, Gemm{(const bfu*)(ws + WS_XB), (const bfu*)(wl + WL_IN), 1024, 1024, 1024}, s, e);
#endif
        }
        SEAM(pb + 0);
        if (IN(pb + 1)) {
            PHASE_HDR
#ifdef REP_G2
            for (int rep = 0; rep < 2; ++rep)
#endif
            {
            {
                XSched s{3, 128 * 3, G, bid, wv};
                Unit u; __syncthreads();
                for (int i = 0; s.next(i, u); ++i) rows_rstd_lds<256>((const bfu*)(ws + WS_PROJ) + PC_CQ, PW, u.pm * 256, (LAS float*)(smem + LDS_RS) + i * 256, wv);
                __syncthreads();
#ifdef REP_G2A
                for (int i = 0; s.next(i, u); ++i) rows_rstd_lds<256>((const bfu*)(ws + WS_PROJ) + PC_CQ, PW, u.pm * 256, (LAS float*)(smem + LDS_RS) + i * 256, wv);
                __syncthreads();
#endif
                EpiScaled<true> e{(const LAS float*)(smem + LDS_RS), (bfu*)(ws + WS_Q), 768, ct, st, 0.10206207261596577f * 1.4426950408889634f};
                gemm_phase(smemu, Gemm{(const bfu*)(ws + WS_PROJ) + PC_CQ, (const bfu*)(wl + WL_UQ), PW, 256, 256}, s, e);
#ifdef REP_G2Q
                __syncthreads(); gemm_phase(smemu, Gemm{(const bfu*)(ws + WS_PROJ) + PC_CQ, (const bfu*)(wl + WL_UQ), PW, 256, 256}, s, e);
#endif
            }
            {
                XSched s{4, 128 * 4, G, (bid + 128) % G, wv};
                Unit u; __syncthreads();
                for (int i = 0; s.next(i, u); ++i) rows_rstd_lds<128>((const bfu*)(ws + WS_PROJ) + PC_CKV, PW, u.pm * 256, (LAS float*)(smem + LDS_RS) + i * 256, wv);
                __syncthreads();
#ifdef REP_G2A
                for (int i = 0; s.next(i, u); ++i) rows_rstd_lds<128>((const bfu*)(ws + WS_PROJ) + PC_CKV, PW, u.pm * 256, (LAS float*)(smem + LDS_RS) + i * 256, wv);
                __syncthreads();
#endif
                EpiScaled<false> e{(const LAS float*)(smem + LDS_RS), (bfu*)(ws + WS_KV), 1024, ct, st, 1.f};
                gemm_phase(smemu, Gemm{(const bfu*)(ws + WS_PROJ) + PC_CKV, (const bfu*)(wl + WL_UKV), PW, 256, 256}, s, e);
#ifdef REP_G2K
                __syncthreads(); gemm_phase(smemu, Gemm{(const bfu*)(ws + WS_PROJ) + PC_CKV, (const bfu*)(wl + WL_UKV), PW, 256, 256}, s, e);
#endif
            }
            }
            gmlp_phase(p, l, smem0, wv);
#ifdef REP_GM
            gmlp_phase(p, l, smem0, wv);
#endif
            hg_local_phase(p, l, smem0, wv);
#ifdef REP_H1
            hg_local_phase(p, l, smem0, wv);
#endif
        }
        SEAM(pb + 1);
        if (IN(pb + 2)) { attn_phase(p, l, smem0, wv);
#ifdef REP_ATT
            attn_phase(p, l, smem0, wv);
#endif
            hg_prefix_phase(p, wv); }
        SEAM(pb + 2);
        if (IN(pb + 3)) { hg_out_phase(p, l, smem0, wv);
#ifdef REP_H3
            hg_out_phase(p, l, smem0, wv);
#endif
        }
        SEAM(pb + 3);
        if (IN(pb + 4)) {
            PHASE_HDR
#ifdef REP_G3
            EpiResid e{(bfu*)(ws + WS_XB), (bfu*)(ws + WS_XB)};
            XSched s{4, 128 * 4, G, bid, wv};
            __syncthreads();
            { EpiResid e2{(bfu*)(ws + WS_XB), (bfu*)(ws + WS_PQ)}; gemm_phase(smemu, Gemm{(const bfu*)(ws + WS_YCAT), (const bfu*)(wl + WL_OUT), 1024, 1024, 1024}, s, e2); __syncthreads(); }
#else
            EpiResid e{(bfu*)(ws + WS_XB)};
            XSched s{4, 128 * 4, G, bid, wv};
            __syncthreads();
#endif
            gemm_phase(smemu, Gemm{(const bfu*)(ws + WS_YCAT), (const bfu*)(wl + WL_OUT), 1024, 1024, 1024}, s, e);
        }
        SEAM(pb + 4);
        if (IN(pb + 5)) {
            PHASE_HDR
            XSched s{4, 128 * 4, G, bid, wv};
            Unit u; __syncthreads();
            for (int i = 0; s.next(i, u); ++i) rows_rstd_lds<1024>((const bfu*)(ws + WS_XB), DM, u.pm * 256, (LAS float*)(smem + LDS_RS) + i * 256, wv, (float*)(ws + WS_RSTF));
            __syncthreads();
            EpiScaled<false> e{(const LAS float*)(smem + LDS_RS), (bfu*)(ws + WS_PQ), 1024, ct, st, 1.f};
            gemm_phase(smemu, Gemm{(const bfu*)(ws + WS_XB), (const bfu*)(wl + WL_Q), 1024, 1024, 1024}, s, e);
#ifdef REP_G4
            __syncthreads(); gemm_phase(smemu, Gemm{(const bfu*)(ws + WS_XB), (const bfu*)(wl + WL_Q), 1024, 1024, 1024}, s, e);
#endif
        }
        SEAM(pb + 5);
        if (IN(pb + 6)) { peer_topk_phase(p, l, smem0, wv);
#ifdef REP_PK
            peer_topk_phase(p, l, smem0, wv);
#endif
        }
        SEAM(pb + 6);
        if (IN(pb + 7)) { peer_u_phase(p, l, smem0, wv);
#ifdef REP_PU
            __syncthreads(); peer_u_phase(p, l, smem0, wv, 2);
#endif
        }
        SEAM(pb + 7);
        if (IN(pb + 8)) { peer_c_phase(p, l, wv);
#ifdef REP_PC
            peer_c_phase(p, l, wv);
#endif
        }
        SEAM(pb + 8);
        if (IN(pb + 9)) {
#ifdef REP_PV
            peer_v_phase(p, l, smem0, wv, 3, true); __syncthreads();
#endif
            peer_v_phase(p, l, smem0, wv); }
        SEAM(pb + 9);
    }
    if (IN(NPH - 1)) { final_norm_phase(p, wv);
#ifdef REP_FIN
        final_norm_phase(p, wv);
#endif
    }
#undef PHASE_HDR
#undef IN
#undef SEAM
}

extern "C" void kernel_launch(void* const* d_in, const int* in_sizes, int n_in, void* d_out, int out_size, void* d_ws, size_t ws_size, hipStream_t stream) {
    static int grid = 0;
    if (grid == 0) {
        if (n_in != 22 || in_sizes[0] != T * DM || out_size != T * DM || ws_size < WS_END) {
            fprintf(stderr, "kernel_launch: unexpected shapes (n_in %d, in0 %d, out %d, ws %zu, need %zu)\n", n_in, n_in > 0 ? in_sizes[0] : -1, out_size, ws_size, (size_t)WS_END); grid = -1; return; }
        int dev = 0, cus = 0, per_cu = 0;
        if (hipGetDevice(&dev) != hipSuccess || hipDeviceGetAttribute(&cus, hipDeviceAttributeMultiprocessorCount, dev) != hipSuccess) { grid = -1; return; }
        if (hipFuncSetAttribute((const void*)hymba_fwd, hipFuncAttributeMaxDynamicSharedMemorySize, LDS_TOTAL) != hipSuccess) { fprintf(stderr, "kernel_launch: hipFuncSetAttribute failed\n"); grid = -1; return; }
        if (hipOccupancyMaxActiveBlocksPerMultiprocessor(&per_cu, (const void*)hymba_fwd, 512, LDS_TOTAL) != hipSuccess || per_cu < 1) fprintf(stderr, "kernel_launch: occupancy query says %d\n", per_cu);
        (void)hipGetLastError();
        grid = cus;
    }
    if (grid < 0) return;
    (void)hipMemsetAsync((char*)d_ws + WS_CTL, 0, 65536, stream);
    Params p{};
    p.x = (const float*)d_in[0]; p.pos = (const int*)d_in[1]; p.norm_mix = (const float*)d_in[2]; p.w_in = (const float*)d_in[3]; p.gm_v_norm = (const float*)d_in[4];
    p.gm_ws = (const float*)d_in[5]; p.gm_b = (const float*)d_in[6]; p.gm_out_norm = (const float*)d_in[7]; p.mla_q_norm = (const float*)d_in[8]; p.mla_w_uq = (const float*)d_in[9];
    p.mla_kv_norm = (const float*)d_in[10]; p.mla_w_ukv = (const float*)d_in[11]; p.mla_out_norm = (const float*)d_in[12]; p.hg_lb_logits = (const float*)d_in[13];
    p.hg_out_norm = (const float*)d_in[14]; p.w_out = (const float*)d_in[15]; p.norm_ffn = (const float*)d_in[16]; p.peer_w_q = (const float*)d_in[17];
    p.peer_sub_keys = (const float*)d_in[18]; p.peer_u = (const float*)d_in[19]; p.peer_v = (const float*)d_in[20]; p.norm_final = (const float*)d_in[21];
    p.out = (float*)d_out; p.ws = (unsigned char*)d_ws;
    hipLaunchKernelGGL(hymba_fwd, dim3(grid), dim3(512), LDS_TOTAL, stream, p);
}
```

```cpp
#include <hip/hip_runtime.h>
#include <cstdio>
#include <cstdint>
#include <cmath>
#include <type_traits>

constexpr int T = 32768, DM = 1024, NL = 4, SEQ = 2048;
constexpr int PW = 2048;
constexpr int PC_U = 0, PC_V = 256, PC_CQ = 512, PC_CKV = 768, PC_KR = 896, PC_HQ = 1024, PC_HF = 1280, PC_HI = 1536, PC_HG = 1792;
constexpr int NEXP = 16384;
constexpr float EPS = 1e-6f;

typedef unsigned short bfu;
typedef __attribute__((ext_vector_type(8))) short bf16x8;
typedef __attribute__((ext_vector_type(4))) short s16x4;
typedef __attribute__((ext_vector_type(4))) float f32x4;
typedef __attribute__((ext_vector_type(16))) float f32x16;
typedef __attribute__((ext_vector_type(2))) __bf16 bf2_t;
typedef __attribute__((ext_vector_type(2))) float f2_t;
typedef __attribute__((ext_vector_type(4))) unsigned u32x4;
typedef __attribute__((ext_vector_type(2))) unsigned u32x2;
typedef short v4i16_t __attribute__((ext_vector_type(4)));
#define DI __device__ __forceinline__
#define LAS __attribute__((address_space(3)))
#define GAS __attribute__((address_space(1)))

DI float bf2f(bfu v) { return __uint_as_float((unsigned)v << 16); }
DI float bflo(unsigned u) { return __uint_as_float(u << 16); }
DI float bfhi(unsigned u) { return __uint_as_float(u & 0xffff0000u); }
DI unsigned pk2(float a, float b) { f2_t v = {a, b}; bf2_t r = __builtin_convertvector(v, bf2_t); return __builtin_bit_cast(unsigned, r); }
DI bfu f2bf(float a) { return (bfu)(pk2(a, 0.f) & 0xffffu); }
DI f32x16 mfma32(bf16x8 a, bf16x8 b, f32x16 c) { return __builtin_amdgcn_mfma_f32_32x32x16_bf16(a, b, c, 0, 0, 0); }
DI int crow(int r, int hi) { return (r & 3) + 8 * (r >> 2) + 4 * hi; }
DI f32x16 zero16() { f32x16 z; for (int i = 0; i < 16; ++i) z[i] = 0.f; return z; }
DI bf16x8 pack8(const f32x16& x, int s) {
    u32x4 p; p[0] = pk2(x[8 * s], x[8 * s + 1]); p[1] = pk2(x[8 * s + 2], x[8 * s + 3]); p[2] = pk2(x[8 * s + 4], x[8 * s + 5]); p[3] = pk2(x[8 * s + 6], x[8 * s + 7]);
    return __builtin_bit_cast(bf16x8, p);
}
DI float swap32(float v) { return __shfl_xor(v, 32); }
DI float wave_sum(float v) {
    v += __shfl_xor(v, 1); v += __shfl_xor(v, 2); v += __shfl_xor(v, 4); v += __shfl_xor(v, 8); v += __shfl_xor(v, 16); v += __shfl_xor(v, 32); return v;
}
DI float sum16(float v) { v += __shfl_xor(v, 1); v += __shfl_xor(v, 2); v += __shfl_xor(v, 4); v += __shfl_xor(v, 8); return v; }
DI float fast_exp(float x) { return __expf(x); }
DI float sigmoidf(float x) { return 1.f / (1.f + __expf(-x)); }
DI float geluf(float x) { const float u = 1.5957691216057308f * (x + 0.044715f * x * x * x); return x / (1.f + __expf(-u)); }
DI float siluf(float x) { return x / (1.f + __expf(-x)); }
DI s16x4 ldtr(const LAS char* p) { return __builtin_bit_cast(s16x4, __builtin_amdgcn_ds_read_tr16_b64_v4i16((LAS v4i16_t*)p)); }
DI bf16x8 cat4(s16x4 a, s16x4 b) { return __builtin_shufflevector(a, b, 0, 1, 2, 3, 4, 5, 6, 7); }
DI int mk_tid(int wv) { int ln; asm volatile("v_mbcnt_lo_u32_b32 %0, -1, 0\n\tv_mbcnt_hi_u32_b32 %0, -1, %0" : "=v"(ln)); return wv * 64 + ln; }
DI unsigned char* opq(unsigned char* q) { GAS unsigned char* g = (GAS unsigned char*)q; asm volatile("" : "+s"(g)); return (unsigned char*)g; }
DI LAS char* opql(LAS char* q) { unsigned v = (unsigned)(size_t)q; asm volatile("" : "+s"(v)); return (LAS char*)(size_t)v; }
DI int opqi(int v) { asm volatile("" : "+s"(v)); return v; }
DI f32x4 zero4_opaque() { float z; asm volatile("v_mov_b32 %0, 0" : "=v"(z)); return (f32x4){z, z, z, z}; }
DI float dot2u(unsigned a, unsigned b, float c) { return __builtin_amdgcn_fdot2_f32_bf16(__builtin_bit_cast(bf2_t, a), __builtin_bit_cast(bf2_t, b), c, false); }
typedef __attribute__((ext_vector_type(2))) float f32x2;
template <int CTRL, int ROWMASK> DI float dpp_get(float v) { return __builtin_bit_cast(float, __builtin_amdgcn_update_dpp(0, __builtin_bit_cast(int, v), CTRL, ROWMASK, 0xf, false)); }
DI float dpp_sum63(float v) {
    v += dpp_get<0x111, 0xf>(v); v += dpp_get<0x112, 0xf>(v); v += dpp_get<0x114, 0xf>(v); v += dpp_get<0x118, 0xf>(v);
    v += dpp_get<0x142, 0xa>(v); v += dpp_get<0x143, 0xc>(v); return v;
}
DI float dpp_max63(float v) {
    v = fmaxf(v, dpp_get<0x111, 0xf>(v)); v = fmaxf(v, dpp_get<0x112, 0xf>(v)); v = fmaxf(v, dpp_get<0x114, 0xf>(v)); v = fmaxf(v, dpp_get<0x118, 0xf>(v));
    v = fmaxf(v, dpp_get<0x142, 0xa>(v)); v = fmaxf(v, dpp_get<0x143, 0xc>(v)); return v;
}
DI float rdlane_f(float v, int l) { return __builtin_bit_cast(float, __builtin_amdgcn_readlane(__builtin_bit_cast(int, v), l)); }
DI unsigned pack_i8x4(float a, float b, float c, float d) {
    const int q0 = (int)__builtin_rintf(fminf(fmaxf(a, -127.f), 127.f)), q1 = (int)__builtin_rintf(fminf(fmaxf(b, -127.f), 127.f));
    const int q2 = (int)__builtin_rintf(fminf(fmaxf(c, -127.f), 127.f)), q3 = (int)__builtin_rintf(fminf(fmaxf(d, -127.f), 127.f));
    return (unsigned)(q0 & 0xff) | ((unsigned)(q1 & 0xff) << 8) | ((unsigned)(q2 & 0xff) << 16) | ((unsigned)(q3 & 0xff) << 24);
}

constexpr size_t WS_CTL   = 0;
constexpr size_t WS_XB    = 65536;
constexpr size_t WS_PROJ  = WS_XB   + (size_t)T * DM * 2;
constexpr size_t WS_Q     = WS_PROJ + (size_t)T * PW * 2;
constexpr size_t WS_KV    = WS_Q    + (size_t)T * 768 * 2;
constexpr size_t WS_YCAT  = WS_KV   + (size_t)T * 1024 * 2;
constexpr size_t WS_PQ    = WS_YCAT + (size_t)T * 1024 * 2;
constexpr size_t WS_IDS   = WS_PQ   + (size_t)T * 1024 * 2;
constexpr size_t WS_GATE  = WS_IDS  + (size_t)T * 128 * 4;
constexpr size_t WS_HST   = WS_GATE + (size_t)T * 128 * 4;
constexpr size_t WS_HDEC  = WS_HST  + (size_t)2048 * 4096 * 4;
constexpr size_t WS_COS   = WS_HDEC + (size_t)512 * 256 * 4;
constexpr size_t WS_SIN   = WS_COS  + (size_t)T * 16 * 4;
constexpr size_t WS_SSP   = WS_SIN  + (size_t)T * 16 * 4;
constexpr size_t WS_RSTF  = WS_SSP  + (size_t)T * 8 * 4;
constexpr size_t WS_COEF  = WS_RSTF + (size_t)T * 4;
constexpr size_t WS_LB    = WS_COEF + (size_t)T * 128 * 4;
constexpr size_t WS_SP    = WS_LB   + 4096;
constexpr int SP_GMV = 0, SP_GMB = 256, SP_GMO = 768, SP_MLO = 1024, SP_HGO = 1536, SP_NFF = 1792, SP_STRIDE = 3072, SP_FIN = NL * SP_STRIDE;
constexpr size_t WS_W     = WS_SP   + (size_t)(SP_FIN + 1024) * 4;
constexpr size_t WL_IN    = 0;
constexpr size_t WL_UQ    = WL_IN  + (size_t)2048 * 1024 * 2;
constexpr size_t WL_UKV   = WL_UQ  + (size_t)768 * 256 * 2;
constexpr size_t WL_OUT   = WL_UKV + (size_t)1024 * 256 * 2;
constexpr size_t WL_Q     = WL_OUT + (size_t)1024 * 1024 * 2;
constexpr size_t WL_SK    = WL_Q   + (size_t)1024 * 1024 * 2;
constexpr size_t WL_GM    = WL_SK  + (size_t)16 * 128 * 64 * 2;
constexpr size_t WL_SIZE  = WL_GM  + (size_t)4 * 128 * 128 * 2;
constexpr size_t WS_TABU  = WS_W + NL * WL_SIZE;
constexpr size_t WS_TABV  = WS_TABU + (size_t)NL * NEXP * DM;
constexpr size_t WS_SCU   = WS_TABV + (size_t)NL * NEXP * DM;
constexpr size_t WS_SCV   = WS_SCU  + (size_t)NL * NEXP * 4;
constexpr size_t WS_END   = WS_SCV  + (size_t)NL * NEXP * 4;

struct Params {
    const float* x; const int* pos; const float* norm_mix; const float* w_in; const float* gm_v_norm; const float* gm_ws; const float* gm_b; const float* gm_out_norm;
    const float* mla_q_norm; const float* mla_w_uq; const float* mla_kv_norm; const float* mla_w_ukv; const float* mla_out_norm; const float* hg_lb_logits; const float* hg_out_norm;
    const float* w_out; const float* norm_ffn; const float* peer_w_q; const float* peer_sub_keys; const float* peer_u; const float* peer_v; const float* norm_final;
    float* out; unsigned char* ws;
};

#define XB_TMO      128
#define XB_XCNT(j)  (256  + 64 * (j))
#define XB_XSUB(j)  (1280 + 64 * (j))
#define XB_XGEN(j)  (2304 + 64 * (j))
#define XB_TOP      3328
#define XB_TOPGEN   3392
#define XCD_BAR_WORDS 3456
#define XB_SPIN_CAP (1u << 20)
DI unsigned xb_ld(unsigned* p)              { return __hip_atomic_load(p, __ATOMIC_RELAXED, __HIP_MEMORY_SCOPE_AGENT); }
DI unsigned xb_add(unsigned* p, unsigned v) { return __hip_atomic_fetch_add(p, v, __ATOMIC_RELAXED, __HIP_MEMORY_SCOPE_AGENT); }
DI unsigned xb_xcc_id() { return (unsigned)__builtin_amdgcn_s_getreg((3 << 11) | 20) & 0xFu; }
#define XB_SPIN(cond, bar) do { unsigned _sp = 0; while (cond) { __builtin_amdgcn_s_sleep(1); \
    if ((++_sp & 255u) == 0u) { if (xb_ld(&(bar)[XB_TMO])) break; if (_sp > XB_SPIN_CAP) { atomicAdd(&(bar)[XB_TMO], 1u); break; } } } } while (0)
struct XcdBarrier { unsigned* bar; unsigned x; volatile LAS unsigned* st; int wv; };
DI XcdBarrier xcd_barrier_post(unsigned* bar, volatile LAS unsigned* st, int wv) {
    XcdBarrier b; b.bar = bar; b.x = xb_xcc_id(); b.st = st; b.wv = wv;
    if (mk_tid(wv) == 0) (void)xb_add(&bar[XB_XCNT(b.x)], 1u);
    return b;
}
DI void xcd_barrier_complete(unsigned* bar, unsigned x, unsigned& nloc, unsigned& nx) {
    const unsigned G = gridDim.x * gridDim.y * gridDim.z;
    unsigned sum, cnt, mine, sp = 0u;
    for (;;) {
        sum = 0u; cnt = 0u; mine = 0u;
#pragma unroll
        for (unsigned j = 0; j < 16; ++j) { const unsigned c = xb_ld(&bar[XB_XCNT(j)]); sum += c; cnt += (c > 0u) ? 1u : 0u; }
        if (sum == G) { mine = xb_ld(&bar[XB_XCNT(x)]); break; }
        __builtin_amdgcn_s_sleep(1);
        if ((++sp & 255u) == 0u) { if (xb_ld(&bar[XB_TMO])) break; if (sp > XB_SPIN_CAP) { atomicAdd(&bar[XB_TMO], 1u); break; } }
    }
    nloc = mine > 0u ? mine : 1u; nx = cnt > 0u ? cnt : 1u;
}
DI void xcd_barrier(const XcdBarrier& b) {
    asm volatile("s_waitcnt vmcnt(0)" ::: "memory");
    __syncthreads();
    if (mk_tid(b.wv) == 0) {
        unsigned* bar = b.bar; unsigned bx = b.x;
        asm volatile("" : "+s"(bar), "+s"(bx));
        __builtin_amdgcn_s_waitcnt(0);
        unsigned nloc = b.st[0], nx = b.st[1];
        if (nloc == 0u) { xcd_barrier_complete(bar, bx, nloc, nx); b.st[0] = nloc; b.st[1] = nx; }
        const unsigned old = xb_add(&bar[XB_XSUB(bx)], 1u);
        const unsigned gen = old / nloc;
        if (old + 1u == (gen + 1u) * nloc) {
            __builtin_amdgcn_fence(__ATOMIC_RELEASE, "agent");
            asm volatile("s_waitcnt vmcnt(0)" ::: "memory");
            const unsigned og = xb_add(&bar[XB_TOP], 1u);
            const unsigned tg = og / nx;
            if (og + 1u == (tg + 1u) * nx) xb_add(&bar[XB_TOPGEN], 1u);
            else XB_SPIN(xb_ld(&bar[XB_TOPGEN]) == tg, bar);
            __builtin_amdgcn_fence(__ATOMIC_ACQUIRE, "agent");
            xb_add(&bar[XB_XGEN(bx)], 1u);
            asm volatile("s_waitcnt vmcnt(0)" ::: "memory");
        } else {
            XB_SPIN(xb_ld(&bar[XB_XGEN(bx)]) == gen, bar);
            __builtin_amdgcn_fence(__ATOMIC_ACQUIRE, "agent");
            asm volatile("s_waitcnt vmcnt(0)" ::: "memory");
        }
    }
    __syncthreads();
}

template <int MODE>
DI int srccol(int n) {
    if (MODE == 1) { return n < 928 ? n : (n < 1024 ? -1 : n - 96); }
    if (MODE == 2) { return n < 512 ? ((n >> 6) * 128 + (n & 63)) : (((n - 512) >> 6) * 128 + 64 + ((n - 512) & 63)); }
    return n;
}
template <int MODE>
DI void conv_tile(int t, const float* __restrict__ src, int ld_src, const float* __restrict__ gain, bfu* __restrict__ dst, int K, int n0, int k0, float* tile, int ksrc = 1 << 30) {
    float ld[8];
#pragma unroll
    for (int i = 0; i < 8; ++i) {
        const int kk = (t >> 6) + i * 8, nn = t & 63;
        const int sc = srccol<MODE>(n0 + nn);
        const int kr = k0 + kk < ksrc ? k0 + kk : 0;
        ld[i] = src[(size_t)kr * ld_src + (sc >= 0 ? sc : 0)] * (gain ? gain[kr] : 1.f);
    }
#pragma unroll
    for (int i = 0; i < 8; ++i) {
        const int kk = (t >> 6) + i * 8, nn = t & 63;
        const int sc = srccol<MODE>(n0 + nn);
        tile[kk * 65 + nn] = (sc >= 0 && k0 + kk < ksrc) ? ld[i] : 0.f;
    }
    __syncthreads();
#pragma unroll
    for (int i = 0; i < 8; ++i) {
        const int nn = (t >> 6) + i * 8, kk = t & 63;
        dst[(size_t)(n0 + nn) * K + k0 + kk] = f2bf(tile[kk * 65 + nn]);
    }
    __syncthreads();
}

DI void phase_prologue(const Params& p, LAS char* smem, int wv) {
    const int tid = mk_tid(wv), bid = blockIdx.x, nb = gridDim.x; smem = opql(smem);
    const int w = tid >> 6, lane = tid & 63;
    unsigned char* ws = opq(p.ws);
    {
        bfu* xb = (bfu*)(ws + WS_XB); float* ssp = (float*)(ws + WS_SSP);
        for (int t0 = (bid * 8 + w) * 4; t0 < T; t0 += nb * 8 * 4) {
            float4 xv[4][4];
#pragma unroll
            for (int q = 0; q < 4; ++q)
#pragma unroll
                for (int i = 0; i < 4; ++i) xv[q][i] = ((const float4*)(p.x + (size_t)(t0 + q) * DM))[i * 64 + lane];
#pragma unroll
            for (int q = 0; q < 4; ++q) { const int t = t0 + q;
                float ss = 0.f;
#pragma unroll
                for (int i = 0; i < 4; ++i) {
                    const float4 v = xv[q][i];
                    ss += v.x * v.x + v.y * v.y + v.z * v.z + v.w * v.w;
                    u32x2 o; o[0] = pk2(v.x, v.y); o[1] = pk2(v.z, v.w);
                    *(u32x2*)(xb + (size_t)t * DM + (i * 64 + lane) * 4) = o;
                }
                ss = wave_sum(ss);
                if (lane < 8) ssp[(size_t)t * 8 + lane] = lane == 0 ? ss : 0.f;
            }
        }
    }
    {
        float* tile = (float*)smem;
        for (int u = bid; u < NL * 1136; u += nb) {
            const int l = u / 1136; int r = u % 1136;
            unsigned char* wl = ws + WS_W + (size_t)l * WL_SIZE;
            if (r < 512) { conv_tile<1>(tid, p.w_in + (size_t)l * 1024 * 1952, 1952, p.norm_mix + l * 1024, (bfu*)(wl + WL_IN), 1024, (r >> 4) * 64, (r & 15) * 64, tile); continue; }
            r -= 512;
            if (r < 48) { conv_tile<0>(tid, p.mla_w_uq + (size_t)l * 256 * 768, 768, p.mla_q_norm + l * 256, (bfu*)(wl + WL_UQ), 256, (r >> 2) * 64, (r & 3) * 64, tile); continue; }
            r -= 48;
            if (r < 64) { conv_tile<2>(tid, p.mla_w_ukv + (size_t)l * 128 * 1024, 1024, p.mla_kv_norm + l * 128, (bfu*)(wl + WL_UKV), 256, (r >> 2) * 64, (r & 3) * 64, tile, 128); continue; }
            r -= 64;
            if (r < 256) { conv_tile<0>(tid, p.w_out + (size_t)l * 1024 * 1024, 1024, nullptr, (bfu*)(wl + WL_OUT), 1024, (r >> 4) * 64, (r & 15) * 64, tile); continue; }
            r -= 256;
            conv_tile<0>(tid, p.peer_w_q + (size_t)l * 1024 * 1024, 1024, p.norm_ffn + l * 1024, (bfu*)(wl + WL_Q), 1024, (r >> 4) * 64, (r & 15) * 64, tile);
        }
    }
    const size_t gtid = (size_t)bid * 512 + tid, gsz = (size_t)nb * 512;
    for (size_t e = gtid; e < (size_t)NL * 16 * 128 * 64; e += gsz) {
        const int l = (int)(e / (16 * 128 * 64)); const size_t r = e % (16 * 128 * 64);
        ((bfu*)(ws + WS_W + (size_t)l * WL_SIZE + WL_SK))[r] = f2bf(p.peer_sub_keys[e]);
    }
    for (size_t e = gtid; e < (size_t)NL * 4 * 128 * 128; e += gsz) {
        const int l = (int)(e / (4 * 128 * 128)); const size_t r = e % (4 * 128 * 128);
        const int tt = (int)((r >> 7) & 127), s = (int)(r & 127);
        ((bfu*)(ws + WS_W + (size_t)l * WL_SIZE + WL_GM))[r] = f2bf(s <= tt ? p.gm_ws[e] : 0.f);
    }
    {
        const int nrows = NL * NEXP;
        for (int rr0 = (bid * 8 + w) * 4; rr0 < 2 * nrows; rr0 += nb * 8 * 4) {
            f32x4 v[4][4];
#pragma unroll
            for (int q = 0; q < 4; ++q) { const int rr = rr0 + q; const int tab = rr >= nrows, row = tab ? rr - nrows : rr;
                const float* src = (tab ? p.peer_v : p.peer_u) + (size_t)row * DM;
#pragma unroll
                for (int i = 0; i < 4; ++i) v[q][i] = *(const f32x4*)(src + 256 * i + 4 * lane); }
#pragma unroll
            for (int q = 0; q < 4; ++q) { const int rr = rr0 + q; const int tab = rr >= nrows, row = tab ? rr - nrows : rr;
                float am = 0.f;
#pragma unroll
                for (int i = 0; i < 4; ++i) am = fmaxf(am, fmaxf(fmaxf(fabsf(v[q][i][0]), fabsf(v[q][i][1])), fmaxf(fabsf(v[q][i][2]), fabsf(v[q][i][3]))));
                am = rdlane_f(dpp_max63(am), 63);
                const bool i8 = !tab;
                const float qmax = i8 ? 127.f : 440.f;
                const float sc = am > 0.f ? qmax / am : 0.f;
                u32x4 o;
#pragma unroll
                for (int i = 0; i < 4; ++i) {
                    if (i8) o[i] = pack_i8x4(v[q][i][0] * sc, v[q][i][1] * sc, v[q][i][2] * sc, v[q][i][3] * sc);
                    else { int wd = 0; wd = __builtin_amdgcn_cvt_pk_fp8_f32(v[q][i][0] * sc, v[q][i][1] * sc, wd, false); wd = __builtin_amdgcn_cvt_pk_fp8_f32(v[q][i][2] * sc, v[q][i][3] * sc, wd, true); o[i] = (unsigned)wd; }
                }
                const int ly = row / NEXP, rw = row % NEXP;
                *(u32x4*)(ws + (tab ? WS_TABV : WS_TABU) + (size_t)ly * NEXP * DM + (size_t)(lane >> 3) * NEXP * 128 + (size_t)rw * 128 + 16 * (lane & 7)) = o;
                if (lane == 0) ((float*)(ws + (tab ? WS_SCV : WS_SCU)))[row] = am / qmax;
            }
        }
    }
    {
        float* ct = (float*)(ws + WS_COS); float* st = (float*)(ws + WS_SIN);
        for (size_t e = gtid; e < (size_t)T * 16; e += gsz) {
            const int t = (int)(e >> 4), i = (int)(e & 15);
            const float inv = expf(-9.210340371976184f * (float)i * (1.f / 16.f));
            const float ang = (float)p.pos[t] * inv;
            const float kq = rintf(ang * 0.15915494309189535f);
            float rr = fmaf(-kq, 6.2831854820251465f, ang); rr = fmaf(-kq, -1.7484555e-7f, rr);
            ct[e] = __cosf(rr); st[e] = __sinf(rr);
        }
    }
    {
        float* sp = (float*)(ws + WS_SP);
        for (int e = (int)gtid; e < NL * SP_STRIDE + 1024; e += (int)gsz) {
            float v = 0.f;
            if (e >= SP_FIN) v = p.norm_final[e - SP_FIN];
            else { const int l = e / SP_STRIDE, r = e % SP_STRIDE;
                if (r < SP_GMB) v = p.gm_v_norm[l * 256 + r];
                else if (r < SP_GMO) v = p.gm_b[l * 512 + r - SP_GMB];
                else if (r < SP_MLO) v = p.gm_out_norm[l * 256 + r - SP_GMO];
                else if (r < SP_HGO) v = p.mla_out_norm[l * 512 + r - SP_MLO];
                else if (r < SP_NFF) v = p.hg_out_norm[l * 256 + r - SP_HGO];
                else if (r < SP_NFF + 1024) v = p.norm_ffn[l * 1024 + r - SP_NFF]; }
            sp[e] = v;
        }
    }
    if (bid == 0 && tid < 256) {
        float lg[NL], mx = -1e30f;
#pragma unroll
        for (int l = 0; l < NL; ++l) { lg[l] = p.hg_lb_logits[l * 256 + tid]; mx = fmaxf(mx, lg[l]); }
        float sum = 0.f; for (int l = 0; l < NL; ++l) { lg[l] = expf(lg[l] - mx); sum += lg[l]; }
        float cum = 0.f; const float p0 = lg[0] / sum;
        for (int l = 0; l < NL; ++l) { cum += lg[l] / sum; ((float*)(ws + WS_LB))[l * 256 + tid] = cum - p0; }
    }
}

constexpr int BM = 256, BK = 64, HALF = 128, HTB = HALF * BK * 2, STAGE_BYTES = 8 * HTB;
constexpr int LDS_RS = STAGE_BYTES;
constexpr int LDS_TOTAL = 163840;
constexpr int LDS_BAR = LDS_TOTAL - 16;
DI int lds_byte(int r, int c) { const int st = (r >> 4) * 2 + (c >> 5), rr = r & 15, cc = c & 31, ob = rr * 64 + cc * 2; return st * 1024 + (ob ^ (((ob >> 9) & 1) << 5)); }
DI void stage_rc(int b, int& R, int& C) { const int st = b / 1024, sb = b % 1024, swz = sb ^ (((sb >> 9) & 1) << 5); R = (st >> 1) * 16 + swz / 64; C = (st & 1) * 32 + (swz % 64) / 2; }
DI int perm32(int rho) { const int n = rho >> 4, i = rho & 15; return 8 * (i >> 2) + 4 * n + (i & 3); }
struct Unit { int pm, pn, idx; };
struct Gemm { const bfu* A; const bfu* Bt; int lda, ldb, K; };
struct XSched {
    int nN, nunits, G, c, wv;
    DI bool next(int i, Unit& u) const { const int L = i * G + c; if (L >= nunits) return false; const int xcd = L & 7, slot = L >> 3; u.pm = (slot / nN) * 8 + xcd; u.pn = slot % nN; u.idx = i; return true; }
    DI void a_ready(const Unit&) const {}
    DI void done(const Unit&) const {}
};
template <class Epi, class Sched, bool STAMP = false>
DI void gemm_phase(LAS unsigned char* lds, const Gemm g, const Sched& S, const Epi& E, unsigned long long* stamps = nullptr) {
    int tid_ = mk_tid(S.wv);
    const int tid = tid_, wid = __builtin_amdgcn_readfirstlane(tid >> 6), lane = tid & 63, wr = wid >> 2, wc = wid & 3, fr = lane & 15, fq = lane >> 4;
    const int K = g.K, nt = K / BK, lda = g.lda, ldb = g.ldb;
    int ts_lo = 0, ts_hi = 0, nts = 0; const unsigned long long rt_entry = STAMP ? (unsigned long long)wall_clock64() : 0ull;
#define PG8_STAMP() do { if (STAMP && wid == 0 && nts < 64) { const unsigned long long _c = (unsigned long long)clock64(); \
        ts_lo = (lane == nts) ? (int)(unsigned)_c : ts_lo; ts_hi = (lane == nts) ? (int)(unsigned)(_c >> 32) : ts_hi; ++nts; } } while (0)
    PG8_STAMP();
    unsigned voffA[2], voffB[2];
#pragma unroll
    for (int i = 0; i < 2; ++i) { int R, C; stage_rc(tid * 16 + i * 8192, R, C); const int Rb = Epi::PERM ? ((R & ~31) + perm32(R & 31)) : R;
        voffA[i] = (unsigned)(R * lda + C) * 2u; voffB[i] = (unsigned)(Rb * ldb + C) * 2u; }
    const size_t kstep = (size_t)(BK * 2);
    const size_t hstepA = (size_t)HALF * lda * 2, hstepB = (size_t)HALF * ldb * 2;
    const size_t tstepA = 2 * hstepA, tstepB = 2 * hstepB;
    const unsigned ldsw = (unsigned)wid * 1024u;
    const int aoff = lds_byte(wr * 64 + fr, fq * 8), boff = lds_byte(wc * 32 + fr, fq * 8);
#define PG8_SA(b, h) (((b) * 2 + (h)) * HTB)
#define PG8_SB(b, h) ((4 + (b) * 2 + (h)) * HTB)
#define PG8_STAGE(bufoff, gbase, voff) do { _Pragma("unroll") for (int _i = 0; _i < 2; ++_i) \
        __builtin_amdgcn_global_load_lds((const unsigned*)((const char*)(gbase) + (voff)[_i]), (LAS unsigned*)(lds + (bufoff) + ldsw + _i * 8192), 16, 0, 0); } while (0)
#define PG8_LDA(dst, b, h) do { _Pragma("unroll") for (int m = 0; m < 4; ++m) _Pragma("unroll") for (int k = 0; k < 2; ++k) dst[m][k] = *(const LAS bf16x8*)(lds + PG8_SA(b, h) + aoff + m * 2048 + k * 1024); } while (0)
#define PG8_LDB(dst, b, h) do { _Pragma("unroll") for (int n = 0; n < 2; ++n) _Pragma("unroll") for (int k = 0; k < 2; ++k) dst[n][k] = *(const LAS bf16x8*)(lds + PG8_SB(b, h) + boff + n * 2048 + k * 1024); } while (0)
#define PG8_MMA(ai, bj, At, Bt) do { __builtin_amdgcn_s_setprio(1); _Pragma("unroll") for (int m = 0; m < 4; ++m) _Pragma("unroll") for (int n = 0; n < 2; ++n) _Pragma("unroll") for (int k = 0; k < 2; ++k) \
        acc[ai][bj][m][n] = __builtin_amdgcn_mfma_f32_16x16x32_bf16(Bt[n][k], At[m][k], acc[ai][bj][m][n], 0, 0, 0); __builtin_amdgcn_s_setprio(0); } while (0)
#define PG8_WAIT_V(n) asm volatile("s_waitcnt vmcnt(" #n ")" ::: "memory")
#define PG8_WAIT_L(n) asm volatile("s_waitcnt lgkmcnt(" #n ")" ::: "memory")
#define PG8_BAR __builtin_amdgcn_s_barrier()
#define PG8_SCHED __builtin_amdgcn_sched_barrier(0)
    Unit cur, nxt; int ui = 0;
    if (!S.next(0, cur)) return;
    f32x4 acc[2][2][4][2]; { const f32x4 zz = zero4_opaque();
#pragma unroll
    for (int a = 0; a < 2; ++a)
#pragma unroll
        for (int b = 0; b < 2; ++b)
#pragma unroll
            for (int m = 0; m < 4; ++m)
#pragma unroll
                for (int n = 0; n < 2; ++n) acc[a][b][m][n] = zz; }
    bf16x8 At[4][2], B0[2][2], B1[2][2];
    const char* cA = (const char*)g.A + (size_t)cur.pm * tstepA; const char* cB = (const char*)g.Bt + (size_t)cur.pn * tstepB;
    S.a_ready(cur);
    PG8_STAGE(PG8_SB(0, 0), cB, voffB); PG8_STAGE(PG8_SA(0, 0), cA, voffA); PG8_STAGE(PG8_SB(0, 1), cB + hstepB, voffB); PG8_STAGE(PG8_SA(0, 1), cA + hstepA, voffA);
    if (wr == 1) PG8_BAR;
    PG8_WAIT_V(4); PG8_BAR;
    PG8_STAGE(PG8_SB(1, 0), cB + kstep, voffB); PG8_STAGE(PG8_SA(1, 0), cA + kstep, voffA); PG8_STAGE(PG8_SB(1, 1), cB + hstepB + kstep, voffB);
    PG8_WAIT_V(6); PG8_BAR;
    PG8_STAMP();
    for (;;) {
        const bool has_next = S.next(ui + 1, nxt);
        const char* nA = has_next ? (const char*)g.A + (size_t)nxt.pm * tstepA : cA; const char* nB = has_next ? (const char*)g.Bt + (size_t)nxt.pn * tstepB : cB;
        for (int t = 0; t < nt; t += 2) {
            const bool last = (t == nt - 2);
            const char* a1 = cA + (size_t)(t + 1) * kstep;
            const char* a2 = last ? nA : cA + (size_t)(t + 2) * kstep; const char* b2 = last ? nB : cB + (size_t)(t + 2) * kstep;
            const char* a3 = a2 + kstep; const char* b3 = b2 + kstep;
            if (last && has_next) S.a_ready(nxt);
            PG8_LDB(B0, 0, 0); PG8_SCHED; PG8_LDA(At, 0, 0); PG8_STAGE(PG8_SA(1, 1), a1 + hstepA, voffA);
            PG8_WAIT_L(8); PG8_BAR; PG8_WAIT_L(0); PG8_MMA(0, 0, At, B0); PG8_BAR; PG8_SCHED;
            PG8_LDB(B1, 0, 1); PG8_STAGE(PG8_SB(0, 0), b2, voffB);
            PG8_BAR; PG8_WAIT_L(0); PG8_MMA(0, 1, At, B1); PG8_BAR;
            PG8_LDA(At, 0, 1); PG8_STAGE(PG8_SA(0, 0), a2, voffA);
            PG8_BAR; PG8_WAIT_L(0); PG8_MMA(1, 0, At, B0); PG8_BAR; PG8_SCHED;
            PG8_STAGE(PG8_SB(0, 1), b2 + hstepB, voffB);
            PG8_WAIT_V(6); PG8_BAR; PG8_MMA(1, 1, At, B1); PG8_BAR;
            PG8_LDB(B0, 1, 0); PG8_SCHED; PG8_LDA(At, 1, 0); PG8_STAGE(PG8_SA(0, 1), a2 + hstepA, voffA);
            PG8_WAIT_L(8); PG8_BAR; PG8_WAIT_L(0); PG8_MMA(0, 0, At, B0); PG8_BAR; PG8_SCHED;
            PG8_LDB(B1, 1, 1); PG8_STAGE(PG8_SB(1, 0), b3, voffB);
            PG8_BAR; PG8_WAIT_L(0); PG8_MMA(0, 1, At, B1); PG8_BAR;
            PG8_LDA(At, 1, 1); PG8_STAGE(PG8_SA(1, 0), a3, voffA);
            PG8_BAR; PG8_WAIT_L(0); PG8_MMA(1, 0, At, B0); PG8_BAR; PG8_SCHED;
            PG8_STAGE(PG8_SB(1, 1), b3 + hstepB, voffB);
            PG8_WAIT_V(6); PG8_BAR; PG8_MMA(1, 1, At, B1); PG8_BAR;
        }
        PG8_STAMP();
        if constexpr (!Epi::AFTER_DRAIN) { E(acc, cur, wr, wc, fr, fq); S.done(cur); }
        PG8_STAMP();
        if (!has_next) break;
        { const f32x4 zz = zero4_opaque();
#pragma unroll
        for (int a = 0; a < 2; ++a)
#pragma unroll
            for (int b = 0; b < 2; ++b)
#pragma unroll
                for (int m = 0; m < 4; ++m)
#pragma unroll
                    for (int n = 0; n < 2; ++n) acc[a][b][m][n] = zz; }
        cur = nxt; cA = nA; cB = nB; ++ui;
    }
    PG8_WAIT_V(0);
    if (wr == 0) PG8_BAR;
    PG8_BAR;
    if constexpr (Epi::AFTER_DRAIN) { E.fused(acc, cur, wr, wc, fr, fq, lds, wid, lane); S.done(cur); }
    PG8_STAMP();
    if (STAMP && wid == 0) { stamps[lane] = lane < nts ? (((unsigned long long)(unsigned)ts_hi << 32) | (unsigned)ts_lo) : 0ull;
        if (lane == 62) stamps[62] = rt_entry; if (lane == 63) stamps[63] = (unsigned long long)wall_clock64(); }
#undef PG8_STAMP
#undef PG8_SA
#undef PG8_SB
#undef PG8_STAGE
#undef PG8_LDA
#undef PG8_LDB
#undef PG8_MMA
#undef PG8_WAIT_V
#undef PG8_WAIT_L
#undef PG8_BAR
#undef PG8_SCHED
}

template <int NC>
DI void rows_rstd_lds(const bfu* __restrict__ A, int lda, int brow, LAS float* rs, int wv, float* gout = nullptr) {
    int tid = mk_tid(wv);
    const int w = tid >> 6, lane = tid & 63;
    if constexpr (NC == 1024) {
        for (int i0 = 0; i0 < 32; i0 += 8) {
            u32x4 va[8], vb[8];
#pragma unroll
            for (int i = 0; i < 8; ++i) { const bfu* row = A + (size_t)(brow + w * 32 + i0 + i) * lda; va[i] = *(const u32x4*)(row + lane * 8); vb[i] = *(const u32x4*)(row + 512 + lane * 8); }
#pragma unroll
            for (int i = 0; i < 8; ++i) {
                float ss = 0.f;
#pragma unroll
                for (int j = 0; j < 4; ++j) { const float x0 = bflo(va[i][j]), x1 = bfhi(va[i][j]), y0 = bflo(vb[i][j]), y1 = bfhi(vb[i][j]); ss += x0 * x0 + x1 * x1 + y0 * y0 + y1 * y1; }
                ss = rdlane_f(dpp_sum63(ss), 63);
                const int r = w * 32 + i0 + i;
                if (lane == 0) { const float rv = rsqrtf(ss * (1.f / NC) + EPS); rs[r] = rv; if (gout) gout[brow + r] = rv; }
            }
        }
    } else {
        constexpr int PER = NC / 64;
        for (int i0 = 0; i0 < 32; i0 += 16) {
            u32x2 v[16];
#pragma unroll
            for (int i = 0; i < 16; ++i) { const bfu* row = A + (size_t)(brow + w * 32 + i0 + i) * lda;
                if constexpr (PER == 4) v[i] = *(const u32x2*)(row + lane * 4); else { v[i][0] = *(const unsigned*)(row + lane * 2); v[i][1] = 0u; } }
#pragma unroll
            for (int i = 0; i < 16; ++i) {
                const float x0 = bflo(v[i][0]), x1 = bfhi(v[i][0]), y0 = bflo(v[i][1]), y1 = bfhi(v[i][1]);
                const float ss = rdlane_f(dpp_sum63(x0 * x0 + x1 * x1 + y0 * y0 + y1 * y1), 63);
                const int r = w * 32 + i0 + i;
                if (lane == 0) { const float rv = rsqrtf(ss * (1.f / NC) + EPS); rs[r] = rv; if (gout) gout[brow + r] = rv; }
            }
        }
    }
}
DI u32x2 pack4(f32x4 v) { u32x2 o; o[0] = pk2(v[0], v[1]); o[1] = pk2(v[2], v[3]); return o; }

DI void rope_perm(f32x4& a, f32x4& b, const float* ct, const float* st, size_t row, int fq) {
    const int i0 = 8 * (fq & 1);
    const f32x4 c0 = *(const f32x4*)(ct + row * 16 + i0), c1 = *(const f32x4*)(ct + row * 16 + i0 + 4), s0 = *(const f32x4*)(st + row * 16 + i0), s1 = *(const f32x4*)(st + row * 16 + i0 + 4);
    f32x4 pa, pb;
#pragma unroll
    for (int j = 0; j < 4; ++j) { pa[j] = swap32(a[j]); pb[j] = swap32(b[j]); }
    const float sg = fq < 2 ? -1.f : 1.f;
    a = a * c0 + pa * s0 * sg; b = b * c1 + pb * s1 * sg;
}
struct EpiProj {
    static constexpr bool PERM = true, AFTER_DRAIN = false;
    const float* rs; bfu* out; const float* ct; const float* st;
    DI void operator()(const f32x4 (&acc)[2][2][4][2], const Unit& u, int wr, int wc, int fr_, int fq_) const {
        int tz = mk_tid(wr * 4 + wc); const int fr = tz & 15, fq = (tz >> 4) & 3;
        const int row0 = u.pm * BM + wr * 64 + fr, colg = u.pn * BM + wc * 32;
        float sv[2][4];
        { f32x4 q0[2][4], q1[2][4];
#pragma unroll
          for (int ai = 0; ai < 2; ++ai)
#pragma unroll
            for (int m = 0; m < 4; ++m) { const int row = row0 + ai * HALF + m * 16; q0[ai][m] = *(const f32x4*)(rs + (size_t)row * 8); q1[ai][m] = *(const f32x4*)(rs + (size_t)row * 8 + 4); }
#pragma unroll
          for (int ai = 0; ai < 2; ++ai)
#pragma unroll
            for (int m = 0; m < 4; ++m) sv[ai][m] = rsqrtf((((q0[ai][m][0] + q0[ai][m][1]) + (q0[ai][m][2] + q0[ai][m][3])) + ((q1[ai][m][0] + q1[ai][m][1]) + (q1[ai][m][2] + q1[ai][m][3]))) * (1.f / DM) + EPS); }
#pragma unroll
        for (int ai = 0; ai < 2; ++ai)
#pragma unroll
            for (int m = 0; m < 4; ++m) {
                const int row = row0 + ai * HALF + m * 16; const float s = sv[ai][m];
#pragma unroll
                for (int bj = 0; bj < 2; ++bj) {
                    const int cg = colg + bj * HALF;
                    f32x4 a = acc[ai][bj][m][0] * s, b = acc[ai][bj][m][1] * s;
                    if (cg == PC_KR) rope_perm(a, b, ct, st, (size_t)row, fq);
                    u32x4 w4; w4[0] = pk2(a[0], a[1]); w4[1] = pk2(a[2], a[3]); w4[2] = pk2(b[0], b[1]); w4[3] = pk2(b[2], b[3]);
                    *(u32x4*)(out + (size_t)row * PW + cg + 8 * fq) = w4;
                }
            }
    }
};
template <bool ROPE>
struct EpiScaled {
    static constexpr bool PERM = true, AFTER_DRAIN = false;
    const LAS float* rs; bfu* out; int ld; const float* ct; const float* st; float scale;
    DI void operator()(const f32x4 (&acc)[2][2][4][2], const Unit& u, int wr, int wc, int fr_, int fq_) const {
        int tz = mk_tid(wr * 4 + wc); const int fr = tz & 15, fq = (tz >> 4) & 3;
        const int lrow0 = wr * 64 + fr, colg = u.pn * BM + wc * 32;
#pragma unroll
        for (int ai = 0; ai < 2; ++ai)
#pragma unroll
            for (int m = 0; m < 4; ++m) {
                const int lrow = lrow0 + ai * HALF + m * 16; const int row = u.pm * BM + lrow; const float s = rs[u.idx * 256 + lrow] * scale;
#pragma unroll
                for (int bj = 0; bj < 2; ++bj) {
                    const int cg = colg + bj * HALF;
                    f32x4 a = acc[ai][bj][m][0] * s, b = acc[ai][bj][m][1] * s;
                    if constexpr (ROPE) { if (((cg >> 5) % 3) == 2) rope_perm(a, b, ct, st, (size_t)row, fq); }
                    u32x4 w4; w4[0] = pk2(a[0], a[1]); w4[1] = pk2(a[2], a[3]); w4[2] = pk2(b[0], b[1]); w4[3] = pk2(b[2], b[3]);
                    *(u32x4*)(out + (size_t)row * ld + cg + 8 * fq) = w4;
                }
            }
    }
};
struct EpiResid {
    static constexpr bool PERM = true, AFTER_DRAIN = false;
    bfu* x;
#ifdef REP_G3
    bfu* xo;
#endif
    DI void operator()(const f32x4 (&acc)[2][2][4][2], const Unit& u, int wr, int wc, int fr_, int fq_) const {
        int tz = mk_tid(wr * 4 + wc); const int fr = tz & 15, fq = (tz >> 4) & 3;
        const int row0 = u.pm * BM + wr * 64 + fr, colg = u.pn * BM + wc * 32 + 8 * fq;
#ifndef REP_G3
        bfu* const xo = x;
#endif
#pragma unroll
        for (int ai = 0; ai < 2; ++ai) {
            u32x4 old[4][2];
#pragma unroll
            for (int m = 0; m < 4; ++m)
#pragma unroll
                for (int bj = 0; bj < 2; ++bj) old[m][bj] = *(const u32x4*)(x + (size_t)(row0 + ai * HALF + m * 16) * DM + colg + bj * HALF);
#pragma unroll
            for (int m = 0; m < 4; ++m)
#pragma unroll
                for (int bj = 0; bj < 2; ++bj) {
                    const u32x4 od = old[m][bj]; const f32x4 v0 = acc[ai][bj][m][0], v1 = acc[ai][bj][m][1];
                    u32x4 o; o[0] = pk2(bflo(od[0]) + v0[0], bfhi(od[0]) + v0[1]); o[1] = pk2(bflo(od[1]) + v0[2], bfhi(od[1]) + v0[3]);
                    o[2] = pk2(bflo(od[2]) + v1[0], bfhi(od[2]) + v1[1]); o[3] = pk2(bflo(od[3]) + v1[2], bfhi(od[3]) + v1[3]);
                    *(u32x4*)(xo + (size_t)(row0 + ai * HALF + m * 16) * DM + colg + bj * HALF) = o;
                }
        }
    }
};

constexpr int AT_KS = 208;
constexpr int AT_VS = 192;
constexpr int AT_KB = 64 * AT_KS, AT_VB = 64 * AT_VS, AT_BUF = AT_KB + AT_VB;

DI void attn_unit(const Params& p, unsigned char* ws, int l, int b, int h, int qt, LAS char* smem, int tid) {
    const int w = tid >> 6, lane = tid & 63, r = lane & 31, hh = lane >> 5;
    const bfu* Q = (const bfu*)(ws + WS_Q); const bfu* KV = (const bfu*)(ws + WS_KV); const bfu* PR = (const bfu*)(ws + WS_PROJ);
    const size_t tok0 = (size_t)b * SEQ;
    const int q0 = qt * 256 + w * 32;
    bf16x8 qf[6];
    { const bfu* qrow = Q + (tok0 + q0 + r) * 768 + h * 96 + 8 * hh;
#pragma unroll
      for (int ks = 0; ks < 6; ++ks) qf[ks] = *(const bf16x8*)(qrow + 16 * ks); }
    f32x16 o0 = zero16(), o1 = zero16();
    float mrun = -1e30f, lsum = 0.f;
    const int nkt = qt * 4 + 4, my_last = qt * 4 + (w >> 1);
    const int skey = tid >> 3, sch = tid & 7, rkey = (tid & 255) >> 2, rch = tid & 3;
    struct Stg { u32x4 k, v, r; } gA, gB;
    auto gload = [&](int kt, Stg& g) {
        const size_t t1 = tok0 + (size_t)kt * 64 + skey;
        g.k = *(const u32x4*)(KV + t1 * 1024 + h * 64 + sch * 8);
        g.v = *(const u32x4*)(KV + t1 * 1024 + 512 + h * 64 + sch * 8);
        g.r = *(const u32x4*)(PR + (tok0 + (size_t)kt * 64 + rkey) * PW + PC_KR + rch * 8);
    };
    auto lstore = [&](int buf, const Stg& g) {
        LAS char* kb = smem + buf * AT_BUF; LAS char* vb = kb + AT_KB;
        *(LAS u32x4*)(kb + skey * AT_KS + sch * 16) = g.k;
        *(LAS u32x4*)(vb + skey * AT_VS + sch * 16) = g.v;
        if (tid < 256) *(LAS u32x4*)(kb + rkey * AT_KS + 128 + rch * 16) = g.r;
    };
    gload(0, gA); gload(1, gB);
    __syncthreads();
    lstore(0, gA);
    __syncthreads();
    const int i16 = lane & 15, q4 = i16 >> 2, p4 = i16 & 3, blk = (lane >> 4) & 1;
    auto tile = [&](int kt, int cur, auto maskc) {
            constexpr bool MASK = decltype(maskc)::value;
            const LAS char* kb = smem + cur * AT_BUF; const LAS char* vb = kb + AT_KB;
            f32x16 s0 = zero16(), s1 = zero16();
            {
                bf16x8 a0[6], a1[6];
#pragma unroll
                for (int ks = 0; ks < 6; ++ks) { a0[ks] = *(const LAS bf16x8*)(kb + r * AT_KS + ks * 32 + hh * 16); a1[ks] = *(const LAS bf16x8*)(kb + (32 + r) * AT_KS + ks * 32 + hh * 16); }
                __builtin_amdgcn_sched_barrier(0);
#pragma unroll
                for (int ks = 0; ks < 6; ++ks) { s0 = mfma32(a0[ks], qf[ks], s0); s1 = mfma32(a1[ks], qf[ks], s1); }
            }
            bf16x8 vf[2][2][2];
#pragma unroll
            for (int kk = 0; kk < 2; ++kk)
#pragma unroll
                for (int s = 0; s < 2; ++s)
#pragma unroll
                    for (int vt = 0; vt < 2; ++vt) {
                        const LAS char* a = vb + (32 * kk + 16 * s + 4 * hh + q4) * AT_VS + (32 * vt + 16 * blk) * 2 + 8 * p4;
                        vf[kk][s][vt] = cat4(ldtr(a), ldtr(a + 8 * AT_VS));
                    }
            __builtin_amdgcn_sched_barrier(0);
            if constexpr (MASK) {
                const int qa = q0 + r, kbase = kt * 64 + 4 * hh;
#pragma unroll
                for (int i = 0; i < 16; ++i) { const int kk = kbase + (i & 3) + 8 * (i >> 2); if (kk > qa) s0[i] = -1e30f; if (kk + 32 > qa) s1[i] = -1e30f; }
            }
            float mx = s0[0];
#pragma unroll
            for (int i = 1; i < 16; ++i) mx = fmaxf(mx, s0[i]);
#pragma unroll
            for (int i = 0; i < 16; ++i) mx = fmaxf(mx, s1[i]);
            mx = fmaxf(mx, swap32(mx));
            const float mnew = fmaxf(mrun, mx);
            if (__any(mnew > mrun)) {
                const float alpha = __builtin_amdgcn_exp2f(mrun - mnew);
                lsum *= alpha;
#pragma unroll
                for (int i = 0; i < 16; ++i) { o0[i] *= alpha; o1[i] *= alpha; }
                mrun = mnew;
            }
            float ps = 0.f;
#pragma unroll
            for (int i = 0; i < 16; ++i) { s0[i] = __builtin_amdgcn_exp2f(s0[i] - mrun); s1[i] = __builtin_amdgcn_exp2f(s1[i] - mrun); ps += s0[i] + s1[i]; }
            lsum += ps;
#pragma unroll
            for (int kk = 0; kk < 2; ++kk)
#pragma unroll
                for (int s = 0; s < 2; ++s) {
                    const bf16x8 pf = pack8(kk == 0 ? s0 : s1, s);
                    o0 = mfma32(vf[kk][s][0], pf, o0); o1 = mfma32(vf[kk][s][1], pf, o1);
                }
        };
    auto run = [&](int kt, int cur) { if (kt < my_last) tile(kt, cur, std::false_type{}); else if (kt == my_last) tile(kt, cur, std::true_type{}); };
    for (int kt = 0; kt < nkt; kt += 2) {
        gload(min(kt + 2, nkt - 1), gA);
        run(kt, 0);
        lstore(1, gB);
        __syncthreads();
        gload(min(kt + 3, nkt - 1), gB);
        run(kt + 1, 1);
        if (kt + 2 < nkt) lstore(0, gA);
        __syncthreads();
    }
    const float ltot = lsum + swap32(lsum);
    const float inv = 1.f / ltot;
    float ss = 0.f;
#pragma unroll
    for (int i = 0; i < 16; ++i) { o0[i] *= inv; o1[i] *= inv; ss += o0[i] * o0[i] + o1[i] * o1[i]; }
    ss += swap32(ss);
    const float rstd = rsqrtf(ss * (1.f / 64.f) + EPS);
    const float* gain = (const float*)(ws + WS_SP) + l * SP_STRIDE + SP_MLO + h * 64;
    bfu* yrow = (bfu*)(ws + WS_YCAT) + (tok0 + q0 + r) * 1024 + 256 + h * 64;
#pragma unroll
    for (int vt = 0; vt < 2; ++vt)
#pragma unroll
        for (int g = 0; g < 4; ++g) {
            const int v0 = 32 * vt + 8 * g + 4 * hh;
            const f32x4 gn = *(const f32x4*)(gain + v0);
            f32x4 ov;
#pragma unroll
            for (int i = 0; i < 4; ++i) ov[i] = (vt == 0 ? o0[4 * g + i] : o1[4 * g + i]) * rstd * gn[i];
            *(u32x2*)(yrow + v0) = pack4(ov);
        }
}

DI void attn_phase(const Params& p, int l, LAS char* smem, int wv) {
    int tid = mk_tid(wv); smem = opql(smem);
    unsigned char* ws = opq(p.ws);
    for (int pi = blockIdx.x; pi < 512; pi += gridDim.x) {
        const int xx = pi & 7, mm = pi >> 3, j = mm & 3, bh = (mm >> 2) * 8 + xx;
        attn_unit(p, ws, l, bh >> 3, bh & 7, 7 - j, smem, tid);
        attn_unit(p, ws, l, bh >> 3, bh & 7, j, smem, tid);
    }
}

constexpr int GM_VS = 576;

DI void gmlp_phase(const Params& p, int l, LAS char* smem, int wv) {
    int tid = mk_tid(wv); smem = opql(smem);
    const int w = tid >> 6, lane = tid & 63, r = lane & 31, hh = lane >> 5;
    unsigned char* ws = opq(p.ws);
    const bfu* PR = (const bfu*)(ws + WS_PROJ);
    bfu* YC = (bfu*)(ws + WS_YCAT);
    const bfu* WC = (const bfu*)(ws + WS_W + (size_t)l * WL_SIZE + WL_GM);
    for (int c = blockIdx.x; c < T / 128; c += gridDim.x) {
        const size_t tok0 = (size_t)c * 128;
        __syncthreads();
        {
            const f32x4 gn = *(const f32x4*)((const float*)(ws + WS_SP) + l * SP_STRIDE + SP_GMV + lane * 4);
            u32x2 vraw[16];
#pragma unroll
            for (int i = 0; i < 16; ++i) vraw[i] = *(const u32x2*)(PR + (tok0 + w * 16 + i) * PW + PC_V + lane * 4);
#pragma unroll
            for (int i = 0; i < 16; ++i) {
                const int s = w * 16 + i;
                const u32x2 raw = vraw[i];
                f32x4 v; v[0] = geluf(bflo(raw[0])); v[1] = geluf(bfhi(raw[0])); v[2] = geluf(bflo(raw[1])); v[3] = geluf(bfhi(raw[1]));
                float ss = v[0] * v[0] + v[1] * v[1] + v[2] * v[2] + v[3] * v[3];
                ss = sum16(ss);
                const float rstd = rsqrtf(ss * (1.f / 64.f) + EPS);
                f32x4 o; for (int j = 0; j < 4; ++j) o[j] = v[j] * rstd * gn[j];
                *(LAS u32x2*)(smem + s * GM_VS + lane * 8) = pack4(o);
            }
        }
        __syncthreads();
        const int h = w >> 1, th = w & 1;
        const int i16 = lane & 15, q4 = i16 >> 2, p4 = i16 & 3, blk = (lane >> 4) & 1;
        f32x16 acc[2][2];
#pragma unroll
        for (int a = 0; a < 2; ++a)
#pragma unroll
            for (int b2 = 0; b2 < 2; ++b2) acc[a][b2] = zero16();
        const bfu* wrow = WC + ((size_t)h * 128 + 64 * th + r) * 128 + 8 * hh;
#pragma unroll
        for (int ks = 0; ks < 8; ++ks) {
            bf16x8 af[2];
#pragma unroll
            for (int mt = 0; mt < 2; ++mt) {
                const LAS char* a = smem + (16 * ks + 8 * hh + q4) * GM_VS + (h * 64 + 32 * mt + 16 * blk) * 2 + 8 * p4;
                af[mt] = cat4(ldtr(a), ldtr(a + 4 * GM_VS));
            }
#pragma unroll
            for (int nt = 0; nt < 2; ++nt) {
                if (ks <= 4 * th + 2 * nt + 1) {
                    const bf16x8 bfr = *(const bf16x8*)(wrow + (size_t)nt * 32 * 128 + 16 * ks);
                    acc[0][nt] = mfma32(af[0], bfr, acc[0][nt]); acc[1][nt] = mfma32(af[1], bfr, acc[1][nt]);
                }
            }
        }
        const float* og = (const float*)(ws + WS_SP) + l * SP_STRIDE + SP_GMO + h * 64;
#pragma unroll
        for (int nt = 0; nt < 2; ++nt) {
            const int tl = 64 * th + 32 * nt + r;
            const float bv = ((const float*)(ws + WS_SP))[l * SP_STRIDE + SP_GMB + h * 128 + tl];
            const bfu* urow = PR + (tok0 + tl) * PW + PC_U + h * 64;
            f32x4 y[2][4]; float ss = 0.f;
#pragma unroll
            for (int mt = 0; mt < 2; ++mt)
#pragma unroll
                for (int g = 0; g < 4; ++g) {
                    const int d0 = 32 * mt + 8 * g + 4 * hh;
                    const u32x2 raw = *(const u32x2*)(urow + d0);
                    f32x4 u; u[0] = geluf(bflo(raw[0])); u[1] = geluf(bfhi(raw[0])); u[2] = geluf(bflo(raw[1])); u[3] = geluf(bfhi(raw[1]));
#pragma unroll
                    for (int i = 0; i < 4; ++i) { const float yy = u[i] * (acc[mt][nt][4 * g + i] + bv); y[mt][g][i] = yy; ss += yy * yy; }
                }
            ss += swap32(ss);
            const float rstd = rsqrtf(ss * (1.f / 64.f) + EPS);
            bfu* yrow = YC + (tok0 + tl) * 1024 + h * 64;
#pragma unroll
            for (int mt = 0; mt < 2; ++mt)
#pragma unroll
                for (int g = 0; g < 4; ++g) {
                    const int d0 = 32 * mt + 8 * g + 4 * hh;
                    const f32x4 gn = *(const f32x4*)(og + d0);
                    f32x4 o; for (int i = 0; i < 4; ++i) o[i] = y[mt][g][i] * rstd * gn[i];
                    *(u32x2*)(yrow + d0) = pack4(o);
                }
        }
    }
}

constexpr int HG_RS = 528;
constexpr int HG_TS = 576;
constexpr float HG_CLAMP = 80.f;

struct HgScan { float cum[32]; float kf[32]; float tot0, tot1; };
DI void hg_scan_pre(const unsigned short (&hfr)[32], int ch, int half, float lb, LAS float* xch, HgScan& S) {
    float run = 0.f;
#pragma unroll
    for (int i = 0; i < 32; ++i) {
        const float fx = bf2f(hfr[i]);
        const float sg = sigmoidf(fx);
        const float f = lb + (1.f - lb) * sg;
        run += __logf(fmaxf(f, 1e-20f));
        S.cum[i] = run; S.kf[i] = (1.f - lb) * (1.f - sg);
    }
    xch[half * 256 + ch] = run;
    __syncthreads();
    S.tot0 = xch[ch]; S.tot1 = xch[256 + ch];
}

DI void hg_local_phase(const Params& p, int l, LAS char* smem, int wv) {
    int tid = mk_tid(wv); smem = opql(smem);
    const int w = tid >> 6, lane = tid & 63, r = lane & 31, hh = lane >> 5;
    const int ch = tid & 255, half = tid >> 8;
    unsigned char* ws = opq(p.ws);
    const bfu* PR = (const bfu*)(ws + WS_PROJ);
    float* HST = (float*)(ws + WS_HST); float* HDEC = (float*)(ws + WS_HDEC);
    const float lb = ((const float*)(ws + WS_LB))[l * 256 + ch];
    LAS char* Kt = smem;
    LAS char* Vn = smem + 64 * HG_TS;
    LAS float* xch = (LAS float*)(smem + 2 * 64 * HG_TS);
    const int nb = gridDim.x, bid = blockIdx.x;
    const bool skew = nb == 256;
    const int u_lo = skew ? (bid < 128 ? bid : 128 + (bid - 128) * 3) : bid, u_n = skew ? (bid < 128 ? 1 : 3) : (512 - bid + nb - 1) / nb, u_st = skew ? 1 : nb;
    for (int ui = 0; ui < u_n; ++ui) {
        const int uc = u_lo + ui * u_st;
        const size_t tok0 = (size_t)uc * 64;
        unsigned short hfr[32];
#pragma unroll
        for (int i = 0; i < 32; ++i) hfr[i] = PR[(tok0 + 32 * half + i) * PW + PC_HF + ch];
        u32x4 vch[4];
#pragma unroll
        for (int i = 0; i < 4; ++i) { const int e = tid + i * 512, s = e >> 5, cch = e & 31; vch[i] = *(const u32x4*)(PR + (tok0 + s) * PW + PC_HI + cch * 8); }
        __syncthreads();
        HgScan S; hg_scan_pre(hfr, ch, half, lb, xch, S);
        const float btot = S.tot0 + S.tot1;
        const float e0 = half == 0 ? btot : S.tot1;
#pragma unroll
        for (int i = 0; i < 32; ++i) {
            const float kv = S.kf[i] * __expf(e0 - S.cum[i]);
            *(LAS bfu*)(Kt + (32 * half + i) * HG_TS + ch * 2) = f2bf(kv);
        }
        if (half == 0) HDEC[(size_t)uc * 256 + ch] = __expf(btot);
#pragma unroll
        for (int i = 0; i < 4; ++i) { const int e = tid + i * 512, s = e >> 5, cch = e & 31; *(LAS u32x4*)(Vn + s * HG_TS + cch * 16) = vch[i]; }
        __syncthreads();
        const int h = w >> 1, vh = w & 1;
        const int i16 = lane & 15, q4 = i16 >> 2, p4 = i16 & 3, blk = (lane >> 4) & 1;
        f32x16 acc0 = zero16(), acc1 = zero16();
#pragma unroll
        for (int ks = 0; ks < 4; ++ks) {
            const int srow = 16 * ks + 8 * hh + q4;
            const LAS char* a = Vn + srow * HG_TS + (h * 64 + 32 * vh + 16 * blk) * 2 + 8 * p4;
            const bf16x8 af = cat4(ldtr(a), ldtr(a + 4 * HG_TS));
            const LAS char* b0 = Kt + srow * HG_TS + (h * 64 + 16 * blk) * 2 + 8 * p4;
            const bf16x8 bf0 = cat4(ldtr(b0), ldtr(b0 + 4 * HG_TS));
            const bf16x8 bf1 = cat4(ldtr(b0 + 64), ldtr(b0 + 64 + 4 * HG_TS));
            acc0 = mfma32(af, bf0, acc0); acc1 = mfma32(af, bf1, acc1);
        }
        float* out = HST + ((size_t)uc * 4 + h) * 4096;
#pragma unroll
        for (int i = 0; i < 16; ++i) {
            const int v = 32 * vh + crow(i, hh);
            out[v * 64 + r] = acc0[i]; out[v * 64 + 32 + r] = acc1[i];
        }
    }
}

DI void hg_prefix_phase(const Params& p, int wv) {
    unsigned char* ws = opq(p.ws);
    float* HST = (float*)(ws + WS_HST); const float* HDEC = (const float*)(ws + WS_HDEC);
    int tid = mk_tid(wv);
    const int gsz = gridDim.x * 512;
    for (int e = blockIdx.x * 512 + tid; e < 64 * 4096; e += gsz) {
        const int bh = e >> 12, idx = e & 4095, b = bh >> 2, h = bh & 3;
        float S = 0.f;
        for (int c0 = 0; c0 < 32; c0 += 8) {
            float g8[8], d8[8];
#pragma unroll
            for (int k = 0; k < 8; ++k) { const size_t uc = (size_t)b * 32 + c0 + k; g8[k] = HST[(uc * 4 + h) * 4096 + idx]; d8[k] = HDEC[uc * 256 + h * 64 + (idx & 63)]; }
#pragma unroll
            for (int k = 0; k < 8; ++k) { const size_t uc = (size_t)b * 32 + c0 + k; HST[(uc * 4 + h) * 4096 + idx] = S; S = d8[k] * S + g8[k]; }
        }
    }
}

DI void hg_out_phase(const Params& p, int l, LAS char* smem, int wv) {
    int tid = mk_tid(wv); smem = opql(smem);
    const int w = tid >> 6, lane = tid & 63, r = lane & 31, hh = lane >> 5;
    const int ch = tid & 255, half = tid >> 8;
    unsigned char* ws = opq(p.ws);
    const bfu* PR = (const bfu*)(ws + WS_PROJ);
    const float* HST = (const float*)(ws + WS_HST);
    bfu* YC = (bfu*)(ws + WS_YCAT);
    const float lb = ((const float*)(ws + WS_LB))[l * 256 + ch];
    LAS char* Qe = smem;
    LAS char* Qm = smem + 64 * HG_RS;
    LAS char* Km = smem + 2 * 64 * HG_RS;
    LAS char* Vn = smem + 3 * 64 * HG_RS;
    LAS float* xch = (LAS float*)(smem + 3 * 64 * HG_RS + 64 * HG_TS);
    for (int uc = blockIdx.x; uc < 512; uc += gridDim.x) {
        const size_t tok0 = (size_t)uc * 64;
        const int h = w >> 1, th = w & 1;
        unsigned short hfr[32], hqr[32];
#pragma unroll
        for (int i = 0; i < 32; ++i) { const bfu* pp = PR + (tok0 + 32 * half + i) * PW + ch; hfr[i] = pp[PC_HF]; hqr[i] = pp[PC_HQ]; }
        u32x4 vch[4];
#pragma unroll
        for (int i = 0; i < 4; ++i) { const int e = tid + i * 512, s = e >> 5, cch = e & 31; vch[i] = *(const u32x4*)(PR + (tok0 + s) * PW + PC_HI + cch * 8); }
        const size_t tok = tok0 + 32 * th + r;
        u32x2 graw[2][4];
#pragma unroll
        for (int vt = 0; vt < 2; ++vt)
#pragma unroll
            for (int g = 0; g < 4; ++g) graw[vt][g] = *(const u32x2*)(PR + tok * PW + PC_HG + h * 64 + 32 * vt + 8 * g + 4 * hh);
        __syncthreads();
        HgScan S; hg_scan_pre(hfr, ch, half, lb, xch, S);
        f32x4 hs[2][4][2];
        { const float* st = HST + ((size_t)uc * 4 + h) * 4096;
#pragma unroll
          for (int vt = 0; vt < 2; ++vt)
#pragma unroll
            for (int ks = 0; ks < 4; ++ks) { const float* sp = st + (32 * vt + r) * 64 + 16 * ks + 8 * hh; hs[vt][ks][0] = *(const f32x4*)sp; hs[vt][ks][1] = *(const f32x4*)(sp + 4); } }
        const float em = __expf(S.tot0);
#pragma unroll
        for (int i = 0; i < 32; ++i) {
            const int s = 32 * half + i;
            const float q = siluf(bf2f(hqr[i]));
            const float bm = half == 0 ? S.cum[i] - S.tot0 : S.cum[i];
            const float ebm = __expf(fminf(fmaxf(bm, -HG_CLAMP), HG_CLAMP));
            const float qm = q * ebm;
            const float qe = qm * em;
            const float km = S.kf[i] * __builtin_amdgcn_rcpf(ebm);
            *(LAS bfu*)(Qe + s * HG_RS + ch * 2) = f2bf(qe);
            *(LAS bfu*)(Qm + s * HG_RS + ch * 2) = f2bf(qm);
            *(LAS bfu*)(Km + s * HG_RS + ch * 2) = f2bf(km);
        }
#pragma unroll
        for (int i = 0; i < 4; ++i) { const int e = tid + i * 512, s = e >> 5, cch = e & 31; *(LAS u32x4*)(Vn + s * HG_TS + cch * 16) = vch[i]; }
        __syncthreads();
        const int i16 = lane & 15, q4 = i16 >> 2, p4 = i16 & 3, blk = (lane >> 4) & 1;
        f32x16 o0 = zero16(), o1 = zero16();
        {
#pragma unroll
            for (int ks = 0; ks < 4; ++ks) {
                const bf16x8 bq = *(const LAS bf16x8*)(Qe + (32 * th + r) * HG_RS + (h * 64 + 16 * ks + 8 * hh) * 2);
#pragma unroll
                for (int vt = 0; vt < 2; ++vt) {
                    const f32x4 s0 = hs[vt][ks][0], s1 = hs[vt][ks][1];
                    u32x4 pa; pa[0] = pk2(s0[0], s0[1]); pa[1] = pk2(s0[2], s0[3]); pa[2] = pk2(s1[0], s1[1]); pa[3] = pk2(s1[2], s1[3]);
                    const bf16x8 af = __builtin_bit_cast(bf16x8, pa);
                    if (vt == 0) o0 = mfma32(af, bq, o0); else o1 = mfma32(af, bq, o1);
                }
            }
        }
#pragma unroll
        for (int st_ = 0; st_ < 2; ++st_) {
            if (st_ <= th) {
                f32x16 x = zero16();
#pragma unroll
                for (int ks = 0; ks < 4; ++ks) {
                    const bf16x8 ak = *(const LAS bf16x8*)(Km + (32 * st_ + r) * HG_RS + (h * 64 + 16 * ks + 8 * hh) * 2);
                    const bf16x8 bq = *(const LAS bf16x8*)(Qm + (32 * th + r) * HG_RS + (h * 64 + 16 * ks + 8 * hh) * 2);
                    x = mfma32(ak, bq, x);
                }
                if (st_ == th) {
#pragma unroll
                    for (int i = 0; i < 16; ++i) if (crow(i, hh) > r) x[i] = 0.f;
                }
#pragma unroll
                for (int s2 = 0; s2 < 2; ++s2) {
                    const bf16x8 pf = pack8(x, s2);
                    const int srow = 32 * st_ + 16 * s2 + 4 * hh + q4;
#pragma unroll
                    for (int vt = 0; vt < 2; ++vt) {
                        const LAS char* a = Vn + srow * HG_TS + (h * 64 + 32 * vt + 16 * blk) * 2 + 8 * p4;
                        const bf16x8 vf = cat4(ldtr(a), ldtr(a + 8 * HG_TS));
                        if (vt == 0) o0 = mfma32(vf, pf, o0); else o1 = mfma32(vf, pf, o1);
                    }
                }
            }
        }
        float ss = 0.f;
#pragma unroll
        for (int i = 0; i < 16; ++i) ss += o0[i] * o0[i] + o1[i] * o1[i];
        ss += swap32(ss);
        const float rstd = rsqrtf(ss * (1.f / 64.f) + EPS);
        bfu* yrow = YC + tok * 1024 + 768 + h * 64;
        const float* og = (const float*)(ws + WS_SP) + l * SP_STRIDE + SP_HGO + h * 64;
#pragma unroll
        for (int vt = 0; vt < 2; ++vt)
#pragma unroll
            for (int g = 0; g < 4; ++g) {
                const int v0 = 32 * vt + 8 * g + 4 * hh;
                const u32x2 raw = graw[vt][g];
                const f32x4 gn = *(const f32x4*)(og + v0);
                f32x4 gg; gg[0] = siluf(bflo(raw[0])); gg[1] = siluf(bfhi(raw[0])); gg[2] = siluf(bflo(raw[1])); gg[3] = siluf(bfhi(raw[1]));
                f32x4 ov;
#pragma unroll
                for (int i = 0; i < 4; ++i) ov[i] = (vt == 0 ? o0[4 * g + i] : o1[4 * g + i]) * rstd * gn[i] * gg[i];
                *(u32x2*)(yrow + v0) = pack4(ov);
            }
    }
}

DI void ins16(float (&a)[16], float v) {
#pragma unroll
    for (int j = 15; j >= 1; --j) a[j] = __builtin_amdgcn_fmed3f(a[j - 1], a[j], v);
    a[0] = fmaxf(a[0], v);
}
DI void peer_topk_phase(const Params& p, int l, LAS char* smem, int wv) {
    int tid = mk_tid(wv); smem = opql(smem);
    const int w = tid >> 6, lane = tid & 63, r = lane & 31, hh = lane >> 5;
    unsigned char* ws = opq(p.ws);
    const bfu* PQ = (const bfu*)(ws + WS_PQ);
    const bfu* SK = (const bfu*)(ws + WS_W + (size_t)l * WL_SIZE + WL_SK);
    unsigned short* IDS = (unsigned short*)(ws + WS_IDS); float* GATE = (float*)(ws + WS_GATE);
    for (int u = blockIdx.x; u < T / 32; u += gridDim.x) {
        const size_t tok = (size_t)u * 32 + r;
        float lst[2][16];
        bf16x8 qf[2][4];
#pragma unroll
        for (int pp = 0; pp < 2; ++pp)
#pragma unroll
            for (int ks = 0; ks < 4; ++ks) qf[pp][ks] = *(const bf16x8*)(PQ + tok * 1024 + w * 128 + pp * 64 + 16 * ks + 8 * hh);
        const bfu* skb = SK + ((size_t)(w * 2) * 128 + r) * 64 + 8 * hh;
        bf16x8 af[2][4];
#pragma unroll
        for (int ks = 0; ks < 4; ++ks) af[0][ks] = *(const bf16x8*)(skb + 16 * ks);
        float a[16];
#pragma unroll
        for (int st = 0; st < 8; ++st) {
            const int pp = st >> 2, kt = st & 3;
            if (kt == 0) {
#pragma unroll
                for (int j = 0; j < 16; ++j) a[j] = -3.0e38f;
            }
            f32x16 acc = zero16();
#pragma unroll
            for (int ks = 0; ks < 4; ++ks) acc = mfma32(af[st & 1][ks], qf[pp][ks], acc);
            if (st < 7) {
                const int np = (st + 1) >> 2, nk = (st + 1) & 3;
#pragma unroll
                for (int ks = 0; ks < 4; ++ks) af[(st + 1) & 1][ks] = *(const bf16x8*)(skb + (size_t)np * 128 * 64 + (size_t)nk * 32 * 64 + 16 * ks);
            }
#pragma unroll
            for (int i = 0; i < 16; ++i) {
                const unsigned key = 32 * kt + (i & 3) + 8 * (i >> 2) + 4 * hh;
                ins16(a, __uint_as_float((__float_as_uint(acc[i]) & 0xffffff80u) | key));
            }
            if (kt == 3) {
                float ob[16];
#pragma unroll
                for (int j = 0; j < 16; ++j) ob[j] = swap32(a[j]);
#pragma unroll
                for (int j = 0; j < 16; ++j) ins16(a, ob[j]);
#pragma unroll
                for (int j = 0; j < 16; ++j) lst[pp][j] = a[j];
            }
        }
        float c[16];
#pragma unroll
        for (int j = 0; j < 16; ++j) c[j] = lst[0][0] + lst[1][j];
#pragma unroll
        for (int i = 1; i < 16; ++i)
#pragma unroll
            for (int j = 0; j < 16; ++j) if ((i + 1) * (j + 1) <= 16) ins16(c, lst[0][i] + lst[1][j]);
        const float thr = c[15], mx = c[0];
        float den = 0.f;
#pragma unroll
        for (int j = 0; j < 16; ++j) den += __expf(c[j] - mx);
        const float rden = 1.f / den;
        int cnt = 0;
        unsigned short* idp = IDS + tok * 128 + w * 16; float* gp = GATE + tok * 128 + w * 16;
        if (hh == 0) {
#pragma unroll
            for (int i = 0; i < 16; ++i)
#pragma unroll
                for (int j = 0; j < 16; ++j) if ((i + 1) * (j + 1) <= 16) {
                    const float s = lst[0][i] + lst[1][j];
                    if (s >= thr && cnt < 16) {
                        idp[cnt] = (unsigned short)((__float_as_uint(lst[0][i]) & 127u) * 128u + (__float_as_uint(lst[1][j]) & 127u));
                        gp[cnt] = __expf(s - mx) * rden;
                        ++cnt;
                    }
                }
            if (cnt < 16) {
#pragma unroll
                for (int k = 0; k < 16; ++k) if (k >= cnt) { idp[k] = 0; gp[k] = 0.f; }
            }
        }
    }
}

#ifndef PGQT
#define PGQT 512
#endif
constexpr int PGQ_TILE = PGQT, PGQ_ITEMS = T / PGQ_TILE;
constexpr int LDS_PGQ = 160 * 1024 - 64;
DI f32x2 fp8lo(unsigned w) { return __builtin_amdgcn_cvt_pk_f32_fp8(w, false); }
DI f32x2 fp8hi(unsigned w) { return __builtin_amdgcn_cvt_pk_f32_fp8(w, true); }
typedef _Float16 h2_t __attribute__((ext_vector_type(2)));
constexpr float PGV_CSCALE = 1024.f;
DI unsigned* pgq_counter(unsigned char* ws, int l, int ph, int slice) { return (unsigned*)(ws + WS_CTL + 16384) + ((l * 4 + ph) * 8 + slice) * 64; }
DI bool pgq_pop(unsigned char* ws, int l, int ph, int home, int& kdone, LAS int* bc, int tid, int& slice, int& tile) {
    __syncthreads();
    if (tid == 0) {
        int k = kdone, s = -1, ti = 0;
        while (k < 8) {
            s = (home + k) & 7;
            ti = (int)__hip_atomic_fetch_add(pgq_counter(ws, l, ph, s), 1u, __ATOMIC_RELAXED, __HIP_MEMORY_SCOPE_AGENT);
            if (ti < PGQ_ITEMS) break;
            ++k;
        }
        bc[0] = k < 8 ? s : -1; bc[1] = ti; bc[2] = k;
    }
    __syncthreads();
    slice = __builtin_amdgcn_readfirstlane(bc[0]); tile = __builtin_amdgcn_readfirstlane(bc[1]); kdone = __builtin_amdgcn_readfirstlane(bc[2]);
    return slice >= 0;
}
template <int CTRL> DI float dpp_perm(float v) { return __builtin_bit_cast(float, __builtin_amdgcn_update_dpp(0, __builtin_bit_cast(int, v), CTRL, 0xf, 0xf, false)); }
DI float sum8(float v) { v += dpp_perm<0xB1>(v); v += dpp_perm<0x4E>(v); v += dpp_perm<0x141>(v); return v; }

#ifndef PGVR
#define PGVR 16
#endif
constexpr int PGV_STRIDE = 129;
DI void peer_u_phase(const Params& p, int l, LAS char* smem, int wv, int qid = 0) {
    int tid = mk_tid(wv); smem = opql(smem);
    const int w = tid >> 6, lane = tid & 63, g = lane >> 3, j = lane & 7;
    unsigned char* ws = opq(p.ws);
    const bfu* XB = (const bfu*)(ws + WS_XB);
    const unsigned short* IDS = (const unsigned short*)(ws + WS_IDS);
    const GAS unsigned char* TU = (const GAS unsigned char*)(ws + WS_TABU + (size_t)l * NEXP * DM);
    const float* RSTF = (const float*)(ws + WS_RSTF);
    unsigned* PART = (unsigned*)(ws + WS_PROJ);
    const float* gn = (const float*)(ws + WS_SP) + l * SP_STRIDE + SP_NFF;
    LAS int* bc = (LAS int*)(smem + LDS_PGQ);
    LAS int* idl = (LAS int*)smem + w * (2 * 8 * PGV_STRIDE) + g * PGV_STRIDE;
    const int home = (int)xb_xcc_id() & 7;
    int kdone = 0, x, tile;
    while (pgq_pop(ws, l, qid, home, kdone, bc, tid, x, tile)) {
      u32x4 nids[2]; u32x2 nx[4]; float nrstd; f32x4 gv[4];
#define PGU_FETCH(tt) { _Pragma("unroll") for (int k = 0; k < 2; ++k) nids[k] = *(const u32x4*)(IDS + (size_t)(tt) * 128 + 16 * j + 8 * k); nrstd = RSTF[tt]; \
        _Pragma("unroll") for (int i = 0; i < 4; ++i) nx[i] = *(const u32x2*)(XB + (size_t)(tt) * DM + 32 * x + 4 * j + 256 * i); }
      PGU_FETCH(tile * PGQ_TILE + w * 8 + g)
#pragma unroll
      for (int i = 0; i < 4; ++i) gv[i] = *(const f32x4*)(gn + 256 * i + 32 * x + 4 * j);
      for (int sub = 0; sub < PGQ_TILE / 64; ++sub) {
        const int t = tile * PGQ_TILE + sub * 64 + w * 8 + g;
#pragma unroll
        for (int k = 0; k < 2; ++k)
#pragma unroll
            for (int c = 0; c < 4; ++c) { idl[16 * j + 8 * k + 2 * c] = (int)(nids[k][c] & 0xffffu); idl[16 * j + 8 * k + 2 * c + 1] = (int)(nids[k][c] >> 16); }
        const float rstd = nrstd;
        u32x2 xr[4];
#pragma unroll
        for (int i = 0; i < 4; ++i) xr[i] = nx[i];
        if (sub + 1 < PGQ_TILE / 64) PGU_FETCH(t + 64)
        f32x4 xf[4]; float am = 0.f;
#pragma unroll
        for (int i = 0; i < 4; ++i) { const u32x2 raw = xr[i];
            xf[i][0] = bflo(raw[0]) * rstd * gv[i][0]; xf[i][1] = bfhi(raw[0]) * rstd * gv[i][1]; xf[i][2] = bflo(raw[1]) * rstd * gv[i][2]; xf[i][3] = bfhi(raw[1]) * rstd * gv[i][3];
            am = fmaxf(am, fmaxf(fmaxf(fabsf(xf[i][0]), fabsf(xf[i][1])), fmaxf(fabsf(xf[i][2]), fabsf(xf[i][3])))); }
        am = fmaxf(am, dpp_perm<0xB1>(am)); am = fmaxf(am, dpp_perm<0x4E>(am)); am = fmaxf(am, dpp_perm<0x141>(am));
        const float qs = am > 0.f ? 127.f / am : 0.f, sx = am * (1.f / 127.f);
        unsigned xq[4];
#pragma unroll
        for (int i = 0; i < 4; ++i) xq[i] = pack_i8x4(xf[i][0] * qs, xf[i][1] * qs, xf[i][2] * qs, xf[i][3] * qs);
        const GAS unsigned char* tux = TU + (size_t)x * NEXP * 128;
        unsigned* prow = PART + ((size_t)x * T + t) * 64 + j;
        {
            u32x4 r[16];
#define PGU_ISSUE(k, e) { const unsigned off_ = (unsigned)idl[e] * 128u + 16u * (unsigned)j; r[k] = *(const GAS u32x4*)(tux + off_); }
#define PGU_DOT(k) { int di_ = 0; _Pragma("unroll") for (int i = 0; i < 4; ++i) di_ = __builtin_amdgcn_sdot4((int)r[k][i], (int)xq[i], di_, false); dk[(k) & 7] = di_; }
#define PGU_REDUCE(OUT) { int a_[4], b_[2]; \
                _Pragma("unroll") for (int m = 0; m < 4; ++m) { const int snd = lo4 ? dk[4 + m] : dk[m], kp = lo4 ? dk[m] : dk[4 + m]; a_[m] = kp + __builtin_amdgcn_update_dpp(0, snd, 0x141, 0xf, 0xf, false); } \
                _Pragma("unroll") for (int n = 0; n < 2; ++n) { const int snd = b2 ? a_[n] : a_[2 + n], kp = b2 ? a_[2 + n] : a_[n]; b_[n] = kp + __builtin_amdgcn_update_dpp(0, snd, 0x4E, 0xf, 0xf, false); } \
                { const int snd = b1 ? b_[0] : b_[1], kp = b1 ? b_[1] : b_[0]; OUT = (float)(kp + __builtin_amdgcn_update_dpp(0, snd, 0xB1, 0xf, 0xf, false)) * sx; } }
            const bool lo4 = j < 4, b2 = (j & 2) != 0, b1 = (j & 1) != 0;
            int dk[8];
#pragma unroll
            for (int k = 0; k < 16; ++k) PGU_ISSUE(k, k)
#pragma unroll 1
            for (int e0 = 0; e0 < 128; e0 += 16) {
                float p0, p1;
                if (e0 + 16 < 128) {
#pragma unroll
                    for (int k = 0; k < 8; ++k) { PGU_DOT(k) PGU_ISSUE(k, e0 + 16 + k) }
                    PGU_REDUCE(p0)
#pragma unroll
                    for (int k = 8; k < 16; ++k) { PGU_DOT(k) PGU_ISSUE(k, e0 + 16 + k) }
                    PGU_REDUCE(p1)
                } else {
#pragma unroll
                    for (int k = 0; k < 8; ++k) { PGU_DOT(k) }
                    PGU_REDUCE(p0)
#pragma unroll
                    for (int k = 8; k < 16; ++k) { PGU_DOT(k) }
                    PGU_REDUCE(p1)
                }
                { const h2_t hp = {(_Float16)p0, (_Float16)p1}; prow[e0 >> 1] = __builtin_bit_cast(unsigned, hp); }
            }
#undef PGU_DOT
#undef PGU_REDUCE
#undef PGU_ISSUE
        }
      }
    }
}
DI void peer_c_phase(const Params& p, int l, int wv) {
    int tid = mk_tid(wv);
    const int w = tid >> 6, lane = tid & 63;
    unsigned char* ws = opq(p.ws);
    const unsigned short* IDS = (const unsigned short*)(ws + WS_IDS); const float* GATE = (const float*)(ws + WS_GATE);
    const float* SCU = (const float*)(ws + WS_SCU) + l * NEXP; const float* SCV = (const float*)(ws + WS_SCV) + l * NEXP;
    const unsigned* PART = (const unsigned*)(ws + WS_PROJ); _Float16* COEF = (_Float16*)(ws + WS_COEF);
    for (int t0 = (blockIdx.x * 8 + w) * 4; t0 < T; t0 += gridDim.x * 8 * 4) {
        const int e0 = 16 * (lane >> 3) + (lane & 7);
        unsigned pr[4][8]; int id0[4], id1[4]; float g0[4], g1[4];
#pragma unroll
        for (int q = 0; q < 4; ++q) { const int t = t0 + q;
#pragma unroll
            for (int x = 0; x < 8; ++x) pr[q][x] = PART[((size_t)x * T + t) * 64 + lane];
            id0[q] = IDS[(size_t)t * 128 + e0]; id1[q] = IDS[(size_t)t * 128 + e0 + 8]; g0[q] = GATE[(size_t)t * 128 + e0]; g1[q] = GATE[(size_t)t * 128 + e0 + 8]; }
#pragma unroll
        for (int q = 0; q < 4; ++q) { const int t = t0 + q;
            f32x2 s = {0.f, 0.f};
#pragma unroll
            for (int x = 0; x < 8; ++x) { const h2_t hp = __builtin_bit_cast(h2_t, pr[q][x]); s.x += (float)hp.x; s.y += (float)hp.y; }
            COEF[(size_t)t * 128 + e0] = (_Float16)(geluf(s.x * SCU[id0[q]]) * g0[q] * SCV[id0[q]] * PGV_CSCALE);
            COEF[(size_t)t * 128 + e0 + 8] = (_Float16)(geluf(s.y * SCU[id1[q]]) * g1[q] * SCV[id1[q]] * PGV_CSCALE);
        }
    }
}

DI void peer_v_phase(const Params& p, int l, LAS char* smem, int wv, int qid = 1, bool dummy = false) {
    int tid = mk_tid(wv); smem = opql(smem);
    const int w = tid >> 6, lane = tid & 63, g = lane >> 3, j = lane & 7;
    unsigned char* ws = opq(p.ws);
    bfu* XB = (bfu*)(ws + WS_XB);
    bfu* XO = dummy ? (bfu*)(ws + WS_PQ) : XB;
    const unsigned short* IDS = (const unsigned short*)(ws + WS_IDS); const unsigned short* COEF = (const unsigned short*)(ws + WS_COEF);
    const GAS unsigned char* TV = (const GAS unsigned char*)(ws + WS_TABV + (size_t)l * NEXP * DM);
    float* SSP = dummy ? (float*)(ws + WS_GATE) : (float*)(ws + WS_SSP);
    LAS int* bc = (LAS int*)(smem + LDS_PGQ);
    LAS int* idl = (LAS int*)smem + w * (2 * 8 * PGV_STRIDE) + g * PGV_STRIDE;
    LAS float* cfl = (LAS float*)idl + 8 * PGV_STRIDE;
    const int home = (int)xb_xcc_id() & 7;
    int kdone = 0, x, tile;
    while (pgq_pop(ws, l, qid, home, kdone, bc, tid, x, tile)) {
      u32x4 nids[2], ncf[2]; u32x2 nx[4];
#define PGV_FETCH(tt) { _Pragma("unroll") for (int k = 0; k < 2; ++k) { nids[k] = *(const u32x4*)(IDS + (size_t)(tt) * 128 + 16 * j + 8 * k); ncf[k] = *(const u32x4*)(COEF + (size_t)(tt) * 128 + 16 * j + 8 * k); } \
        _Pragma("unroll") for (int i = 0; i < 4; ++i) nx[i] = *(const u32x2*)(XB + (size_t)(tt) * DM + 32 * x + 4 * j + 256 * i); }
      PGV_FETCH(tile * PGQ_TILE + w * 8 + g)
      for (int sub = 0; sub < PGQ_TILE / 64; ++sub) {
        const int t = tile * PGQ_TILE + sub * 64 + w * 8 + g;
#pragma unroll
        for (int k = 0; k < 2; ++k)
#pragma unroll
            for (int c = 0; c < 4; ++c) { const unsigned iw = nids[k][c], cw = ncf[k][c];
                idl[16 * j + 8 * k + 2 * c] = (int)(iw & 0xffffu); idl[16 * j + 8 * k + 2 * c + 1] = (int)(iw >> 16);
                cfl[16 * j + 8 * k + 2 * c] = __uint_as_float((cw & 0xffffu) | (cw << 16)); cfl[16 * j + 8 * k + 2 * c + 1] = __uint_as_float((cw >> 16) | (cw & 0xffff0000u)); }
        u32x2 xold[4];
#pragma unroll
        for (int i = 0; i < 4; ++i) xold[i] = nx[i];
        if (sub + 1 < PGQ_TILE / 64) PGV_FETCH(t + 64)
        h2_t acc[8];
#pragma unroll
        for (int c = 0; c < 8; ++c) acc[c] = (h2_t){(_Float16)0.f, (_Float16)0.f};
        const GAS unsigned char* tvx = TV + (size_t)x * NEXP * 128;
        {
            u32x4 r[PGVR]; float cf[PGVR];
#define PGV_ISSUE(k, e) { const unsigned off_ = (unsigned)idl[e] * 128u + 16u * (unsigned)j; cf[k] = cfl[e]; r[k] = *(const GAS u32x4*)(tvx + off_); }
#define PGV_USE(k) { const h2_t c2 = __builtin_bit_cast(h2_t, cf[k]); _Pragma("unroll") for (int i = 0; i < 4; ++i) { const unsigned wd = r[k][i]; \
                acc[2 * i] = __builtin_elementwise_fma(c2, __builtin_bit_cast(h2_t, __builtin_amdgcn_cvt_scalef32_pk_f16_fp8(wd, 1.0f, false)), acc[2 * i]); \
                acc[2 * i + 1] = __builtin_elementwise_fma(c2, __builtin_bit_cast(h2_t, __builtin_amdgcn_cvt_scalef32_pk_f16_fp8(wd, 1.0f, true)), acc[2 * i + 1]); } }
#pragma unroll
            for (int k = 0; k < PGVR; ++k) PGV_ISSUE(k, k)
            for (int e0 = PGVR; e0 < 128; e0 += PGVR) {
#pragma unroll
                for (int k = 0; k < PGVR; ++k) { PGV_USE(k) PGV_ISSUE(k, e0 + k) }
            }
#pragma unroll
            for (int k = 0; k < PGVR; ++k) PGV_USE(k)
#undef PGV_ISSUE
#undef PGV_USE
#undef PGV_FETCH
        }
        bfu* xrow = XO + (size_t)t * DM + 32 * x + 4 * j;
        float s2 = 0.f;
#pragma unroll
        for (int i = 0; i < 4; ++i) {
            u32x2* px = (u32x2*)(xrow + 256 * i); const u32x2 old = xold[i];
            const float us = 1.f / PGV_CSCALE;
            const float y0 = bflo(old[0]) + (float)acc[2 * i].x * us, y1 = bfhi(old[0]) + (float)acc[2 * i].y * us, y2 = bflo(old[1]) + (float)acc[2 * i + 1].x * us, y3 = bfhi(old[1]) + (float)acc[2 * i + 1].y * us;
            u32x2 o; o[0] = pk2(y0, y1); o[1] = pk2(y2, y3); *px = o;
            const float z0 = bflo(o[0]), z1 = bfhi(o[0]), z2 = bflo(o[1]), z3 = bfhi(o[1]);
            s2 += z0 * z0 + z1 * z1 + z2 * z2 + z3 * z3;
        }
        s2 = sum8(s2);
        if (j == 0) SSP[(size_t)t * 8 + x] = s2;
      }
    }
}

DI void final_norm_phase(const Params& p, int wv) {
    int tid = mk_tid(wv);
    const int w = tid >> 6, lane = tid & 63;
    unsigned char* ws = opq(p.ws);
    const bfu* XB = (const bfu*)(ws + WS_XB); const float* SSP = (const float*)(ws + WS_SSP);
    const float* gfin = (const float*)(ws + WS_SP) + SP_FIN;
    f32x4 g[4];
#pragma unroll
    for (int i = 0; i < 4; ++i) g[i] = *(const f32x4*)(gfin + 256 * i + 4 * lane);
    for (int t0 = (blockIdx.x * 8 + w) * 4; t0 < T; t0 += gridDim.x * 8 * 4) {
        f32x4 q0[4], q1[4]; u32x2 raw[4][4];
#pragma unroll
        for (int q = 0; q < 4; ++q) { const int t = t0 + q; q0[q] = *(const f32x4*)(SSP + (size_t)t * 8); q1[q] = *(const f32x4*)(SSP + (size_t)t * 8 + 4);
#pragma unroll
            for (int i = 0; i < 4; ++i) raw[q][i] = *(const u32x2*)(XB + (size_t)t * DM + 256 * i + 4 * lane); }
#pragma unroll
        for (int q = 0; q < 4; ++q) { const int t = t0 + q;
            const float r2 = rsqrtf((((q0[q][0] + q0[q][1]) + (q0[q][2] + q0[q][3])) + ((q1[q][0] + q1[q][1]) + (q1[q][2] + q1[q][3]))) * (1.f / DM) + EPS);
            float* orow = p.out + (size_t)t * DM;
#pragma unroll
            for (int i = 0; i < 4; ++i) {
                f32x4 o; o[0] = bflo(raw[q][i][0]) * r2 * g[i][0]; o[1] = bfhi(raw[q][i][0]) * r2 * g[i][1]; o[2] = bflo(raw[q][i][1]) * r2 * g[i][2]; o[3] = bfhi(raw[q][i][1]) * r2 * g[i][3];
                *(f32x4*)(orow + 256 * i + 4 * lane) = o; }
        }
    }
}

constexpr int PPL = 10, NPH = 2 + PPL * NL;
__global__ void __launch_bounds__(512, 2) hymba_fwd(Params p) {
    extern __shared__ __attribute__((aligned(16))) char smem_raw[];
    LAS char* smem0 = (LAS char*)smem_raw;
    const int wv = __builtin_amdgcn_readfirstlane((int)(threadIdx.x >> 6));
    if (mk_tid(wv) < 4) ((LAS unsigned*)(smem0 + LDS_BAR))[mk_tid(wv)] = 0u;
    __syncthreads();
    XcdBarrier bar = xcd_barrier_post((unsigned*)(p.ws + WS_CTL), (volatile LAS unsigned*)(smem0 + LDS_BAR), wv);
#define IN(k) true
#ifdef REP_BAR
#define SEAM(k) do { xcd_barrier(bar); xcd_barrier(bar); } while (0)
#else
#define SEAM(k) xcd_barrier(bar)
#endif
#define PHASE_HDR const int G = opqi((int)gridDim.x), bid = opqi((int)blockIdx.x); LAS char* smem = opql(smem0); LAS unsigned char* smemu = (LAS unsigned char*)smem; unsigned char* ws = opq(p.ws); \
        const unsigned char* wl = ws + WS_W + (size_t)l * WL_SIZE; const float* ct = (const float*)(ws + WS_COS); const float* st = (const float*)(ws + WS_SIN); (void)wl; (void)ct; (void)st; (void)G; (void)bid; (void)smemu;
    if (IN(0)) { phase_prologue(p, smem0, wv);
#ifdef REP_PRO
        __syncthreads(); phase_prologue(p, smem0, wv);
#endif
    }
    SEAM(0);
#pragma unroll 1
    for (int l_ = 0; l_ < NL; ++l_) {
        const int l = opqi(l_);
        const int pb = 1 + PPL * l; (void)pb;
        if (IN(pb + 0)) {
            PHASE_HDR
            EpiProj e{(const float*)(ws + WS_SSP), (bfu*)(ws + WS_PROJ), ct, st};
            XSched s{8, 128 * 8, G, bid, wv};
            gemm_phase(smemu, Gemm{(const bfu*)(ws + WS_XB), (const bfu*)(wl + WL_IN), 1024, 1024, 1024}, s, e);
#ifdef REP_G1
            __syncthreads(); gemm_phase(smemu, Gemm{(const bfu*)(ws + WS_XB), (const bfu*)(wl + WL_IN), 1024, 1024, 1024}, s, e);
#endif
        }
        SEAM(pb + 0);
        if (IN(pb + 1)) {
            PHASE_HDR
#ifdef REP_G2
            for (int rep = 0; rep < 2; ++rep)
#endif
            {
            {
                XSched s{3, 128 * 3, G, bid, wv};
                Unit u; __syncthreads();
                for (int i = 0; s.next(i, u); ++i) rows_rstd_lds<256>((const bfu*)(ws + WS_PROJ) + PC_CQ, PW, u.pm * 256, (LAS float*)(smem + LDS_RS) + i * 256, wv);
                __syncthreads();
#ifdef REP_G2A
                for (int i = 0; s.next(i, u); ++i) rows_rstd_lds<256>((const bfu*)(ws + WS_PROJ) + PC_CQ, PW, u.pm * 256, (LAS float*)(smem + LDS_RS) + i * 256, wv);
                __syncthreads();
#endif
                EpiScaled<true> e{(const LAS float*)(smem + LDS_RS), (bfu*)(ws + WS_Q), 768, ct, st, 0.10206207261596577f * 1.4426950408889634f};
                gemm_phase(smemu, Gemm{(const bfu*)(ws + WS_PROJ) + PC_CQ, (const bfu*)(wl + WL_UQ), PW, 256, 256}, s, e);
#ifdef REP_G2Q
                __syncthreads(); gemm_phase(smemu, Gemm{(const bfu*)(ws + WS_PROJ) + PC_CQ, (const bfu*)(wl + WL_UQ), PW, 256, 256}, s, e);
#endif
            }
            {
                XSched s{4, 128 * 4, G, (bid + 128) % G, wv};
                Unit u; __syncthreads();
                for (int i = 0; s.next(i, u); ++i) rows_rstd_lds<128>((const bfu*)(ws + WS_PROJ) + PC_CKV, PW, u.pm * 256, (LAS float*)(smem + LDS_RS) + i * 256, wv);
                __syncthreads();
#ifdef REP_G2A
                for (int i = 0; s.next(i, u); ++i) rows_rstd_lds<128>((const bfu*)(ws + WS_PROJ) + PC_CKV, PW, u.pm * 256, (LAS float*)(smem + LDS_RS) + i * 256, wv);
                __syncthreads();
#endif
                EpiScaled<false> e{(const LAS float*)(smem + LDS_RS), (bfu*)(ws + WS_KV), 1024, ct, st, 1.f};
                gemm_phase(smemu, Gemm{(const bfu*)(ws + WS_PROJ) + PC_CKV, (const bfu*)(wl + WL_UKV), PW, 256, 256}, s, e);
#ifdef REP_G2K
                __syncthreads(); gemm_phase(smemu, Gemm{(const bfu*)(ws + WS_PROJ) + PC_CKV, (const bfu*)(wl + WL_UKV), PW, 256, 256}, s, e);
#endif
            }
            }
            gmlp_phase(p, l, smem0, wv);
#ifdef REP_GM
            gmlp_phase(p, l, smem0, wv);
#endif
            hg_local_phase(p, l, smem0, wv);
#ifdef REP_H1
            hg_local_phase(p, l, smem0, wv);
#endif
        }
        SEAM(pb + 1);
        if (IN(pb + 2)) { attn_phase(p, l, smem0, wv);
#ifdef REP_ATT
            attn_phase(p, l, smem0, wv);
#endif
            hg_prefix_phase(p, wv); }
        SEAM(pb + 2);
        if (IN(pb + 3)) { hg_out_phase(p, l, smem0, wv);
#ifdef REP_H3
            hg_out_phase(p, l, smem0, wv);
#endif
        }
        SEAM(pb + 3);
        if (IN(pb + 4)) {
            PHASE_HDR
#ifdef REP_G3
            EpiResid e{(bfu*)(ws + WS_XB), (bfu*)(ws + WS_XB)};
            XSched s{4, 128 * 4, G, bid, wv};
            __syncthreads();
            { EpiResid e2{(bfu*)(ws + WS_XB), (bfu*)(ws + WS_PQ)}; gemm_phase(smemu, Gemm{(const bfu*)(ws + WS_YCAT), (const bfu*)(wl + WL_OUT), 1024, 1024, 1024}, s, e2); __syncthreads(); }
#else
            EpiResid e{(bfu*)(ws + WS_XB)};
            XSched s{4, 128 * 4, G, bid, wv};
            __syncthreads();
#endif
            gemm_phase(smemu, Gemm{(const bfu*)(ws + WS_YCAT), (const bfu*)(wl + WL_OUT), 1024, 1024, 1024}, s, e);
        }
        SEAM(pb + 4);
        if (IN(pb + 5)) {
            PHASE_HDR
            XSched s{4, 128 * 4, G, bid, wv};
            Unit u; __syncthreads();
            for (int i = 0; s.next(i, u); ++i) rows_rstd_lds<1024>((const bfu*)(ws + WS_XB), DM, u.pm * 256, (LAS float*)(smem + LDS_RS) + i * 256, wv, (float*)(ws + WS_RSTF));
            __syncthreads();
            EpiScaled<false> e{(const LAS float*)(smem + LDS_RS), (bfu*)(ws + WS_PQ), 1024, ct, st, 1.f};
            gemm_phase(smemu, Gemm{(const bfu*)(ws + WS_XB), (const bfu*)(wl + WL_Q), 1024, 1024, 1024}, s, e);
#ifdef REP_G4
            __syncthreads(); gemm_phase(smemu, Gemm{(const bfu*)(ws + WS_XB), (const bfu*)(wl + WL_Q), 1024, 1024, 1024}, s, e);
#endif
        }
        SEAM(pb + 5);
        if (IN(pb + 6)) { peer_topk_phase(p, l, smem0, wv);
#ifdef REP_PK
            peer_topk_phase(p, l, smem0, wv);
#endif
        }
        SEAM(pb + 6);
        if (IN(pb + 7)) { peer_u_phase(p, l, smem0, wv);
#ifdef REP_PU
            __syncthreads(); peer_u_phase(p, l, smem0, wv, 2);
#endif
        }
        SEAM(pb + 7);
        if (IN(pb + 8)) { peer_c_phase(p, l, wv);
#ifdef REP_PC
            peer_c_phase(p, l, wv);
#endif
        }
        SEAM(pb + 8);
        if (IN(pb + 9)) {
#ifdef REP_PV
            peer_v_phase(p, l, smem0, wv, 3, true); __syncthreads();
#endif
            peer_v_phase(p, l, smem0, wv); }
        SEAM(pb + 9);
    }
    if (IN(NPH - 1)) { final_norm_phase(p, wv);
#ifdef REP_FIN
        final_norm_phase(p, wv);
#endif
    }
#undef PHASE_HDR
#undef IN
#undef SEAM
}

extern "C" void kernel_launch(void* const* d_in, const int* in_sizes, int n_in, void* d_out, int out_size, void* d_ws, size_t ws_size, hipStream_t stream) {
    static int grid = 0;
    if (grid == 0) {
        if (n_in != 22 || in_sizes[0] != T * DM || out_size != T * DM || ws_size < WS_END) {
            fprintf(stderr, "kernel_launch: unexpected shapes (n_in %d, in0 %d, out %d, ws %zu, need %zu)\n", n_in, n_in > 0 ? in_sizes[0] : -1, out_size, ws_size, (size_t)WS_END); grid = -1; return; }
        int dev = 0, cus = 0, per_cu = 0;
        if (hipGetDevice(&dev) != hipSuccess || hipDeviceGetAttribute(&cus, hipDeviceAttributeMultiprocessorCount, dev) != hipSuccess) { grid = -1; return; }
        if (hipFuncSetAttribute((const void*)hymba_fwd, hipFuncAttributeMaxDynamicSharedMemorySize, LDS_TOTAL) != hipSuccess) { fprintf(stderr, "kernel_launch: hipFuncSetAttribute failed\n"); grid = -1; return; }
        if (hipOccupancyMaxActiveBlocksPerMultiprocessor(&per_cu, (const void*)hymba_fwd, 512, LDS_TOTAL) != hipSuccess || per_cu < 1) fprintf(stderr, "kernel_launch: occupancy query says %d\n", per_cu);
        (void)hipGetLastError();
        grid = cus;
    }
    if (grid < 0) return;
    (void)hipMemsetAsync((char*)d_ws + WS_CTL, 0, 65536, stream);
    Params p{};
    p.x = (const float*)d_in[0]; p.pos = (const int*)d_in[1]; p.norm_mix = (const float*)d_in[2]; p.w_in = (const float*)d_in[3]; p.gm_v_norm = (const float*)d_in[4];
    p.gm_ws = (const float*)d_in[5]; p.gm_b = (const float*)d_in[6]; p.gm_out_norm = (const float*)d_in[7]; p.mla_q_norm = (const float*)d_in[8]; p.mla_w_uq = (const float*)d_in[9];
    p.mla_kv_norm = (const float*)d_in[10]; p.mla_w_ukv = (const float*)d_in[11]; p.mla_out_norm = (const float*)d_in[12]; p.hg_lb_logits = (const float*)d_in[13];
    p.hg_out_norm = (const float*)d_in[14]; p.w_out = (const float*)d_in[15]; p.norm_ffn = (const float*)d_in[16]; p.peer_w_q = (const float*)d_in[17];
    p.peer_sub_keys = (const float*)d_in[18]; p.peer_u = (const float*)d_in[19]; p.peer_v = (const float*)d_in[20]; p.norm_final = (const float*)d_in[21];
    p.out = (float*)d_out; p.ws = (unsigned char*)d_ws;
    hipLaunchKernelGGL(hymba_fwd, dim3(grid), dim3(512), LDS_TOTAL, stream, p);
}
```

```cpp
#include <hip/hip_runtime.h>
#include <cstdio>
#include <cstdint>
#include <cmath>
#include <type_traits>

constexpr int T = 32768, DM = 1024, NL = 4, SEQ = 2048;
constexpr int PW = 2048;
constexpr int PC_U = 0, PC_V = 256, PC_CQ = 512, PC_CKV = 768, PC_KR = 896, PC_HQ = 1024, PC_HF = 1280, PC_HI = 1536, PC_HG = 1792;
constexpr int NEXP = 16384;
constexpr float EPS = 1e-6f;

typedef unsigned short bfu;
typedef __attribute__((ext_vector_type(8))) short bf16x8;
typedef __attribute__((ext_vector_type(4))) short s16x4;
typedef __attribute__((ext_vector_type(4))) float f32x4;
typedef __attribute__((ext_vector_type(16))) float f32x16;
typedef __attribute__((ext_vector_type(2))) __bf16 bf2_t;
typedef __attribute__((ext_vector_type(2))) float f2_t;
typedef __attribute__((ext_vector_type(4))) unsigned u32x4;
typedef __attribute__((ext_vector_type(2))) unsigned u32x2;
typedef short v4i16_t __attribute__((ext_vector_type(4)));
#define DI __device__ __forceinline__
#define LAS __attribute__((address_space(3)))
#define GAS __attribute__((address_space(1)))

DI float bf2f(bfu v) { return __uint_as_float((unsigned)v << 16); }
DI float bflo(unsigned u) { return __uint_as_float(u << 16); }
DI float bfhi(unsigned u) { return __uint_as_float(u & 0xffff0000u); }
DI unsigned pk2(float a, float b) { f2_t v = {a, b}; bf2_t r = __builtin_convertvector(v, bf2_t); return __builtin_bit_cast(unsigned, r); }
DI bfu f2bf(float a) { return (bfu)(pk2(a, 0.f) & 0xffffu); }
DI f32x16 mfma32(bf16x8 a, bf16x8 b, f32x16 c) { return __builtin_amdgcn_mfma_f32_32x32x16_bf16(a, b, c, 0, 0, 0); }
DI int crow(int r, int hi) { return (r & 3) + 8 * (r >> 2) + 4 * hi; }
DI f32x16 zero16() { f32x16 z; for (int i = 0; i < 16; ++i) z[i] = 0.f; return z; }
DI bf16x8 pack8(const f32x16& x, int s) {
    u32x4 p; p[0] = pk2(x[8 * s], x[8 * s + 1]); p[1] = pk2(x[8 * s + 2], x[8 * s + 3]); p[2] = pk2(x[8 * s + 4], x[8 * s + 5]); p[3] = pk2(x[8 * s + 6], x[8 * s + 7]);
    return __builtin_bit_cast(bf16x8, p);
}
DI float swap32(float v) { return __shfl_xor(v, 32); }
DI float xmax32(float v) { const unsigned u = __builtin_bit_cast(unsigned, v); const auto r = __builtin_amdgcn_permlane32_swap(u, u, false, false);
    return __builtin_amdgcn_fmed3f(__builtin_bit_cast(float, (unsigned)r[0]), __builtin_bit_cast(float, (unsigned)r[1]), __builtin_inff()); }
DI void store_row64_wide(bfu* row, const u32x2 (&pk)[2][4], int hh) {
#pragma unroll
    for (int vt = 0; vt < 2; ++vt)
#pragma unroll
        for (int g = 0; g < 4; g += 2) {
            const auto r0 = __builtin_amdgcn_permlane32_swap(pk[vt][g][0], pk[vt][g + 1][0], false, false);
            const auto r1 = __builtin_amdgcn_permlane32_swap(pk[vt][g][1], pk[vt][g + 1][1], false, false);
            u32x4 w4; w4[0] = r0[0]; w4[1] = r1[0]; w4[2] = r0[1]; w4[3] = r1[1];
            *(u32x4*)(row + 32 * vt + 8 * g + 8 * hh) = w4;
        }
}
DI float xsum32(float v) { const unsigned u = __builtin_bit_cast(unsigned, v); const auto r = __builtin_amdgcn_permlane32_swap(u, u, false, false);
    return __builtin_bit_cast(float, (unsigned)r[0]) + __builtin_bit_cast(float, (unsigned)r[1]); }
DI float wave_sum(float v) {
    v += __shfl_xor(v, 1); v += __shfl_xor(v, 2); v += __shfl_xor(v, 4); v += __shfl_xor(v, 8); v += __shfl_xor(v, 16); v += __shfl_xor(v, 32); return v;
}
template <int CTRL> DI float dpp_permf(float v) { return __builtin_bit_cast(float, __builtin_amdgcn_update_dpp(0, __builtin_bit_cast(int, v), CTRL, 0xf, 0xf, false)); }
DI float sum16(float v) { v += dpp_permf<0xB1>(v); v += dpp_permf<0x4E>(v); v += dpp_permf<0x141>(v); v += dpp_permf<0x140>(v); return v; }
DI float swap32p(float v, bool up) { const unsigned u = __builtin_bit_cast(unsigned, v); const auto r = __builtin_amdgcn_permlane32_swap(u, u, false, false);
    return __builtin_bit_cast(float, up ? (unsigned)r[0] : (unsigned)r[1]); }
DI float fast_exp(float x) { return __expf(x); }
DI float sigmoidf(float x) { return __builtin_amdgcn_rcpf(1.f + __expf(-x)); }
DI float geluf(float x) { const float u = 1.5957691216057308f * (x + 0.044715f * x * x * x); return x * __builtin_amdgcn_rcpf(1.f + __expf(-u)); }
DI float siluf(float x) { return x * __builtin_amdgcn_rcpf(1.f + __expf(-x)); }
DI s16x4 ldtr(const LAS char* p) { return __builtin_bit_cast(s16x4, __builtin_amdgcn_ds_read_tr16_b64_v4i16((LAS v4i16_t*)p)); }
DI bf16x8 cat4(s16x4 a, s16x4 b) { return __builtin_shufflevector(a, b, 0, 1, 2, 3, 4, 5, 6, 7); }
DI int mk_tid(int wv) { int ln; asm volatile("v_mbcnt_lo_u32_b32 %0, -1, 0\n\tv_mbcnt_hi_u32_b32 %0, -1, %0" : "=v"(ln)); return wv * 64 + ln; }
DI unsigned char* opq(unsigned char* q) { GAS unsigned char* g = (GAS unsigned char*)q; asm volatile("" : "+s"(g)); return (unsigned char*)g; }
DI LAS char* opql(LAS char* q) { unsigned v = (unsigned)(size_t)q; asm volatile("" : "+s"(v)); return (LAS char*)(size_t)v; }
DI int opqi(int v) { asm volatile("" : "+s"(v)); return v; }
DI f32x4 zero4_opaque() { float z; asm volatile("v_mov_b32 %0, 0" : "=v"(z)); return (f32x4){z, z, z, z}; }
DI float dot2u(unsigned a, unsigned b, float c) { return __builtin_amdgcn_fdot2_f32_bf16(__builtin_bit_cast(bf2_t, a), __builtin_bit_cast(bf2_t, b), c, false); }
typedef __attribute__((ext_vector_type(2))) float f32x2;
template <int CTRL, int ROWMASK> DI float dpp_get(float v) { return __builtin_bit_cast(float, __builtin_amdgcn_update_dpp(0, __builtin_bit_cast(int, v), CTRL, ROWMASK, 0xf, false)); }
DI float dpp_sum63(float v) {
    v += dpp_get<0x111, 0xf>(v); v += dpp_get<0x112, 0xf>(v); v += dpp_get<0x114, 0xf>(v); v += dpp_get<0x118, 0xf>(v);
    v += dpp_get<0x142, 0xa>(v); v += dpp_get<0x143, 0xc>(v); return v;
}
DI float dpp_max63(float v) {
    v = fmaxf(v, dpp_get<0x111, 0xf>(v)); v = fmaxf(v, dpp_get<0x112, 0xf>(v)); v = fmaxf(v, dpp_get<0x114, 0xf>(v)); v = fmaxf(v, dpp_get<0x118, 0xf>(v));
    v = fmaxf(v, dpp_get<0x142, 0xa>(v)); v = fmaxf(v, dpp_get<0x143, 0xc>(v)); return v;
}
DI float rdlane_f(float v, int l) { return __builtin_bit_cast(float, __builtin_amdgcn_readlane(__builtin_bit_cast(int, v), l)); }
DI unsigned pack_i8x4(float a, float b, float c, float d) {
    const int q0 = (int)__builtin_rintf(fminf(fmaxf(a, -127.f), 127.f)), q1 = (int)__builtin_rintf(fminf(fmaxf(b, -127.f), 127.f));
    const int q2 = (int)__builtin_rintf(fminf(fmaxf(c, -127.f), 127.f)), q3 = (int)__builtin_rintf(fminf(fmaxf(d, -127.f), 127.f));
    return (unsigned)(q0 & 0xff) | ((unsigned)(q1 & 0xff) << 8) | ((unsigned)(q2 & 0xff) << 16) | ((unsigned)(q3 & 0xff) << 24);
}

constexpr size_t WS_CTL   = 0;
constexpr size_t WS_XB    = 65536;
constexpr size_t WS_PROJ  = WS_XB   + (size_t)T * DM * 2;
constexpr size_t WS_Q     = WS_PROJ + (size_t)T * PW * 2;
constexpr size_t WS_KV    = WS_Q    + (size_t)T * 768 * 2;
constexpr size_t WS_YCAT  = WS_KV   + (size_t)T * 1024 * 2;
constexpr size_t WS_PQ    = WS_YCAT + (size_t)T * 1024 * 2;
constexpr size_t WS_IDS   = WS_PQ   + (size_t)T * 1024 * 2;
constexpr size_t WS_GATE  = WS_IDS  + (size_t)T * 128 * 4;
constexpr size_t WS_HST   = WS_GATE + (size_t)T * 128 * 4;
constexpr size_t WS_HDEC  = WS_HST  + (size_t)2048 * 4096 * 4;
constexpr size_t WS_COS   = WS_HDEC + (size_t)512 * 256 * 4;
constexpr size_t WS_SIN   = WS_COS  + (size_t)T * 16 * 4;
constexpr size_t WS_SSP   = WS_SIN  + (size_t)T * 16 * 4;
constexpr size_t WS_RSTF  = WS_SSP  + (size_t)T * 8 * 4;
constexpr size_t WS_COEF  = WS_RSTF + (size_t)T * 4;
constexpr size_t WS_LB    = WS_COEF + (size_t)T * 128 * 4;
constexpr size_t WS_SP    = WS_LB   + 4096;
constexpr int SP_GMV = 0, SP_GMB = 256, SP_GMO = 768, SP_MLO = 1024, SP_HGO = 1536, SP_NFF = 1792, SP_STRIDE = 3072, SP_FIN = NL * SP_STRIDE;
constexpr size_t WS_W     = WS_SP   + (size_t)(SP_FIN + 1024) * 4;
constexpr size_t WL_IN    = 0;
constexpr size_t WL_UQ    = WL_IN  + (size_t)2048 * 1024 * 2;
constexpr size_t WL_UKV   = WL_UQ  + (size_t)768 * 256 * 2;
constexpr size_t WL_OUT   = WL_UKV + (size_t)1024 * 256 * 2;
constexpr size_t WL_Q     = WL_OUT + (size_t)1024 * 1024 * 2;
constexpr size_t WL_SK    = WL_Q   + (size_t)1024 * 1024 * 2;
constexpr size_t WL_GM    = WL_SK  + (size_t)16 * 128 * 64 * 2;
constexpr size_t WL_SIZE  = WL_GM  + (size_t)4 * 128 * 128 * 2;
constexpr size_t WS_TABU  = WS_W + NL * WL_SIZE;
constexpr size_t WS_TABV  = WS_TABU + (size_t)NL * NEXP * DM;
constexpr size_t WS_SCU   = WS_TABV + (size_t)NL * NEXP * DM;
constexpr size_t WS_SCV   = WS_SCU  + (size_t)NL * NEXP * 4;
constexpr size_t WS_END   = WS_SCV  + (size_t)NL * NEXP * 4;

struct Params {
    const float* x; const int* pos; const float* norm_mix; const float* w_in; const float* gm_v_norm; const float* gm_ws; const float* gm_b; const float* gm_out_norm;
    const float* mla_q_norm; const float* mla_w_uq; const float* mla_kv_norm; const float* mla_w_ukv; const float* mla_out_norm; const float* hg_lb_logits; const float* hg_out_norm;
    const float* w_out; const float* norm_ffn; const float* peer_w_q; const float* peer_sub_keys; const float* peer_u; const float* peer_v; const float* norm_final;
    float* out; unsigned char* ws;
};

#define XB_TMO      128
#define XB_XCNT(j)  (256  + 64 * (j))
#define XB_XSUB(j)  (1280 + 64 * (j))
#define XB_XGEN(j)  (2304 + 64 * (j))
#define XB_TOP      3328
#define XB_TOPGEN   3392
#define XCD_BAR_WORDS 3456
#define XB_SPIN_CAP (1u << 20)
DI unsigned xb_ld(unsigned* p)              { return __hip_atomic_load(p, __ATOMIC_RELAXED, __HIP_MEMORY_SCOPE_AGENT); }
DI unsigned xb_add(unsigned* p, unsigned v) { return __hip_atomic_fetch_add(p, v, __ATOMIC_RELAXED, __HIP_MEMORY_SCOPE_AGENT); }
DI unsigned xb_xcc_id() { return (unsigned)__builtin_amdgcn_s_getreg((3 << 11) | 20) & 0xFu; }
#define XB_SPIN(cond, bar) do { unsigned _sp = 0; while (cond) { __builtin_amdgcn_s_sleep(1); \
    if ((++_sp & 255u) == 0u) { if (xb_ld(&(bar)[XB_TMO])) break; if (_sp > XB_SPIN_CAP) { atomicAdd(&(bar)[XB_TMO], 1u); break; } } } } while (0)
struct XcdBarrier { unsigned* bar; unsigned x; volatile LAS unsigned* st; int wv; };
DI XcdBarrier xcd_barrier_post(unsigned* bar, volatile LAS unsigned* st, int wv) {
    XcdBarrier b; b.bar = bar; b.x = xb_xcc_id(); b.st = st; b.wv = wv;
    if (mk_tid(wv) == 0) (void)xb_add(&bar[XB_XCNT(b.x)], 1u);
    return b;
}
DI void xcd_barrier_complete(unsigned* bar, unsigned x, unsigned& nloc, unsigned& nx) {
    const unsigned G = gridDim.x * gridDim.y * gridDim.z;
    unsigned sum, cnt, mine, sp = 0u;
    for (;;) {
        sum = 0u; cnt = 0u; mine = 0u;
#pragma unroll
        for (unsigned j = 0; j < 16; ++j) { const unsigned c = xb_ld(&bar[XB_XCNT(j)]); sum += c; cnt += (c > 0u) ? 1u : 0u; }
        if (sum == G) { mine = xb_ld(&bar[XB_XCNT(x)]); break; }
        __builtin_amdgcn_s_sleep(1);
        if ((++sp & 255u) == 0u) { if (xb_ld(&bar[XB_TMO])) break; if (sp > XB_SPIN_CAP) { atomicAdd(&bar[XB_TMO], 1u); break; } }
    }
    nloc = mine > 0u ? mine : 1u; nx = cnt > 0u ? cnt : 1u;
}
DI void xcd_barrier(const XcdBarrier& b) {
    asm volatile("s_waitcnt vmcnt(0)" ::: "memory");
    __syncthreads();
    if (mk_tid(b.wv) == 0) {
        unsigned* bar = b.bar; unsigned bx = b.x;
        asm volatile("" : "+s"(bar), "+s"(bx));
        __builtin_amdgcn_s_waitcnt(0);
        unsigned nloc = b.st[0], nx = b.st[1];
        if (nloc == 0u) { xcd_barrier_complete(bar, bx, nloc, nx); b.st[0] = nloc; b.st[1] = nx; }
        const unsigned old = xb_add(&bar[XB_XSUB(bx)], 1u);
        const unsigned gen = old / nloc;
        if (old + 1u == (gen + 1u) * nloc) {
            __builtin_amdgcn_fence(__ATOMIC_RELEASE, "agent");
            asm volatile("s_waitcnt vmcnt(0)" ::: "memory");
            const unsigned og = xb_add(&bar[XB_TOP], 1u);
            const unsigned tg = og / nx;
            if (og + 1u == (tg + 1u) * nx) xb_add(&bar[XB_TOPGEN], 1u);
            else XB_SPIN(xb_ld(&bar[XB_TOPGEN]) == tg, bar);
            __builtin_amdgcn_fence(__ATOMIC_ACQUIRE, "agent");
            xb_add(&bar[XB_XGEN(bx)], 1u);
            asm volatile("s_waitcnt vmcnt(0)" ::: "memory");
        } else {
            XB_SPIN(xb_ld(&bar[XB_XGEN(bx)]) == gen, bar);
            __builtin_amdgcn_fence(__ATOMIC_ACQUIRE, "agent");
            asm volatile("s_waitcnt vmcnt(0)" ::: "memory");
        }
    }
    __syncthreads();
}

template <int MODE>
DI int srccol(int n) {
    if (MODE == 1) { return n < 928 ? n : (n < 1024 ? -1 : n - 96); }
    if (MODE == 2) { return n < 512 ? ((n >> 6) * 128 + (n & 63)) : (((n - 512) >> 6) * 128 + 64 + ((n - 512) & 63)); }
    return n;
}
template <int MODE>
DI void conv_tile(int t, const float* __restrict__ src, int ld_src, const float* __restrict__ gain, bfu* __restrict__ dst, int K, int n0, int k0, float* tile, int ksrc = 1 << 30) {
    float ld[8];
#pragma unroll
    for (int i = 0; i < 8; ++i) {
        const int kk = (t >> 6) + i * 8, nn = t & 63;
        const int sc = srccol<MODE>(n0 + nn);
        const int kr = k0 + kk < ksrc ? k0 + kk : 0;
        ld[i] = src[(size_t)kr * ld_src + (sc >= 0 ? sc : 0)] * (gain ? gain[kr] : 1.f);
    }
#pragma unroll
    for (int i = 0; i < 8; ++i) {
        const int kk = (t >> 6) + i * 8, nn = t & 63;
        const int sc = srccol<MODE>(n0 + nn);
        tile[kk * 65 + nn] = (sc >= 0 && k0 + kk < ksrc) ? ld[i] : 0.f;
    }
    __syncthreads();
#pragma unroll
    for (int i = 0; i < 8; ++i) {
        const int nn = (t >> 6) + i * 8, kk = t & 63;
        dst[(size_t)(n0 + nn) * K + k0 + kk] = f2bf(tile[kk * 65 + nn]);
    }
    __syncthreads();
}

DI void phase_prologue(const Params& p, LAS char* smem, int wv) {
    const int tid = mk_tid(wv), bid = blockIdx.x, nb = gridDim.x; smem = opql(smem);
    const int w = tid >> 6, lane = tid & 63;
    unsigned char* ws = opq(p.ws);
    {
        bfu* xb = (bfu*)(ws + WS_XB); float* ssp = (float*)(ws + WS_SSP);
        for (int t0 = (bid * 8 + w) * 8; t0 < T; t0 += nb * 8 * 8) {
            float4 xv[8][4];
#pragma unroll
            for (int q = 0; q < 8; ++q)
#pragma unroll
                for (int i = 0; i < 4; ++i) xv[q][i] = ((const float4*)(p.x + (size_t)(t0 + q) * DM))[i * 64 + lane];
#pragma unroll
            for (int q = 0; q < 8; ++q) { const int t = t0 + q;
                float ss = 0.f;
#pragma unroll
                for (int i = 0; i < 4; ++i) {
                    const float4 v = xv[q][i];
                    ss += v.x * v.x + v.y * v.y + v.z * v.z + v.w * v.w;
                    u32x2 o; o[0] = pk2(v.x, v.y); o[1] = pk2(v.z, v.w);
                    *(u32x2*)(xb + (size_t)t * DM + (i * 64 + lane) * 4) = o;
                }
                ss = rdlane_f(dpp_sum63(ss), 63);
                if (lane < 8) ssp[(size_t)t * 8 + lane] = lane == 0 ? ss : 0.f;
            }
        }
    }
#pragma unroll 1
    for (int step_ = 0; step_ < 2; ++step_) {
    if ((step_ == 0) != ((bid & 1) != 0)) {
    {
        float* tile = (float*)smem;
        for (int u = bid; u < NL * 1136; u += nb) {
            const int l = u / 1136; int r = u % 1136;
            unsigned char* wl = ws + WS_W + (size_t)l * WL_SIZE;
            if (r < 512) { conv_tile<1>(tid, p.w_in + (size_t)l * 1024 * 1952, 1952, p.norm_mix + l * 1024, (bfu*)(wl + WL_IN), 1024, (r >> 4) * 64, (r & 15) * 64, tile); continue; }
            r -= 512;
            if (r < 48) { conv_tile<0>(tid, p.mla_w_uq + (size_t)l * 256 * 768, 768, p.mla_q_norm + l * 256, (bfu*)(wl + WL_UQ), 256, (r >> 2) * 64, (r & 3) * 64, tile); continue; }
            r -= 48;
            if (r < 64) { conv_tile<2>(tid, p.mla_w_ukv + (size_t)l * 128 * 1024, 1024, p.mla_kv_norm + l * 128, (bfu*)(wl + WL_UKV), 256, (r >> 2) * 64, (r & 3) * 64, tile, 128); continue; }
            r -= 64;
            if (r < 256) { conv_tile<0>(tid, p.w_out + (size_t)l * 1024 * 1024, 1024, nullptr, (bfu*)(wl + WL_OUT), 1024, (r >> 4) * 64, (r & 15) * 64, tile); continue; }
            r -= 256;
            conv_tile<0>(tid, p.peer_w_q + (size_t)l * 1024 * 1024, 1024, p.norm_ffn + l * 1024, (bfu*)(wl + WL_Q), 1024, (r >> 4) * 64, (r & 15) * 64, tile);
        }
    }
    } else {
    {
        const int nrows = NL * NEXP;
        for (int rr0 = (bid * 8 + w) * 8; rr0 < 2 * nrows; rr0 += nb * 8 * 8) {
            f32x4 v[8][4];
#pragma unroll
            for (int q = 0; q < 8; ++q) { const int rr = rr0 + q; const int tab = rr >= nrows, row = tab ? rr - nrows : rr;
                const float* src = (tab ? p.peer_v : p.peer_u) + (size_t)row * DM;
#pragma unroll
                for (int i = 0; i < 4; ++i) v[q][i] = *(const f32x4*)(src + 256 * i + 4 * lane); }
#pragma unroll
            for (int q = 0; q < 8; ++q) { const int rr = rr0 + q; const int tab = rr >= nrows, row = tab ? rr - nrows : rr;
                float am = 0.f;
#pragma unroll
                for (int i = 0; i < 4; ++i) am = fmaxf(am, fmaxf(fmaxf(fabsf(v[q][i][0]), fabsf(v[q][i][1])), fmaxf(fabsf(v[q][i][2]), fabsf(v[q][i][3]))));
                am = rdlane_f(dpp_max63(am), 63);
                const bool i8 = !tab;
                const float qmax = i8 ? 127.f : 440.f;
                const float sc = am > 0.f ? qmax / am : 0.f;
                u32x4 o;
#pragma unroll
                for (int i = 0; i < 4; ++i) {
                    if (i8) o[i] = pack_i8x4(v[q][i][0] * sc, v[q][i][1] * sc, v[q][i][2] * sc, v[q][i][3] * sc);
                    else { int wd = 0; wd = __builtin_amdgcn_cvt_pk_fp8_f32(v[q][i][0] * sc, v[q][i][1] * sc, wd, false); wd = __builtin_amdgcn_cvt_pk_fp8_f32(v[q][i][2] * sc, v[q][i][3] * sc, wd, true); o[i] = (unsigned)wd; }
                }
                const int ly = row / NEXP, rw = row % NEXP;
                *(u32x4*)(ws + (tab ? WS_TABV : WS_TABU) + (size_t)ly * NEXP * DM + (size_t)(lane >> 3) * NEXP * 128 + (size_t)rw * 128 + 16 * (lane & 7)) = o;
                if (lane == 0) ((float*)(ws + (tab ? WS_SCV : WS_SCU)))[row] = am / qmax;
            }
        }
    }
    }
    }
    const size_t gtid = (size_t)bid * 512 + tid, gsz = (size_t)nb * 512;
    for (size_t e = gtid; e < (size_t)NL * 16 * 128 * 64; e += gsz) {
        const int l = (int)(e / (16 * 128 * 64)); const size_t r = e % (16 * 128 * 64);
        ((bfu*)(ws + WS_W + (size_t)l * WL_SIZE + WL_SK))[r] = f2bf(p.peer_sub_keys[e]);
    }
    for (size_t e = gtid; e < (size_t)NL * 4 * 128 * 128; e += gsz) {
        const int l = (int)(e / (4 * 128 * 128)); const size_t r = e % (4 * 128 * 128);
        const int tt = (int)((r >> 7) & 127), s = (int)(r & 127);
        ((bfu*)(ws + WS_W + (size_t)l * WL_SIZE + WL_GM))[r] = f2bf(s <= tt ? p.gm_ws[e] : 0.f);
    }
    {
        _Float16* rt = (_Float16*)(ws + WS_COS);
        for (size_t e = gtid; e < (size_t)T * 16; e += gsz) {
            const int t = (int)(e >> 4), i = (int)(e & 15);
            const float inv = expf(-9.210340371976184f * (float)i * (1.f / 16.f));
            const float ang = (float)p.pos[t] * inv;
            const float kq = rintf(ang * 0.15915494309189535f);
            float rr = fmaf(-kq, 6.2831854820251465f, ang); rr = fmaf(-kq, -1.7484555e-7f, rr);
            const size_t o = (size_t)t * 32 + (size_t)(i >> 3) * 16 + (i & 7);
            rt[o] = (_Float16)__cosf(rr); rt[o + 8] = (_Float16)__sinf(rr);
        }
    }
    {
        float* sp = (float*)(ws + WS_SP);
        for (int e = (int)gtid; e < NL * SP_STRIDE + 1024; e += (int)gsz) {
            float v = 0.f;
            if (e >= SP_FIN) v = p.norm_final[e - SP_FIN];
            else { const int l = e / SP_STRIDE, r = e % SP_STRIDE;
                if (r < SP_GMB) v = p.gm_v_norm[l * 256 + r];
                else if (r < SP_GMO) v = p.gm_b[l * 512 + r - SP_GMB];
                else if (r < SP_MLO) v = p.gm_out_norm[l * 256 + r - SP_GMO];
                else if (r < SP_HGO) v = p.mla_out_norm[l * 512 + r - SP_MLO];
                else if (r < SP_NFF) v = p.hg_out_norm[l * 256 + r - SP_HGO];
                else if (r < SP_NFF + 1024) v = p.norm_ffn[l * 1024 + r - SP_NFF]; }
            sp[e] = v;
        }
    }
    if (bid == 0 && tid < 256) {
        float lg[NL], mx = -1e30f;
#pragma unroll
        for (int l = 0; l < NL; ++l) { lg[l] = p.hg_lb_logits[l * 256 + tid]; mx = fmaxf(mx, lg[l]); }
        float sum = 0.f; for (int l = 0; l < NL; ++l) { lg[l] = expf(lg[l] - mx); sum += lg[l]; }
        float cum = 0.f; const float p0 = lg[0] / sum;
        for (int l = 0; l < NL; ++l) { cum += lg[l] / sum; ((float*)(ws + WS_LB))[l * 256 + tid] = cum - p0; }
    }
}

constexpr int BM = 256, BK = 64, HALF = 128, HTB = HALF * BK * 2, STAGE_BYTES = 8 * HTB;
constexpr int LDS_RS = STAGE_BYTES;
constexpr int LDS_TOTAL = 163840;
constexpr int LDS_BAR = LDS_TOTAL - 16;
DI int lds_byte(int r, int c) { const int st = (r >> 4) * 2 + (c >> 5), rr = r & 15, cc = c & 31, ob = rr * 64 + cc * 2; return st * 1024 + (ob ^ (((ob >> 9) & 1) << 5)); }
DI void stage_rc(int b, int& R, int& C) { const int st = b / 1024, sb = b % 1024, swz = sb ^ (((sb >> 9) & 1) << 5); R = (st >> 1) * 16 + swz / 64; C = (st & 1) * 32 + (swz % 64) / 2; }
DI int perm32(int rho) { const int n = rho >> 4, i = rho & 15; return 8 * (i >> 2) + 4 * n + (i & 3); }
struct Unit { int pm, pn, idx; };
struct Gemm { const bfu* A; const bfu* Bt; int lda, ldb, K; };
struct XSched {
    int nN, nunits, G, c, wv;
    DI bool next(int i, Unit& u) const { const int L = i * G + c; if (L >= nunits) return false; const int xcd = L & 7, slot = L >> 3; u.pm = (slot / nN) * 8 + xcd; u.pn = slot % nN; u.idx = i; return true; }
    DI void a_ready(const Unit&) const {}
    DI void done(const Unit&) const {}
};
template <class Epi, class Sched, bool STAMP = false>
DI void gemm_phase(LAS unsigned char* lds, const Gemm g, const Sched& S, const Epi& E, unsigned long long* stamps = nullptr) {
    int tid_ = mk_tid(S.wv);
    const int tid = tid_, wid = __builtin_amdgcn_readfirstlane(tid >> 6), lane = tid & 63, wr = wid >> 2, wc = wid & 3, fr = lane & 15, fq = lane >> 4;
    const int K = g.K, nt = K / BK, lda = g.lda, ldb = g.ldb;
    int ts_lo = 0, ts_hi = 0, nts = 0; const unsigned long long rt_entry = STAMP ? (unsigned long long)wall_clock64() : 0ull;
#define PG8_STAMP() do { if (STAMP && wid == 0 && nts < 64) { const unsigned long long _c = (unsigned long long)clock64(); \
        ts_lo = (lane == nts) ? (int)(unsigned)_c : ts_lo; ts_hi = (lane == nts) ? (int)(unsigned)(_c >> 32) : ts_hi; ++nts; } } while (0)
    PG8_STAMP();
    unsigned voffA[2], voffB[2];
#pragma unroll
    for (int i = 0; i < 2; ++i) { int R, C; stage_rc(tid * 16 + i * 8192, R, C); const int Rb = Epi::PERM ? ((R & ~31) + perm32(R & 31)) : R;
        voffA[i] = (unsigned)(R * lda + C) * 2u; voffB[i] = (unsigned)(Rb * ldb + C) * 2u; }
    const size_t kstep = (size_t)(BK * 2);
    const size_t hstepA = (size_t)HALF * lda * 2, hstepB = (size_t)HALF * ldb * 2;
    const size_t tstepA = 2 * hstepA, tstepB = 2 * hstepB;
    const unsigned ldsw = (unsigned)wid * 1024u;
    const int aoff = lds_byte(wr * 64 + fr, fq * 8), boff = lds_byte(wc * 32 + fr, fq * 8);
#define PG8_SA(b, h) (((b) * 2 + (h)) * HTB)
#define PG8_SB(b, h) ((4 + (b) * 2 + (h)) * HTB)
#define PG8_STAGE(bufoff, gbase, voff) do { _Pragma("unroll") for (int _i = 0; _i < 2; ++_i) \
        __builtin_amdgcn_global_load_lds((const unsigned*)((const char*)(gbase) + (voff)[_i]), (LAS unsigned*)(lds + (bufoff) + ldsw + _i * 8192), 16, 0, 0); } while (0)
#define PG8_LDA(dst, b, h) do { _Pragma("unroll") for (int m = 0; m < 4; ++m) _Pragma("unroll") for (int k = 0; k < 2; ++k) dst[m][k] = *(const LAS bf16x8*)(lds + PG8_SA(b, h) + aoff + m * 2048 + k * 1024); } while (0)
#define PG8_LDB(dst, b, h) do { _Pragma("unroll") for (int n = 0; n < 2; ++n) _Pragma("unroll") for (int k = 0; k < 2; ++k) dst[n][k] = *(const LAS bf16x8*)(lds + PG8_SB(b, h) + boff + n * 2048 + k * 1024); } while (0)
#define PG8_MMA(ai, bj, At, Bt) do { __builtin_amdgcn_s_setprio(1); _Pragma("unroll") for (int m = 0; m < 4; ++m) _Pragma("unroll") for (int n = 0; n < 2; ++n) _Pragma("unroll") for (int k = 0; k < 2; ++k) \
        acc[ai][bj][m][n] = __builtin_amdgcn_mfma_f32_16x16x32_bf16(Bt[n][k], At[m][k], acc[ai][bj][m][n], 0, 0, 0); __builtin_amdgcn_s_setprio(0); } while (0)
#define PG8_WAIT_V(n) asm volatile("s_waitcnt vmcnt(" #n ")" ::: "memory")
#define PG8_WAIT_L(n) asm volatile("s_waitcnt lgkmcnt(" #n ")" ::: "memory")
#define PG8_BAR __builtin_amdgcn_s_barrier()
#define PG8_SCHED __builtin_amdgcn_sched_barrier(0)
    Unit cur, nxt; int ui = 0;
    if (!S.next(0, cur)) return;
    f32x4 acc[2][2][4][2]; { const f32x4 zz = zero4_opaque();
#pragma unroll
    for (int a = 0; a < 2; ++a)
#pragma unroll
        for (int b = 0; b < 2; ++b)
#pragma unroll
            for (int m = 0; m < 4; ++m)
#pragma unroll
                for (int n = 0; n < 2; ++n) acc[a][b][m][n] = zz; }
    bf16x8 At[4][2], B0[2][2], B1[2][2];
    const char* cA = (const char*)g.A + (size_t)cur.pm * tstepA; const char* cB = (const char*)g.Bt + (size_t)cur.pn * tstepB;
    S.a_ready(cur);
    PG8_STAGE(PG8_SB(0, 0), cB, voffB); PG8_STAGE(PG8_SA(0, 0), cA, voffA); PG8_STAGE(PG8_SB(0, 1), cB + hstepB, voffB); PG8_STAGE(PG8_SA(0, 1), cA + hstepA, voffA);
    if (wr == 1) PG8_BAR;
    PG8_WAIT_V(4); PG8_BAR;
    PG8_STAGE(PG8_SB(1, 0), cB + kstep, voffB); PG8_STAGE(PG8_SA(1, 0), cA + kstep, voffA); PG8_STAGE(PG8_SB(1, 1), cB + hstepB + kstep, voffB);
    PG8_WAIT_V(6); PG8_BAR;
    PG8_STAMP();
    for (;;) {
        const bool has_next = S.next(ui + 1, nxt);
        const char* nA = has_next ? (const char*)g.A + (size_t)nxt.pm * tstepA : cA; const char* nB = has_next ? (const char*)g.Bt + (size_t)nxt.pn * tstepB : cB;
        for (int t = 0; t < nt; t += 2) {
            const bool last = (t == nt - 2);
            const char* a1 = cA + (size_t)(t + 1) * kstep;
            const char* a2 = last ? nA : cA + (size_t)(t + 2) * kstep; const char* b2 = last ? nB : cB + (size_t)(t + 2) * kstep;
            const char* a3 = a2 + kstep; const char* b3 = b2 + kstep;
            if (last && has_next) S.a_ready(nxt);
            PG8_LDB(B0, 0, 0); PG8_SCHED; PG8_LDA(At, 0, 0); PG8_STAGE(PG8_SA(1, 1), a1 + hstepA, voffA);
            PG8_WAIT_L(8); PG8_BAR; PG8_WAIT_L(0); PG8_MMA(0, 0, At, B0); PG8_BAR; PG8_SCHED;
            PG8_LDB(B1, 0, 1); PG8_STAGE(PG8_SB(0, 0), b2, voffB);
            PG8_BAR; PG8_WAIT_L(0); PG8_MMA(0, 1, At, B1); PG8_BAR;
            PG8_LDA(At, 0, 1); PG8_STAGE(PG8_SA(0, 0), a2, voffA);
            PG8_BAR; PG8_WAIT_L(0); PG8_MMA(1, 0, At, B0); PG8_BAR; PG8_SCHED;
            PG8_STAGE(PG8_SB(0, 1), b2 + hstepB, voffB);
            PG8_WAIT_V(6); PG8_BAR; PG8_MMA(1, 1, At, B1); PG8_BAR;
            PG8_LDB(B0, 1, 0); PG8_SCHED; PG8_LDA(At, 1, 0); PG8_STAGE(PG8_SA(0, 1), a2 + hstepA, voffA);
            PG8_WAIT_L(8); PG8_BAR; PG8_WAIT_L(0); PG8_MMA(0, 0, At, B0); PG8_BAR; PG8_SCHED;
            PG8_LDB(B1, 1, 1); PG8_STAGE(PG8_SB(1, 0), b3, voffB);
            PG8_BAR; PG8_WAIT_L(0); PG8_MMA(0, 1, At, B1); PG8_BAR;
            PG8_LDA(At, 1, 1); PG8_STAGE(PG8_SA(1, 0), a3, voffA);
            PG8_BAR; PG8_WAIT_L(0); PG8_MMA(1, 0, At, B0); PG8_BAR; PG8_SCHED;
            PG8_STAGE(PG8_SB(1, 1), b3 + hstepB, voffB);
            PG8_WAIT_V(6); PG8_BAR; PG8_MMA(1, 1, At, B1); PG8_BAR;
        }
        PG8_STAMP();
        if constexpr (!Epi::AFTER_DRAIN) { E(acc, cur, wr, wc, fr, fq); S.done(cur); }
        PG8_STAMP();
        if (!has_next) break;
        { const f32x4 zz = zero4_opaque();
#pragma unroll
        for (int a = 0; a < 2; ++a)
#pragma unroll
            for (int b = 0; b < 2; ++b)
#pragma unroll
                for (int m = 0; m < 4; ++m)
#pragma unroll
                    for (int n = 0; n < 2; ++n) acc[a][b][m][n] = zz; }
        cur = nxt; cA = nA; cB = nB; ++ui;
    }
    PG8_WAIT_V(0);
    if (wr == 0) PG8_BAR;
    PG8_BAR;
    if constexpr (Epi::AFTER_DRAIN) { E.fused(acc, cur, wr, wc, fr, fq, lds, wid, lane); S.done(cur); }
    PG8_STAMP();
    if (STAMP && wid == 0) { stamps[lane] = lane < nts ? (((unsigned long long)(unsigned)ts_hi << 32) | (unsigned)ts_lo) : 0ull;
        if (lane == 62) stamps[62] = rt_entry; if (lane == 63) stamps[63] = (unsigned long long)wall_clock64(); }
#undef PG8_STAMP
#undef PG8_SA
#undef PG8_SB
#undef PG8_STAGE
#undef PG8_LDA
#undef PG8_LDB
#undef PG8_MMA
#undef PG8_WAIT_V
#undef PG8_WAIT_L
#undef PG8_BAR
#undef PG8_SCHED
}

template <int NC>
DI void rows_rstd_lds(const bfu* __restrict__ A, int lda, int brow, LAS float* rs, int wv, float* gout = nullptr) {
    int tid = mk_tid(wv);
    const int w = tid >> 6, lane = tid & 63;
    if constexpr (NC == 1024) {
        for (int i0 = 0; i0 < 32; i0 += 8) {
            u32x4 va[8], vb[8];
#pragma unroll
            for (int i = 0; i < 8; ++i) { const bfu* row = A + (size_t)(brow + w * 32 + i0 + i) * lda; va[i] = *(const u32x4*)(row + lane * 8); vb[i] = *(const u32x4*)(row + 512 + lane * 8); }
#pragma unroll
            for (int i = 0; i < 8; ++i) {
                float ss = 0.f;
#pragma unroll
                for (int j = 0; j < 4; ++j) { const float x0 = bflo(va[i][j]), x1 = bfhi(va[i][j]), y0 = bflo(vb[i][j]), y1 = bfhi(vb[i][j]); ss += x0 * x0 + x1 * x1 + y0 * y0 + y1 * y1; }
                ss = rdlane_f(dpp_sum63(ss), 63);
                const int r = w * 32 + i0 + i;
                if (lane == 0) { const float rv = rsqrtf(ss * (1.f / NC) + EPS); rs[r] = rv; if (gout) gout[brow + r] = rv; }
            }
        }
    } else {
        constexpr int PER = NC / 64;
        for (int i0 = 0; i0 < 32; i0 += 16) {
            u32x2 v[16];
#pragma unroll
            for (int i = 0; i < 16; ++i) { const bfu* row = A + (size_t)(brow + w * 32 + i0 + i) * lda;
                if constexpr (PER == 4) v[i] = *(const u32x2*)(row + lane * 4); else { v[i][0] = *(const unsigned*)(row + lane * 2); v[i][1] = 0u; } }
#pragma unroll
            for (int i = 0; i < 16; ++i) {
                const float x0 = bflo(v[i][0]), x1 = bfhi(v[i][0]), y0 = bflo(v[i][1]), y1 = bfhi(v[i][1]);
                const float ss = rdlane_f(dpp_sum63(x0 * x0 + x1 * x1 + y0 * y0 + y1 * y1), 63);
                const int r = w * 32 + i0 + i;
                if (lane == 0) { const float rv = rsqrtf(ss * (1.f / NC) + EPS); rs[r] = rv; if (gout) gout[brow + r] = rv; }
            }
        }
    }
}
DI u32x2 pack4(f32x4 v) { u32x2 o; o[0] = pk2(v[0], v[1]); o[1] = pk2(v[2], v[3]); return o; }

DI void rope_load(const float* ct, size_t row, int fq, u32x4& cw, u32x4& sw) {
    const u32x4* rp = (const u32x4*)((const unsigned char*)ct + row * 64 + (size_t)(fq & 1) * 32);
    cw = rp[0]; sw = rp[1];
}
DI void rope_perm(f32x4& a, f32x4& b, const u32x4 cw, const u32x4 sw, int fq) {
    typedef _Float16 h2v __attribute__((ext_vector_type(2)));
    f32x4 c0, c1, s0, s1;
#pragma unroll
    for (int j = 0; j < 2; ++j) {
        const unsigned c_lo = cw[j], c_hi = cw[2 + j], s_lo = sw[j], s_hi = sw[2 + j];
        const h2v a0 = __builtin_bit_cast(h2v, c_lo), a1 = __builtin_bit_cast(h2v, c_hi), b0 = __builtin_bit_cast(h2v, s_lo), b1 = __builtin_bit_cast(h2v, s_hi);
        c0[2 * j] = (float)a0.x; c0[2 * j + 1] = (float)a0.y; c1[2 * j] = (float)a1.x; c1[2 * j + 1] = (float)a1.y;
        s0[2 * j] = (float)b0.x; s0[2 * j + 1] = (float)b0.y; s1[2 * j] = (float)b1.x; s1[2 * j + 1] = (float)b1.y;
    }
    f32x4 pa, pb;
#pragma unroll
    for (int j = 0; j < 4; ++j) { pa[j] = swap32(a[j]); pb[j] = swap32(b[j]); }
    const float sg = fq < 2 ? -1.f : 1.f;
    a = a * c0 + pa * s0 * sg; b = b * c1 + pb * s1 * sg;
}
DI void proj_rstd_lds(const float* ssp, int brow, LAS float* rs, int wv) {
    int tid = mk_tid(wv);
    if (tid < 256) { const float* q = ssp + (size_t)(brow + tid) * 8; const f32x4 q0 = *(const f32x4*)q, q1 = *(const f32x4*)(q + 4);
        rs[tid] = rsqrtf((((q0[0] + q0[1]) + (q0[2] + q0[3])) + ((q1[0] + q1[1]) + (q1[2] + q1[3]))) * (1.f / DM) + EPS); }
}
struct EpiProj {
    static constexpr bool PERM = true, AFTER_DRAIN = false;
    const LAS float* rs; bfu* out; const float* ct; const float* st;
    DI void operator()(const f32x4 (&acc)[2][2][4][2], const Unit& u, int wr, int wc, int fr_, int fq_) const {
        int tz = mk_tid(wr * 4 + wc); const int fr = tz & 15, fq = (tz >> 4) & 3;
        const int row0 = u.pm * BM + wr * 64 + fr, colg = u.pn * BM + wc * 32;
        float sv[2][4];
#pragma unroll
        for (int ai = 0; ai < 2; ++ai)
#pragma unroll
            for (int m = 0; m < 4; ++m) sv[ai][m] = rs[u.idx * 256 + wr * 64 + fr + ai * HALF + m * 16];
        const bool hasr = colg == PC_KR || colg + HALF == PC_KR;
#pragma unroll
        for (int ai = 0; ai < 2; ++ai) {
#pragma unroll
            for (int m = 0; m < 4; ++m) {
                const int row = row0 + ai * HALF + m * 16; const float s = sv[ai][m];
                u32x4 cw[4], sw[4];
                if (hasr) rope_load(ct, (size_t)row, fq, cw[m], sw[m]);
#pragma unroll
                for (int bj = 0; bj < 2; ++bj) {
                    const int cg = colg + bj * HALF;
                    f32x4 a = acc[ai][bj][m][0] * s, b = acc[ai][bj][m][1] * s;
                    if (cg == PC_KR) rope_perm(a, b, cw[m], sw[m], fq);
                    u32x4 w4; w4[0] = pk2(a[0], a[1]); w4[1] = pk2(a[2], a[3]); w4[2] = pk2(b[0], b[1]); w4[3] = pk2(b[2], b[3]);
                    *(u32x4*)(out + (size_t)row * PW + cg + 8 * fq) = w4;
                }
            }
        }
    }
};
struct EpiPlain {
    static constexpr bool PERM = true, AFTER_DRAIN = false;
    bfu* out; int ld;
    DI void operator()(const f32x4 (&acc)[2][2][4][2], const Unit& u, int wr, int wc, int fr_, int fq_) const {
        int tz = mk_tid(wr * 4 + wc); const int fr = tz & 15, fq = (tz >> 4) & 3;
        const int row0 = u.pm * BM + wr * 64 + fr, colg = u.pn * BM + wc * 32;
#pragma unroll
        for (int ai = 0; ai < 2; ++ai)
#pragma unroll
            for (int m = 0; m < 4; ++m) {
                const int row = row0 + ai * HALF + m * 16;
#pragma unroll
                for (int bj = 0; bj < 2; ++bj) {
                    const int cg = colg + bj * HALF;
                    const f32x4 a = acc[ai][bj][m][0], b = acc[ai][bj][m][1];
                    u32x4 w4; w4[0] = pk2(a[0], a[1]); w4[1] = pk2(a[2], a[3]); w4[2] = pk2(b[0], b[1]); w4[3] = pk2(b[2], b[3]);
                    *(u32x4*)(out + (size_t)row * ld + cg + 8 * fq) = w4;
                }
            }
    }
};
template <bool ROPE>
struct EpiScaled {
    static constexpr bool PERM = true, AFTER_DRAIN = false;
    const LAS float* rs; bfu* out; int ld; const float* ct; const float* st; float scale;
    DI void operator()(const f32x4 (&acc)[2][2][4][2], const Unit& u, int wr, int wc, int fr_, int fq_) const {
        int tz = mk_tid(wr * 4 + wc); const int fr = tz & 15, fq = (tz >> 4) & 3;
        const int lrow0 = wr * 64 + fr, colg = u.pn * BM + wc * 32;
        const bool hasr = ROPE && ((((colg >> 5) % 3) == 2) || ((((colg + HALF) >> 5) % 3) == 2));
#pragma unroll
        for (int am = 0; am < 4; ++am) {
            const int ai = am >> 1;
            u32x4 cw[4], sw[4];
            if constexpr (ROPE) { if (hasr) {
#pragma unroll
                for (int m = 2 * (am & 1); m < 2 * (am & 1) + 2; ++m) rope_load(ct, (size_t)(u.pm * BM + lrow0 + ai * HALF + m * 16), fq, cw[m], sw[m]);
            } }
#pragma unroll
            for (int m = 2 * (am & 1); m < 2 * (am & 1) + 2; ++m) {
                const int lrow = lrow0 + ai * HALF + m * 16; const int row = u.pm * BM + lrow; const float s = rs[u.idx * 256 + lrow] * scale;
#pragma unroll
                for (int bj = 0; bj < 2; ++bj) {
                    const int cg = colg + bj * HALF;
                    f32x4 a = acc[ai][bj][m][0] * s, b = acc[ai][bj][m][1] * s;
                    if constexpr (ROPE) { if (((cg >> 5) % 3) == 2) rope_perm(a, b, cw[m], sw[m], fq); }
                    u32x4 w4; w4[0] = pk2(a[0], a[1]); w4[1] = pk2(a[2], a[3]); w4[2] = pk2(b[0], b[1]); w4[3] = pk2(b[2], b[3]);
                    *(u32x4*)(out + (size_t)row * ld + cg + 8 * fq) = w4;
                }
            }
        }
    }
};
struct EpiResid {
    static constexpr bool PERM = true, AFTER_DRAIN = false;
    bfu* x;
    DI void operator()(const f32x4 (&acc)[2][2][4][2], const Unit& u, int wr, int wc, int fr_, int fq_) const {
        int tz = mk_tid(wr * 4 + wc); const int fr = tz & 15, fq = (tz >> 4) & 3;
        const int row0 = u.pm * BM + wr * 64 + fr, colg = u.pn * BM + wc * 32 + 8 * fq;
        bfu* const xo = x;
        u32x4 old[2][4][2];
#pragma unroll
        for (int ai = 0; ai < 2; ++ai)
#pragma unroll
            for (int m = 0; m < 4; ++m)
#pragma unroll
                for (int bj = 0; bj < 2; ++bj) old[ai][m][bj] = *(const u32x4*)(x + (size_t)(row0 + ai * HALF + m * 16) * DM + colg + bj * HALF);
#pragma unroll
        for (int ai = 0; ai < 2; ++ai) {
#pragma unroll
            for (int m = 0; m < 4; ++m)
#pragma unroll
                for (int bj = 0; bj < 2; ++bj) {
                    const u32x4 od = old[ai][m][bj]; const f32x4 v0 = acc[ai][bj][m][0], v1 = acc[ai][bj][m][1];
                    u32x4 o; o[0] = pk2(bflo(od[0]) + v0[0], bfhi(od[0]) + v0[1]); o[1] = pk2(bflo(od[1]) + v0[2], bfhi(od[1]) + v0[3]);
                    o[2] = pk2(bflo(od[2]) + v1[0], bfhi(od[2]) + v1[1]); o[3] = pk2(bflo(od[3]) + v1[2], bfhi(od[3]) + v1[3]);
                    *(u32x4*)(xo + (size_t)(row0 + ai * HALF + m * 16) * DM + colg + bj * HALF) = o;
                }
        }
    }
};

constexpr int AT_KS = 208;
constexpr int AT_VS = 192;
constexpr float AT_THR = 8.f;
constexpr int AT_KB = 64 * AT_KS, AT_VB = 64 * AT_VS, AT_BUF = AT_KB + AT_VB;

DI void attn_unit(const Params& p, unsigned char* ws, int l, int b, int h, int qt, LAS char* smem, int tid) {
    const int w = tid >> 6, lane = tid & 63, r = lane & 31, hh = lane >> 5;
    const bfu* Q = (const bfu*)(ws + WS_Q); const bfu* KV = (const bfu*)(ws + WS_KV); const bfu* PR = (const bfu*)(ws + WS_PROJ);
    const size_t tok0 = (size_t)b * SEQ;
    const int q0 = qt * 256 + w * 32;
    bf16x8 qf[6];
    { const bfu* qrow = Q + (tok0 + q0 + r) * 768 + h * 96 + 8 * hh;
#pragma unroll
      for (int ks = 0; ks < 6; ++ks) qf[ks] = *(const bf16x8*)(qrow + 16 * ks); }
    f32x16 o0 = zero16(), o1 = zero16();
    float mrun = -1e30f, lsum = 0.f;
    float one_op; asm volatile("v_mov_b32 %0, 1.0" : "=v"(one_op));

    const int nkt = qt * 4 + 4, my_last = qt * 4 + (w >> 1);
    const int skey = tid >> 3, sch = tid & 7, rkey = (tid & 255) >> 2, rch = tid & 3;
    struct Stg { u32x4 k, v, r; } gA, gB;
    const GAS char* kvg = (const GAS char*)KV + ((size_t)tok0 * 1024 + h * 64) * 2;
    const GAS char* prg = (const GAS char*)PR + ((size_t)tok0 * PW + PC_KR) * 2;
    const unsigned koff = (unsigned)((skey * 1024 + sch * 8) * 2), roff = (unsigned)((rkey * PW + rch * 8) * 2);
    auto gload = [&](int kt, Stg& g) {
        const GAS char* kb = kvg + (size_t)kt * (64 * 1024 * 2);
        g.k = *(const GAS u32x4*)(kb + koff);
        g.v = *(const GAS u32x4*)(kb + 1024 + koff);
        g.r = *(const GAS u32x4*)(prg + (size_t)kt * (64 * PW * 2) + roff);
    };
    auto lstore = [&](int buf, const Stg& g) {
        LAS char* kb = smem + buf * AT_BUF; LAS char* vb = kb + AT_KB;
        *(LAS u32x4*)(kb + skey * AT_KS + sch * 16) = g.k;
        *(LAS u32x4*)(vb + skey * AT_VS + sch * 16) = g.v;
        if (tid < 256) *(LAS u32x4*)(kb + rkey * AT_KS + 128 + rch * 16) = g.r;
    };
    gload(0, gA); gload(1, gB);
    __syncthreads();
    lstore(0, gA);
    __syncthreads();
    const int i16 = lane & 15, q4 = i16 >> 2, p4 = i16 & 3, blk = (lane >> 4) & 1;
    auto tile = [&](int kt, int cur, auto maskc) {
            constexpr bool MASK = decltype(maskc)::value;
            const LAS char* kb = smem + cur * AT_BUF; const LAS char* vb = kb + AT_KB;
            f32x16 s0 = zero16(), s1 = zero16();
            {
                bf16x8 a0[6], a1[6];
#pragma unroll
                for (int ks = 0; ks < 6; ++ks) { a0[ks] = *(const LAS bf16x8*)(kb + r * AT_KS + ks * 32 + hh * 16); a1[ks] = *(const LAS bf16x8*)(kb + (32 + r) * AT_KS + ks * 32 + hh * 16); }
                __builtin_amdgcn_sched_barrier(0);
#pragma unroll
                for (int ks = 0; ks < 6; ++ks) { s0 = mfma32(a0[ks], qf[ks], s0); s1 = mfma32(a1[ks], qf[ks], s1); }
            }
            bf16x8 vf[2][2][2];
#pragma unroll
            for (int kk = 0; kk < 2; ++kk)
#pragma unroll
                for (int s = 0; s < 2; ++s)
#pragma unroll
                    for (int vt = 0; vt < 2; ++vt) {
                        const LAS char* a = vb + (32 * kk + 16 * s + 4 * hh + q4) * AT_VS + (32 * vt + 16 * blk) * 2 + 8 * p4;
                        vf[kk][s][vt] = cat4(ldtr(a), ldtr(a + 8 * AT_VS));
                    }
            __builtin_amdgcn_sched_barrier(0);
            if constexpr (MASK) {
                const int qa = q0 + r, kbase = kt * 64 + 4 * hh;
#pragma unroll
                for (int i = 0; i < 16; ++i) { const int kk = kbase + (i & 3) + 8 * (i >> 2); if (kk > qa) s0[i] = -1e30f; if (kk + 32 > qa) s1[i] = -1e30f; }
            }
            float mx = s0[0], my = s1[0];
#pragma unroll
            for (int i = 1; i < 16; ++i) { mx = fmaxf(mx, s0[i]); my = fmaxf(my, s1[i]); }
            mx = xmax32(fmaxf(mx, my));
            if (__any(mx - mrun > AT_THR)) {
                const float mnew = fmaxf(mrun, mx);
                const float alpha = __builtin_amdgcn_exp2f(mrun - mnew);
                lsum *= alpha;
#pragma unroll
                for (int i = 0; i < 16; ++i) { o0[i] *= alpha; o1[i] *= alpha; }
                mrun = mnew;
            }
            float psa = 0.f, psb = 0.f;
#pragma unroll
            for (int i = 0; i < 16; ++i) { s0[i] = __builtin_amdgcn_exp2f(s0[i] - mrun); s1[i] = __builtin_amdgcn_exp2f(s1[i] - mrun); psa += s0[i]; psb = __builtin_fmaf(s1[i], one_op, psb); }
            lsum += psa + psb;
#pragma unroll
            for (int kk = 0; kk < 2; ++kk)
#pragma unroll
                for (int s = 0; s < 2; ++s) {
                    const bf16x8 pf = pack8(kk == 0 ? s0 : s1, s);
                    o0 = mfma32(vf[kk][s][0], pf, o0); o1 = mfma32(vf[kk][s][1], pf, o1);
                }
        };
    auto run = [&](int kt, int cur) { if (kt < my_last) tile(kt, cur, std::false_type{}); else if (kt == my_last) tile(kt, cur, std::true_type{}); };
    for (int kt = 0; kt < nkt; kt += 2) {
        run(kt, 0);
        gload(min(kt + 2, nkt - 1), gA);
        lstore(1, gB);
        __syncthreads();
        run(kt + 1, 1);
        gload(min(kt + 3, nkt - 1), gB);
        if (kt + 2 < nkt) lstore(0, gA);
        __syncthreads();
    }
    const float ltot = xsum32(lsum);
    const float inv = __builtin_amdgcn_rcpf(ltot);
    float ss = 0.f;
#pragma unroll
    for (int i = 0; i < 16; ++i) { o0[i] *= inv; o1[i] *= inv; ss += o0[i] * o0[i] + o1[i] * o1[i]; }
    ss = xsum32(ss);
    const float rstd = __builtin_amdgcn_rsqf(ss * (1.f / 64.f) + EPS);
    const float* gain = (const float*)(ws + WS_SP) + l * SP_STRIDE + SP_MLO + h * 64;
    bfu* yrow = (bfu*)(ws + WS_YCAT) + (tok0 + q0 + r) * 1024 + 256 + h * 64;
    f32x4 gnv[2][4];
#pragma unroll
    for (int vt = 0; vt < 2; ++vt)
#pragma unroll
        for (int g = 0; g < 4; ++g) gnv[vt][g] = *(const f32x4*)(gain + 32 * vt + 8 * g + 4 * hh);
    u32x2 pk[2][4];
#pragma unroll
    for (int vt = 0; vt < 2; ++vt)
#pragma unroll
        for (int g = 0; g < 4; ++g) {
            const f32x4 gn = gnv[vt][g];
            f32x4 ov;
#pragma unroll
            for (int i = 0; i < 4; ++i) ov[i] = (vt == 0 ? o0[4 * g + i] : o1[4 * g + i]) * rstd * gn[i];
            pk[vt][g] = pack4(ov);
        }
    store_row64_wide(yrow, pk, hh);
}

DI void attn_phase(const Params& p, int l, LAS char* smem, int wv) {
    int tid = mk_tid(wv); smem = opql(smem);
    unsigned char* ws = opq(p.ws);
    if (wv >= 4) __builtin_amdgcn_s_setprio(1);
    for (int pi = blockIdx.x; pi < 512; pi += gridDim.x) {
        const int xx = pi & 7, mm = pi >> 3, j = mm & 3, bh = (mm >> 2) * 8 + xx;
        attn_unit(p, ws, l, bh >> 3, bh & 7, 7 - j, smem, tid);
        attn_unit(p, ws, l, bh >> 3, bh & 7, j, smem, tid);
    }
    __builtin_amdgcn_s_setprio(0);
}

constexpr int GM_VS = 576;

DI void gmlp_phase(const Params& p, int l, LAS char* smem, int wv) {
    int tid = mk_tid(wv); smem = opql(smem);
    const int w = tid >> 6, lane = tid & 63, r = lane & 31, hh = lane >> 5;
    unsigned char* ws = opq(p.ws);
    const bfu* PR = (const bfu*)(ws + WS_PROJ);
    bfu* YC = (bfu*)(ws + WS_YCAT);
    const bfu* WC = (const bfu*)(ws + WS_W + (size_t)l * WL_SIZE + WL_GM);
    for (int c = blockIdx.x; c < T / 128; c += gridDim.x) {
        const size_t tok0 = (size_t)c * 128;
        const int h = w >> 1, th = w & 1;
        bf16x8 bw[8][2];
        { const bfu* wrow = WC + ((size_t)h * 128 + 64 * th + r) * 128 + 8 * hh;
#pragma unroll
          for (int ks = 0; ks < 8; ++ks)
#pragma unroll
            for (int nt = 0; nt < 2; ++nt) bw[ks][nt] = *(const bf16x8*)(wrow + (size_t)nt * 32 * 128 + 16 * ks); }
        __syncthreads();
        {
            const f32x4 gn = *(const f32x4*)((const float*)(ws + WS_SP) + l * SP_STRIDE + SP_GMV + lane * 4);
            u32x2 vraw[16];
#pragma unroll
            for (int i = 0; i < 16; ++i) vraw[i] = *(const u32x2*)(PR + (tok0 + w * 16 + i) * PW + PC_V + lane * 4);
#pragma unroll
            for (int i = 0; i < 16; ++i) {
                const int s = w * 16 + i;
                const u32x2 raw = vraw[i];
                f32x4 v; v[0] = geluf(bflo(raw[0])); v[1] = geluf(bfhi(raw[0])); v[2] = geluf(bflo(raw[1])); v[3] = geluf(bfhi(raw[1]));
                float ss = v[0] * v[0] + v[1] * v[1] + v[2] * v[2] + v[3] * v[3];
                ss = sum16(ss);
                const float rstd = __builtin_amdgcn_rsqf(ss * (1.f / 64.f) + EPS);
                f32x4 o; for (int j = 0; j < 4; ++j) o[j] = v[j] * rstd * gn[j];
                *(LAS u32x2*)(smem + s * GM_VS + lane * 8) = pack4(o);
            }
        }
        __syncthreads();
        const int i16 = lane & 15, q4 = i16 >> 2, p4 = i16 & 3, blk = (lane >> 4) & 1;
        u32x2 uraw[2][2][4]; float bvv[2];
#pragma unroll
        for (int nt = 0; nt < 2; ++nt) {
            const int tl = 64 * th + 32 * nt + r;
            bvv[nt] = ((const float*)(ws + WS_SP))[l * SP_STRIDE + SP_GMB + h * 128 + tl];
            const bfu* urow = PR + (tok0 + tl) * PW + PC_U + h * 64;
#pragma unroll
            for (int mt = 0; mt < 2; ++mt)
#pragma unroll
                for (int g = 0; g < 4; ++g) uraw[nt][mt][g] = *(const u32x2*)(urow + 32 * mt + 8 * g + 4 * hh);
        }
        f32x16 acc[2][2];
#pragma unroll
        for (int a = 0; a < 2; ++a)
#pragma unroll
            for (int b2 = 0; b2 < 2; ++b2) acc[a][b2] = zero16();
#pragma unroll
        for (int ks = 0; ks < 8; ++ks) {
            bf16x8 af[2];
#pragma unroll
            for (int mt = 0; mt < 2; ++mt) {
                const LAS char* a = smem + (16 * ks + 8 * hh + q4) * GM_VS + (h * 64 + 32 * mt + 16 * blk) * 2 + 8 * p4;
                af[mt] = cat4(ldtr(a), ldtr(a + 4 * GM_VS));
            }
#pragma unroll
            for (int nt = 0; nt < 2; ++nt) {
                if (ks <= 4 * th + 2 * nt + 1) {
                    acc[0][nt] = mfma32(af[0], bw[ks][nt], acc[0][nt]); acc[1][nt] = mfma32(af[1], bw[ks][nt], acc[1][nt]);
                }
            }
        }
        const float* og = (const float*)(ws + WS_SP) + l * SP_STRIDE + SP_GMO + h * 64;
        f32x4 gnv[2][4];
#pragma unroll
        for (int mt = 0; mt < 2; ++mt)
#pragma unroll
            for (int g = 0; g < 4; ++g) gnv[mt][g] = *(const f32x4*)(og + 32 * mt + 8 * g + 4 * hh);
#pragma unroll
        for (int nt = 0; nt < 2; ++nt) {
            const int tl = 64 * th + 32 * nt + r;
            const float bv = bvv[nt];
            f32x4 y[2][4]; float ss = 0.f;
#pragma unroll
            for (int mt = 0; mt < 2; ++mt)
#pragma unroll
                for (int g = 0; g < 4; ++g) {
                    const u32x2 raw = uraw[nt][mt][g];
                    f32x4 u; u[0] = geluf(bflo(raw[0])); u[1] = geluf(bfhi(raw[0])); u[2] = geluf(bflo(raw[1])); u[3] = geluf(bfhi(raw[1]));
#pragma unroll
                    for (int i = 0; i < 4; ++i) { const float yy = u[i] * (acc[mt][nt][4 * g + i] + bv); y[mt][g][i] = yy; ss += yy * yy; }
                }
            ss = xsum32(ss);
            const float rstd = __builtin_amdgcn_rsqf(ss * (1.f / 64.f) + EPS);
            bfu* yrow = YC + (tok0 + tl) * 1024 + h * 64;
            u32x2 pk[2][4];
#pragma unroll
            for (int mt = 0; mt < 2; ++mt)
#pragma unroll
                for (int g = 0; g < 4; ++g) {
                    const f32x4 gn = gnv[mt][g];
                    f32x4 o; for (int i = 0; i < 4; ++i) o[i] = y[mt][g][i] * rstd * gn[i];
                    pk[mt][g] = pack4(o);
                }
            store_row64_wide(yrow, pk, hh);
        }
    }
}

constexpr int HG_RS = 528;
constexpr int HG_TS = 576;
constexpr float HG_CLAMP = 80.f;

struct HgScan { float cum[32]; float kf[32]; float tot0, tot1; };
DI void hg_scan_pre(const unsigned short (&hfr)[32], int ch, int half, float lb, LAS float* xch, HgScan& S) {
    float run = 0.f;
#pragma unroll
    for (int i = 0; i < 32; ++i) {
        const float fx = bf2f(hfr[i]);
        const float sg = sigmoidf(fx);
        const float f = lb + (1.f - lb) * sg;
        run += __builtin_amdgcn_logf(fmaxf(f, 1e-20f)) * 0.6931471805599453f;
        S.cum[i] = run; S.kf[i] = (1.f - lb) * (1.f - sg);
    }
    xch[half * 256 + ch] = run;
    __syncthreads();
    S.tot0 = xch[ch]; S.tot1 = xch[256 + ch];
}

DI void hg_local_phase(const Params& p, int l, LAS char* smem, int wv) {
    int tid = mk_tid(wv); smem = opql(smem);
    const int w = tid >> 6, lane = tid & 63, r = lane & 31, hh = lane >> 5;
    const int ch = tid & 255, half = tid >> 8;
    unsigned char* ws = opq(p.ws);
    const bfu* PR = (const bfu*)(ws + WS_PROJ);
    float* HST = (float*)(ws + WS_HST); float* HDEC = (float*)(ws + WS_HDEC);
    const float lb = ((const float*)(ws + WS_LB))[l * 256 + ch];
    LAS char* Kt = smem;
    LAS char* Vn = smem + 64 * HG_TS;
    LAS float* xch = (LAS float*)(smem + 2 * 64 * HG_TS);
    const int nb = gridDim.x, bid = blockIdx.x;
    const bool skew = nb == 256;
    const int u_lo = skew ? (bid < 128 ? bid : 128 + (bid - 128) * 3) : bid, u_n = skew ? (bid < 128 ? 1 : 3) : (512 - bid + nb - 1) / nb, u_st = skew ? 1 : nb;
    for (int ui = 0; ui < u_n; ++ui) {
        const int uc = u_lo + ui * u_st;
        const size_t tok0 = (size_t)uc * 64;
        unsigned short hfr[32];
#pragma unroll
        for (int i = 0; i < 32; ++i) hfr[i] = PR[(tok0 + 32 * half + i) * PW + PC_HF + ch];
        u32x4 vch[4];
#pragma unroll
        for (int i = 0; i < 4; ++i) { const int e = tid + i * 512, s = e >> 5, cch = e & 31; vch[i] = *(const u32x4*)(PR + (tok0 + s) * PW + PC_HI + cch * 8); }
        __syncthreads();
        HgScan S; hg_scan_pre(hfr, ch, half, lb, xch, S);
        const float btot = S.tot0 + S.tot1;
        const float e0 = half == 0 ? btot : S.tot1;
#pragma unroll
        for (int i = 0; i < 32; ++i) {
            const float kv = S.kf[i] * __expf(e0 - S.cum[i]);
            *(LAS bfu*)(Kt + (32 * half + i) * HG_TS + ch * 2) = f2bf(kv);
        }
        if (half == 0) HDEC[(size_t)uc * 256 + ch] = __expf(btot);
#pragma unroll
        for (int i = 0; i < 4; ++i) { const int e = tid + i * 512, s = e >> 5, cch = e & 31; *(LAS u32x4*)(Vn + s * HG_TS + cch * 16) = vch[i]; }
        __syncthreads();
        const int h = w >> 1, vh = w & 1;
        const int i16 = lane & 15, q4 = i16 >> 2, p4 = i16 & 3, blk = (lane >> 4) & 1;
        f32x16 acc0 = zero16(), acc1 = zero16();
#pragma unroll
        for (int ks = 0; ks < 4; ++ks) {
            const int srow = 16 * ks + 8 * hh + q4;
            const LAS char* a = Vn + srow * HG_TS + (h * 64 + 32 * vh + 16 * blk) * 2 + 8 * p4;
            const bf16x8 af = cat4(ldtr(a), ldtr(a + 4 * HG_TS));
            const LAS char* b0 = Kt + srow * HG_TS + (h * 64 + 16 * blk) * 2 + 8 * p4;
            const bf16x8 bf0 = cat4(ldtr(b0), ldtr(b0 + 4 * HG_TS));
            const bf16x8 bf1 = cat4(ldtr(b0 + 64), ldtr(b0 + 64 + 4 * HG_TS));
            acc0 = mfma32(af, bf0, acc0); acc1 = mfma32(af, bf1, acc1);
        }
        float* out = HST + ((size_t)uc * 4 + h) * 4096;
#pragma unroll
        for (int i = 0; i < 16; ++i) {
            const int v = 32 * vh + crow(i, hh);
            out[v * 64 + r] = acc0[i]; out[v * 64 + 32 + r] = acc1[i];
        }
    }
}

DI void hg_prefix_phase(const Params& p, int wv) {
    unsigned char* ws = opq(p.ws);
    float* HST = (float*)(ws + WS_HST); const float* HDEC = (const float*)(ws + WS_HDEC);
    int tid = mk_tid(wv);
    const int gsz = gridDim.x * 512;
    for (int e = blockIdx.x * 512 + tid; e < 64 * 4096; e += gsz) {
        const int bh = e >> 12, idx = e & 4095, b = bh >> 2, h = bh & 3;
        float S = 0.f;
        for (int c0 = 0; c0 < 32; c0 += 8) {
            float g8[8], d8[8];
#pragma unroll
            for (int k = 0; k < 8; ++k) { const size_t uc = (size_t)b * 32 + c0 + k; g8[k] = HST[(uc * 4 + h) * 4096 + idx]; d8[k] = HDEC[uc * 256 + h * 64 + (idx & 63)]; }
#pragma unroll
            for (int k = 0; k < 8; ++k) { const size_t uc = (size_t)b * 32 + c0 + k; HST[(uc * 4 + h) * 4096 + idx] = S; S = d8[k] * S + g8[k]; }
        }
    }
}

DI void hg_out_phase(const Params& p, int l, LAS char* smem, int wv) {
    int tid = mk_tid(wv); smem = opql(smem);
    const int w = tid >> 6, lane = tid & 63, r = lane & 31, hh = lane >> 5;
    const int ch = tid & 255, half = tid >> 8;
    unsigned char* ws = opq(p.ws);
    const bfu* PR = (const bfu*)(ws + WS_PROJ);
    const float* HST = (const float*)(ws + WS_HST);
    bfu* YC = (bfu*)(ws + WS_YCAT);
    const float lb = ((const float*)(ws + WS_LB))[l * 256 + ch];
    LAS char* Qe = smem;
    LAS char* Qm = smem + 64 * HG_RS;
    LAS char* Km = smem + 2 * 64 * HG_RS;
    LAS char* Vn = smem + 3 * 64 * HG_RS;
    LAS float* xch = (LAS float*)(smem + 3 * 64 * HG_RS + 64 * HG_TS);
    for (int uc = blockIdx.x; uc < 512; uc += gridDim.x) {
        const size_t tok0 = (size_t)uc * 64;
        const int h = w >> 1, th = w & 1;
        unsigned short hfr[32], hqr[32];
#pragma unroll
        for (int i = 0; i < 32; ++i) { const bfu* pp = PR + (tok0 + 32 * half + i) * PW + ch; hfr[i] = pp[PC_HF]; hqr[i] = pp[PC_HQ]; }
        u32x4 vch[4];
#pragma unroll
        for (int i = 0; i < 4; ++i) { const int e = tid + i * 512, s = e >> 5, cch = e & 31; vch[i] = *(const u32x4*)(PR + (tok0 + s) * PW + PC_HI + cch * 8); }
        const size_t tok = tok0 + 32 * th + r;
        u32x2 graw[2][4];
#pragma unroll
        for (int vt = 0; vt < 2; ++vt)
#pragma unroll
            for (int g = 0; g < 4; ++g) graw[vt][g] = *(const u32x2*)(PR + tok * PW + PC_HG + h * 64 + 32 * vt + 8 * g + 4 * hh);
        __syncthreads();
        HgScan S; hg_scan_pre(hfr, ch, half, lb, xch, S);
        f32x4 hs[2][4][2];
        { const float* st = HST + ((size_t)uc * 4 + h) * 4096;
#pragma unroll
          for (int vt = 0; vt < 2; ++vt)
#pragma unroll
            for (int ks = 0; ks < 4; ++ks) { const float* sp = st + (32 * vt + r) * 64 + 16 * ks + 8 * hh; hs[vt][ks][0] = *(const f32x4*)sp; hs[vt][ks][1] = *(const f32x4*)(sp + 4); } }
        const float em = __expf(S.tot0);
#pragma unroll
        for (int i = 0; i < 32; ++i) {
            const int s = 32 * half + i;
            const float q = siluf(bf2f(hqr[i]));
            const float bm = half == 0 ? S.cum[i] - S.tot0 : S.cum[i];
            const float ebm = __expf(fminf(fmaxf(bm, -HG_CLAMP), HG_CLAMP));
            const float qm = q * ebm;
            const float qe = qm * em;
            const float km = S.kf[i] * __builtin_amdgcn_rcpf(ebm);
            *(LAS bfu*)(Qe + s * HG_RS + ch * 2) = f2bf(qe);
            *(LAS bfu*)(Qm + s * HG_RS + ch * 2) = f2bf(qm);
            *(LAS bfu*)(Km + s * HG_RS + ch * 2) = f2bf(km);
        }
#pragma unroll
        for (int i = 0; i < 4; ++i) { const int e = tid + i * 512, s = e >> 5, cch = e & 31; *(LAS u32x4*)(Vn + s * HG_TS + cch * 16) = vch[i]; }
        __syncthreads();
        const int i16 = lane & 15, q4 = i16 >> 2, p4 = i16 & 3, blk = (lane >> 4) & 1;
        f32x16 o0 = zero16(), o1 = zero16();
        {
#pragma unroll
            for (int ks = 0; ks < 4; ++ks) {
                const bf16x8 bq = *(const LAS bf16x8*)(Qe + (32 * th + r) * HG_RS + (h * 64 + 16 * ks + 8 * hh) * 2);
#pragma unroll
                for (int vt = 0; vt < 2; ++vt) {
                    const f32x4 s0 = hs[vt][ks][0], s1 = hs[vt][ks][1];
                    u32x4 pa; pa[0] = pk2(s0[0], s0[1]); pa[1] = pk2(s0[2], s0[3]); pa[2] = pk2(s1[0], s1[1]); pa[3] = pk2(s1[2], s1[3]);
                    const bf16x8 af = __builtin_bit_cast(bf16x8, pa);
                    if (vt == 0) o0 = mfma32(af, bq, o0); else o1 = mfma32(af, bq, o1);
                }
            }
        }
#pragma unroll
        for (int st_ = 0; st_ < 2; ++st_) {
            if (st_ <= th) {
                f32x16 x = zero16();
#pragma unroll
                for (int ks = 0; ks < 4; ++ks) {
                    const bf16x8 ak = *(const LAS bf16x8*)(Km + (32 * st_ + r) * HG_RS + (h * 64 + 16 * ks + 8 * hh) * 2);
                    const bf16x8 bq = *(const LAS bf16x8*)(Qm + (32 * th + r) * HG_RS + (h * 64 + 16 * ks + 8 * hh) * 2);
                    x = mfma32(ak, bq, x);
                }
                if (st_ == th) {
#pragma unroll
                    for (int i = 0; i < 16; ++i) if (crow(i, hh) > r) x[i] = 0.f;
                }
#pragma unroll
                for (int s2 = 0; s2 < 2; ++s2) {
                    const bf16x8 pf = pack8(x, s2);
                    const int srow = 32 * st_ + 16 * s2 + 4 * hh + q4;
#pragma unroll
                    for (int vt = 0; vt < 2; ++vt) {
                        const LAS char* a = Vn + srow * HG_TS + (h * 64 + 32 * vt + 16 * blk) * 2 + 8 * p4;
                        const bf16x8 vf = cat4(ldtr(a), ldtr(a + 8 * HG_TS));
                        if (vt == 0) o0 = mfma32(vf, pf, o0); else o1 = mfma32(vf, pf, o1);
                    }
                }
            }
        }
        float ss = 0.f;
#pragma unroll
        for (int i = 0; i < 16; ++i) ss += o0[i] * o0[i] + o1[i] * o1[i];
        ss = xsum32(ss);
        const float rstd = __builtin_amdgcn_rsqf(ss * (1.f / 64.f) + EPS);
        bfu* yrow = YC + tok * 1024 + 768 + h * 64;
        const float* og = (const float*)(ws + WS_SP) + l * SP_STRIDE + SP_HGO + h * 64;
        f32x4 gnv[2][4];
#pragma unroll
        for (int vt = 0; vt < 2; ++vt)
#pragma unroll
            for (int g = 0; g < 4; ++g) gnv[vt][g] = *(const f32x4*)(og + 32 * vt + 8 * g + 4 * hh);
        u32x2 pk[2][4];
#pragma unroll
        for (int vt = 0; vt < 2; ++vt)
#pragma unroll
            for (int g = 0; g < 4; ++g) {
                const u32x2 raw = graw[vt][g];
                const f32x4 gn = gnv[vt][g];
                f32x4 gg; gg[0] = siluf(bflo(raw[0])); gg[1] = siluf(bfhi(raw[0])); gg[2] = siluf(bflo(raw[1])); gg[3] = siluf(bfhi(raw[1]));
                f32x4 ov;
#pragma unroll
                for (int i = 0; i < 4; ++i) ov[i] = (vt == 0 ? o0[4 * g + i] : o1[4 * g + i]) * rstd * gn[i] * gg[i];
                pk[vt][g] = pack4(ov);
            }
        store_row64_wide(yrow, pk, hh);
    }
}

DI void ins16(float (&a)[16], float v) {
#pragma unroll
    for (int j = 15; j >= 1; --j) a[j] = __builtin_amdgcn_fmed3f(a[j - 1], a[j], v);
    a[0] = __builtin_amdgcn_fmed3f(a[0], v, __builtin_inff());
}
DI float fmax_nc(float a, float b) { return __builtin_amdgcn_fmed3f(a, b, __builtin_inff()); }
DI float fmin_nc(float a, float b) { return __builtin_amdgcn_fmed3f(a, b, -__builtin_inff()); }
#define TK_CS(x, y) { const float hi_ = fmax_nc(x, y), lo_ = fmin_nc(x, y); x = hi_; y = lo_; }
DI void sort16_desc(float (&v)[16]) {
    TK_CS(v[0], v[1]) TK_CS(v[2], v[3]) TK_CS(v[0], v[2]) TK_CS(v[1], v[3]) TK_CS(v[1], v[2]) TK_CS(v[4], v[5]) TK_CS(v[6], v[7]) TK_CS(v[4], v[6]) TK_CS(v[5], v[7]) TK_CS(v[5], v[6]) TK_CS(v[0], v[4]) TK_CS(v[2], v[6]) TK_CS(v[2], v[4]) TK_CS(v[1], v[5]) TK_CS(v[3], v[7]) TK_CS(v[3], v[5]) TK_CS(v[1], v[2]) TK_CS(v[3], v[4]) TK_CS(v[5], v[6]) TK_CS(v[8], v[9]) TK_CS(v[10], v[11]) TK_CS(v[8], v[10]) TK_CS(v[9], v[11]) TK_CS(v[9], v[10]) TK_CS(v[12], v[13]) TK_CS(v[14], v[15]) TK_CS(v[12], v[14]) TK_CS(v[13], v[15]) TK_CS(v[13], v[14]) TK_CS(v[8], v[12]) TK_CS(v[10], v[14]) TK_CS(v[10], v[12]) TK_CS(v[9], v[13]) TK_CS(v[11], v[15]) TK_CS(v[11], v[13]) TK_CS(v[9], v[10]) TK_CS(v[11], v[12]) TK_CS(v[13], v[14]) TK_CS(v[0], v[8]) TK_CS(v[4], v[12]) TK_CS(v[4], v[8]) TK_CS(v[2], v[10]) TK_CS(v[6], v[14]) TK_CS(v[6], v[10]) TK_CS(v[2], v[4]) TK_CS(v[6], v[8]) TK_CS(v[10], v[12]) TK_CS(v[1], v[9]) TK_CS(v[5], v[13]) TK_CS(v[5], v[9]) TK_CS(v[3], v[11]) TK_CS(v[7], v[15]) TK_CS(v[7], v[11]) TK_CS(v[3], v[5]) TK_CS(v[7], v[9]) TK_CS(v[11], v[13]) TK_CS(v[1], v[2]) TK_CS(v[3], v[4]) TK_CS(v[5], v[6]) TK_CS(v[7], v[8]) TK_CS(v[9], v[10]) TK_CS(v[11], v[12]) TK_CS(v[13], v[14])
}
DI void merge16_desc(float (&a)[16], const float (&b)[16]) {
#pragma unroll
    for (int i = 0; i < 16; ++i) a[i] = fmax_nc(a[i], b[15 - i]);
#pragma unroll
    for (int d = 8; d >= 1; d >>= 1)
#pragma unroll
        for (int i = 0; i < 16; ++i) if ((i & d) == 0) TK_CS(a[i], a[i + d])
}
DI void peer_topk_phase(const Params& p, int l, LAS char* smem, int wv) {
    smem = opql(smem);
    unsigned char* ws = opq(p.ws);
    const bfu* PQ = (const bfu*)(ws + WS_PQ);
    const bfu* SK = (const bfu*)(ws + WS_W + (size_t)l * WL_SIZE + WL_SK);
    unsigned short* IDS = (unsigned short*)(ws + WS_IDS); float* GATE = (float*)(ws + WS_GATE);
    int uit = 0;
    for (int u = blockIdx.x; u < T / 32; u += gridDim.x, ++uit) {
        int tid = mk_tid(wv);
        const int w = tid >> 6, lane = tid & 63, r = lane & 31, hh = lane >> 5;
        const size_t tok = (size_t)u * 32 + r;
        float lst[2][16];
        bf16x8 qf[2][4];
#pragma unroll
        for (int pp = 0; pp < 2; ++pp)
#pragma unroll
            for (int ks = 0; ks < 4; ++ks) qf[pp][ks] = *(const bf16x8*)(PQ + tok * 1024 + w * 128 + pp * 64 + 16 * ks + 8 * hh);
        const GAS bfu* skb = (const GAS bfu*)SK + (size_t)(wv * 2) * 128 * 64;
        const unsigned sko = (unsigned)(r * 64 + 8 * hh);
        bf16x8 af[3][4];
#pragma unroll
        for (int ks = 0; ks < 4; ++ks) af[0][ks] = *(const GAS bf16x8*)(skb + 16 * ks + sko);
#pragma unroll
        for (int ks = 0; ks < 4; ++ks) af[1][ks] = *(const GAS bf16x8*)(skb + (32 * 64 + 16 * ks) + sko);
        float rstd_t;
        {
            LAS float* rsl = (LAS float*)(smem + 40960) + (uit & 1) * 32;
            const bfu* XB = (const bfu*)(ws + WS_XB); float* RSTF = (float*)(ws + WS_RSTF);
            u32x4 xa[4], xc[4];
#pragma unroll
            for (int i = 0; i < 4; ++i) { const bfu* xr_ = XB + ((size_t)u * 32 + 4 * w + i) * DM; xa[i] = *(const u32x4*)(xr_ + lane * 8); xc[i] = *(const u32x4*)(xr_ + 512 + lane * 8); }
#pragma unroll
            for (int i = 0; i < 4; ++i) {
                float ss = 0.f;
#pragma unroll
                for (int jj = 0; jj < 4; ++jj) { const unsigned wa = xa[i][jj], wc_ = xc[i][jj]; const float x0 = bflo(wa), x1 = bfhi(wa), y0 = bflo(wc_), y1 = bfhi(wc_); ss += x0 * x0 + x1 * x1 + y0 * y0 + y1 * y1; }
                ss = rdlane_f(dpp_sum63(ss), 63);
                if (lane == 0) { const float rv = __builtin_amdgcn_rsqf(ss * (1.f / DM) + EPS); rsl[4 * w + i] = rv; RSTF[(size_t)u * 32 + 4 * w + i] = rv; }
            }
            __syncthreads();
            rstd_t = rsl[r];
        }
        float a[16];
#pragma unroll
        for (int st = 0; st < 8; ++st) {
            const int pp = st >> 2, kt = st & 3;
            f32x16 acc = zero16();
#pragma unroll
            for (int ks = 0; ks < 4; ++ks) acc = mfma32(af[st % 3][ks], qf[pp][ks], acc);
            if (st < 6) {
                const int np = (st + 2) >> 2, nk = (st + 2) & 3;
#pragma unroll
                for (int ks = 0; ks < 4; ++ks) af[(st + 2) % 3][ks] = *(const GAS bf16x8*)(skb + (np * 128 * 64 + nk * 32 * 64 + 16 * ks) + sko);
            }
            float tv[16];
#pragma unroll
            for (int i = 0; i < 16; ++i) {
                const unsigned key = 32 * kt + (i & 3) + 8 * (i >> 2) + 4 * hh;
                tv[i] = __uint_as_float((__float_as_uint(acc[i]) & 0xffffff80u) | key);
            }
            sort16_desc(tv);
            if (kt == 0) {
#pragma unroll
                for (int j = 0; j < 16; ++j) a[j] = tv[j];
            } else merge16_desc(a, tv);
            if (kt == 3) {
                float ob[16];
#pragma unroll
                for (int j = 0; j < 16; ++j) ob[j] = swap32(a[j]);
                merge16_desc(a, ob);
#pragma unroll
                for (int j = 0; j < 16; ++j) lst[pp][j] = a[j];
            }
        }
        const bool up = hh != 0;
        float A[16], B[16];
#pragma unroll
        for (int k = 0; k < 16; ++k) { A[k] = up ? lst[1][k] : lst[0][k]; B[k] = up ? lst[0][k] : lst[1][k]; }
        float c[16];
#pragma unroll
        for (int j = 0; j < 16; ++j) { const float lo_ = A[0] + B[j], hi_ = j < 15 ? A[0] + B[j + 1] : -3.0e38f; c[j] = up ? hi_ : lo_; }
#pragma unroll
        for (int i = 1; i < 4; ++i)
#pragma unroll
            for (int j = i; j < 16; ++j) if ((i + 1) * (j + 1) <= 16) { float v = A[i] + B[j]; if (i == j) v = up ? -3.0e38f : v; ins16(c, v); }
        {
            float ob[16];
#pragma unroll
            for (int j = 0; j < 16; ++j) ob[j] = swap32(c[j]);
            merge16_desc(c, ob);
        }
        const float thr = c[15], mx = c[0];
        float den = 0.f;
#pragma unroll
        for (int j = 0; j < 16; ++j) den += __expf((c[j] - mx) * rstd_t);
        const float rden = __builtin_amdgcn_rcpf(den);
        {
            unsigned KA[16], KB[16];
#pragma unroll
            for (int k = 0; k < 16; ++k) { KA[k] = (__float_as_uint(A[k]) & 127u) << (up ? 0 : 7); KB[k] = (__float_as_uint(B[k]) & 127u) << (up ? 7 : 0); }
            LAS unsigned* row = (LAS unsigned*)smem + (w * 32 + r) * 35;
#pragma unroll
            for (int k = 0; k < 16; ++k) { row[k] = 0u; row[17 + k] = 0xff7fffffu; }
            int cur = up ? 15 : 0; const int dir = up ? -1 : 1;
#pragma unroll
            for (int i = 0; i < 4; ++i)
#pragma unroll
                for (int j = i; j < 16; ++j) if ((i + 1) * (j + 1) <= 16) {
                    const float sv = A[i] + B[j];
                    bool pass = sv >= thr && (unsigned)cur < 16u;
                    if (i == j) pass = pass && !up;
                    const int slot = pass ? cur : 16;
                    row[slot] = KA[i] + KB[j];
                    row[17 + slot] = __float_as_uint(sv);
                    cur += pass ? dir : 0;
                }
            unsigned idv[8]; float gv8[8];
#pragma unroll
            for (int k = 0; k < 8; ++k) { idv[k] = row[8 * hh + k]; gv8[k] = __expf((__uint_as_float(row[17 + 8 * hh + k]) - mx) * rstd_t) * rden; }
            u32x4 iw; f32x4 g0, g1;
#pragma unroll
            for (int k = 0; k < 4; ++k) { iw[k] = idv[2 * k] | (idv[2 * k + 1] << 16); g0[k] = gv8[k]; g1[k] = gv8[4 + k]; }
            *(u32x4*)(IDS + tok * 128 + w * 16 + 8 * hh) = iw;
            float* gp = GATE + tok * 128 + w * 16 + 8 * hh;
            *(f32x4*)gp = g0; *(f32x4*)(gp + 4) = g1;
        }
    }
}

#ifndef PGQT
#define PGQT 512
#endif
constexpr int PGQ_TILE = PGQT, PGQ_ITEMS = T / PGQ_TILE;
constexpr int LDS_PGQ = 160 * 1024 - 64;
DI f32x2 fp8lo(unsigned w) { return __builtin_amdgcn_cvt_pk_f32_fp8(w, false); }
DI f32x2 fp8hi(unsigned w) { return __builtin_amdgcn_cvt_pk_f32_fp8(w, true); }
typedef _Float16 h2_t __attribute__((ext_vector_type(2)));
constexpr float PGV_CSCALE = 1024.f;
DI unsigned* pgq_counter(unsigned char* ws, int l, int ph, int slice) { return (unsigned*)(ws + WS_CTL + 16384) + ((l * 4 + ph) * 8 + slice) * 64; }
DI bool pgq_pop(unsigned char* ws, int l, int ph, int home, int& kdone, LAS int* bc, int tid, int& slice, int& tile) {
    __syncthreads();
    if (tid == 0) {
        int k = kdone, s = -1, ti = 0;
        while (k < 8) {
            s = (home + k) & 7;
            ti = (int)__hip_atomic_fetch_add(pgq_counter(ws, l, ph, s), 1u, __ATOMIC_RELAXED, __HIP_MEMORY_SCOPE_AGENT);
            if (ti < PGQ_ITEMS) break;
            ++k;
        }
        bc[0] = k < 8 ? s : -1; bc[1] = ti; bc[2] = k;
    }
    __syncthreads();
    slice = __builtin_amdgcn_readfirstlane(bc[0]); tile = __builtin_amdgcn_readfirstlane(bc[1]); kdone = __builtin_amdgcn_readfirstlane(bc[2]);
    return slice >= 0;
}
template <int CTRL> DI float dpp_perm(float v) { return __builtin_bit_cast(float, __builtin_amdgcn_update_dpp(0, __builtin_bit_cast(int, v), CTRL, 0xf, 0xf, false)); }
DI float sum8(float v) { v += dpp_perm<0xB1>(v); v += dpp_perm<0x4E>(v); v += dpp_perm<0x141>(v); return v; }

#ifndef PGVR
#define PGVR 16
#endif
constexpr int PGV_STRIDE = 129;
DI void peer_u_phase(const Params& p, int l, LAS char* smem, int wv, int qid = 0) {
    int tid = mk_tid(wv); smem = opql(smem);
    const int w = tid >> 6, lane = tid & 63, g = lane >> 3, j = lane & 7;
    unsigned char* ws = opq(p.ws);
    const bfu* XB = (const bfu*)(ws + WS_XB);
    const unsigned short* IDS = (const unsigned short*)(ws + WS_IDS);
    const GAS unsigned char* TU = (const GAS unsigned char*)(ws + WS_TABU + (size_t)l * NEXP * DM);
    const float* RSTF = (const float*)(ws + WS_RSTF);
    unsigned* PART = (unsigned*)(ws + WS_PROJ);
    const float* gn = (const float*)(ws + WS_SP) + l * SP_STRIDE + SP_NFF;
    LAS int* bc = (LAS int*)(smem + LDS_PGQ);
    LAS int* idl = (LAS int*)smem + w * (2 * 8 * PGV_STRIDE) + g * PGV_STRIDE;
    const int home = (int)xb_xcc_id() & 7;
    int kdone = 0, x, tile;
    while (pgq_pop(ws, l, qid, home, kdone, bc, tid, x, tile)) {
      u32x4 nids[2]; u32x2 nx[4]; float nrstd; f32x4 gv[4];
#define PGU_FETCH(tt) { _Pragma("unroll") for (int k = 0; k < 2; ++k) nids[k] = *(const u32x4*)(IDS + (size_t)(tt) * 128 + 16 * j + 8 * k); nrstd = RSTF[tt]; \
        _Pragma("unroll") for (int i = 0; i < 4; ++i) nx[i] = *(const u32x2*)(XB + (size_t)(tt) * DM + 32 * x + 4 * j + 256 * i); }
      PGU_FETCH(tile * PGQ_TILE + w * 8 + g)
#pragma unroll
      for (int i = 0; i < 4; ++i) gv[i] = *(const f32x4*)(gn + 256 * i + 32 * x + 4 * j);
      for (int sub = 0; sub < PGQ_TILE / 64; ++sub) {
        const int t = tile * PGQ_TILE + sub * 64 + w * 8 + g;
#pragma unroll
        for (int k = 0; k < 2; ++k)
#pragma unroll
            for (int c = 0; c < 4; ++c) { idl[16 * j + 8 * k + 2 * c] = (int)((nids[k][c] & 0xffffu) << 7); idl[16 * j + 8 * k + 2 * c + 1] = (int)((nids[k][c] >> 16) << 7); }
        const float rstd = nrstd;
        u32x2 xr[4];
#pragma unroll
        for (int i = 0; i < 4; ++i) xr[i] = nx[i];
        f32x4 xf[4]; float am = 0.f;
#pragma unroll
        for (int i = 0; i < 4; ++i) { const u32x2 raw = xr[i];
            xf[i][0] = bflo(raw[0]) * rstd * gv[i][0]; xf[i][1] = bfhi(raw[0]) * rstd * gv[i][1]; xf[i][2] = bflo(raw[1]) * rstd * gv[i][2]; xf[i][3] = bfhi(raw[1]) * rstd * gv[i][3];
            am = fmaxf(am, fmaxf(fmaxf(fabsf(xf[i][0]), fabsf(xf[i][1])), fmaxf(fabsf(xf[i][2]), fabsf(xf[i][3])))); }
        am = fmaxf(am, dpp_perm<0xB1>(am)); am = fmaxf(am, dpp_perm<0x4E>(am)); am = fmaxf(am, dpp_perm<0x141>(am));
        const float qs = am > 0.f ? 127.f * __builtin_amdgcn_rcpf(am) : 0.f, sx = am * (1.f / 127.f);
        unsigned xq[4];
#pragma unroll
        for (int i = 0; i < 4; ++i) xq[i] = pack_i8x4(xf[i][0] * qs, xf[i][1] * qs, xf[i][2] * qs, xf[i][3] * qs);
        const GAS unsigned char* tux = TU + (size_t)x * NEXP * 128;
        unsigned* prow = PART + ((size_t)x * T + t) * 64 + j;
        {
            u32x4 r[16];
#define PGU_ISSUE(k, e) { const unsigned off_ = (unsigned)idl[e] | j16; r[k] = *(const GAS u32x4*)(tux + off_); }
#define PGU_DOT(k) { int di_ = 0; _Pragma("unroll") for (int i = 0; i < 4; ++i) di_ = __builtin_amdgcn_sdot4((int)r[k][i], (int)xq[i], di_, false); dk[(k) & 7] = di_; }
#define PGU_REDUCE(OUT) { int a_[4], b_[2]; \
                _Pragma("unroll") for (int m = 0; m < 4; ++m) { const int snd = lo4 ? dk[4 + m] : dk[m], kp = lo4 ? dk[m] : dk[4 + m]; a_[m] = kp + __builtin_amdgcn_update_dpp(0, snd, 0x141, 0xf, 0xf, false); } \
                _Pragma("unroll") for (int n = 0; n < 2; ++n) { const int snd = b2 ? a_[n] : a_[2 + n], kp = b2 ? a_[2 + n] : a_[n]; b_[n] = kp + __builtin_amdgcn_update_dpp(0, snd, 0x4E, 0xf, 0xf, false); } \
                { const int snd = b1 ? b_[0] : b_[1], kp = b1 ? b_[1] : b_[0]; OUT = (float)(kp + __builtin_amdgcn_update_dpp(0, snd, 0xB1, 0xf, 0xf, false)) * sx; } }
            const bool lo4 = j < 4, b2 = (j & 2) != 0, b1 = (j & 1) != 0;
            const unsigned j16 = 16u * (unsigned)j;
            int dk[8];
#pragma unroll
            for (int k = 0; k < 16; ++k) PGU_ISSUE(k, k)
            if (sub + 1 < PGQ_TILE / 64) PGU_FETCH(t + 64)
#pragma unroll 1
            for (int e0 = 0; e0 < 112; e0 += 16) {
                float p0, p1;
#pragma unroll
                for (int k = 0; k < 8; ++k) { PGU_DOT(k) PGU_ISSUE(k, e0 + 16 + k) }
                PGU_REDUCE(p0)
#pragma unroll
                for (int k = 8; k < 16; ++k) { PGU_DOT(k) PGU_ISSUE(k, e0 + 16 + k) }
                PGU_REDUCE(p1)
                { const h2_t hp = {(_Float16)p0, (_Float16)p1}; prow[e0 >> 1] = __builtin_bit_cast(unsigned, hp); }
            }
            {
                float p0, p1;
#pragma unroll
                for (int k = 0; k < 8; ++k) { PGU_DOT(k) }
                PGU_REDUCE(p0)
#pragma unroll
                for (int k = 8; k < 16; ++k) { PGU_DOT(k) }
                PGU_REDUCE(p1)
                { const h2_t hp = {(_Float16)p0, (_Float16)p1}; prow[56] = __builtin_bit_cast(unsigned, hp); }
            }
#undef PGU_DOT
#undef PGU_REDUCE
#undef PGU_ISSUE
        }
      }
    }
}
DI void peer_c_phase(const Params& p, int l, int wv) {
    int tid = mk_tid(wv);
    const int w = tid >> 6, lane = tid & 63;
    unsigned char* ws = opq(p.ws);
    const unsigned short* IDS = (const unsigned short*)(ws + WS_IDS); const float* GATE = (const float*)(ws + WS_GATE);
    const float* SCU = (const float*)(ws + WS_SCU) + l * NEXP; const float* SCV = (const float*)(ws + WS_SCV) + l * NEXP;
    const unsigned* PART = (const unsigned*)(ws + WS_PROJ); _Float16* COEF = (_Float16*)(ws + WS_COEF);
    for (int t0 = (blockIdx.x * 8 + w) * 8; t0 < T; t0 += gridDim.x * 8 * 8) {
        const int e0 = 16 * (lane >> 3) + (lane & 7);
        unsigned pr[8][8]; int id0[8], id1[8]; float g0[8], g1[8];
#pragma unroll
        for (int q = 0; q < 8; ++q) { const int t = t0 + q;
#pragma unroll
            for (int x = 0; x < 8; ++x) pr[q][x] = PART[((size_t)x * T + t) * 64 + lane];
            id0[q] = IDS[(size_t)t * 128 + e0]; id1[q] = IDS[(size_t)t * 128 + e0 + 8]; g0[q] = GATE[(size_t)t * 128 + e0]; g1[q] = GATE[(size_t)t * 128 + e0 + 8]; }
        float su0[8], su1[8], sv0[8], sv1[8];
#pragma unroll
        for (int q = 0; q < 8; ++q) { su0[q] = SCU[id0[q]]; su1[q] = SCU[id1[q]]; sv0[q] = SCV[id0[q]]; sv1[q] = SCV[id1[q]]; }
#pragma unroll
        for (int q = 0; q < 8; ++q) { const int t = t0 + q;
            f32x2 s = {0.f, 0.f};
#pragma unroll
            for (int x = 0; x < 8; ++x) { const h2_t hp = __builtin_bit_cast(h2_t, pr[q][x]); s.x += (float)hp.x; s.y += (float)hp.y; }
            COEF[(size_t)t * 128 + e0] = (_Float16)(geluf(s.x * su0[q]) * g0[q] * sv0[q] * PGV_CSCALE);
            COEF[(size_t)t * 128 + e0 + 8] = (_Float16)(geluf(s.y * su1[q]) * g1[q] * sv1[q] * PGV_CSCALE);
        }
    }
}

DI void peer_v_phase(const Params& p, int l, LAS char* smem, int wv, int qid = 1, bool dummy = false) {
    int tid = mk_tid(wv); smem = opql(smem);
    const int w = tid >> 6, lane = tid & 63, g = lane >> 3, j = lane & 7;
    unsigned char* ws = opq(p.ws);
    bfu* XB = (bfu*)(ws + WS_XB);
    bfu* XO = dummy ? (bfu*)(ws + WS_PQ) : XB;
    const unsigned short* IDS = (const unsigned short*)(ws + WS_IDS); const unsigned short* COEF = (const unsigned short*)(ws + WS_COEF);
    const GAS unsigned char* TV = (const GAS unsigned char*)(ws + WS_TABV + (size_t)l * NEXP * DM);
    float* SSP = dummy ? (float*)(ws + WS_GATE) : (float*)(ws + WS_SSP);
    LAS int* bc = (LAS int*)(smem + LDS_PGQ);
    LAS int* idl = (LAS int*)smem + w * (2 * 8 * PGV_STRIDE) + g * PGV_STRIDE;
    LAS float* cfl = (LAS float*)idl + 8 * PGV_STRIDE;
    const int home = (int)xb_xcc_id() & 7;
    int kdone = 0, x, tile;
    while (pgq_pop(ws, l, qid, home, kdone, bc, tid, x, tile)) {
      u32x4 nids[2], ncf[2]; u32x2 nx[4];
#define PGV_FETCH(tt) { _Pragma("unroll") for (int k = 0; k < 2; ++k) { nids[k] = *(const u32x4*)(IDS + (size_t)(tt) * 128 + 16 * j + 8 * k); ncf[k] = *(const u32x4*)(COEF + (size_t)(tt) * 128 + 16 * j + 8 * k); } \
        _Pragma("unroll") for (int i = 0; i < 4; ++i) nx[i] = *(const u32x2*)(XB + (size_t)(tt) * DM + 32 * x + 4 * j + 256 * i); }
      PGV_FETCH(tile * PGQ_TILE + w * 8 + g)
      for (int sub = 0; sub < PGQ_TILE / 64; ++sub) {
        const int t = tile * PGQ_TILE + sub * 64 + w * 8 + g;
#pragma unroll
        for (int k = 0; k < 2; ++k)
#pragma unroll
            for (int c = 0; c < 4; ++c) { const unsigned iw = nids[k][c], cw = ncf[k][c];
                idl[16 * j + 8 * k + 2 * c] = (int)(iw & 0xffffu); idl[16 * j + 8 * k + 2 * c + 1] = (int)(iw >> 16);
                cfl[16 * j + 8 * k + 2 * c] = __uint_as_float((cw & 0xffffu) | (cw << 16)); cfl[16 * j + 8 * k + 2 * c + 1] = __uint_as_float((cw >> 16) | (cw & 0xffff0000u)); }
        u32x2 xold[4];
#pragma unroll
        for (int i = 0; i < 4; ++i) xold[i] = nx[i];
        h2_t acc[8];
#pragma unroll
        for (int c = 0; c < 8; ++c) acc[c] = (h2_t){(_Float16)0.f, (_Float16)0.f};
        const GAS unsigned char* tvx = TV + (size_t)x * NEXP * 128;
        {
            u32x4 r[PGVR]; float cf[PGVR];
#define PGV_ISSUE(k, e) { const unsigned off_ = (unsigned)idl[e] * 128u + 16u * (unsigned)j; cf[k] = cfl[e]; r[k] = *(const GAS u32x4*)(tvx + off_); }
#define PGV_USE(k) { const h2_t c2 = __builtin_bit_cast(h2_t, cf[k]); _Pragma("unroll") for (int i = 0; i < 4; ++i) { const unsigned wd = r[k][i]; \
                acc[2 * i] = __builtin_elementwise_fma(c2, __builtin_bit_cast(h2_t, __builtin_amdgcn_cvt_scalef32_pk_f16_fp8(wd, 1.0f, false)), acc[2 * i]); \
                acc[2 * i + 1] = __builtin_elementwise_fma(c2, __builtin_bit_cast(h2_t, __builtin_amdgcn_cvt_scalef32_pk_f16_fp8(wd, 1.0f, true)), acc[2 * i + 1]); } }
#pragma unroll
            for (int k = 0; k < PGVR; ++k) PGV_ISSUE(k, k)
            if (sub + 1 < PGQ_TILE / 64) PGV_FETCH(t + 64)
            for (int e0 = PGVR; e0 < 128; e0 += PGVR) {
#pragma unroll
                for (int k = 0; k < PGVR; ++k) { PGV_USE(k) PGV_ISSUE(k, e0 + k) }
            }
#pragma unroll
            for (int k = 0; k < PGVR; ++k) PGV_USE(k)
#undef PGV_ISSUE
#undef PGV_USE
#undef PGV_FETCH
        }
        bfu* xrow = XO + (size_t)t * DM + 32 * x + 4 * j;
        float s2 = 0.f;
#pragma unroll
        for (int i = 0; i < 4; ++i) {
            u32x2* px = (u32x2*)(xrow + 256 * i); const u32x2 old = xold[i];
            const float us = 1.f / PGV_CSCALE;
            const float y0 = bflo(old[0]) + (float)acc[2 * i].x * us, y1 = bfhi(old[0]) + (float)acc[2 * i].y * us, y2 = bflo(old[1]) + (float)acc[2 * i + 1].x * us, y3 = bfhi(old[1]) + (float)acc[2 * i + 1].y * us;
            u32x2 o; o[0] = pk2(y0, y1); o[1] = pk2(y2, y3); *px = o;
            const float z0 = bflo(o[0]), z1 = bfhi(o[0]), z2 = bflo(o[1]), z3 = bfhi(o[1]);
            s2 += z0 * z0 + z1 * z1 + z2 * z2 + z3 * z3;
        }
        s2 = sum8(s2);
        if (j == 0) SSP[(size_t)t * 8 + x] = s2;
      }
    }
}

DI void final_norm_phase(const Params& p, int wv) {
    int tid = mk_tid(wv);
    const int w = tid >> 6, lane = tid & 63;
    unsigned char* ws = opq(p.ws);
    const bfu* XB = (const bfu*)(ws + WS_XB); const float* SSP = (const float*)(ws + WS_SSP);
    const float* gfin = (const float*)(ws + WS_SP) + SP_FIN;
    f32x4 g[4];
#pragma unroll
    for (int i = 0; i < 4; ++i) g[i] = *(const f32x4*)(gfin + 256 * i + 4 * lane);
    for (int t0 = (blockIdx.x * 8 + w) * 8; t0 < T; t0 += gridDim.x * 8 * 8) {
        f32x4 q0[8], q1[8]; u32x2 raw[8][4];
#pragma unroll
        for (int q = 0; q < 8; ++q) { const int t = t0 + q; q0[q] = *(const f32x4*)(SSP + (size_t)t * 8); q1[q] = *(const f32x4*)(SSP + (size_t)t * 8 + 4);
#pragma unroll
            for (int i = 0; i < 4; ++i) raw[q][i] = *(const u32x2*)(XB + (size_t)t * DM + 256 * i + 4 * lane); }
#pragma unroll
        for (int q = 0; q < 8; ++q) { const int t = t0 + q;
            const float r2 = __builtin_amdgcn_rsqf((((q0[q][0] + q0[q][1]) + (q0[q][2] + q0[q][3])) + ((q1[q][0] + q1[q][1]) + (q1[q][2] + q1[q][3]))) * (1.f / DM) + EPS);
            float* orow = p.out + (size_t)t * DM;
#pragma unroll
            for (int i = 0; i < 4; ++i) {
                f32x4 o; o[0] = bflo(raw[q][i][0]) * r2 * g[i][0]; o[1] = bfhi(raw[q][i][0]) * r2 * g[i][1]; o[2] = bflo(raw[q][i][1]) * r2 * g[i][2]; o[3] = bfhi(raw[q][i][1]) * r2 * g[i][3];
                *(f32x4*)(orow + 256 * i + 4 * lane) = o; }
        }
    }
}

constexpr int PPL = 10, NPH = 2 + PPL * NL;
__global__ void __launch_bounds__(512, 2) hymba_fwd(Params p) {
    extern __shared__ __attribute__((aligned(16))) char smem_raw[];
    LAS char* smem0 = (LAS char*)smem_raw;
    const int wv = __builtin_amdgcn_readfirstlane((int)(threadIdx.x >> 6));
    if (mk_tid(wv) < 4) ((LAS unsigned*)(smem0 + LDS_BAR))[mk_tid(wv)] = 0u;
    __syncthreads();
    XcdBarrier bar = xcd_barrier_post((unsigned*)(p.ws + WS_CTL), (volatile LAS unsigned*)(smem0 + LDS_BAR), wv);
#define IN(k) true
#define SEAM(k) xcd_barrier(bar)
#define PHASE_HDR const int G = opqi((int)gridDim.x), bid = opqi((int)blockIdx.x); LAS char* smem = opql(smem0); LAS unsigned char* smemu = (LAS unsigned char*)smem; unsigned char* ws = opq(p.ws); \
        const unsigned char* wl = ws + WS_W + (size_t)l * WL_SIZE; const float* ct = (const float*)(ws + WS_COS); const float* st = (const float*)(ws + WS_SIN); (void)wl; (void)ct; (void)st; (void)G; (void)bid; (void)smemu;
    if (IN(0)) { phase_prologue(p, smem0, wv);
    }
    SEAM(0);
#pragma unroll 1
    for (int l_ = 0; l_ < NL; ++l_) {
        const int l = opqi(l_);
        const int pb = 1 + PPL * l; (void)pb;
        if (IN(pb + 0)) {
            PHASE_HDR
            XSched s{8, 128 * 8, G, bid, wv};
            { Unit u; __syncthreads();
              for (int i = 0; s.next(i, u); ++i) proj_rstd_lds((const float*)(ws + WS_SSP), u.pm * 256, (LAS float*)(smem + LDS_RS) + i * 256, wv);
              __syncthreads(); }
            EpiProj e{(const LAS float*)(smem + LDS_RS), (bfu*)(ws + WS_PROJ), ct, st};
            gemm_phase(smemu, Gemm{(const bfu*)(ws + WS_XB), (const bfu*)(wl + WL_IN), 1024, 1024, 1024}, s, e);
        }
        SEAM(pb + 0);
        if (IN(pb + 1)) {
            PHASE_HDR
            {
            {
                XSched s{3, 128 * 3, G, bid, wv};
                Unit u; __syncthreads();
                for (int i = 0; s.next(i, u); ++i) rows_rstd_lds<256>((const bfu*)(ws + WS_PROJ) + PC_CQ, PW, u.pm * 256, (LAS float*)(smem + LDS_RS) + i * 256, wv);
                __syncthreads();
                EpiScaled<true> e{(const LAS float*)(smem + LDS_RS), (bfu*)(ws + WS_Q), 768, ct, st, 0.10206207261596577f * 1.4426950408889634f};
                gemm_phase(smemu, Gemm{(const bfu*)(ws + WS_PROJ) + PC_CQ, (const bfu*)(wl + WL_UQ), PW, 256, 256}, s, e);
            }
            {
                XSched s{4, 128 * 4, G, (bid + 128) % G, wv};
                Unit u; __syncthreads();
                for (int i = 0; s.next(i, u); ++i) rows_rstd_lds<128>((const bfu*)(ws + WS_PROJ) + PC_CKV, PW, u.pm * 256, (LAS float*)(smem + LDS_RS) + i * 256, wv);
                __syncthreads();
                EpiScaled<false> e{(const LAS float*)(smem + LDS_RS), (bfu*)(ws + WS_KV), 1024, ct, st, 1.f};
                gemm_phase(smemu, Gemm{(const bfu*)(ws + WS_PROJ) + PC_CKV, (const bfu*)(wl + WL_UKV), PW, 256, 128}, s, e);
            }
            }
            gmlp_phase(p, l, smem0, wv);

            hg_local_phase(p, l, smem0, wv);

        }
        SEAM(pb + 1);
        if (IN(pb + 2)) { attn_phase(p, l, smem0, wv);

            hg_prefix_phase(p, wv); }
        SEAM(pb + 2);
        if (IN(pb + 3)) { hg_out_phase(p, l, smem0, wv);

        }
        SEAM(pb + 3);
        if (IN(pb + 4)) {
            PHASE_HDR
            EpiResid e{(bfu*)(ws + WS_XB)};
            XSched s{4, 128 * 4, G, bid, wv};
            __syncthreads();
            gemm_phase(smemu, Gemm{(const bfu*)(ws + WS_YCAT), (const bfu*)(wl + WL_OUT), 1024, 1024, 1024}, s, e);
        }
        SEAM(pb + 4);
        if (IN(pb + 5)) {
            PHASE_HDR
            XSched s{4, 128 * 4, G, bid, wv};
            __syncthreads();
            EpiPlain e{(bfu*)(ws + WS_PQ), 1024};
            gemm_phase(smemu, Gemm{(const bfu*)(ws + WS_XB), (const bfu*)(wl + WL_Q), 1024, 1024, 1024}, s, e);
        }
        SEAM(pb + 5);
        if (IN(pb + 6)) { peer_topk_phase(p, l, smem0, wv);

        }
        SEAM(pb + 6);
        if (IN(pb + 7)) { peer_u_phase(p, l, smem0, wv);

        }
        SEAM(pb + 7);
        if (IN(pb + 8)) { peer_c_phase(p, l, wv);

        }
        SEAM(pb + 8);
        if (IN(pb + 9)) {

            peer_v_phase(p, l, smem0, wv); }
        SEAM(pb + 9);
    }
    if (IN(NPH - 1)) { final_norm_phase(p, wv);
    }
#undef PHASE_HDR
#undef IN
#undef SEAM
}

extern "C" void kernel_launch(void* const* d_in, const int* in_sizes, int n_in, void* d_out, int out_size, void* d_ws, size_t ws_size, hipStream_t stream) {
    static int grid = 0;
    if (grid == 0) {
        if (n_in != 22 || in_sizes[0] != T * DM || out_size != T * DM || ws_size < WS_END) {
            fprintf(stderr, "kernel_launch: unexpected shapes (n_in %d, in0 %d, out %d, ws %zu, need %zu)\n", n_in, n_in > 0 ? in_sizes[0] : -1, out_size, ws_size, (size_t)WS_END); grid = -1; return; }
        int dev = 0, cus = 0, per_cu = 0;
        if (hipGetDevice(&dev) != hipSuccess || hipDeviceGetAttribute(&cus, hipDeviceAttributeMultiprocessorCount, dev) != hipSuccess) { grid = -1; return; }
        if (hipFuncSetAttribute((const void*)hymba_fwd, hipFuncAttributeMaxDynamicSharedMemorySize, LDS_TOTAL) != hipSuccess) { fprintf(stderr, "kernel_launch: hipFuncSetAttribute failed\n"); grid = -1; return; }
        if (hipOccupancyMaxActiveBlocksPerMultiprocessor(&per_cu, (const void*)hymba_fwd, 512, LDS_TOTAL) != hipSuccess || per_cu < 1) fprintf(stderr, "kernel_launch: occupancy query says %d\n", per_cu);
        (void)hipGetLastError();
        grid = cus;
    }
    if (grid < 0) return;
    (void)hipMemsetAsync((char*)d_ws + WS_CTL, 0, 65536, stream);
    Params p{};
    p.x = (const float*)d_in[0]; p.pos = (const int*)d_in[1]; p.norm_mix = (const float*)d_in[2]; p.w_in = (const float*)d_in[3]; p.gm_v_norm = (const float*)d_in[4];
    p.gm_ws = (const float*)d_in[5]; p.gm_b = (const float*)d_in[6]; p.gm_out_norm = (const float*)d_in[7]; p.mla_q_norm = (const float*)d_in[8]; p.mla_w_uq = (const float*)d_in[9];
    p.mla_kv_norm = (const float*)d_in[10]; p.mla_w_ukv = (const float*)d_in[11]; p.mla_out_norm = (const float*)d_in[12]; p.hg_lb_logits = (const float*)d_in[13];
    p.hg_out_norm = (const float*)d_in[14]; p.w_out = (const float*)d_in[15]; p.norm_ffn = (const float*)d_in[16]; p.peer_w_q = (const float*)d_in[17];
    p.peer_sub_keys = (const float*)d_in[18]; p.peer_u = (const float*)d_in[19]; p.peer_v = (const float*)d_in[20]; p.norm_final = (const float*)d_in[21];
    p.out = (float*)d_out; p.ws = (unsigned char*)d_ws;
    hipLaunchKernelGGL(hymba_fwd, dim3(grid), dim3(512), LDS_TOTAL, stream, p);
}
```
